# Optimizing an MI355X kernel written in HIP

```python
import math
import jax, jax.numpy as jnp
from jax import lax
import numpy as np

D_MODEL = 2048
BATCH = 2
SEQ = 8192
DEPTH = 1

CTX_LEN = 256
GRID_W = 64
EPS = 1e-6

MLA_HEADS = 8
MLA_Q_RANK = 512
MLA_KV_RANK = 256
MLA_NOPE = 128
MLA_ROPE = 64
MLA_V = 128
MLA_SCALE = (MLA_NOPE + MLA_ROPE) ** -0.5
ROPE_BASE = 10000.0
Q_BLOCK = 128

DN_HEADS = 8
DN_DK = 128
DN_DV = 128
DN_QKV = DN_HEADS * (2 * DN_DK + DN_DV)
CONV_W = 5
CHUNK = 64

PEER_HEADS = 8
PEER_KEYS = 128
PEER_EXPERTS = PEER_KEYS * PEER_KEYS
PEER_QDIM = 256
PEER_TOPK = 16
PEER_BLOCK = 64

IN_SIZES = (MLA_Q_RANK, MLA_KV_RANK, MLA_ROPE, DN_QKV, DN_HEADS * DN_DV,
            DN_HEADS, DN_HEADS, DN_HEADS, DN_HEADS, D_MODEL, D_MODEL)
D_IN = sum(IN_SIZES)
IN_POINTS = tuple(int(p) for p in np.cumsum(IN_SIZES)[:-1])

kernel_name = 'hybrid_mla_gdn_peer_block'


def rmsnorm(x, w):
    xf = x.astype(jnp.float32)
    y = xf * lax.rsqrt(jnp.mean(xf * xf, axis=-1, keepdims=True) + EPS)
    return (y * w.astype(jnp.float32)).astype(x.dtype)


def modulate(x, w, shift, scale):
    return rmsnorm(x, w) * (1 + scale) + shift


def l2norm(x):
    xf = x.astype(jnp.float32)
    return xf * lax.rsqrt(jnp.sum(xf * xf, axis=-1, keepdims=True) + EPS)


def grid_angles(n):
    n_rows = n // GRID_W
    rows = jnp.repeat(jnp.arange(n_rows, dtype=jnp.float32), GRID_W)
    cols = jnp.tile(jnp.arange(GRID_W, dtype=jnp.float32), n_rows)
    axis_dim = MLA_ROPE // 2
    inv_freq = ROPE_BASE ** (-jnp.arange(0, axis_dim, 2, dtype=jnp.float32) / axis_dim)
    return rows[:, None] * inv_freq, cols[:, None] * inv_freq


def rotate(x, ang):
    x1, x2 = jnp.split(x.astype(jnp.float32), 2, axis=-1)
    cos, sin = jnp.cos(ang), jnp.sin(ang)
    return jnp.concatenate([x1 * cos - x2 * sin, x1 * sin + x2 * cos], axis=-1).astype(x.dtype)


def axial_rope(x, ang_r, ang_c):
    xr, xc = jnp.split(x, 2, axis=-1)
    return jnp.concatenate([rotate(xr, ang_r), rotate(xc, ang_c)], axis=-1)


def mla_heads(c_q, c_kv, q_norm_w, kv_norm_w, w_uq, w_ukv):
    b, n = c_q.shape[:2]
    q = (rmsnorm(c_q, q_norm_w) @ w_uq).reshape(b, n, MLA_HEADS, MLA_NOPE + MLA_ROPE)
    kv = (rmsnorm(c_kv, kv_norm_w) @ w_ukv).reshape(b, n, MLA_HEADS, MLA_NOPE + MLA_V)
    return q[..., :MLA_NOPE], q[..., MLA_NOPE:], kv[..., :MLA_NOPE], kv[..., MLA_NOPE:]


def mla_attend(q_nope, q_rope, k_nope, k_rope, v):
    s = (jnp.einsum('bthd,blhd->bhtl', q_nope, k_nope)
         + jnp.einsum('bthr,blr->bhtl', q_rope, k_rope))
    p = jax.nn.softmax(s.astype(jnp.float32) * MLA_SCALE, axis=-1).astype(v.dtype)
    o = jnp.einsum('bhtl,blhd->bthd', p, v)
    return o.reshape(o.shape[0], o.shape[1], MLA_HEADS * MLA_V)


def short_conv(x, w):
    c = x.shape[-1]
    return lax.conv_general_dilated(
        x, w[:, None, :].astype(x.dtype), window_strides=(1,),
        padding=[(CONV_W // 2, CONV_W // 2)],
        dimension_numbers=('NWC', 'WIO', 'NWC'), feature_group_count=c)


def dn_qkv(qkv, conv_w):
    b, n = qkv.shape[:2]
    y = jax.nn.silu(short_conv(qkv, conv_w))
    q, k, v = jnp.split(y, [DN_HEADS * DN_DK, 2 * DN_HEADS * DN_DK], axis=-1)
    q = l2norm(q.reshape(b, n, DN_HEADS, DN_DK)) * DN_DK ** -0.5
    k = l2norm(k.reshape(b, n, DN_HEADS, DN_DK))
    v = v.reshape(b, n, DN_HEADS, DN_DV).astype(jnp.float32)
    return q, k, v


def dn_decay(a, beta_logit, a_log, dt_bias):
    g = -jnp.exp(a_log.astype(jnp.float32)) * jax.nn.softplus(a.astype(jnp.float32) + dt_bias.astype(jnp.float32))
    return g, jax.nn.sigmoid(beta_logit.astype(jnp.float32))


def gated_delta_chunked(q, k, v, g, beta, s0):
    b, n, h, _ = q.shape
    dv = v.shape[-1]
    nc = n // CHUNK

    def chunks(t):
        return t.reshape(b, nc, CHUNK, h, -1).transpose(0, 3, 1, 2, 4)

    q, k, v = chunks(q), chunks(k), chunks(v)
    g = g.reshape(b, nc, CHUNK, h).transpose(0, 3, 1, 2)
    beta = beta.reshape(b, nc, CHUNK, h).transpose(0, 3, 1, 2)
    gc = jnp.cumsum(g, axis=-1)
    incl = jnp.tril(jnp.ones((CHUNK, CHUNK), dtype=bool))
    strict = jnp.tril(jnp.ones((CHUNK, CHUNK), dtype=bool), -1)
    decay = jnp.exp(jnp.where(incl, gc[..., :, None] - gc[..., None, :], -jnp.inf))
    kb = k * beta[..., None]
    m = jnp.where(strict, jnp.einsum('bhnid,bhnjd->bhnij', kb, k) * decay, 0.0)
    rhs = jnp.concatenate([v * beta[..., None], kb * jnp.exp(gc)[..., None]], axis=-1)
    sol = lax.linalg.triangular_solve(m + jnp.eye(CHUNK, dtype=m.dtype), rhs,
                                      left_side=True, lower=True, unit_diagonal=True)
    u, w = sol[..., :dv], sol[..., dv:]
    attn = jnp.where(incl, jnp.einsum('bhnid,bhnjd->bhnij', q, k) * decay, 0.0)
    g_last = gc[..., -1]

    def step(state, xs):
        q_i, k_i, u_i, w_i, a_i, gc_i, gl_i = xs
        v_new = u_i - jnp.einsum('bhck,bhkv->bhcv', w_i, state)
        o_i = (jnp.einsum('bhck,bhkv->bhcv', q_i * jnp.exp(gc_i)[..., None], state)
               + jnp.einsum('bhij,bhjv->bhiv', a_i, v_new))
        k_dec = k_i * jnp.exp(gl_i[..., None] - gc_i)[..., None]
        state = state * jnp.exp(gl_i)[..., None, None] + jnp.einsum('bhck,bhcv->bhkv', k_dec, v_new)
        return state, o_i

    xs = tuple(jnp.moveaxis(t, 2, 0) for t in (q, k, u, w, attn, gc, g_last))
    state, o = lax.scan(step, s0, xs)
    o = o.transpose(1, 0, 3, 2, 4).reshape(b, n, h, dv)
    return o, state


def flip(t):
    return t[:, ::-1]


def dn_gated_out(o, z, norm_w):
    b, n = z.shape[:2]
    o = rmsnorm(o, norm_w) * jax.nn.silu(z.reshape(b, n, DN_HEADS, DN_DV).astype(jnp.float32))
    return o.reshape(b, n, DN_HEADS * DN_DV).astype(z.dtype)


def token_mixer(h, hc, w_in, q_norm_w, kv_norm_w, w_uq, w_ukv, conv_w, a_log, dt_bias,
                dn_norm_w, w_branch_a, w_branch_b, w_out, with_ctx_out):
    b, n, _ = h.shape
    (cq, ckv, kr, qkv, z, a_f, a_b, b_f, b_b, gate_a, gate_b) = jnp.split(h @ w_in, IN_POINTS, axis=-1)
    (cq_c, ckv_c, kr_c, qkv_c, z_c, a_f_c, a_b_c, b_f_c, b_b_c,
     gate_a_c, gate_b_c) = jnp.split(hc @ w_in, IN_POINTS, axis=-1)

    ang_r, ang_c = grid_angles(n)
    qn, qr, kn, v = mla_heads(cq, ckv, q_norm_w, kv_norm_w, w_uq, w_ukv)
    qr = axial_rope(qr, ang_r[:, None, :], ang_c[:, None, :])
    kr = axial_rope(kr, ang_r, ang_c)
    qn_c, qr_c, kn_c, v_c = mla_heads(cq_c, ckv_c, q_norm_w, kv_norm_w, w_uq, w_ukv)
    kn_all = jnp.concatenate([kn_c, kn], axis=1)
    kr_all = jnp.concatenate([kr_c, kr], axis=1)
    v_all = jnp.concatenate([v_c, v], axis=1)
    nb = n // Q_BLOCK

    def to_blocks(t):
        return jnp.swapaxes(t.reshape(b, nb, Q_BLOCK, *t.shape[2:]), 0, 1)

    y_a = lax.map(lambda qs: mla_attend(qs[0], qs[1], kn_all, kr_all, v_all), (to_blocks(qn), to_blocks(qr)))
    y_a = jnp.swapaxes(y_a, 0, 1).reshape(b, n, MLA_HEADS * MLA_V)

    ql, kl, vl = dn_qkv(qkv, conv_w)
    qc, kc, vc = dn_qkv(qkv_c, conv_w)
    g_lf, be_lf = dn_decay(a_f, b_f, a_log[0], dt_bias[0])
    g_lb, be_lb = dn_decay(a_b, b_b, a_log[1], dt_bias[1])
    g_cf, be_cf = dn_decay(a_f_c, b_f_c, a_log[0], dt_bias[0])
    g_cb, be_cb = dn_decay(a_b_c, b_b_c, a_log[1], dt_bias[1])
    s0 = jnp.zeros((b, DN_HEADS, DN_DK, DN_DV), jnp.float32)
    o_cf, s_cf = gated_delta_chunked(qc, kc, vc, g_cf, be_cf, s0)
    o_lf, _ = gated_delta_chunked(ql, kl, vl, g_lf, be_lf, s_cf)
    o_cb, s_cb = gated_delta_chunked(flip(qc), flip(kc), flip(vc), flip(g_cb), flip(be_cb), s0)
    o_lb, _ = gated_delta_chunked(flip(ql), flip(kl), flip(vl), flip(g_lb), flip(be_lb), s_cb)
    y_b = dn_gated_out(o_lf + flip(o_lb), z, dn_norm_w)

    def merge(ya, yb, ga, gb):
        return (jax.nn.sigmoid(ga) * (ya @ w_branch_a) + jax.nn.sigmoid(gb) * (yb @ w_branch_b)) @ w_out

    y = merge(y_a, y_b, gate_a, gate_b)
    if not with_ctx_out:
        return y, None
    y_a_c = mla_attend(qn_c, qr_c, kn_c, kr_c, v_c)
    y_b_c = dn_gated_out(o_cf + flip(o_cb), z_c, dn_norm_w)
    return y, merge(y_a_c, y_b_c, gate_a_c, gate_b_c)


def peer_ffn(h, w_q, sub_keys, u, v):
    b, n, d = h.shape
    nb = (b * n) // PEER_BLOCK
    hb = h.reshape(nb, PEER_BLOCK, d)

    def block(hx):
        t = hx.shape[0]
        q = (hx @ w_q).reshape(t, PEER_HEADS, 2, PEER_QDIM // 2).astype(jnp.float32)
        s = jnp.einsum('thpd,pkd->thpk', q, sub_keys.astype(jnp.float32))
        top_s, top_i = lax.top_k(s, PEER_TOPK)
        cand = top_s[:, :, 0, :, None] + top_s[:, :, 1, None, :]
        cand_idx = top_i[:, :, 0, :, None] * PEER_KEYS + top_i[:, :, 1, None, :]
        best_s, best_pos = lax.top_k(cand.reshape(t, PEER_HEADS, -1), PEER_TOPK)
        idx = jnp.take_along_axis(cand_idx.reshape(t, PEER_HEADS, -1), best_pos, axis=-1)
        wts = jax.nn.softmax(best_s, axis=-1).astype(hx.dtype)
        act = jax.nn.gelu(jnp.einsum('td,thkd->thk', hx, u[idx]), approximate=False)
        return jnp.einsum('thk,thkd->td', wts * act, v[idx])

    return lax.map(block, hb).reshape(b, n, d)


def setup_inputs(seed: int = 0) -> dict:
    key = jax.random.key(seed)
    ks = jax.random.split(key, 26)
    f32 = jnp.float32
    L, D = DEPTH, D_MODEL

    def nrm(k, shape, scale=1.0):
        return jax.random.normal(k, shape, f32) * scale

    dt = jnp.exp(jax.random.uniform(ks[14], (L, 2, DN_HEADS), f32, math.log(1e-3), math.log(1e-1)))
    return {
        'x': nrm(ks[0], (BATCH, SEQ, D)),
        'c': nrm(ks[1], (BATCH, D)),
        'ctx': nrm(ks[2], (BATCH, CTX_LEN, D)),
        'c_ctx': nrm(ks[3], (D,)),
        'w_mod': nrm(ks[4], (L, D, 6 * D), 0.5 * D ** -0.5),
        'b_mod': nrm(ks[5], (L, 6 * D), 0.02),
        'norm1_w': 1.0 + nrm(ks[6], (L, D), 0.1),
        'w_in': nrm(ks[7], (L, D, D_IN), D ** -0.5),
        'mla_q_norm_w': 1.0 + nrm(ks[8], (L, MLA_Q_RANK), 0.1),
        'mla_kv_norm_w': 1.0 + nrm(ks[9], (L, MLA_KV_RANK), 0.1),
        'w_uq': nrm(ks[10], (L, MLA_Q_RANK, MLA_HEADS * (MLA_NOPE + MLA_ROPE)), MLA_Q_RANK ** -0.5),
        'w_ukv': nrm(ks[11], (L, MLA_KV_RANK, MLA_HEADS * (MLA_NOPE + MLA_V)), MLA_KV_RANK ** -0.5),
        'dn_conv_w': nrm(ks[12], (L, CONV_W, DN_QKV), CONV_W ** -0.5),
        'dn_a_log': jnp.log(jax.random.uniform(ks[13], (L, 2, DN_HEADS), f32, 1.0, 16.0)),
        'dn_dt_bias': dt + jnp.log(-jnp.expm1(-dt)),
        'dn_norm_w': 1.0 + nrm(ks[15], (L, DN_DV), 0.1),
        'w_branch_a': nrm(ks[16], (L, MLA_HEADS * MLA_V, D), (MLA_HEADS * MLA_V) ** -0.5),
        'w_branch_b': nrm(ks[17], (L, DN_HEADS * DN_DV, D), (DN_HEADS * DN_DV) ** -0.5),
        'w_out': nrm(ks[18], (L, D, D), D ** -0.5),
        'norm2_w': 1.0 + nrm(ks[19], (L, D), 0.1),
        'peer_w_q': nrm(ks[20], (L, D, PEER_HEADS * PEER_QDIM), D ** -0.5),
        'peer_sub_keys': nrm(ks[21], (L, 2, PEER_KEYS, PEER_QDIM // 2), (PEER_QDIM // 2) ** -0.5),
        'peer_u': nrm(ks[22], (L, PEER_EXPERTS, D), D ** -0.5),
        'peer_v': nrm(ks[23], (L, PEER_EXPERTS, D), PEER_HEADS ** -0.5),
        'final_norm_w': 1.0 + nrm(ks[24], (D,), 0.1),
    }


def reference(x, c, ctx, c_ctx, w_mod, b_mod, norm1_w, w_in, mla_q_norm_w, mla_kv_norm_w,
              w_uq, w_ukv, dn_conv_w, dn_a_log, dn_dt_bias, dn_norm_w, w_branch_a, w_branch_b,
              w_out, norm2_w, peer_w_q, peer_sub_keys, peer_u, peer_v, final_norm_w):
    silu_c = jax.nn.silu(c)
    silu_cc = jax.nn.silu(c_ctx)
    for i in range(DEPTH):
        last = i == DEPTH - 1
        mod = (silu_c @ w_mod[i] + b_mod[i])[:, None, :]
        sh1, sc1, g1, sh2, sc2, g2 = jnp.split(mod, 6, axis=-1)
        mod_c = silu_cc @ w_mod[i] + b_mod[i]
        shc1, scc1, gc1, shc2, scc2, gc2 = jnp.split(mod_c, 6, axis=-1)
        h = modulate(x, norm1_w[i], sh1, sc1)
        hc = modulate(ctx, norm1_w[i], shc1, scc1)
        y, yc = token_mixer(h, hc, w_in[i], mla_q_norm_w[i], mla_kv_norm_w[i], w_uq[i], w_ukv[i],
                            dn_conv_w[i], dn_a_log[i], dn_dt_bias[i], dn_norm_w[i],
                            w_branch_a[i], w_branch_b[i], w_out[i], not last)
        x = x + g1 * y
        x = x + g2 * peer_ffn(modulate(x, norm2_w[i], sh2, sc2), peer_w_q[i], peer_sub_keys[i], peer_u[i], peer_v[i])
        if not last:
            ctx = ctx + gc1 * yc
            ctx = ctx + gc2 * peer_ffn(modulate(ctx, norm2_w[i], shc2, scc2), peer_w_q[i], peer_sub_keys[i], peer_u[i], peer_v[i])
    return rmsnorm(x, final_norm_w)
```

```cpp
#include <hip/hip_runtime.h>
#include <hip/hip_bf16.h>
#include <cstdio>
#include <cstdint>
#include <cmath>
namespace pg8 {
#define PG8_LAS __attribute__((address_space(3)))
typedef unsigned short bf16_t;
typedef short bf16x8 __attribute__((ext_vector_type(8)));
typedef float f32x4 __attribute__((ext_vector_type(4)));
typedef unsigned u32x4 __attribute__((ext_vector_type(4)));
constexpr int BM = 256, BK = 64, HALF = 128, HTB = HALF * BK * 2  , STAGE_BYTES = 8 * HTB, NXCD = 8, WGM = 8;

__host__ __device__ __forceinline__ int lds_byte(int r, int c) { const int st = (r >> 4) * 2 + (c >> 5), rr = r & 15, cc = c & 31, ob = rr * 64 + cc * 2; return st * 1024 + (ob ^ (((ob >> 9) & 1) << 5)); }
__host__ __device__ __forceinline__ void stage_rc(int b, int& R, int& C) { const int st = b / 1024, sb = b % 1024, swz = sb ^ (((sb >> 9) & 1) << 5); R = (st >> 1) * 16 + swz / 64; C = (st & 1) * 32 + (swz % 64) / 2; }
__host__ __device__ __forceinline__ int perm32(int rho) { const int n = rho >> 4, i = rho & 15; return 8 * (i >> 2) + 4 * n + (i & 3); }

struct Unit { int pm, pn; };
struct Gemm { const bf16_t* A; const bf16_t* Bt; int M, N, K; };

struct StaticOrder {
    int nM, nN, nwg, G, c;
    __host__ __device__ void init(int M, int N, int G_, int c_) { nM = M / BM; nN = N / BM; nwg = nM * nN; G = G_; c = c_; }
    __host__ __device__ bool next(int i, Unit& u) const {
        const long L = (long)i * G + c; if (L >= nwg) return false;
        int wgid = (int)L; { const int q = nwg / NXCD, r = nwg % NXCD, xcd = wgid % NXCD, off = wgid / NXCD; wgid = (xcd < r ? xcd * (q + 1) : r * (q + 1) + (xcd - r) * q) + off; }
        const int nig = WGM * nN, gid = wgid / nig, fm = gid * WGM, gsz = (nM - fm) < WGM ? (nM - fm) : WGM;
        u.pm = fm + ((wgid % nig) % gsz); u.pn = (wgid % nig) / gsz; return true;
    }
    __device__ __forceinline__ void a_ready(const Unit&) const {}
    __device__ __forceinline__ void done(const Unit&) const {}
};
typedef float f32x2 __attribute__((ext_vector_type(2)));
__device__ __forceinline__ unsigned cvt_pk_bf16(float lo, float hi) { unsigned r; asm volatile("v_cvt_pk_bf16_f32 %0, %1, %2" : "=v"(r) : "v"(lo), "v"(hi)); return r; }
template <class Epi, class Sched, bool ALIGN_EPI = false, bool SP2 = false>
__device__ __forceinline__ void gemm_phase(PG8_LAS unsigned char* lds, const Gemm g, const Sched& S, const Epi& E, const int tid) {
    const int wid = __builtin_amdgcn_readfirstlane(tid >> 6), lane = tid & 63, wr = wid >> 2, wc = wid & 3, fr = lane & 15, fq = lane >> 4;
    const int K = g.K, nt = K / BK;
    unsigned voffA[2], voffB[2];
#pragma unroll
    for (int i = 0; i < 2; ++i) { int R, C; stage_rc(tid * 16 + i * 8192, R, C); const int Rb = Epi::PERM ? ((R & ~31) + perm32(R & 31)) : R;
        voffA[i] = (unsigned)(R * K + C) * 2u; voffB[i] = (unsigned)(Rb * K + C) * 2u; }
    const size_t kstep = (size_t)(BK * 2);
    const size_t hstep = (size_t)HALF * K * 2;
    const size_t tstep = 2 * hstep;
    const unsigned ldsw = (unsigned)wid * 1024u;
    const int aoff = lds_byte(wr * 64 + fr, fq * 8), boff = lds_byte(wc * 32 + fr, fq * 8);
#define PG8_SA(b, h) (((b) * 2 + (h)) * HTB)
#define PG8_SB(b, h) ((4 + (b) * 2 + (h)) * HTB)
#define PG8_STAGE(bufoff, gbase, voff) do { _Pragma("unroll") for (int _i = 0; _i < 2; ++_i) \
        __builtin_amdgcn_global_load_lds((const unsigned*)((const char*)(gbase) + (voff)[_i]), (PG8_LAS unsigned*)(lds + (bufoff) + ldsw + _i * 8192), 16, 0, 0); } while (0)
#define PG8_LDA(dst, b, h) do { _Pragma("unroll") for (int m = 0; m < 4; ++m) _Pragma("unroll") for (int k = 0; k < 2; ++k) dst[m][k] = *(const PG8_LAS bf16x8*)(lds + PG8_SA(b, h) + aoff + m * 2048 + k * 1024); } while (0)
#define PG8_LDB(dst, b, h) do { _Pragma("unroll") for (int n = 0; n < 2; ++n) _Pragma("unroll") for (int k = 0; k < 2; ++k) dst[n][k] = *(const PG8_LAS bf16x8*)(lds + PG8_SB(b, h) + boff + n * 2048 + k * 1024); } while (0)
#define PG8_MMA(ai, bj, At, Bt) do { __builtin_amdgcn_s_setprio(1); _Pragma("unroll") for (int m = 0; m < 4; ++m) _Pragma("unroll") for (int n = 0; n < 2; ++n) _Pragma("unroll") for (int k = 0; k < 2; ++k) \
        acc[ai][bj][m][n] = __builtin_amdgcn_mfma_f32_16x16x32_bf16(Bt[n][k], At[m][k], acc[ai][bj][m][n], 0, 0, 0); __builtin_amdgcn_s_setprio(0); } while (0)
#define PG8_WAIT_V(n) asm volatile("s_waitcnt vmcnt(" #n ")" ::: "memory")
#define PG8_WAIT_L(n) asm volatile("s_waitcnt lgkmcnt(" #n ")" ::: "memory")
#define PG8_BAR __builtin_amdgcn_s_barrier()
#define PG8_SCHED __builtin_amdgcn_sched_barrier(0)
    Unit cur, nxt; int ui = 0;
    if (!S.next(0, cur)) return;
    f32x4 acc[2][2][4][2];
#pragma unroll
    for (int a = 0; a < 2; ++a)
#pragma unroll
        for (int b = 0; b < 2; ++b)
#pragma unroll
            for (int m = 0; m < 4; ++m)
#pragma unroll
                for (int n = 0; n < 2; ++n) acc[a][b][m][n] = (f32x4){0.f, 0.f, 0.f, 0.f};
    bf16x8 At[4][2], B0[2][2], B1[2][2];
    const char* cA = (const char*)g.A + (size_t)cur.pm * tstep; const char* cB = (const char*)g.Bt + (size_t)cur.pn * tstep;
    S.a_ready(cur);
    if constexpr (SP2) {
        PG8_STAGE(PG8_SB(0, 0), cB, voffB); PG8_STAGE(PG8_SB(0, 1), cB + hstep, voffB); PG8_STAGE(PG8_SA(0, 0), cA, voffA); PG8_STAGE(PG8_SA(0, 1), cA + hstep, voffA);
        if (wr == 1) PG8_BAR;
        PG8_WAIT_V(2); PG8_BAR;
        PG8_STAGE(PG8_SB(1, 0), cB + kstep, voffB); PG8_STAGE(PG8_SA(1, 0), cA + kstep, voffA); PG8_STAGE(PG8_SB(1, 1), cB + hstep + kstep, voffB);
        PG8_WAIT_V(6); PG8_BAR;
    } else {
        PG8_STAGE(PG8_SB(0, 0), cB, voffB); PG8_STAGE(PG8_SA(0, 0), cA, voffA); PG8_STAGE(PG8_SB(0, 1), cB + hstep, voffB); PG8_STAGE(PG8_SA(0, 1), cA + hstep, voffA);
        if (wr == 1) PG8_BAR;
        PG8_WAIT_V(4); PG8_BAR;
        PG8_STAGE(PG8_SB(1, 0), cB + kstep, voffB); PG8_STAGE(PG8_SA(1, 0), cA + kstep, voffA); PG8_STAGE(PG8_SB(1, 1), cB + hstep + kstep, voffB);
        PG8_WAIT_V(6); PG8_BAR;
    }
    for (;;) {
        const bool has_next = S.next(ui + 1, nxt);
        const char* nA = has_next ? (const char*)g.A + (size_t)nxt.pm * tstep : cA; const char* nB = has_next ? (const char*)g.Bt + (size_t)nxt.pn * tstep : cB;
        for (int t = 0; t < nt; t += 2) {
            const bool last = (t == nt - 2);
            const char* a1 = cA + (size_t)(t + 1) * kstep;
            const char* a2 = last ? nA : cA + (size_t)(t + 2) * kstep; const char* b2 = last ? nB : cB + (size_t)(t + 2) * kstep;
            const char* a3 = a2 + kstep; const char* b3 = b2 + kstep;
            if (last && has_next) S.a_ready(nxt);
            if constexpr (SP2) {
            PG8_LDB(B0, 0, 0); PG8_LDB(B1, 0, 1); PG8_SCHED; PG8_LDA(At, 0, 0); PG8_STAGE(PG8_SA(1, 1), a1 + hstep, voffA);
            PG8_WAIT_V(8); PG8_WAIT_L(0); PG8_BAR; PG8_MMA(0, 0, At, B0); PG8_MMA(0, 1, At, B1); PG8_BAR; PG8_SCHED;
            PG8_LDA(At, 0, 1); PG8_STAGE(PG8_SB(0, 0), b2, voffB); PG8_STAGE(PG8_SB(0, 1), b2 + hstep, voffB); PG8_STAGE(PG8_SA(0, 0), a2, voffA);
            PG8_WAIT_V(8); PG8_WAIT_L(0); PG8_BAR; PG8_MMA(1, 0, At, B0); PG8_MMA(1, 1, At, B1); PG8_BAR; PG8_SCHED;
            PG8_LDB(B0, 1, 0); PG8_LDB(B1, 1, 1); PG8_SCHED; PG8_LDA(At, 1, 0); PG8_STAGE(PG8_SA(0, 1), a2 + hstep, voffA);
            PG8_WAIT_V(8); PG8_WAIT_L(0); PG8_BAR; PG8_MMA(0, 0, At, B0); PG8_MMA(0, 1, At, B1); PG8_BAR; PG8_SCHED;
            PG8_LDA(At, 1, 1); PG8_STAGE(PG8_SB(1, 0), b3, voffB); PG8_STAGE(PG8_SB(1, 1), b3 + hstep, voffB); PG8_STAGE(PG8_SA(1, 0), a3, voffA);
            PG8_WAIT_V(8); PG8_WAIT_L(0); PG8_BAR; PG8_MMA(1, 0, At, B0); PG8_MMA(1, 1, At, B1); PG8_BAR; PG8_SCHED;
            } else {
            PG8_LDB(B0, 0, 0); PG8_SCHED; PG8_LDA(At, 0, 0); PG8_STAGE(PG8_SA(1, 1), a1 + hstep, voffA);
            PG8_WAIT_L(8); PG8_BAR; PG8_WAIT_L(0); PG8_MMA(0, 0, At, B0); PG8_BAR; PG8_SCHED;
            PG8_LDB(B1, 0, 1); PG8_STAGE(PG8_SB(0, 0), b2, voffB);
            PG8_BAR; PG8_WAIT_L(0); PG8_MMA(0, 1, At, B1); PG8_BAR;
            PG8_LDA(At, 0, 1); PG8_STAGE(PG8_SA(0, 0), a2, voffA);
            PG8_BAR; PG8_WAIT_L(0); PG8_MMA(1, 0, At, B0); PG8_BAR; PG8_SCHED;
            PG8_STAGE(PG8_SB(0, 1), b2 + hstep, voffB);
            PG8_WAIT_V(6); PG8_BAR; PG8_MMA(1, 1, At, B1); PG8_BAR;
            PG8_LDB(B0, 1, 0); PG8_SCHED; PG8_LDA(At, 1, 0); PG8_STAGE(PG8_SA(0, 1), a2 + hstep, voffA);
            PG8_WAIT_L(8); PG8_BAR; PG8_WAIT_L(0); PG8_MMA(0, 0, At, B0); PG8_BAR; PG8_SCHED;
            PG8_LDB(B1, 1, 1); PG8_STAGE(PG8_SB(1, 0), b3, voffB);
            PG8_BAR; PG8_WAIT_L(0); PG8_MMA(0, 1, At, B1); PG8_BAR;
            PG8_LDA(At, 1, 1); PG8_STAGE(PG8_SA(1, 0), a3, voffA);
            PG8_BAR; PG8_WAIT_L(0); PG8_MMA(1, 0, At, B0); PG8_BAR; PG8_SCHED;
            PG8_STAGE(PG8_SB(1, 1), b3 + hstep, voffB);
            PG8_WAIT_V(6); PG8_BAR; PG8_MMA(1, 1, At, B1); PG8_BAR;
            }
        }
        if constexpr (ALIGN_EPI) { if (wr == 0) PG8_BAR; }
        if constexpr (!Epi::AFTER_DRAIN) { E(acc, cur, wr, wc, fr, fq); S.done(cur); }
        if (!has_next) break;
#pragma unroll
        for (int a = 0; a < 2; ++a)
#pragma unroll
            for (int b = 0; b < 2; ++b)
#pragma unroll
                for (int m = 0; m < 4; ++m)
#pragma unroll
                    for (int n = 0; n < 2; ++n) acc[a][b][m][n] = (f32x4){0.f, 0.f, 0.f, 0.f};
        cur = nxt; cA = nA; cB = nB; ++ui;
        if constexpr (ALIGN_EPI) { if (wr == 1) PG8_BAR; }
    }
    PG8_WAIT_V(0);
    if constexpr (!ALIGN_EPI) { if (wr == 0) PG8_BAR; }
    PG8_BAR;
    if constexpr (Epi::AFTER_DRAIN) { E.fused(acc, cur, wr, wc, fr, fq, lds, wid, lane); S.done(cur); }
#undef PG8_SA
#undef PG8_SB
#undef PG8_STAGE
#undef PG8_LDA
#undef PG8_LDB
#undef PG8_MMA
#undef PG8_WAIT_V
#undef PG8_WAIT_L
#undef PG8_BAR
#undef PG8_SCHED
}
__device__ __forceinline__ float bfu(unsigned short v) { return __uint_as_float(((unsigned)v) << 16); }
__device__ __forceinline__ void fast_sincos(float x, float& sn, float& cs) {
    float rev = x * 0.15915494309189535f; rev -= rintf(rev); sn = __builtin_amdgcn_sinf(rev); cs = __builtin_amdgcn_cosf(rev); }
__device__ __forceinline__ float sigm(float v) { return 1.0f / (1.0f + __expf(-v)); }
__device__ __forceinline__ void store_tile_bf16(const f32x4 (&acc)[2][2][4][2], bf16_t* tile  , int ld, int wr, int wc, int fr, int fq) {
#pragma unroll
    for (int ai = 0; ai < 2; ++ai)
#pragma unroll
        for (int m = 0; m < 4; ++m) { bf16_t* rowp = tile + (size_t)(ai * HALF + wr * 64 + m * 16 + fr) * ld + wc * 32 + 8 * fq;
#pragma unroll
            for (int bj = 0; bj < 2; ++bj) { const f32x4 v0 = acc[ai][bj][m][0], v1 = acc[ai][bj][m][1];
                u32x4 w; w.x = cvt_pk_bf16(v0[0], v0[1]); w.y = cvt_pk_bf16(v0[2], v0[3]); w.z = cvt_pk_bf16(v1[0], v1[1]); w.w = cvt_pk_bf16(v1[2], v1[3]);
                *(u32x4*)(rowp + bj * HALF) = w; } }
}
__device__ __forceinline__ void tile_ssq(const f32x4 (&acc)[2][2][4][2], float* ssq  , int nslot, int slot, int wr, int fr, int fq) {
#pragma unroll
    for (int ai = 0; ai < 2; ++ai)
#pragma unroll
        for (int m = 0; m < 4; ++m) { float s = 0.f;
#pragma unroll
            for (int bj = 0; bj < 2; ++bj)
#pragma unroll
                for (int n = 0; n < 2; ++n) { const f32x4 x = acc[ai][bj][m][n]; s += (x[0] * x[0] + x[1] * x[1]) + (x[2] * x[2] + x[3] * x[3]); }
            s += __shfl_xor(s, 16); s += __shfl_xor(s, 32);
            if (fq == 0) ssq[(size_t)(ai * HALF + wr * 64 + m * 16 + fr) * nslot + slot] = s; }
}
struct EpiIn {
    static constexpr bool PERM = true, AFTER_DRAIN = false;
    bf16_t *CQ, *CKV, *QKV, *Z, *GA, *GB; float *KR, *AB, *ssq_q, *ssq_kv;
    __device__ __forceinline__ void operator()(const f32x4 (&acc)[2][2][4][2], const Unit& u, int wr, int wc, int fr, int fq) const {
        const int pn = u.pn, pm = u.pm; const size_t r0 = (size_t)pm * BM;
        const bool lat = pm < 64;
        if (pn == 35) {
            const int cl = wc * 32 + 8 * fq;
            if (cl < 96) {
#pragma unroll
                for (int ai = 0; ai < 2; ++ai)
#pragma unroll
                    for (int m = 0; m < 4; ++m) { const size_t r = r0 + ai * HALF + wr * 64 + m * 16 + fr;
                        float* dst = (cl < 64) ? (KR + r * 64 + cl) : (AB + r * 32 + (cl - 64));
                        *(f32x4*)dst = acc[ai][0][m][0]; *(f32x4*)(dst + 4) = acc[ai][0][m][1]; }
            }
            return;
        }
        bf16_t* base; int ld; bool latonly = true; float* ssq = nullptr; int nslot = 4, slot = wc;
        if (pn < 2) { base = CQ + pn * 256; ld = 512; ssq = ssq_q; nslot = 8; slot = pn * 4 + wc; }
        else if (pn == 2) { base = CKV; ld = 256; ssq = ssq_kv; latonly = false; }
        else if (pn < 15) { base = QKV + (pn - 3) * 256; ld = 3072; latonly = false; }
        else if (pn < 19) { base = Z + (pn - 15) * 256; ld = 1024; }
        else if (pn < 27) { base = GA + (pn - 19) * 256; ld = 2048; }
        else { base = GB + (pn - 27) * 256; ld = 2048; }
        if (latonly && !lat) return;
        store_tile_bf16(acc, base + r0 * ld, ld, wr, wc, fr, fq);
        if (ssq) tile_ssq(acc, ssq + r0 * nslot, nslot, slot, wr, fr, fq);
    }
};
struct EpiQ {
    static constexpr bool PERM = true, AFTER_DRAIN = false;
    bf16_t* Q; const float* ssq_q; float qscale;
    __device__ __forceinline__ void operator()(const f32x4 (&acc)[2][2][4][2], const Unit& u, int wr, int wc, int fr, int fq) const {
        const int pn = u.pn;
#pragma unroll
        for (int ai = 0; ai < 2; ++ai)
#pragma unroll
            for (int m = 0; m < 4; ++m) {
                const int r = u.pm * BM + ai * HALF + wr * 64 + m * 16 + fr; const int b = r >> 13, t = r & 8191;
                const f32x4 sa = *(const f32x4*)(ssq_q + (size_t)r * 8), sb = *(const f32x4*)(ssq_q + (size_t)r * 8 + 4);
                const float rs = rsqrtf((((sa[0] + sa[1]) + (sa[2] + sa[3])) + ((sb[0] + sb[1]) + (sb[2] + sb[3]))) * (1.0f / 512.0f) + 1e-6f) * qscale;
#pragma unroll
                for (int bj = 0; bj < 2; ++bj) {
                    f32x4 v0 = acc[ai][bj][m][0] * rs, v1 = acc[ai][bj][m][1] * rs;
                    bf16_t* dst;
                    if (pn < 4) { const int head = pn * 2 + bj; dst = Q + ((size_t)(b * 8 + head) * 8192 + t) * 192 + wc * 32 + 8 * fq; }
                    else {
                        const int head = (pn - 4) * 4 + bj * 2 + (wc >> 1), half = wc & 1;
                        const float pos = (float)(half == 0 ? (t >> 6) : (t & 63));
                        const int i0 = (8 * fq) & 15;
                        float xs[8] = {v0[0], v0[1], v0[2], v0[3], v1[0], v1[1], v1[2], v1[3]};
#pragma unroll
                        for (int e = 0; e < 8; ++e) {
                            const float other = __shfl_xor(xs[e], 32);
                            const float invf = exp2f(-(float)(i0 + e) * (13.287712379549449f / 16.0f));
                            float sn, cs; fast_sincos(pos * invf, sn, cs);
                            xs[e] = (fq < 2) ? (xs[e] * cs - other * sn) : (other * sn + xs[e] * cs);
                        }
                        v0 = (f32x4){xs[0], xs[1], xs[2], xs[3]}; v1 = (f32x4){xs[4], xs[5], xs[6], xs[7]};
                        dst = Q + ((size_t)(b * 8 + head) * 8192 + t) * 192 + 128 + half * 32 + 8 * fq;
                    }
                    u32x4 w; w.x = cvt_pk_bf16(v0[0], v0[1]); w.y = cvt_pk_bf16(v0[2], v0[3]); w.z = cvt_pk_bf16(v1[0], v1[1]); w.w = cvt_pk_bf16(v1[2], v1[3]);
                    *(u32x4*)dst = w;
                }
            }
    }
};
struct EpiKV {
    static constexpr bool PERM = true, AFTER_DRAIN = false;
    bf16_t *K, *V; const float* ssq_kv;
    __device__ __forceinline__ void operator()(const f32x4 (&acc)[2][2][4][2], const Unit& u, int wr, int wc, int fr, int fq) const {
        const int head = u.pn;
#pragma unroll
        for (int ai = 0; ai < 2; ++ai)
#pragma unroll
            for (int m = 0; m < 4; ++m) {
                const int r = u.pm * BM + ai * HALF + wr * 64 + m * 16 + fr;
                int b, l; if (r < 16384) { b = r >> 13; l = 256 + (r & 8191); } else { b = (r - 16384) >> 8; l = (r - 16384) & 255; }
                const f32x4 sa = *(const f32x4*)(ssq_kv + (size_t)r * 4);
                const float rs = rsqrtf(((sa[0] + sa[1]) + (sa[2] + sa[3])) * (1.0f / 256.0f) + 1e-6f);
                const size_t rowi = (size_t)(b * 8 + head) * 8448 + l;
#pragma unroll
                for (int bj = 0; bj < 2; ++bj) {
                    const f32x4 v0 = acc[ai][bj][m][0] * rs, v1 = acc[ai][bj][m][1] * rs;
                    bf16_t* dst = (bj == 0) ? (K + rowi * 192 + wc * 32 + 8 * fq) : (V + rowi * 128 + wc * 32 + 8 * fq);
                    u32x4 w; w.x = cvt_pk_bf16(v0[0], v0[1]); w.y = cvt_pk_bf16(v0[2], v0[3]); w.z = cvt_pk_bf16(v1[0], v1[1]); w.w = cvt_pk_bf16(v1[2], v1[3]);
                    *(u32x4*)dst = w;
                }
            }
    }
};
template <bool FIRST> struct EpiMerge {
    static constexpr bool PERM = true, AFTER_DRAIN = false;
    const bf16_t* G; bf16_t* MG;
    __device__ __forceinline__ void operator()(const f32x4 (&acc)[2][2][4][2], const Unit& u, int wr, int wc, int fr, int fq) const {
#pragma unroll
        for (int ai = 0; ai < 2; ++ai)
#pragma unroll
            for (int m = 0; m < 4; ++m) {
                const size_t off = (size_t)(u.pm * BM + ai * HALF + wr * 64 + m * 16 + fr) * 2048 + u.pn * BM + wc * 32 + 8 * fq;
#pragma unroll
                for (int bj = 0; bj < 2; ++bj) {
                    const u32x4 g = *(const u32x4*)(G + off + bj * HALF);
                    float gv[8] = {__uint_as_float(g.x << 16), __uint_as_float(g.x & 0xffff0000u), __uint_as_float(g.y << 16), __uint_as_float(g.y & 0xffff0000u),
                                   __uint_as_float(g.z << 16), __uint_as_float(g.z & 0xffff0000u), __uint_as_float(g.w << 16), __uint_as_float(g.w & 0xffff0000u)};
                    float o[8];
#pragma unroll
                    for (int e = 0; e < 8; ++e) o[e] = sigm(gv[e]) * acc[ai][bj][m][e >> 2][e & 3];
                    if (!FIRST) { const u32x4 p = *(const u32x4*)(MG + off + bj * HALF);
                        o[0] += __uint_as_float(p.x << 16); o[1] += __uint_as_float(p.x & 0xffff0000u); o[2] += __uint_as_float(p.y << 16); o[3] += __uint_as_float(p.y & 0xffff0000u);
                        o[4] += __uint_as_float(p.z << 16); o[5] += __uint_as_float(p.z & 0xffff0000u); o[6] += __uint_as_float(p.w << 16); o[7] += __uint_as_float(p.w & 0xffff0000u); }
                    u32x4 w; w.x = cvt_pk_bf16(o[0], o[1]); w.y = cvt_pk_bf16(o[2], o[3]); w.z = cvt_pk_bf16(o[4], o[5]); w.w = cvt_pk_bf16(o[6], o[7]);
                    *(u32x4*)(MG + off + bj * HALF) = w;
                }
            }
    }
};
struct EpiOut {
    static constexpr bool PERM = false, AFTER_DRAIN = false;
    const float* X; const float* G1  ; float* X1;
    __device__ __forceinline__ void operator()(const f32x4 (&acc)[2][2][4][2], const Unit& u, int wr, int wc, int fr, int fq) const {
        const int b = u.pm >> 5;
        const int col0 = u.pn * BM + wc * 32 + 4 * fq;
#pragma unroll
        for (int bj = 0; bj < 2; ++bj)
#pragma unroll
            for (int n = 0; n < 2; ++n) { const int c = col0 + bj * HALF + n * 16; const f32x4 g = *(const f32x4*)(G1 + b * 12288 + c);
#pragma unroll
                for (int ai = 0; ai < 2; ++ai)
#pragma unroll
                    for (int m = 0; m < 4; ++m) { const size_t off = (size_t)(u.pm * BM + ai * HALF + wr * 64 + m * 16 + fr) * 2048 + c;
                        *(f32x4*)(X1 + off) = *(const f32x4*)(X + off) + g * acc[ai][bj][m][n]; } }
    }
};
struct EpiScore {
    static constexpr bool PERM = false, AFTER_DRAIN = false;
    float* SC;
    __device__ __forceinline__ void operator()(const f32x4 (&acc)[2][2][4][2], const Unit& u, int wr, int wc, int fr, int fq) const {
        const int col0 = u.pn * BM + wc * 32 + 4 * fq;
#pragma unroll
        for (int ai = 0; ai < 2; ++ai)
#pragma unroll
            for (int m = 0; m < 4; ++m) { const size_t off = (size_t)(u.pm * BM + ai * HALF + wr * 64 + m * 16 + fr) * 2048 + col0;
#pragma unroll
                for (int bj = 0; bj < 2; ++bj)
#pragma unroll
                    for (int n = 0; n < 2; ++n) *(f32x4*)(SC + off + bj * HALF + n * 16) = acc[ai][bj][m][n]; }
    }
};
}
namespace attn {
using bf16x8 = __attribute__((ext_vector_type(8))) short;
using s16x4  = __attribute__((ext_vector_type(4))) short;
using f32x16 = __attribute__((ext_vector_type(16))) float;
using u32x4  = __attribute__((ext_vector_type(4))) unsigned;
typedef unsigned short bf16_t;
constexpr int DQK = 192, DV = 128, NW = 8, QBLK = 32, KVBLK = 64;
constexpr int SHM_V = KVBLK * DV * 2  , SHM_K = KVBLK * DQK * 2  , SHM_QR = 2 * SHM_V + 2 * SHM_K + NW * 64 * 4, SHM_ATTN = SHM_QR + NW * 4096;
constexpr float THR = 8.0f;
#define KSWZ(row, colB) ((row) * 384 + ((colB) ^ (((row) & 7) << 4)))
#define SBAR() __builtin_amdgcn_sched_barrier(0)
__device__ __forceinline__ int crow(int r, int hi) { return (r & 3) + 8 * (r >> 2) + 4 * hi; }
__device__ __forceinline__ unsigned cvtpk(float lo, float hi) { unsigned r; asm volatile("v_cvt_pk_bf16_f32 %0, %1, %2" : "=v"(r) : "v"(lo), "v"(hi)); return r; }
__device__ __forceinline__ void partialSM(f32x16& p0, f32x16& p1, float& m_reg, float& mn, float& alpha) {
  float pmax = p0[0];
#pragma unroll
  for (int r = 1; r < 16; ++r) pmax = fmaxf(pmax, p0[r]);
#pragma unroll
  for (int r = 0; r < 16; ++r) pmax = fmaxf(pmax, p1[r]);
  { auto rr = __builtin_amdgcn_permlane32_swap(__float_as_uint(pmax), __float_as_uint(pmax), false, false);
    pmax = fmaxf(__uint_as_float(rr[0]), __uint_as_float(rr[1])); }
  if (__builtin_expect(__all(pmax - m_reg <= THR), 1)) { mn = m_reg; alpha = 1.f; }
  else { mn = fmaxf(m_reg, pmax); alpha = __builtin_amdgcn_exp2f(m_reg - mn); m_reg = mn; }
#pragma unroll
  for (int r = 0; r < 16; ++r) p0[r] = p0[r] - mn;
#pragma unroll
  for (int r = 0; r < 16; ++r) p1[r] = p1[r] - mn;
#pragma unroll
  for (int r = 0; r < 16; ++r) p0[r] = __builtin_amdgcn_exp2f(p0[r]);
}
__device__ __forceinline__ void finishSM(f32x16& p0, f32x16& p1, float alpha, float& l_reg, bf16x8& pa0, bf16x8& pa1, bf16x8& pa2, bf16x8& pa3) {
#pragma unroll
  for (int r = 0; r < 16; ++r) p1[r] = __builtin_amdgcn_exp2f(p1[r]);
  float ps = 0;
#pragma unroll
  for (int r = 0; r < 16; ++r) ps += p0[r];
#pragma unroll
  for (int r = 0; r < 16; ++r) ps += p1[r];
  { auto rr = __builtin_amdgcn_permlane32_swap(__float_as_uint(ps), __float_as_uint(ps), false, false);
    ps = __uint_as_float(rr[0]) + __uint_as_float(rr[1]); }
  l_reg = l_reg * alpha + ps;
#define PK4(P, BASE, OUT) do { unsigned a0 = cvtpk(P[BASE + 0], P[BASE + 1]), a1 = cvtpk(P[BASE + 2], P[BASE + 3]);   \
    unsigned b0 = cvtpk(P[BASE + 4], P[BASE + 5]), b1 = cvtpk(P[BASE + 6], P[BASE + 7]);                              \
    auto r0 = __builtin_amdgcn_permlane32_swap(a0, b0, false, false); auto r1 = __builtin_amdgcn_permlane32_swap(a1, b1, false, false); \
    u32x4 w = {r0[0], r1[0], r0[1], r1[1]}; OUT = *reinterpret_cast<bf16x8*>(&w); } while (0)
  PK4(p0, 0, pa0); PK4(p0, 8, pa1); PK4(p1, 0, pa2); PK4(p1, 8, pa3);
#undef PK4
}
__device__ __forceinline__ void qkt(f32x16& p0, f32x16& p1, const char* Ks, const bf16x8* qr, const char* qrow, int qx, int r32, int hi) {
  p0 = f32x16{}; p1 = f32x16{};
#pragma unroll
  for (int d0 = 0; d0 < 12; ++d0) { const int cb = (d0 * 16 + hi * 8) * 2;
    bf16x8 b0 = *reinterpret_cast<const bf16x8*>(Ks + KSWZ(r32, cb));
    bf16x8 b1 = *reinterpret_cast<const bf16x8*>(Ks + KSWZ(32 + r32, cb));
    const bf16x8 q = (d0 < 8) ? qr[d0 < 8 ? d0 : 0] : *reinterpret_cast<const bf16x8*>(qrow + (qx ^ ((d0 - 8) << 5)));
    p0 = __builtin_amdgcn_mfma_f32_32x32x16_bf16(b0, q, p0, 0, 0, 0);
    p1 = __builtin_amdgcn_mfma_f32_32x32x16_bf16(b1, q, p1, 0, 0, 0); }
}
__device__ __forceinline__ int v_st(int k, int c) { const int kk = (k & ~0xC) | ((k & 4) << 1) | ((k & 8) >> 1); return ((kk >> 3) * 4 + (c >> 5)) * 512 + ((kk & 7) * 32 + (c & 31)) * 2; }
__device__ __forceinline__ int v_rd_base(int lane) { return ((lane & 3) << 3) | (((lane >> 2) & 3) << 6) | (((lane >> 4) & 1) << 5) | (((lane >> 5) & 1) << 8); }
constexpr int v_rd_off(int d0, int ks, int half) { return d0 * 512 + ks * 4096 + half * 2048; }
template <int OFF> __device__ __forceinline__ s16x4 tr_read(int vb) {
  s16x4 r; asm volatile("ds_read_b64_tr_b16 %0, %1 offset:%2" : "=&v"(r) : "v"(vb), "i"(OFF) : "memory"); return r;
}
template <int D0> __device__ __forceinline__ void pv_one(f32x16& od, int vb, bf16x8 pa0, bf16x8 pa1, bf16x8 pa2, bf16x8 pa3) {
  const s16x4 l0 = tr_read<v_rd_off(D0, 0, 0)>(vb), h0 = tr_read<v_rd_off(D0, 0, 1)>(vb), l1 = tr_read<v_rd_off(D0, 1, 0)>(vb), h1 = tr_read<v_rd_off(D0, 1, 1)>(vb);
  const s16x4 l2 = tr_read<v_rd_off(D0, 2, 0)>(vb), h2 = tr_read<v_rd_off(D0, 2, 1)>(vb), l3 = tr_read<v_rd_off(D0, 3, 0)>(vb), h3 = tr_read<v_rd_off(D0, 3, 1)>(vb);
  asm volatile("s_waitcnt lgkmcnt(0)" ::: "memory"); SBAR();
#define PK(L, H) (bf16x8){L[0], L[1], L[2], L[3], H[0], H[1], H[2], H[3]}
  od = __builtin_amdgcn_mfma_f32_32x32x16_bf16(pa0, PK(l0, h0), od, 0, 0, 0);
  od = __builtin_amdgcn_mfma_f32_32x32x16_bf16(pa1, PK(l1, h1), od, 0, 0, 0);
  od = __builtin_amdgcn_mfma_f32_32x32x16_bf16(pa2, PK(l2, h2), od, 0, 0, 0);
  od = __builtin_amdgcn_mfma_f32_32x32x16_bf16(pa3, PK(l3, h3), od, 0, 0, 0);
#undef PK
}
__device__ __forceinline__ void pv_d0(f32x16* o, int vb, bf16x8 pa0, bf16x8 pa1, bf16x8 pa2, bf16x8 pa3) {
  pv_one<0>(o[0], vb, pa0, pa1, pa2, pa3); pv_one<1>(o[1], vb, pa0, pa1, pa2, pa3); pv_one<2>(o[2], vb, pa0, pa1, pa2, pa3); pv_one<3>(o[3], vb, pa0, pa1, pa2, pa3);
}
__device__ __forceinline__ void attn_unit(const bf16_t* __restrict__ Qb, const bf16_t* __restrict__ Kh, const bf16_t* __restrict__ Vh, bf16_t* __restrict__ Ob, int ldo, int seq, char* lds, int tid_in) {
  int tid_ = tid_in; asm volatile("" : "+v"(tid_));
  const int tid = tid_, wid = tid >> 6, lane = tid & 63, r32 = lane & 31, hi = lane >> 5;
  char* V_lds = lds; char* K_lds = lds + 2 * SHM_V;
  float* ws = (float*)(lds + 2 * SHM_V + 2 * SHM_K) + wid * 64; float* li_l = ws; float* al_l = ws + 32;
  float m_reg = -1e30f, l_reg = 0; f32x16 o[4] = {}; bf16x8 qr[8];
  const bf16_t* Qw = Qb + (long)(wid * QBLK + r32) * DQK + hi * 8;
#pragma unroll
  for (int d0 = 0; d0 < 8; ++d0) qr[d0] = *reinterpret_cast<const bf16x8*>(Qw + d0 * 16);
  char* qrow = lds + SHM_QR + wid * 4096 + r32 * 128; const int qx = (hi ^ (r32 & 7)) << 4;
#pragma unroll
  for (int d0 = 8; d0 < 12; ++d0) *reinterpret_cast<bf16x8*>(qrow + (qx ^ ((d0 - 8) << 5))) = *reinterpret_cast<const bf16x8*>(Qw + d0 * 16);
  const int sr = tid >> 4, sc = (tid & 15) * 8, vst0 = v_st(sr, sc), vst1 = v_st(32 + sr, sc);
  unsigned kgo[3], klo[3];
#pragma unroll
  for (int i = 0; i < 3; ++i) { const int id = tid + 512 * i, kr_ = id / 24, kc_ = (id % 24) * 16; kgo[i] = (unsigned)(kr_ * 384 + kc_); klo[i] = (unsigned)KSWZ(kr_, kc_); }
  const unsigned vgo0 = (unsigned)((sr * DV + sc) * 2), vgo1 = (unsigned)(((32 + sr) * DV + sc) * 2);
  const int vb0 = (int)(uintptr_t)V_lds + v_rd_base(lane);
  bf16x8 vs0, vs1, ks0, ks1, ks2;
#define SLOAD(k0) do { const char* Kt_ = (const char*)Kh + (size_t)(k0) * (DQK * 2); const char* Vt_ = (const char*)Vh + (size_t)(k0) * (DV * 2); \
    vs0 = *reinterpret_cast<const bf16x8*>(Vt_ + vgo0); vs1 = *reinterpret_cast<const bf16x8*>(Vt_ + vgo1); \
    ks0 = *reinterpret_cast<const bf16x8*>(Kt_ + kgo[0]); ks1 = *reinterpret_cast<const bf16x8*>(Kt_ + kgo[1]); ks2 = *reinterpret_cast<const bf16x8*>(Kt_ + kgo[2]); } while (0)
#define SWRITE(b) do { *(bf16x8*)(V_lds + (b) * SHM_V + vst0) = vs0; *(bf16x8*)(V_lds + (b) * SHM_V + vst1) = vs1; \
    *(bf16x8*)(K_lds + (b) * SHM_K + klo[0]) = ks0; *(bf16x8*)(K_lds + (b) * SHM_K + klo[1]) = ks1; *(bf16x8*)(K_lds + (b) * SHM_K + klo[2]) = ks2; } while (0)
#define RESC(a) do { if (__any((a) < 1.f)) { if (hi == 0) al_l[r32] = (a); asm volatile("s_waitcnt lgkmcnt(0)" ::: "memory"); \
    _Pragma("unroll") for (int d = 0; d < 4; ++d) _Pragma("unroll") for (int r = 0; r < 16; ++r) o[d][r] *= al_l[crow(r, hi)]; } } while (0)
  f32x16 pA0, pA1, pB0, pB1; float mnA, mnB, alA, alB; bf16x8 pa0, pa1, pa2, pa3; const int NT = seq / KVBLK;
  SLOAD(0); SWRITE(0); __syncthreads();
  qkt(pA0, pA1, K_lds, qr, qrow, qx, r32, hi); partialSM(pA0, pA1, m_reg, mnA, alA);
  SLOAD(KVBLK);
  SWRITE(1); __syncthreads();
  for (int j = 1; j + 1 < NT; j += 2) {
    SBAR(); qkt(pB0, pB1, K_lds + SHM_K, qr, qrow, qx, r32, hi);
    finishSM(pA0, pA1, alA, l_reg, pa0, pa1, pa2, pa3); SBAR();
    SLOAD((j + 1) * KVBLK); SBAR();
    pv_d0(o, vb0, pa0, pa1, pa2, pa3); partialSM(pB0, pB1, m_reg, mnB, alB);
    __syncthreads(); SWRITE(0);
    RESC(alB); __syncthreads();
    SBAR(); qkt(pA0, pA1, K_lds, qr, qrow, qx, r32, hi);
    finishSM(pB0, pB1, alB, l_reg, pa0, pa1, pa2, pa3); SBAR();
    SLOAD((j + 2) * KVBLK); SBAR();
    pv_d0(o, vb0 + SHM_V, pa0, pa1, pa2, pa3); partialSM(pA0, pA1, m_reg, mnA, alA);
    __syncthreads(); SWRITE(1);
    RESC(alA); __syncthreads();
  }
  SBAR(); qkt(pB0, pB1, K_lds + SHM_K, qr, qrow, qx, r32, hi);
  finishSM(pA0, pA1, alA, l_reg, pa0, pa1, pa2, pa3); SBAR();
  pv_d0(o, vb0, pa0, pa1, pa2, pa3); partialSM(pB0, pB1, m_reg, mnB, alB);
  __syncthreads(); RESC(alB);
  finishSM(pB0, pB1, alB, l_reg, pa0, pa1, pa2, pa3); SBAR();
  pv_d0(o, vb0 + SHM_V, pa0, pa1, pa2, pa3);
  if (hi == 0) li_l[r32] = l_reg; asm volatile("s_waitcnt lgkmcnt(0)" ::: "memory");
  float rli[16];
#pragma unroll
  for (int r = 0; r < 16; ++r) rli[r] = __builtin_amdgcn_rcpf(li_l[crow(r, hi)]);
  { int t2 = tid_in; asm volatile("" : "+v"(t2));
    const int w2 = t2 >> 6, l2 = t2 & 63, c2 = l2 & 31, h2 = l2 >> 5;
    bf16_t* Ow = Ob + (unsigned)((w2 * QBLK + 4 * h2) * ldo + c2);
#pragma unroll
    for (int r = 0; r < 16; ++r) { const unsigned ro = (unsigned)(((r & 3) + 8 * (r >> 2)) * ldo);
#pragma unroll
      for (int d0 = 0; d0 < 4; ++d0) { const float v = o[d0][r] * rli[r]; Ow[ro + d0 * 32] = (bf16_t)(cvtpk(v, v) & 0xffffu); } } }
  __syncthreads();
#undef SLOAD
#undef SWRITE
#undef RESC
}
#undef KSWZ
#undef SBAR
}
#define GAS __attribute__((address_space(1)))
#define LAS __attribute__((address_space(3)))
typedef unsigned short bf16_t;
typedef unsigned v4u __attribute__((ext_vector_type(4)));
typedef unsigned v2u __attribute__((ext_vector_type(2)));
typedef float f32x4 __attribute__((ext_vector_type(4)));
typedef short bf16x8 __attribute__((ext_vector_type(8)));
constexpr int NT_ = 512;
constexpr int BATCH = 2, SEQ = 8192, DM = 2048, CTXL = 256;
constexpr int ML = BATCH * SEQ  , MC = BATCH * CTXL  , M1 = ML + MC  ;
constexpr int NIN_PAD = 9216;
constexpr int LKV = CTXL + SEQ;
constexpr int NCH = 132;
constexpr float EPS = 1e-6f;
constexpr float QSCALE = 0.07216878364870322f * 1.4426950408889634f;
constexpr size_t MiB = 1u << 20;
constexpr size_t WS_CTL = 0, CTL_BYTES = 1 * MiB;
constexpr size_t CTL_BAR = 4096;
static_assert(CTL_BAR + 3456 * 4 <= CTL_BYTES, "ctl");
constexpr size_t WS_WUQ = 1 * MiB, WS_WUKV = WS_WUQ + 1536 * 512 * 2, WS_WBA = WS_WUKV + 2048 * 256 * 2, WS_WBB = WS_WBA + 4 * MiB, WS_WOUT = WS_WBB + 4 * MiB, WS_WPQ = WS_WOUT + 8 * MiB;
static_assert(WS_WPQ + 8 * MiB <= 28 * MiB, "small weights");
constexpr size_t WS_C = 28 * MiB;
constexpr size_t WS_D = 66 * MiB;
constexpr size_t WS_E1 = 132 * MiB;
constexpr size_t WS_CQ = WS_E1, WS_CKV = WS_CQ + 16 * MiB, WS_KR = WS_CKV + (size_t)M1 * 256 * 2, WS_AB = WS_KR + (size_t)M1 * 64 * 4;
static_assert(WS_AB + (size_t)M1 * 32 * 4 <= 164 * MiB, "E1");
constexpr size_t WS_Z = 164 * MiB, WS_GA = 196 * MiB, WS_GB = 260 * MiB;
constexpr size_t WS_QKV = 324 * MiB;
constexpr size_t WS_K = 423 * MiB;
constexpr size_t WS_DNQ = 473 * MiB;
constexpr size_t WS_GBETA = 572 * MiB;
constexpr size_t WS_EG = 575 * MiB;
constexpr size_t CTL_MOD = 27 * MiB + 512 * 1024;
constexpr size_t CTL_SSQQ = 575 * MiB, CTL_SSQKV = CTL_SSQQ + (size_t)16384 * 8 * 4;
static_assert(CTL_SSQKV + (size_t)16896 * 4 * 4 <= 577 * MiB && CTL_MOD + 3 * 12288 * 4 <= 28 * MiB && WS_WPQ + 8 * MiB <= CTL_MOD, "mod/ssq");
constexpr size_t WS_W = WS_QKV, WS_U = WS_QKV + 66 * MiB, WS_ATT = WS_C, WS_OF = WS_D, WS_OB = WS_D + 32 * MiB, WS_YA = WS_E1, WS_YB = WS_C;
constexpr size_t WS_MG = 324 * MiB, WS_H2 = 388 * MiB, WS_UB = 452 * MiB, WS_VB = 516 * MiB, WS_SC = 196 * MiB, WS_END = 580 * MiB;
static_assert(WS_EG + (size_t)4224 * 132 * 4 <= WS_END && WS_K + (size_t)16 * LKV * 192 * 2 <= WS_DNQ && WS_DNQ + (size_t)M1 * 3072 * 2 <= WS_GBETA, "ws map");

__device__ __forceinline__ unsigned f2bf(float f) { unsigned u = __builtin_bit_cast(unsigned, f); return (u + 0x7fffu + ((u >> 16) & 1u)) >> 16; }
__device__ __forceinline__ unsigned pk2(float lo, float hi) { unsigned r; asm volatile("v_cvt_pk_bf16_f32 %0, %1, %2" : "=v"(r) : "v"(lo), "v"(hi)); return r; }
__device__ __forceinline__ float bflo(unsigned w) { return __uint_as_float(w << 16); }
__device__ __forceinline__ float bfhi(unsigned w) { return __uint_as_float(w & 0xffff0000u); }
__device__ __forceinline__ float wave_sum(float v) {
#pragma unroll
    for (int o = 1; o < 64; o <<= 1) v += __shfl_xor(v, o);
    return v;
}
__device__ __forceinline__ float siluf(float v) { return v / (1.0f + __expf(-v)); }

struct Params {
    const float *x, *c, *ctx, *c_ctx, *w_mod, *b_mod, *norm1_w, *w_in, *qn_w, *kvn_w, *w_uq, *w_ukv, *conv_w, *a_log, *dt_bias, *dn_norm_w,
                *w_ba, *w_bb, *w_out, *norm2_w, *peer_wq, *sub_keys, *peer_u, *peer_v, *final_w;
    float* out; unsigned char* ws;
    int ph_lo, ph_hi;
};
#define XB_TMO      128
#define XB_XCNT(j)  (256  + 64 * (j))
#define XB_XSUB(j)  (1280 + 64 * (j))
#define XB_XGEN(j)  (2304 + 64 * (j))
#define XB_TOP      3328
#define XB_TOPGEN   3392
#define XCD_BAR_WORDS 3456
#define XB_SPIN_CAP (1u << 18)

__device__ __forceinline__ unsigned xb_ld(unsigned* p)              { return __hip_atomic_load(p, __ATOMIC_RELAXED, __HIP_MEMORY_SCOPE_AGENT); }
__device__ __forceinline__ unsigned xb_add(unsigned* p, unsigned v) { return __hip_atomic_fetch_add(p, v, __ATOMIC_RELAXED, __HIP_MEMORY_SCOPE_AGENT); }
__device__ __forceinline__ unsigned xb_xcc_id() { return (unsigned)__builtin_amdgcn_s_getreg((3 << 11) | 20) & 0xFu; }
#define XB_SPIN(cond, bar) do { unsigned _sp = 0; while (cond) { __builtin_amdgcn_s_sleep(1); \
    if ((++_sp & 255u) == 0u) { if (xb_ld(&(bar)[XB_TMO])) break; if (_sp > XB_SPIN_CAP) { atomicAdd(&(bar)[XB_TMO], 1u); break; } } } } while (0)

struct XcdBarrier {
    unsigned* bar; unsigned x;
    volatile LAS unsigned* st;
};

__device__ __forceinline__ XcdBarrier xcd_barrier_post(unsigned* bar, volatile LAS unsigned* st, int tid) {
    XcdBarrier b; b.bar = bar; b.x = xb_xcc_id(); b.st = st;
    if (tid == 0) (void)xb_add(&bar[XB_XCNT(b.x)], 1u);
    return b;
}
__device__ __forceinline__ void xcd_barrier_complete(unsigned* bar, unsigned x, unsigned& nloc, unsigned& nx) {
    const unsigned G = gridDim.x * gridDim.y * gridDim.z;
    unsigned sum, cnt, mine, sp = 0u;
    for (;;) {
        sum = 0u; cnt = 0u; mine = 0u;
#pragma unroll
        for (unsigned j = 0; j < 16; ++j) { const unsigned c = xb_ld(&bar[XB_XCNT(j)]); sum += c; cnt += (c > 0u) ? 1u : 0u; mine = (j == x) ? c : mine; }
        if (sum == G) break;
        __builtin_amdgcn_s_sleep(1);
        if ((++sp & 255u) == 0u) { if (xb_ld(&bar[XB_TMO])) break; if (sp > XB_SPIN_CAP) { atomicAdd(&bar[XB_TMO], 1u); break; } }
    }
    nloc = mine > 0u ? mine : 1u; nx = cnt > 0u ? cnt : 1u;
}

__device__ __forceinline__ void xcd_barrier(const XcdBarrier& b, int tid) {
    asm volatile("s_waitcnt vmcnt(0)" ::: "memory");
    __syncthreads();
    if (tid == 0) {
        unsigned* bar = b.bar;
        __builtin_amdgcn_s_waitcnt(0);
        unsigned nloc = b.st[0], nx = b.st[1];
        if (nloc == 0u) { xcd_barrier_complete(bar, b.x, nloc, nx); b.st[0] = nloc; b.st[1] = nx; }
        const unsigned old = xb_add(&bar[XB_XSUB(b.x)], 1u);
        const unsigned gen = old / nloc;
        if (old + 1u == (gen + 1u) * nloc) {
            __builtin_amdgcn_fence(__ATOMIC_RELEASE, "agent");
            asm volatile("s_waitcnt vmcnt(0)" ::: "memory");
            const unsigned og = xb_add(&bar[XB_TOP], 1u);
            const unsigned tg = og / nx;
            if (og + 1u == (tg + 1u) * nx) xb_add(&bar[XB_TOPGEN], 1u);
            else XB_SPIN(xb_ld(&bar[XB_TOPGEN]) == tg, bar);
            __builtin_amdgcn_fence(__ATOMIC_ACQUIRE, "agent");
            xb_add(&bar[XB_XGEN(b.x)], 1u);
            asm volatile("s_waitcnt vmcnt(0)" ::: "memory");
        } else {
            XB_SPIN(xb_ld(&bar[XB_XGEN(b.x)]) == gen, bar);
            __builtin_amdgcn_fence(__ATOMIC_ACQUIRE, "agent");
            asm volatile("s_waitcnt vmcnt(0)" ::: "memory");
        }
    }
    __syncthreads();
}
struct Ctx { LAS unsigned char* lds; int tid, lane, wave, vcu, G; };

__device__ __forceinline__ void p0_mod_item(const Params& p, const Ctx& C, int it) {
    LAS float* sl = (LAS float*)C.lds;
    LAS float* red = sl + 3 * 2048;
    for (int e = C.tid; e < 3 * 2048; e += NT_) { const int i = e >> 11, k = e & 2047; const float v = (i < 2) ? p.c[i * DM + k] : p.c_ctx[k]; sl[e] = siluf(v); }
    __syncthreads();
    typedef float f32x2_ __attribute__((ext_vector_type(2)));
    f32x2_ a0 = {0, 0}, a1 = {0, 0}, a2 = {0, 0};
    const int col = it * 128 + C.lane * 2, k0 = C.wave * 256;
    const float* wp = p.w_mod + (size_t)k0 * 12288 + col;
#pragma unroll 8
    for (int k = 0; k < 256; ++k) { const f32x2_ w = *(const f32x2_*)(wp + (size_t)k * 12288); a0 += w * sl[k0 + k]; a1 += w * sl[2048 + k0 + k]; a2 += w * sl[4096 + k0 + k]; }
    LAS float* rw = red + C.wave * 384 + C.lane * 2;
    rw[0] = a0[0]; rw[1] = a0[1]; rw[128] = a1[0]; rw[129] = a1[1]; rw[256] = a2[0]; rw[257] = a2[1];
    __syncthreads();
    if (C.tid < 384) { float s = p.b_mod[it * 128 + (C.tid & 127)];
#pragma unroll
        for (int w = 0; w < 8; ++w) s += red[w * 384 + C.tid];
        ((float*)(p.ws + CTL_MOD))[(C.tid >> 7) * 12288 + it * 128 + (C.tid & 127)] = s; }
    __syncthreads();
}
__device__ __forceinline__ void p0_wprime_item(const Params& p, const Ctx& C, int it) {
    LAS float* As = (LAS float*)C.lds;
    LAS float* Ss = As + 64 * 129;
    const int hp = it >> 5, i0 = (it & 31) * 64, pp = hp & 1;
    for (int e = C.tid; e < 64 * 128; e += NT_) { const int i = e >> 7, d = e & 127; As[i * 129 + d] = p.peer_wq[(size_t)(i0 + i) * 2048 + hp * 128 + d]; }
    for (int e = C.tid; e < 128 * 128; e += NT_) { const int k = e >> 7, d = e & 127; Ss[k * 129 + d] = p.sub_keys[(size_t)(pp * 128 + k) * 128 + d]; }
    __syncthreads();
    const int k = C.tid & 127, ig = C.tid >> 7;
    float acc[16];
#pragma unroll
    for (int ii = 0; ii < 16; ++ii) acc[ii] = 0.f;
    for (int d = 0; d < 128; ++d) { const float s = Ss[k * 129 + d];
#pragma unroll
        for (int ii = 0; ii < 16; ++ii) acc[ii] += As[(ig * 16 + ii) * 129 + d] * s; }
    bf16_t* dst = (bf16_t*)(p.ws + WS_WPQ) + (size_t)(hp * 128 + k) * 2048 + i0 + ig * 16;
    v4u w0, w1; w0.x = pk2(acc[0], acc[1]); w0.y = pk2(acc[2], acc[3]); w0.z = pk2(acc[4], acc[5]); w0.w = pk2(acc[6], acc[7]);
    w1.x = pk2(acc[8], acc[9]); w1.y = pk2(acc[10], acc[11]); w1.z = pk2(acc[12], acc[13]); w1.w = pk2(acc[14], acc[15]);
    *(v4u*)dst = w0; *(v4u*)(dst + 8) = w1;
    __syncthreads();
}
__device__ __forceinline__ void p0_transpose_item(const float* W, int K, int N, int k0, int n0, bf16_t* WT, int drow0, const float* kscale, LAS float* scr, int lane) {
#pragma unroll 8
    for (int i = 0; i < 32; ++i) { const int kk = 2 * i + (lane >> 5); float v = W[(size_t)(k0 + kk) * N + n0 + (lane & 31)]; if (kscale) v *= kscale[k0 + kk]; scr[kk * 33 + (lane & 31)] = v; }
    asm volatile("s_waitcnt lgkmcnt(0)" ::: "memory");
    const int c = lane & 7;
#pragma unroll
    for (int j = 0; j < 4; ++j) { const int n = (lane >> 3) + 8 * j; const LAS float* s = scr + (8 * c) * 33 + n;
        v4u o; o.x = pk2(s[0 * 33], s[1 * 33]); o.y = pk2(s[2 * 33], s[3 * 33]); o.z = pk2(s[4 * 33], s[5 * 33]); o.w = pk2(s[6 * 33], s[7 * 33]);
        *(v4u*)(WT + (size_t)(drow0 + n) * K + k0 + 8 * c) = o; }
    asm volatile("s_waitcnt lgkmcnt(0)" ::: "memory");
}
__device__ __forceinline__ int win_dest_row(int n0) {
    if (n0 < 768) return n0;
    if (n0 < 832) return 8960 + (n0 - 768);
    if (n0 < 3904) return 768 + (n0 - 832);
    if (n0 < 4928) return 3840 + (n0 - 3904);
    if (n0 < 4960) return 9024 + (n0 - 4928);
    if (n0 < 7008) return 4864 + (n0 - 4960);
    return 6912 + (n0 - 7008);
}
__device__ __forceinline__ void p0_prologue(const Params& p, const Ctx& C) {
    for (int it = C.vcu; it < 96; it += C.G) p0_mod_item(p, C, it);
    for (int it = C.vcu; it < 512; it += C.G) p0_wprime_item(p, C, it);
    LAS float* scr = (LAS float*)(C.lds + C.wave * 16384);
    const int gw = C.vcu * 8 + C.wave, NGW = C.G * 8;
    constexpr int I_IN = 32 * 283, I_UQ = 8 * 48, I_UKV = 4 * 64, I_BA = 16 * 64, I_BB = 16 * 64, I_OUT = 32 * 64;
    constexpr int NITEMS = I_IN + I_UQ + I_UKV + I_BA + I_BB + I_OUT;
    unsigned char* ws = p.ws;
    for (int it = gw; it < NITEMS; it += NGW) {
        int r = it;
        if (r < I_IN) { const int kb = r / 283, nb = r % 283; p0_transpose_item(p.w_in, 2048, 9056, kb * 64, nb * 32, (bf16_t*)(ws + WS_C), win_dest_row(nb * 32), nullptr, scr, C.lane); continue; } r -= I_IN;
        if (r < I_UQ) { const int kb = r / 48, nb = r % 48, n0 = nb * 32, h = n0 / 192, j0 = n0 % 192; const int dr = (j0 < 128) ? (h * 128 + j0) : (1024 + h * 64 + (j0 - 128));
            p0_transpose_item(p.w_uq, 512, 1536, kb * 64, n0, (bf16_t*)(ws + WS_WUQ), dr, p.qn_w, scr, C.lane); continue; } r -= I_UQ;
        if (r < I_UKV) { const int kb = r / 64, nb = r % 64; p0_transpose_item(p.w_ukv, 256, 2048, kb * 64, nb * 32, (bf16_t*)(ws + WS_WUKV), nb * 32, p.kvn_w, scr, C.lane); continue; } r -= I_UKV;
        if (r < I_BA) { const int kb = r / 64, nb = r % 64; p0_transpose_item(p.w_ba, 1024, 2048, kb * 64, nb * 32, (bf16_t*)(ws + WS_WBA), nb * 32, nullptr, scr, C.lane); continue; } r -= I_BA;
        if (r < I_BB) { const int kb = r / 64, nb = r % 64; p0_transpose_item(p.w_bb, 1024, 2048, kb * 64, nb * 32, (bf16_t*)(ws + WS_WBB), nb * 32, nullptr, scr, C.lane); continue; } r -= I_BB;
        { const int kb = r / 64, nb = r % 64; p0_transpose_item(p.w_out, 2048, 2048, kb * 64, nb * 32, (bf16_t*)(ws + WS_WOUT), nb * 32, nullptr, scr, C.lane); }
    }
    { v4u* z = (v4u*)((bf16_t*)(ws + WS_C) + (size_t)9056 * 2048); const int n16 = 160 * 2048 * 2 / 16;
      for (int i = C.vcu * NT_ + C.tid; i < n16; i += C.G * NT_) z[i] = (v4u){0u, 0u, 0u, 0u}; }
}

__device__ __forceinline__ void mod_norm_rows(const Ctx& C, const float* X, int nrows, const float* nw, const float* sh, const float* sc, bf16_t* O) {
    f32x4 a[8], s[8];
#pragma unroll
    for (int j = 0; j < 8; ++j) { const int c = 4 * C.lane + 256 * j; const f32x4 w = *(const f32x4*)(nw + c), q = *(const f32x4*)(sc + c); a[j] = w * (q + 1.0f); s[j] = *(const f32x4*)(sh + c); }
    const int gw = C.vcu * 8 + C.wave, NGW = C.G * 8;
    for (int r = gw; r < nrows; r += NGW) {
        const f32x4* xr = (const f32x4*)(X + (size_t)r * DM) + C.lane; f32x4 v[8]; float ss = 0.f;
#pragma unroll
        for (int j = 0; j < 8; ++j) { v[j] = xr[64 * j]; ss += (v[j].x * v[j].x + v[j].y * v[j].y) + (v[j].z * v[j].z + v[j].w * v[j].w); }
        const float rstd = rsqrtf(wave_sum(ss) * (1.0f / DM) + EPS);
        v2u* o8 = (v2u*)(O + (size_t)r * DM) + C.lane;
#pragma unroll
        for (int j = 0; j < 8; ++j) { const f32x4 y = v[j] * rstd * a[j] + s[j]; v2u w; w.x = pk2(y.x, y.y); w.y = pk2(y.z, y.w); o8[64 * j] = w; }
    }
}
__device__ __forceinline__ void p3_conv(const Params& p, const Ctx& C) {
    const bf16_t* QKV = (const bf16_t*)(p.ws + WS_QKV); bf16_t* DNQ = (bf16_t*)(p.ws + WS_DNQ);
    const long total = (long)M1 * 384;
    for (long it = (long)C.vcu * NT_ + C.tid; it < total; it += (long)C.G * NT_) {
        const int r = (int)(it / 384), c8 = (int)(it % 384), ch = c8 * 8;
        int seg0, segn, t;
        if (r < ML) { seg0 = r & ~8191; segn = SEQ; t = r & 8191; } else { seg0 = ML + ((r - ML) & ~255); segn = CTXL; t = (r - ML) & 255; }
        float acc[8];
#pragma unroll
        for (int e = 0; e < 8; ++e) acc[e] = 0.f;
#pragma unroll
        for (int j = 0; j < 5; ++j) { const int tt = t + j - 2;
            if (tt >= 0 && tt < segn) { const v4u xv = *(const v4u*)(QKV + (size_t)(seg0 + tt) * 3072 + ch);
                const f32x4 w0 = *(const f32x4*)(p.conv_w + j * 3072 + ch), w1 = *(const f32x4*)(p.conv_w + j * 3072 + ch + 4);
                acc[0] += bflo(xv.x) * w0.x; acc[1] += bfhi(xv.x) * w0.y; acc[2] += bflo(xv.y) * w0.z; acc[3] += bfhi(xv.y) * w0.w;
                acc[4] += bflo(xv.z) * w1.x; acc[5] += bfhi(xv.z) * w1.y; acc[6] += bflo(xv.w) * w1.z; acc[7] += bfhi(xv.w) * w1.w; } }
        float ss = 0.f;
#pragma unroll
        for (int e = 0; e < 8; ++e) { acc[e] = siluf(acc[e]); ss += acc[e] * acc[e]; }
        ss += __shfl_xor(ss, 1); ss += __shfl_xor(ss, 2); ss += __shfl_xor(ss, 4); ss += __shfl_xor(ss, 8);
        float sc = 1.0f;
        if (ch < 2048) { sc = rsqrtf(ss + EPS); if (ch < 1024) sc *= 0.08838834764831845f; }
        v4u w; w.x = pk2(acc[0] * sc, acc[1] * sc); w.y = pk2(acc[2] * sc, acc[3] * sc); w.z = pk2(acc[4] * sc, acc[5] * sc); w.w = pk2(acc[6] * sc, acc[7] * sc);
        *(v4u*)(DNQ + (size_t)r * 3072 + ch) = w;
    }
}
__device__ __forceinline__ void p3_krope_gbeta(const Params& p, const Ctx& C) {
    const float* KR = (const float*)(p.ws + WS_KR); bf16_t* K = (bf16_t*)(p.ws + WS_K);
    for (int it = C.vcu * NT_ + C.tid; it < M1 * 4; it += C.G * NT_) {
        const int r = it >> 2, q = it & 3, half = q >> 1, part = q & 1;
        int b, l, t; bool lat = r < ML;
        if (lat) { b = r >> 13; t = r & 8191; l = CTXL + t; } else { b = (r - ML) >> 8; t = 0; l = (r - ML) & 255; }
        const float* x1p = KR + (size_t)r * 64 + half * 32; const float* x2p = x1p + 16;
        float o[16];
        if (lat) { const float pos = (float)(half == 0 ? (t >> 6) : (t & 63));
#pragma unroll
            for (int i = 0; i < 16; ++i) { const float invf = exp2f(-(float)i * (13.287712379549449f / 16.0f)); float sn, cs; pg8::fast_sincos(pos * invf, sn, cs);
                const float x1 = x1p[i], x2 = x2p[i]; o[i] = part == 0 ? (x1 * cs - x2 * sn) : (x1 * sn + x2 * cs); } }
        else {
#pragma unroll
            for (int i = 0; i < 16; ++i) o[i] = part == 0 ? x1p[i] : x2p[i]; }
        v4u w0, w1; w0.x = pk2(o[0], o[1]); w0.y = pk2(o[2], o[3]); w0.z = pk2(o[4], o[5]); w0.w = pk2(o[6], o[7]);
        w1.x = pk2(o[8], o[9]); w1.y = pk2(o[10], o[11]); w1.z = pk2(o[12], o[13]); w1.w = pk2(o[14], o[15]);
#pragma unroll
        for (int h = 0; h < 8; ++h) { bf16_t* dst = K + ((size_t)(b * 8 + h) * LKV + l) * 192 + 128 + half * 32 + part * 16; *(v4u*)dst = w0; *(v4u*)(dst + 8) = w1; }
    }
    const float* AB = (const float*)(p.ws + WS_AB); float* Gd = (float*)(p.ws + WS_GBETA); float* Bd = Gd + (size_t)2 * M1 * 8;
    for (int it = C.vcu * NT_ + C.tid; it < M1 * 16; it += C.G * NT_) {
        const int r = it >> 4, dh = it & 15, dir = dh >> 3, h = dh & 7;
        const float a = AB[(size_t)r * 32 + dir * 8 + h] + p.dt_bias[dir * 8 + h], bl = AB[(size_t)r * 32 + 16 + dir * 8 + h];
        const float sp = (a > 20.f) ? a : log1pf(__expf(a));
        Gd[((size_t)dir * M1 + r) * 8 + h] = -__expf(p.a_log[dir * 8 + h]) * sp;
        Bd[((size_t)dir * M1 + r) * 8 + h] = 1.0f / (1.0f + __expf(-bl));
    }
}
constexpr int CP_LD = 136;
constexpr int CP_K = 0, CP_Q = CP_K + 64 * CP_LD * 2, CP_V = CP_Q + 64 * CP_LD * 2, CP_KK = CP_V + 64 * CP_LD * 2, CP_QK = CP_KK + 64 * 65 * 4,
              CP_M = CP_QK + 64 * 65 * 4  , CP_VEC = CP_M + 2 * 64 * 64 * 4  , CP_END = CP_VEC + 10 * 64 * 4;
static_assert(CP_END <= 131072 && (CP_M % 16) == 0, "chunk-prep LDS");
__device__ __forceinline__ void p5_chunk_prep(const Params& p, const Ctx& C) {
    const bf16_t* DNQ = (const bf16_t*)(p.ws + WS_DNQ); const float* Gd = (const float*)(p.ws + WS_GBETA); const float* Bd = Gd + (size_t)2 * M1 * 8;
    bf16_t* Wd = (bf16_t*)(p.ws + WS_W); bf16_t* Ud = (bf16_t*)(p.ws + WS_U); bf16_t* ATd = (bf16_t*)(p.ws + WS_ATT);
    float* EG = (float*)(p.ws + WS_EG); float* EKD = EG + (size_t)4224 * 64; float* EGL = EKD + (size_t)4224 * 64;
    LAS unsigned char* L = C.lds;
    LAS bf16_t* Ks = (LAS bf16_t*)(L + CP_K); LAS bf16_t* Qs = (LAS bf16_t*)(L + CP_Q); LAS bf16_t* Vs = (LAS bf16_t*)(L + CP_V);
    LAS float* KKs = (LAS float*)(L + CP_KK); LAS float* QKs = (LAS float*)(L + CP_QK); LAS float* Ms = (LAS float*)(L + CP_M); LAS float* Vec = (LAS float*)(L + CP_VEC);
    const int tid = C.tid, lane = C.lane, wave = C.wave;
    for (int task = C.vcu; task < 16 * NCH; task += C.G) {
        const int bh = task / NCH, tc = task % NCH, b = bh >> 3, h = bh & 7;
        const int row0 = (tc < 4) ? (ML + b * CTXL + tc * 64) : (b * SEQ + (tc - 4) * 64);
        for (int e = tid; e < 3 * 1024; e += NT_) { const int which = e >> 10, id = e & 1023, i = id >> 4, chn = id & 15;
            const v4u v = *(const v4u*)(DNQ + (size_t)(row0 + i) * 3072 + which * 1024 + h * 128 + chn * 8);
            LAS bf16_t* dst = (which == 0 ? Qs : (which == 1 ? Ks : Vs)) + i * CP_LD + chn * 8; *(LAS v4u*)dst = v; }
        if (tid < 256) { const int which = tid >> 6, i = tid & 63, dir = which & 1; const float* src = (which < 2) ? Gd : Bd; Vec[tid] = src[((size_t)dir * M1 + row0 + i) * 8 + h]; }
        __syncthreads();
        {
#pragma unroll
            for (int q = 0; q < 4; ++q) { const int t16 = wave * 2 + (q & 1), tm = t16 >> 2, tn = t16 & 3; const bool isq = q >= 2;
                const LAS bf16_t* Ab = (isq ? Qs : Ks) + (tm * 16 + (lane & 15)) * CP_LD + 8 * (lane >> 4); const LAS bf16_t* Bb = Ks + (tn * 16 + (lane & 15)) * CP_LD + 8 * (lane >> 4);
                f32x4 acc = {0.f, 0.f, 0.f, 0.f};
#pragma unroll
                for (int kk = 0; kk < 4; ++kk) acc = __builtin_amdgcn_mfma_f32_16x16x32_bf16(*(const LAS bf16x8*)(Ab + kk * 32), *(const LAS bf16x8*)(Bb + kk * 32), acc, 0, 0, 0);
                LAS float* dst = (isq ? QKs : KKs) + (tm * 16 + 4 * (lane >> 4)) * 65 + tn * 16 + (lane & 15);
#pragma unroll
                for (int rg = 0; rg < 4; ++rg) dst[rg * 65] = acc[rg]; }
            if (wave < 2) { float v = (wave == 0) ? Vec[lane] : Vec[64 + 63 - lane];
#pragma unroll
                for (int o = 1; o < 64; o <<= 1) { const float u = __shfl_up(v, o); if (lane >= o) v += u; }
                Vec[256 + wave * 64 + lane] = v; }
        }
        __syncthreads();
        for (int e = tid; e < 2 * 4096; e += NT_) { const int dir = e >> 12, i = (e >> 6) & 63, j = e & 63, pi = dir ? 63 - i : i, pj = dir ? 63 - j : j;
            const float gi = Vec[256 + dir * 64 + i], gj = Vec[256 + dir * 64 + j], beta_i = Vec[128 + dir * 64 + pi];
            const float dec = (i >= j) ? __expf(gi - gj) : 0.f;
            Ms[dir * 4096 + i * 64 + j] = (i > j) ? beta_i * KKs[pi * 65 + pj] * dec : 0.f;
            const size_t cidx = (size_t)(bh * 2 + dir) * NCH + (dir ? (tc < 4 ? 3 - tc : 135 - tc) : tc);
            ATd[cidx * 4096 + i * 64 + j] = (bf16_t)f2bf(QKs[pi * 65 + pj] * dec); }
        if (tid < 128) { const int dir = tid >> 6, i = tid & 63; const size_t cidx = (size_t)(bh * 2 + dir) * NCH + (dir ? (tc < 4 ? 3 - tc : 135 - tc) : tc);
            const float gi = Vec[256 + dir * 64 + i], gl = Vec[256 + dir * 64 + 63], egi = __expf(gi);
            EG[cidx * 64 + i] = egi; EKD[cidx * 64 + i] = __expf(gl - gi); if (i == 0) EGL[cidx] = __expf(gl);
            Vec[384 + dir * 128 + i] = Vec[128 + dir * 64 + (dir ? 63 - i : i)]; Vec[384 + dir * 128 + 64 + i] = egi; }
        __syncthreads();
        {
            const int dir = tid >> 8, c = tid & 255; const LAS float* Mr = Ms + dir * 4096;
            const LAS bf16_t* sp = ((c < 128) ? (Vs + c) : (Ks + (c - 128))) + (dir ? 63 * CP_LD : 0); const int sstep = dir ? -CP_LD : CP_LD;
            const LAS float* bsc = Vec + 384 + dir * 128;
            const size_t cidx = (size_t)(bh * 2 + dir) * NCH + (dir ? (tc < 4 ? 3 - tc : 135 - tc) : tc);
            bf16_t* dp = ((c < 128) ? Ud : Wd) + cidx * 8192 + (c & 127);
            const bool isw = c >= 128;
            float x[64];
#pragma unroll
            for (int i = 0; i < 64; ++i) {
                float r = __uint_as_float(((unsigned)sp[0]) << 16) * bsc[i];
                if (isw) r *= bsc[64 + i];
#pragma unroll
                for (int j4 = 0; j4 < (i + 3) / 4; ++j4) { const f32x4 mv = *(const LAS f32x4*)(Mr + i * 64 + j4 * 4);
#pragma unroll
                    for (int e = 0; e < 4; ++e) if (j4 * 4 + e < i) r -= mv[e] * x[j4 * 4 + e]; }
                x[i] = r; *dp = (bf16_t)f2bf(r); dp += 128; sp += sstep; asm volatile("" : "+v"(dp), "+v"(sp) :: "memory"); }
        }
        __syncthreads();
    }
}
constexpr int SC_WLD = 136, SC_TLD = 72;
constexpr int SC_W = 0, SC_QG = SC_W + 64 * SC_WLD * 2, SC_KDT = SC_QG + 64 * SC_WLD * 2, SC_ATT = SC_KDT + 128 * SC_TLD * 2, SC_U = SC_ATT + 64 * SC_TLD * 2,
              SC_SBT = SC_U + 64 * 16 * 4, SC_VNT = SC_SBT + 16 * SC_WLD * 2, SC_END = SC_VNT + 16 * SC_TLD * 2;
static_assert(SC_END <= 131072 && SC_QG % 16 == 0 && SC_KDT % 16 == 0 && SC_ATT % 16 == 0 && SC_U % 16 == 0 && SC_SBT % 16 == 0 && SC_VNT % 16 == 0, "scan LDS");
__device__ __forceinline__ void p6_scan(const Params& p, const Ctx& C) {
    const bf16_t* DNQ = (const bf16_t*)(p.ws + WS_DNQ); const bf16_t* Wd = (const bf16_t*)(p.ws + WS_W); const bf16_t* Ud = (const bf16_t*)(p.ws + WS_U); const bf16_t* ATd = (const bf16_t*)(p.ws + WS_ATT);
    const float* EG = (const float*)(p.ws + WS_EG); const float* EKD = EG + (size_t)4224 * 64; const float* EGL = EKD + (size_t)4224 * 64;
    LAS unsigned char* L = C.lds;
    LAS bf16_t* Ws = (LAS bf16_t*)(L + SC_W); LAS bf16_t* QGs = (LAS bf16_t*)(L + SC_QG); LAS bf16_t* KDT = (LAS bf16_t*)(L + SC_KDT); LAS bf16_t* ATs = (LAS bf16_t*)(L + SC_ATT);
    LAS float* Us = (LAS float*)(L + SC_U); LAS bf16_t* SBT = (LAS bf16_t*)(L + SC_SBT); LAS bf16_t* VNT = (LAS bf16_t*)(L + SC_VNT);
    const int tid = C.tid, lane = C.lane, wave = C.wave, l15 = lane & 15, lq = lane >> 4;
    for (int task = C.vcu; task < 256; task += C.G) {
        const int bhd = task >> 3, cb = task & 7, bh = bhd >> 1, dir = bhd & 1, b = bh >> 3, h = bh & 7, n0 = cb * 16;
        bf16_t* Od = (bf16_t*)(p.ws + (dir ? WS_OB : WS_OF));
        f32x4 S = {0.f, 0.f, 0.f, 0.f};
        if (tid < 16 * SC_WLD / 2) ((LAS unsigned*)SBT)[tid] = 0u;
        for (int e = tid; e < 16 * SC_WLD / 2; e += NT_) ((LAS unsigned*)SBT)[e] = 0u;
        for (int s = 0; s < NCH; ++s) {
            const size_t cidx = (size_t)bhd * NCH + s;
            int base; if (dir == 0) base = (s < 4) ? (ML + b * CTXL + s * 64) : (b * SEQ + (s - 4) * 64); else base = (s < 4) ? (ML + b * CTXL + (3 - s) * 64) : (b * SEQ + (131 - s) * 64);
            __syncthreads();
#pragma unroll
            for (int e2 = 0; e2 < 2; ++e2) { const int id = tid + NT_ * e2, i = id >> 4, chn = id & 15; const int row = base + (dir ? 63 - i : i);
                *(LAS v4u*)(Ws + i * SC_WLD + chn * 8) = *(const v4u*)(Wd + cidx * 8192 + i * 128 + chn * 8);
                const v4u qv = *(const v4u*)(DNQ + (size_t)row * 3072 + h * 128 + chn * 8); const float eg = EG[cidx * 64 + i];
                v4u qo; qo.x = pk2(bflo(qv.x) * eg, bfhi(qv.x) * eg); qo.y = pk2(bflo(qv.y) * eg, bfhi(qv.y) * eg); qo.z = pk2(bflo(qv.z) * eg, bfhi(qv.z) * eg); qo.w = pk2(bflo(qv.w) * eg, bfhi(qv.w) * eg);
                *(LAS v4u*)(QGs + i * SC_WLD + chn * 8) = qo;
                const v4u kv = *(const v4u*)(DNQ + (size_t)row * 3072 + 1024 + h * 128 + chn * 8); const float ek = EKD[cidx * 64 + i];
                const unsigned k0 = pk2(bflo(kv.x) * ek, bfhi(kv.x) * ek), k1 = pk2(bflo(kv.y) * ek, bfhi(kv.y) * ek), k2 = pk2(bflo(kv.z) * ek, bfhi(kv.z) * ek), k3 = pk2(bflo(kv.w) * ek, bfhi(kv.w) * ek);
                LAS bf16_t* kd = KDT + (chn * 8) * SC_TLD + i;
                kd[0 * SC_TLD] = (bf16_t)k0; kd[1 * SC_TLD] = (bf16_t)(k0 >> 16); kd[2 * SC_TLD] = (bf16_t)k1; kd[3 * SC_TLD] = (bf16_t)(k1 >> 16);
                kd[4 * SC_TLD] = (bf16_t)k2; kd[5 * SC_TLD] = (bf16_t)(k2 >> 16); kd[6 * SC_TLD] = (bf16_t)k3; kd[7 * SC_TLD] = (bf16_t)(k3 >> 16); }
            { const int i = tid >> 3, chn = tid & 7; *(LAS v4u*)(ATs + i * SC_TLD + chn * 8) = *(const v4u*)(ATd + cidx * 4096 + i * 64 + chn * 8); }
            if (tid < 128) { const int i = tid >> 1, hf = tid & 1; const v4u uv = *(const v4u*)(Ud + cidx * 8192 + i * 128 + n0 + hf * 8);
                LAS float* ud = Us + i * 16 + hf * 8; *(LAS f32x4*)ud = (f32x4){bflo(uv.x), bfhi(uv.x), bflo(uv.y), bfhi(uv.y)}; *(LAS f32x4*)(ud + 4) = (f32x4){bflo(uv.z), bfhi(uv.z), bflo(uv.w), bfhi(uv.w)}; }
            const float egl = EGL[cidx];
            __syncthreads();
            const int mt = wave & 3;
            f32x4 acc = {0.f, 0.f, 0.f, 0.f};
            { const LAS bf16_t* Ab = ((wave < 4) ? Ws : QGs) + (mt * 16 + l15) * SC_WLD + 8 * lq; const LAS bf16_t* Bb = SBT + l15 * SC_WLD + 8 * lq;
#pragma unroll
              for (int kk = 0; kk < 4; ++kk) acc = __builtin_amdgcn_mfma_f32_16x16x32_bf16(*(const LAS bf16x8*)(Ab + kk * 32), *(const LAS bf16x8*)(Bb + kk * 32), acc, 0, 0, 0); }
            if (wave < 4) { const int i0 = mt * 16 + 4 * lq;
                const float v0 = Us[(i0 + 0) * 16 + l15] - acc[0], v1 = Us[(i0 + 1) * 16 + l15] - acc[1], v2 = Us[(i0 + 2) * 16 + l15] - acc[2], v3 = Us[(i0 + 3) * 16 + l15] - acc[3];
                v2u w; w.x = pk2(v0, v1); w.y = pk2(v2, v3); *(LAS v2u*)(VNT + l15 * SC_TLD + i0) = w; }
            __syncthreads();
            if (wave >= 4) { const LAS bf16_t* Ab = ATs + (mt * 16 + l15) * SC_TLD + 8 * lq; const LAS bf16_t* Bb = VNT + l15 * SC_TLD + 8 * lq;
#pragma unroll
                for (int kk = 0; kk < 2; ++kk) acc = __builtin_amdgcn_mfma_f32_16x16x32_bf16(*(const LAS bf16x8*)(Ab + kk * 32), *(const LAS bf16x8*)(Bb + kk * 32), acc, 0, 0, 0);
                if (s >= 4) {
#pragma unroll
                    for (int rg = 0; rg < 4; ++rg) { const int i = mt * 16 + 4 * lq + rg; const int row = base + (dir ? 63 - i : i);
                        Od[(size_t)row * 1024 + h * 128 + n0 + l15] = (bf16_t)f2bf(acc[rg]); } } }
            { f32x4 sn = S * egl; const LAS bf16_t* Ab = KDT + (wave * 16 + l15) * SC_TLD + 8 * lq; const LAS bf16_t* Bb = VNT + l15 * SC_TLD + 8 * lq;
#pragma unroll
              for (int kk = 0; kk < 2; ++kk) sn = __builtin_amdgcn_mfma_f32_16x16x32_bf16(*(const LAS bf16x8*)(Ab + kk * 32), *(const LAS bf16x8*)(Bb + kk * 32), sn, 0, 0, 0);
              S = sn; }
            __syncthreads();
            { v2u w; w.x = pk2(S[0], S[1]); w.y = pk2(S[2], S[3]); *(LAS v2u*)(SBT + l15 * SC_WLD + wave * 16 + 4 * lq) = w; }
        }
        __syncthreads();
    }
}
__device__ __forceinline__ void p7_yb(const Params& p, const Ctx& C) {
    const bf16_t* OF = (const bf16_t*)(p.ws + WS_OF); const bf16_t* OB = (const bf16_t*)(p.ws + WS_OB); const bf16_t* Z = (const bf16_t*)(p.ws + WS_Z); bf16_t* YB = (bf16_t*)(p.ws + WS_YB);
    const long total = (long)ML * 128;
    for (long it = (long)C.vcu * NT_ + C.tid; it < total; it += (long)C.G * NT_) {
        const size_t off = (size_t)it * 8; const int d0 = (int)(off & 127);
        const v4u a = *(const v4u*)(OF + off), bq = *(const v4u*)(OB + off), zz = *(const v4u*)(Z + off);
        float o[8] = {bflo(a.x) + bflo(bq.x), bfhi(a.x) + bfhi(bq.x), bflo(a.y) + bflo(bq.y), bfhi(a.y) + bfhi(bq.y), bflo(a.z) + bflo(bq.z), bfhi(a.z) + bfhi(bq.z), bflo(a.w) + bflo(bq.w), bfhi(a.w) + bfhi(bq.w)};
        float zf[8] = {bflo(zz.x), bfhi(zz.x), bflo(zz.y), bfhi(zz.y), bflo(zz.z), bfhi(zz.z), bflo(zz.w), bfhi(zz.w)};
        float ss = 0.f;
#pragma unroll
        for (int e = 0; e < 8; ++e) ss += o[e] * o[e];
        ss += __shfl_xor(ss, 1); ss += __shfl_xor(ss, 2); ss += __shfl_xor(ss, 4); ss += __shfl_xor(ss, 8);
        const float rstd = rsqrtf(ss * (1.0f / 128.0f) + EPS);
        const f32x4 w0 = *(const f32x4*)(p.dn_norm_w + d0), w1 = *(const f32x4*)(p.dn_norm_w + d0 + 4);
        float y[8];
#pragma unroll
        for (int e = 0; e < 8; ++e) y[e] = o[e] * rstd * (e < 4 ? w0[e] : w1[e - 4]) * siluf(zf[e]);
        v4u w; w.x = pk2(y[0], y[1]); w.y = pk2(y[2], y[3]); w.z = pk2(y[4], y[5]); w.w = pk2(y[6], y[7]);
        *(v4u*)(YB + off) = w;
    }
}
__device__ __forceinline__ float gelu_erf(float v) { return 0.5f * v * (1.0f + erff(v * 0.7071067811865476f)); }
__device__ __forceinline__ float dot8(v4u a, v4u b, float acc) {
    acc += bflo(a.x) * bflo(b.x); acc += bfhi(a.x) * bfhi(b.x); acc += bflo(a.y) * bflo(b.y); acc += bfhi(a.y) * bfhi(b.y);
    acc += bflo(a.z) * bflo(b.z); acc += bfhi(a.z) * bfhi(b.z); acc += bflo(a.w) * bflo(b.w); acc += bfhi(a.w) * bfhi(b.w); return acc;
}
__device__ __forceinline__ void p12_peer(const Params& p, const Ctx& C) {
    const float* SCp = (const float*)(p.ws + WS_SC); const bf16_t* H2 = (const bf16_t*)(p.ws + WS_H2); const bf16_t* UB = (const bf16_t*)(p.ws + WS_UB); const bf16_t* VB = (const bf16_t*)(p.ws + WS_VB);
    const float* MOD = (const float*)(p.ws + CTL_MOD);
    LAS int* IDX = (LAS int*)(C.lds) + C.wave * 128; LAS float* PW = (LAS float*)(C.lds + 8 * 128 * 4) + C.wave * 128;
    const int lane = C.lane, l31 = lane & 31;
    const float NEG = -3.0e38f;
    const int gw = C.vcu * 8 + C.wave, NGW = C.G * 8;
    for (int t = gw; t < ML; t += NGW) {
        for (int h = 0; h < 8; ++h) {
            const f32x4 sv = *(const f32x4*)(SCp + (size_t)t * 2048 + h * 256 + lane * 4);
            float v[4] = {sv.x, sv.y, sv.z, sv.w};
            float ts = NEG; int ti = 0;
            for (int j = 0; j < 16; ++j) {
                float mv = v[0]; int mk = 0;
                if (v[1] > mv) { mv = v[1]; mk = 1; } if (v[2] > mv) { mv = v[2]; mk = 2; } if (v[3] > mv) { mv = v[3]; mk = 3; }
                mk += l31 * 4;
#pragma unroll
                for (int o = 16; o >= 1; o >>= 1) { const float ov = __shfl_xor(mv, o); const int ok = __shfl_xor(mk, o); if (ov > mv || (ov == mv && ok < mk)) { mv = ov; mk = ok; } }
                if ((mk >> 2) == l31) {
#pragma unroll
                    for (int e = 0; e < 4; ++e) if ((mk & 3) == e) v[e] = NEG; }
                if (l31 == j) { ts = mv; ti = mk; }
            }
            const int a = lane >> 2; const float s0 = __shfl(ts, a);
            float cv[4];
#pragma unroll
            for (int e = 0; e < 4; ++e) cv[e] = s0 + __shfl(ts, 32 + 4 * (lane & 3) + e);
            float bs = NEG; int bp = 0;
            for (int j = 0; j < 16; ++j) {
                float mv = cv[0]; int mk = 0;
                if (cv[1] > mv) { mv = cv[1]; mk = 1; } if (cv[2] > mv) { mv = cv[2]; mk = 2; } if (cv[3] > mv) { mv = cv[3]; mk = 3; }
                mk += lane * 4;
#pragma unroll
                for (int o = 32; o >= 1; o >>= 1) { const float ov = __shfl_xor(mv, o); const int ok = __shfl_xor(mk, o); if (ov > mv || (ov == mv && ok < mk)) { mv = ov; mk = ok; } }
                if ((mk >> 2) == lane) {
#pragma unroll
                    for (int e = 0; e < 4; ++e) if ((mk & 3) == e) cv[e] = NEG; }
                if (lane == j) { bs = mv; bp = mk; }
            }
            const int i0 = __shfl(ti, bp >> 4), i1 = __shfl(ti, 32 + (bp & 15));
            const float mx = __shfl(bs, 0);
            float ex = (lane < 16) ? __expf(bs - mx) : 0.f;
            float sm = ex; sm += __shfl_xor(sm, 1); sm += __shfl_xor(sm, 2); sm += __shfl_xor(sm, 4); sm += __shfl_xor(sm, 8);
            if (lane < 16) { IDX[h * 16 + lane] = i0 * 128 + i1; PW[h * 16 + lane] = ex / sm; }
        }
        asm volatile("s_waitcnt lgkmcnt(0)" ::: "memory");
        v4u hx[4];
#pragma unroll
        for (int j = 0; j < 4; ++j) hx[j] = *(const v4u*)(H2 + (size_t)t * 2048 + 8 * lane + 512 * j);
#pragma unroll 2
        for (int s4 = 0; s4 < 128; s4 += 4) {
            v4u ur[4][4];
#pragma unroll
            for (int q = 0; q < 4; ++q) { const size_t e = (size_t)IDX[s4 + q];
#pragma unroll
                for (int j = 0; j < 4; ++j) ur[q][j] = *(const v4u*)(UB + e * 2048 + 8 * lane + 512 * j); }
#pragma unroll
            for (int q = 0; q < 4; ++q) { float d = 0.f;
#pragma unroll
                for (int j = 0; j < 4; ++j) d = dot8(hx[j], ur[q][j], d);
                d = wave_sum(d);
                if (lane == 0) PW[s4 + q] = PW[s4 + q] * gelu_erf(d); }
        }
        asm volatile("s_waitcnt lgkmcnt(0)" ::: "memory");
        float acc[32];
#pragma unroll
        for (int i = 0; i < 32; ++i) acc[i] = 0.f;
#pragma unroll 2
        for (int s4 = 0; s4 < 128; s4 += 4) {
            v4u vr[4][4]; float cf[4];
#pragma unroll
            for (int q = 0; q < 4; ++q) { const size_t e = (size_t)IDX[s4 + q]; cf[q] = PW[s4 + q];
#pragma unroll
                for (int j = 0; j < 4; ++j) vr[q][j] = *(const v4u*)(VB + e * 2048 + 8 * lane + 512 * j); }
#pragma unroll
            for (int q = 0; q < 4; ++q)
#pragma unroll
                for (int j = 0; j < 4; ++j) { const v4u w = vr[q][j]; const float c = cf[q];
                    acc[j * 8 + 0] += c * bflo(w.x); acc[j * 8 + 1] += c * bfhi(w.x); acc[j * 8 + 2] += c * bflo(w.y); acc[j * 8 + 3] += c * bfhi(w.y);
                    acc[j * 8 + 4] += c * bflo(w.z); acc[j * 8 + 5] += c * bfhi(w.z); acc[j * 8 + 6] += c * bflo(w.w); acc[j * 8 + 7] += c * bfhi(w.w); }
        }
        const int b = t >> 13; const float* g2 = MOD + b * 12288 + 10240;
        float* orow = p.out + (size_t)t * 2048; float ss = 0.f;
#pragma unroll
        for (int j = 0; j < 4; ++j)
#pragma unroll
            for (int hf = 0; hf < 2; ++hf) { const int c = 8 * lane + 512 * j + 4 * hf; const f32x4 xv = *(const f32x4*)(orow + c), gv = *(const f32x4*)(g2 + c);
#pragma unroll
                for (int e = 0; e < 4; ++e) { const float y = xv[e] + gv[e] * acc[j * 8 + hf * 4 + e]; acc[j * 8 + hf * 4 + e] = y; ss += y * y; } }
        const float rstd = rsqrtf(wave_sum(ss) * (1.0f / DM) + EPS);
#pragma unroll
        for (int j = 0; j < 4; ++j)
#pragma unroll
            for (int hf = 0; hf < 2; ++hf) { const int c = 8 * lane + 512 * j + 4 * hf; const f32x4 fw = *(const f32x4*)(p.final_w + c);
                f32x4 o;
#pragma unroll
                for (int e = 0; e < 4; ++e) o[e] = acc[j * 8 + hf * 4 + e] * rstd * fw[e];
                *(f32x4*)(orow + c) = o; }
        asm volatile("s_waitcnt lgkmcnt(0)" ::: "memory");
    }
}
__device__ __forceinline__ void cvt_rows(const Ctx& C, const float* src, bf16_t* dst, long n8) {
    for (long i = (long)C.vcu * NT_ + C.tid; i < n8; i += (long)C.G * NT_) { const f32x4 a = *(const f32x4*)(src + i * 8), b = *(const f32x4*)(src + i * 8 + 4);
        v4u w; w.x = pk2(a.x, a.y); w.y = pk2(a.z, a.w); w.z = pk2(b.x, b.y); w.w = pk2(b.z, b.w); *(v4u*)(dst + i * 8) = w; }
}
constexpr int LDS_BYTES = 147456;
constexpr int N_PHASES = 13;
constexpr int LDS_MISC = LDS_BYTES - 64;
__global__ void __launch_bounds__(NT_, 2) mega_fwd(Params p_arg) {
    extern __shared__ __attribute__((aligned(16))) unsigned char lds_raw[];
    const int wave_s = __builtin_amdgcn_readfirstlane((int)threadIdx.x >> 6);
    const int G_s = gridDim.x, bx_s = blockIdx.x, vcu_s = (G_s % 8 == 0) ? (bx_s % 8) * (G_s / 8) + bx_s / 8 : bx_s;
#define MKCTX() Ctx C; { unsigned m_ = ~0u; asm volatile("" : "+s"(m_)); C.lane = (int)__builtin_amdgcn_mbcnt_hi(m_, __builtin_amdgcn_mbcnt_lo(m_, 0u)); } \
    C.lds = (LAS unsigned char*)lds_raw; C.wave = wave_s; C.tid = wave_s * 64 + C.lane; C.G = G_s; C.vcu = vcu_s
    const int lo = p_arg.ph_lo, hi = p_arg.ph_hi;
#if defined(__HIP_DEVICE_COMPILE__)
#define LOADP() MKCTX(); typedef const __attribute__((address_space(4))) Params* CPP_; CPP_ kp_ = (CPP_)__builtin_amdgcn_kernarg_segment_ptr(); asm volatile("" : "+s"(kp_)); const Params p = *kp_; \
    unsigned char* ws = p.ws; const float* MOD = (const float*)(ws + CTL_MOD); (void)MOD
#else
#define LOADP() MKCTX(); const Params p = p_arg; unsigned char* ws = p.ws; const float* MOD = (const float*)(ws + CTL_MOD); (void)MOD
#endif
#ifndef PH_MASK
#define PH_MASK 0xffff
#endif
#define IN(k) (((PH_MASK >> (k)) & 1) && lo <= (k) && (k) < hi)
#define SEAM(k) do { if (IN(k) && IN((k) + 1)) { LOADP(); XcdBarrier b_; b_.bar = (unsigned*)(ws + CTL_BAR); b_.x = xb_xcc_id(); b_.st = (volatile LAS unsigned*)(C.lds + LDS_MISC); xcd_barrier(b_, C.tid); } } while (0)
    if (hi - lo > 1) { LOADP(); if (C.tid < 2) ((volatile LAS unsigned*)(C.lds + LDS_MISC))[C.tid] = 0u; __syncthreads();
        (void)xcd_barrier_post((unsigned*)(ws + CTL_BAR), (volatile LAS unsigned*)(C.lds + LDS_MISC), C.tid); }
    if (IN(0)) { LOADP(); p0_prologue(p, C); } SEAM(0);
    if (IN(1)) { LOADP();
        bf16_t* H = (bf16_t*)(ws + WS_D);
        mod_norm_rows(C, p.x, SEQ, p.norm1_w, MOD, MOD + 2048, H);
        mod_norm_rows(C, p.x + (size_t)SEQ * DM, SEQ, p.norm1_w, MOD + 12288, MOD + 12288 + 2048, H + (size_t)SEQ * DM);
        mod_norm_rows(C, p.ctx, MC, p.norm1_w, MOD + 2 * 12288, MOD + 2 * 12288 + 2048, H + (size_t)ML * DM);
    } SEAM(1);
    if (IN(2)) { LOADP();
        pg8::Gemm g{(const bf16_t*)(ws + WS_D), (const bf16_t*)(ws + WS_C), M1, NIN_PAD, DM}; pg8::StaticOrder S; S.init(M1, NIN_PAD, C.G, (int)blockIdx.x);
        pg8::EpiIn E{(bf16_t*)(ws + WS_CQ), (bf16_t*)(ws + WS_CKV), (bf16_t*)(ws + WS_QKV), (bf16_t*)(ws + WS_Z), (bf16_t*)(ws + WS_GA), (bf16_t*)(ws + WS_GB),
                     (float*)(ws + WS_KR), (float*)(ws + WS_AB), (float*)(ws + CTL_SSQQ), (float*)(ws + CTL_SSQKV)};
        pg8::gemm_phase<pg8::EpiIn, pg8::StaticOrder, true, true>(C.lds, g, S, E, C.tid);
    } SEAM(2);
    if (IN(3)) {
        { LOADP(); pg8::Gemm g{(const bf16_t*)(ws + WS_CQ), (const bf16_t*)(ws + WS_WUQ), ML, 1536, 512}; pg8::StaticOrder S; S.init(ML, 1536, C.G, (int)blockIdx.x);
          pg8::EpiQ E{(bf16_t*)(ws + WS_D), (const float*)(ws + CTL_SSQQ), QSCALE};
          pg8::gemm_phase<pg8::EpiQ, pg8::StaticOrder, true, true>(C.lds, g, S, E, C.tid); }
        { LOADP(); pg8::Gemm g{(const bf16_t*)(ws + WS_CKV), (const bf16_t*)(ws + WS_WUKV), M1, 2048, 256}; pg8::StaticOrder S; S.init(M1, 2048, C.G, (int)blockIdx.x);
          pg8::EpiKV E{(bf16_t*)(ws + WS_K), (bf16_t*)(ws + WS_C), (const float*)(ws + CTL_SSQKV)};
          pg8::gemm_phase<pg8::EpiKV, pg8::StaticOrder, true, true>(C.lds, g, S, E, C.tid); }
        { LOADP(); p3_conv(p, C); }
        { LOADP(); p3_krope_gbeta(p, C); }
    } SEAM(3);
    if (IN(4)) { LOADP();
        const bf16_t* Q = (const bf16_t*)(ws + WS_D); const bf16_t* K = (const bf16_t*)(ws + WS_K); const bf16_t* V = (const bf16_t*)(ws + WS_C); bf16_t* YA = (bf16_t*)(ws + WS_YA);
        for (int u = C.vcu; u < 512; u += C.G) { const int bh = u >> 5, qb = u & 31, b = bh >> 3, h = bh & 7;
            attn::attn_unit(Q + ((size_t)bh * SEQ + qb * 256) * 192, K + (size_t)bh * LKV * 192, V + (size_t)bh * LKV * 128,
                            YA + ((size_t)b * SEQ + qb * 256) * 1024 + h * 128, 1024, LKV, (char*)lds_raw, C.tid); }
    } SEAM(4);
    if (IN(5)) { LOADP(); p5_chunk_prep(p, C); } SEAM(5);
    if (IN(6)) { LOADP(); p6_scan(p, C); } SEAM(6);
    if (IN(7)) { LOADP(); p7_yb(p, C); } SEAM(7);
    if (IN(8)) {
        { LOADP(); pg8::Gemm g{(const bf16_t*)(ws + WS_YA), (const bf16_t*)(ws + WS_WBA), ML, 2048, 1024}; pg8::StaticOrder S; S.init(ML, 2048, C.G, (int)blockIdx.x);
          pg8::EpiMerge<true> E{(const bf16_t*)(ws + WS_GA), (bf16_t*)(ws + WS_MG)};
          pg8::gemm_phase<pg8::EpiMerge<true>, pg8::StaticOrder, true, true>(C.lds, g, S, E, C.tid); }
        { LOADP(); pg8::Gemm g{(const bf16_t*)(ws + WS_YB), (const bf16_t*)(ws + WS_WBB), ML, 2048, 1024}; pg8::StaticOrder S; S.init(ML, 2048, C.G, (int)blockIdx.x);
          pg8::EpiMerge<false> E{(const bf16_t*)(ws + WS_GB), (bf16_t*)(ws + WS_MG)};
          pg8::gemm_phase<pg8::EpiMerge<false>, pg8::StaticOrder, true, true>(C.lds, g, S, E, C.tid); }
    } SEAM(8);
    if (IN(9)) { LOADP();
        pg8::Gemm g{(const bf16_t*)(ws + WS_MG), (const bf16_t*)(ws + WS_WOUT), ML, 2048, 2048}; pg8::StaticOrder S; S.init(ML, 2048, C.G, (int)blockIdx.x);
        pg8::EpiOut E{p.x, MOD + 4096, p.out};
        pg8::gemm_phase<pg8::EpiOut, pg8::StaticOrder, true, true>(C.lds, g, S, E, C.tid);
    } SEAM(9);
    if (IN(10)) { LOADP();
        bf16_t* H2 = (bf16_t*)(ws + WS_H2);
        mod_norm_rows(C, p.out, SEQ, p.norm2_w, MOD + 6144, MOD + 8192, H2);
        mod_norm_rows(C, p.out + (size_t)SEQ * DM, SEQ, p.norm2_w, MOD + 12288 + 6144, MOD + 12288 + 8192, H2 + (size_t)SEQ * DM);
        cvt_rows(C, p.peer_u, (bf16_t*)(ws + WS_UB), (long)16384 * 2048 / 8);
        cvt_rows(C, p.peer_v, (bf16_t*)(ws + WS_VB), (long)16384 * 2048 / 8);
    } SEAM(10);
    if (IN(11)) { LOADP();
        pg8::Gemm g{(const bf16_t*)(ws + WS_H2), (const bf16_t*)(ws + WS_WPQ), ML, 2048, 2048}; pg8::StaticOrder S; S.init(ML, 2048, C.G, (int)blockIdx.x);
        pg8::EpiScore E{(float*)(ws + WS_SC)};
        pg8::gemm_phase<pg8::EpiScore, pg8::StaticOrder, true, true>(C.lds, g, S, E, C.tid);
    } SEAM(11);
    if (IN(12)) { LOADP(); p12_peer(p, C); }
#undef IN
#undef SEAM
}

#ifndef MK_SINGLE
#define MK_SINGLE 1
#endif
extern "C" void kernel_launch(void* const* d_in, const int* in_sizes, int n_in, void* d_out, int out_size, void* d_ws, size_t ws_size, hipStream_t stream) {
    static int grid = 0;
    if (grid == 0) {
        if (n_in != 25 || out_size != ML * DM || ws_size < WS_END) { fprintf(stderr, "kernel_launch: unexpected shapes: n_in %d out %d ws %zu (need %zu)\n", n_in, out_size, ws_size, (size_t)WS_END); grid = -1; return; }
        int dev = 0, cus = 0, per_cu = 0;
        if (hipGetDevice(&dev) != hipSuccess || hipDeviceGetAttribute(&cus, hipDeviceAttributeMultiprocessorCount, dev) != hipSuccess) { grid = -1; return; }
        if (hipFuncSetAttribute((const void*)mega_fwd, hipFuncAttributeMaxDynamicSharedMemorySize, LDS_BYTES) != hipSuccess) { fprintf(stderr, "kernel_launch: hipFuncSetAttribute failed\n"); grid = -1; return; }
        if (hipOccupancyMaxActiveBlocksPerMultiprocessor(&per_cu, (const void*)mega_fwd, NT_, LDS_BYTES) != hipSuccess || per_cu < 1) { fprintf(stderr, "kernel_launch: occupancy query says %d\n", per_cu); per_cu = 1; }
        (void)hipGetLastError();
        grid = cus;
    }
    if (grid < 0) return;
    (void)hipMemsetAsync((char*)d_ws + WS_CTL, 0, CTL_BYTES, stream);
    Params p{};
    const float** pp = (const float**)&p;
    for (int i = 0; i < 25; ++i) pp[i] = (const float*)d_in[i];
    p.out = (float*)d_out; p.ws = (unsigned char*)d_ws;
#if MK_SINGLE
    p.ph_lo = 0; p.ph_hi = N_PHASES;
    hipLaunchKernelGGL(mega_fwd, dim3(grid), dim3(NT_), LDS_BYTES, stream, p);
#else
    for (int ph = 0; ph < N_PHASES; ++ph) { p.ph_lo = ph; p.ph_hi = ph + 1; hipLaunchKernelGGL(mega_fwd, dim3(grid), dim3(NT_), LDS_BYTES, stream, p); }
#endif
}
```

```cpp
#include <hip/hip_runtime.h>
#include <hip/hip_bf16.h>
#include <cstdio>
#include <cstdint>
#include <cmath>
namespace pg8 {
#define PG8_LAS __attribute__((address_space(3)))
typedef unsigned short bf16_t;
typedef short bf16x8 __attribute__((ext_vector_type(8)));
typedef float f32x4 __attribute__((ext_vector_type(4)));
typedef unsigned u32x4 __attribute__((ext_vector_type(4)));
constexpr int BM = 256, BK = 64, HALF = 128, HTB = HALF * BK * 2  , STAGE_BYTES = 8 * HTB, NXCD = 8, WGM = 8;

__host__ __device__ __forceinline__ int lds_byte(int r, int c) { const int st = (r >> 4) * 2 + (c >> 5), rr = r & 15, cc = c & 31, ob = rr * 64 + cc * 2; return st * 1024 + (ob ^ (((ob >> 9) & 1) << 5)); }
__host__ __device__ __forceinline__ void stage_rc(int b, int& R, int& C) { const int st = b / 1024, sb = b % 1024, swz = sb ^ (((sb >> 9) & 1) << 5); R = (st >> 1) * 16 + swz / 64; C = (st & 1) * 32 + (swz % 64) / 2; }
__host__ __device__ __forceinline__ int perm32(int rho) { const int n = rho >> 4, i = rho & 15; return 8 * (i >> 2) + 4 * n + (i & 3); }

struct Unit { int pm, pn; };
struct Gemm { const bf16_t* A; const bf16_t* Bt; int M, N, K; };

struct StaticOrder {
    int nM, nN, nwg, G, c;
    __host__ __device__ void init(int M, int N, int G_, int c_) { nM = M / BM; nN = N / BM; nwg = nM * nN; G = G_; c = c_; }
    __host__ __device__ bool next(int i, Unit& u) const {
        const long L = (long)i * G + c; if (L >= nwg) return false;
        int wgid = (int)L; { const int q = nwg / NXCD, r = nwg % NXCD, xcd = wgid % NXCD, off = wgid / NXCD; wgid = (xcd < r ? xcd * (q + 1) : r * (q + 1) + (xcd - r) * q) + off; }
        const int nig = WGM * nN, gid = wgid / nig, fm = gid * WGM, gsz = (nM - fm) < WGM ? (nM - fm) : WGM;
        u.pm = fm + ((wgid % nig) % gsz); u.pn = (wgid % nig) / gsz; return true;
    }
    __device__ __forceinline__ void a_ready(const Unit&) const {}
    __device__ __forceinline__ void done(const Unit&) const {}
};
typedef float f32x2 __attribute__((ext_vector_type(2)));
__device__ __forceinline__ unsigned cvt_pk_bf16(float lo, float hi) { unsigned r; asm volatile("v_cvt_pk_bf16_f32 %0, %1, %2" : "=v"(r) : "v"(lo), "v"(hi)); return r; }
template <class Epi, class Sched, bool ALIGN_EPI = false, bool SP2 = false>
__device__ __forceinline__ void gemm_phase(PG8_LAS unsigned char* lds, const Gemm g, const Sched& S, const Epi& E, const int tid) {
    const int wid = __builtin_amdgcn_readfirstlane(tid >> 6), lane = tid & 63, wr = wid >> 2, wc = wid & 3, fr = lane & 15, fq = lane >> 4;
    const int K = g.K, nt = K / BK;
    unsigned voffA[2], voffB[2];
#pragma unroll
    for (int i = 0; i < 2; ++i) { int R, C; stage_rc(tid * 16 + i * 8192, R, C); const int Rb = Epi::PERM ? ((R & ~31) + perm32(R & 31)) : R;
        voffA[i] = (unsigned)(R * K + C) * 2u; voffB[i] = (unsigned)(Rb * K + C) * 2u; }
    const size_t kstep = (size_t)(BK * 2);
    const size_t hstep = (size_t)HALF * K * 2;
    const size_t tstep = 2 * hstep;
    const unsigned ldsw = (unsigned)wid * 1024u;
    const int aoff = lds_byte(wr * 64 + fr, fq * 8), boff = lds_byte(wc * 32 + fr, fq * 8);
#define PG8_SA(b, h) (((b) * 2 + (h)) * HTB)
#define PG8_SB(b, h) ((4 + (b) * 2 + (h)) * HTB)
#define PG8_STAGE(bufoff, gbase, voff) do { _Pragma("unroll") for (int _i = 0; _i < 2; ++_i) \
        __builtin_amdgcn_global_load_lds((const unsigned*)((const char*)(gbase) + (voff)[_i]), (PG8_LAS unsigned*)(lds + (bufoff) + ldsw + _i * 8192), 16, 0, 0); } while (0)
#define PG8_LDA(dst, b, h) do { _Pragma("unroll") for (int m = 0; m < 4; ++m) _Pragma("unroll") for (int k = 0; k < 2; ++k) dst[m][k] = *(const PG8_LAS bf16x8*)(lds + PG8_SA(b, h) + aoff + m * 2048 + k * 1024); } while (0)
#define PG8_LDB(dst, b, h) do { _Pragma("unroll") for (int n = 0; n < 2; ++n) _Pragma("unroll") for (int k = 0; k < 2; ++k) dst[n][k] = *(const PG8_LAS bf16x8*)(lds + PG8_SB(b, h) + boff + n * 2048 + k * 1024); } while (0)
#define PG8_MMA(ai, bj, At, Bt) do { __builtin_amdgcn_s_setprio(1); _Pragma("unroll") for (int m = 0; m < 4; ++m) _Pragma("unroll") for (int n = 0; n < 2; ++n) _Pragma("unroll") for (int k = 0; k < 2; ++k) \
        acc[ai][bj][m][n] = __builtin_amdgcn_mfma_f32_16x16x32_bf16(Bt[n][k], At[m][k], acc[ai][bj][m][n], 0, 0, 0); __builtin_amdgcn_s_setprio(0); } while (0)
#define PG8_WAIT_V(n) asm volatile("s_waitcnt vmcnt(" #n ")" ::: "memory")
#define PG8_WAIT_L(n) asm volatile("s_waitcnt lgkmcnt(" #n ")" ::: "memory")
#define PG8_BAR __builtin_amdgcn_s_barrier()
#define PG8_SCHED __builtin_amdgcn_sched_barrier(0)
    Unit cur, nxt; int ui = 0;
    if (!S.next(0, cur)) return;
    f32x4 acc[2][2][4][2];
#pragma unroll
    for (int a = 0; a < 2; ++a)
#pragma unroll
        for (int b = 0; b < 2; ++b)
#pragma unroll
            for (int m = 0; m < 4; ++m)
#pragma unroll
                for (int n = 0; n < 2; ++n) acc[a][b][m][n] = (f32x4){0.f, 0.f, 0.f, 0.f};
    bf16x8 At[4][2], B0[2][2], B1[2][2];
    const char* cA = (const char*)g.A + (size_t)cur.pm * tstep; const char* cB = (const char*)g.Bt + (size_t)cur.pn * tstep;
    S.a_ready(cur);
    if constexpr (SP2) {
        PG8_STAGE(PG8_SB(0, 0), cB, voffB); PG8_STAGE(PG8_SB(0, 1), cB + hstep, voffB); PG8_STAGE(PG8_SA(0, 0), cA, voffA); PG8_STAGE(PG8_SA(0, 1), cA + hstep, voffA);
        if (wr == 1) PG8_BAR;
        PG8_WAIT_V(2); PG8_BAR;
        PG8_STAGE(PG8_SB(1, 0), cB + kstep, voffB); PG8_STAGE(PG8_SA(1, 0), cA + kstep, voffA); PG8_STAGE(PG8_SB(1, 1), cB + hstep + kstep, voffB);
        PG8_WAIT_V(6); PG8_BAR;
    } else {
        PG8_STAGE(PG8_SB(0, 0), cB, voffB); PG8_STAGE(PG8_SA(0, 0), cA, voffA); PG8_STAGE(PG8_SB(0, 1), cB + hstep, voffB); PG8_STAGE(PG8_SA(0, 1), cA + hstep, voffA);
        if (wr == 1) PG8_BAR;
        PG8_WAIT_V(4); PG8_BAR;
        PG8_STAGE(PG8_SB(1, 0), cB + kstep, voffB); PG8_STAGE(PG8_SA(1, 0), cA + kstep, voffA); PG8_STAGE(PG8_SB(1, 1), cB + hstep + kstep, voffB);
        PG8_WAIT_V(6); PG8_BAR;
    }
    for (;;) {
        const bool has_next = S.next(ui + 1, nxt);
        const char* nA = has_next ? (const char*)g.A + (size_t)nxt.pm * tstep : cA; const char* nB = has_next ? (const char*)g.Bt + (size_t)nxt.pn * tstep : cB;
        for (int t = 0; t < nt; t += 2) {
            const bool last = (t == nt - 2);
            const char* a1 = cA + (size_t)(t + 1) * kstep;
            const char* a2 = last ? nA : cA + (size_t)(t + 2) * kstep; const char* b2 = last ? nB : cB + (size_t)(t + 2) * kstep;
            const char* a3 = a2 + kstep; const char* b3 = b2 + kstep;
            if (last && has_next) S.a_ready(nxt);
            if constexpr (SP2) {
            PG8_LDB(B0, 0, 0); PG8_LDB(B1, 0, 1); PG8_SCHED; PG8_LDA(At, 0, 0); PG8_STAGE(PG8_SA(1, 1), a1 + hstep, voffA);
            PG8_WAIT_V(8); PG8_WAIT_L(0); PG8_BAR; PG8_MMA(0, 0, At, B0); PG8_MMA(0, 1, At, B1); PG8_BAR; PG8_SCHED;
            PG8_LDA(At, 0, 1); PG8_STAGE(PG8_SB(0, 0), b2, voffB); PG8_STAGE(PG8_SB(0, 1), b2 + hstep, voffB); PG8_STAGE(PG8_SA(0, 0), a2, voffA);
            PG8_WAIT_V(8); PG8_WAIT_L(0); PG8_BAR; PG8_MMA(1, 0, At, B0); PG8_MMA(1, 1, At, B1); PG8_BAR; PG8_SCHED;
            PG8_LDB(B0, 1, 0); PG8_LDB(B1, 1, 1); PG8_SCHED; PG8_LDA(At, 1, 0); PG8_STAGE(PG8_SA(0, 1), a2 + hstep, voffA);
            PG8_WAIT_V(8); PG8_WAIT_L(0); PG8_BAR; PG8_MMA(0, 0, At, B0); PG8_MMA(0, 1, At, B1); PG8_BAR; PG8_SCHED;
            PG8_LDA(At, 1, 1); PG8_STAGE(PG8_SB(1, 0), b3, voffB); PG8_STAGE(PG8_SB(1, 1), b3 + hstep, voffB); PG8_STAGE(PG8_SA(1, 0), a3, voffA);
            PG8_WAIT_V(8); PG8_WAIT_L(0); PG8_BAR; PG8_MMA(1, 0, At, B0); PG8_MMA(1, 1, At, B1); PG8_BAR; PG8_SCHED;
            } else {
            PG8_LDB(B0, 0, 0); PG8_SCHED; PG8_LDA(At, 0, 0); PG8_STAGE(PG8_SA(1, 1), a1 + hstep, voffA);
            PG8_WAIT_L(8); PG8_BAR; PG8_WAIT_L(0); PG8_MMA(0, 0, At, B0); PG8_BAR; PG8_SCHED;
            PG8_LDB(B1, 0, 1); PG8_STAGE(PG8_SB(0, 0), b2, voffB);
            PG8_BAR; PG8_WAIT_L(0); PG8_MMA(0, 1, At, B1); PG8_BAR;
            PG8_LDA(At, 0, 1); PG8_STAGE(PG8_SA(0, 0), a2, voffA);
            PG8_BAR; PG8_WAIT_L(0); PG8_MMA(1, 0, At, B0); PG8_BAR; PG8_SCHED;
            PG8_STAGE(PG8_SB(0, 1), b2 + hstep, voffB);
            PG8_WAIT_V(6); PG8_BAR; PG8_MMA(1, 1, At, B1); PG8_BAR;
            PG8_LDB(B0, 1, 0); PG8_SCHED; PG8_LDA(At, 1, 0); PG8_STAGE(PG8_SA(0, 1), a2 + hstep, voffA);
            PG8_WAIT_L(8); PG8_BAR; PG8_WAIT_L(0); PG8_MMA(0, 0, At, B0); PG8_BAR; PG8_SCHED;
            PG8_LDB(B1, 1, 1); PG8_STAGE(PG8_SB(1, 0), b3, voffB);
            PG8_BAR; PG8_WAIT_L(0); PG8_MMA(0, 1, At, B1); PG8_BAR;
            PG8_LDA(At, 1, 1); PG8_STAGE(PG8_SA(1, 0), a3, voffA);
            PG8_BAR; PG8_WAIT_L(0); PG8_MMA(1, 0, At, B0); PG8_BAR; PG8_SCHED;
            PG8_STAGE(PG8_SB(1, 1), b3 + hstep, voffB);
            PG8_WAIT_V(6); PG8_BAR; PG8_MMA(1, 1, At, B1); PG8_BAR;
            }
        }
        if constexpr (ALIGN_EPI) { if (wr == 0) PG8_BAR; }
        if constexpr (!Epi::AFTER_DRAIN) { E(acc, cur, wr, wc, fr, fq); S.done(cur); }
        if (!has_next) break;
#pragma unroll
        for (int a = 0; a < 2; ++a)
#pragma unroll
            for (int b = 0; b < 2; ++b)
#pragma unroll
                for (int m = 0; m < 4; ++m)
#pragma unroll
                    for (int n = 0; n < 2; ++n) acc[a][b][m][n] = (f32x4){0.f, 0.f, 0.f, 0.f};
        cur = nxt; cA = nA; cB = nB; ++ui;
        if constexpr (ALIGN_EPI) { if (wr == 1) PG8_BAR; }
    }
    PG8_WAIT_V(0);
    if constexpr (!ALIGN_EPI) { if (wr == 0) PG8_BAR; }
    PG8_BAR;
    if constexpr (Epi::AFTER_DRAIN) { E.fused(acc, cur, wr, wc, fr, fq, lds, wid, lane); S.done(cur); }
#undef PG8_SA
#undef PG8_SB
#undef PG8_STAGE
#undef PG8_LDA
#undef PG8_LDB
#undef PG8_MMA
#undef PG8_WAIT_V
#undef PG8_WAIT_L
#undef PG8_BAR
#undef PG8_SCHED
}
__device__ __forceinline__ float bfu(unsigned short v) { return __uint_as_float(((unsigned)v) << 16); }
__device__ __forceinline__ void fast_sincos(float x, float& sn, float& cs) {
    float rev = x * 0.15915494309189535f; rev -= rintf(rev); sn = __builtin_amdgcn_sinf(rev); cs = __builtin_amdgcn_cosf(rev); }
__device__ __forceinline__ float sigm(float v) { return 1.0f / (1.0f + __expf(-v)); }
__device__ __forceinline__ void store_tile_bf16(const f32x4 (&acc)[2][2][4][2], bf16_t* tile  , int ld, int wr, int wc, int fr, int fq) {
#pragma unroll
    for (int ai = 0; ai < 2; ++ai)
#pragma unroll
        for (int m = 0; m < 4; ++m) { bf16_t* rowp = tile + (size_t)(ai * HALF + wr * 64 + m * 16 + fr) * ld + wc * 32 + 8 * fq;
#pragma unroll
            for (int bj = 0; bj < 2; ++bj) { const f32x4 v0 = acc[ai][bj][m][0], v1 = acc[ai][bj][m][1];
                u32x4 w; w.x = cvt_pk_bf16(v0[0], v0[1]); w.y = cvt_pk_bf16(v0[2], v0[3]); w.z = cvt_pk_bf16(v1[0], v1[1]); w.w = cvt_pk_bf16(v1[2], v1[3]);
                *(u32x4*)(rowp + bj * HALF) = w; } }
}
__device__ __forceinline__ void tile_ssq(const f32x4 (&acc)[2][2][4][2], float* ssq  , int nslot, int slot, int wr, int fr, int fq) {
#pragma unroll
    for (int ai = 0; ai < 2; ++ai)
#pragma unroll
        for (int m = 0; m < 4; ++m) { float s = 0.f;
#pragma unroll
            for (int bj = 0; bj < 2; ++bj)
#pragma unroll
                for (int n = 0; n < 2; ++n) { const f32x4 x = acc[ai][bj][m][n]; s += (x[0] * x[0] + x[1] * x[1]) + (x[2] * x[2] + x[3] * x[3]); }
            s += __shfl_xor(s, 16); s += __shfl_xor(s, 32);
            if (fq == 0) ssq[(size_t)(ai * HALF + wr * 64 + m * 16 + fr) * nslot + slot] = s; }
}
struct EpiIn {
    static constexpr bool PERM = true, AFTER_DRAIN = false;
    bf16_t *CQ, *CKV, *QKV, *Z, *GA, *GB; float *KR, *AB, *ssq_q, *ssq_kv;
    __device__ __forceinline__ void operator()(const f32x4 (&acc)[2][2][4][2], const Unit& u, int wr, int wc, int fr, int fq) const {
        const int pn = u.pn, pm = u.pm; const size_t r0 = (size_t)pm * BM;
        const bool lat = pm < 64;
        if (pn == 35) {
            const int cl = wc * 32 + 8 * fq;
            if (cl < 96) {
#pragma unroll
                for (int ai = 0; ai < 2; ++ai)
#pragma unroll
                    for (int m = 0; m < 4; ++m) { const size_t r = r0 + ai * HALF + wr * 64 + m * 16 + fr;
                        float* dst = (cl < 64) ? (KR + r * 64 + cl) : (AB + r * 32 + (cl - 64));
                        *(f32x4*)dst = acc[ai][0][m][0]; *(f32x4*)(dst + 4) = acc[ai][0][m][1]; }
            }
            return;
        }
        bf16_t* base; int ld; bool latonly = true; float* ssq = nullptr; int nslot = 4, slot = wc;
        if (pn < 2) { base = CQ + pn * 256; ld = 512; ssq = ssq_q; nslot = 8; slot = pn * 4 + wc; }
        else if (pn == 2) { base = CKV; ld = 256; ssq = ssq_kv; latonly = false; }
        else if (pn < 15) { base = QKV + (pn - 3) * 256; ld = 3072; latonly = false; }
        else if (pn < 19) { base = Z + (pn - 15) * 256; ld = 1024; }
        else if (pn < 27) { base = GA + (pn - 19) * 256; ld = 2048; }
        else { base = GB + (pn - 27) * 256; ld = 2048; }
        if (latonly && !lat) return;
        store_tile_bf16(acc, base + r0 * ld, ld, wr, wc, fr, fq);
        if (ssq) tile_ssq(acc, ssq + r0 * nslot, nslot, slot, wr, fr, fq);
    }
};
struct EpiQ {
    static constexpr bool PERM = true, AFTER_DRAIN = false;
    bf16_t* Q; const float* ssq_q; float qscale;
    __device__ __forceinline__ void operator()(const f32x4 (&acc)[2][2][4][2], const Unit& u, int wr, int wc, int fr, int fq) const {
        const int pn = u.pn;
#pragma unroll
        for (int ai = 0; ai < 2; ++ai)
#pragma unroll
            for (int m = 0; m < 4; ++m) {
                const int r = u.pm * BM + ai * HALF + wr * 64 + m * 16 + fr; const int b = r >> 13, t = r & 8191;
                const f32x4 sa = *(const f32x4*)(ssq_q + (size_t)r * 8), sb = *(const f32x4*)(ssq_q + (size_t)r * 8 + 4);
                const float rs = rsqrtf((((sa[0] + sa[1]) + (sa[2] + sa[3])) + ((sb[0] + sb[1]) + (sb[2] + sb[3]))) * (1.0f / 512.0f) + 1e-6f) * qscale;
#pragma unroll
                for (int bj = 0; bj < 2; ++bj) {
                    f32x4 v0 = acc[ai][bj][m][0] * rs, v1 = acc[ai][bj][m][1] * rs;
                    bf16_t* dst;
                    if (pn < 4) { const int head = pn * 2 + bj; dst = Q + ((size_t)(b * 8 + head) * 8192 + t) * 192 + wc * 32 + 8 * fq; }
                    else {
                        const int head = (pn - 4) * 4 + bj * 2 + (wc >> 1), half = wc & 1;
                        const float pos = (float)(half == 0 ? (t >> 6) : (t & 63));
                        const int i0 = (8 * fq) & 15;
                        float xs[8] = {v0[0], v0[1], v0[2], v0[3], v1[0], v1[1], v1[2], v1[3]};
#pragma unroll
                        for (int e = 0; e < 8; ++e) {
                            const float other = __shfl_xor(xs[e], 32);
                            const float invf = exp2f(-(float)(i0 + e) * (13.287712379549449f / 16.0f));
                            float sn, cs; fast_sincos(pos * invf, sn, cs);
                            xs[e] = (fq < 2) ? (xs[e] * cs - other * sn) : (other * sn + xs[e] * cs);
                        }
                        v0 = (f32x4){xs[0], xs[1], xs[2], xs[3]}; v1 = (f32x4){xs[4], xs[5], xs[6], xs[7]};
                        dst = Q + ((size_t)(b * 8 + head) * 8192 + t) * 192 + 128 + half * 32 + 8 * fq;
                    }
                    u32x4 w; w.x = cvt_pk_bf16(v0[0], v0[1]); w.y = cvt_pk_bf16(v0[2], v0[3]); w.z = cvt_pk_bf16(v1[0], v1[1]); w.w = cvt_pk_bf16(v1[2], v1[3]);
                    *(u32x4*)dst = w;
                }
            }
    }
};
struct EpiKV {
    static constexpr bool PERM = true, AFTER_DRAIN = false;
    bf16_t *K, *V; const float* ssq_kv;
    __device__ __forceinline__ void operator()(const f32x4 (&acc)[2][2][4][2], const Unit& u, int wr, int wc, int fr, int fq) const {
        const int head = u.pn;
#pragma unroll
        for (int ai = 0; ai < 2; ++ai)
#pragma unroll
            for (int m = 0; m < 4; ++m) {
                const int r = u.pm * BM + ai * HALF + wr * 64 + m * 16 + fr;
                int b, l; if (r < 16384) { b = r >> 13; l = 256 + (r & 8191); } else { b = (r - 16384) >> 8; l = (r - 16384) & 255; }
                const f32x4 sa = *(const f32x4*)(ssq_kv + (size_t)r * 4);
                const float rs = rsqrtf(((sa[0] + sa[1]) + (sa[2] + sa[3])) * (1.0f / 256.0f) + 1e-6f);
                const size_t rowi = (size_t)(b * 8 + head) * 8448 + l;
#pragma unroll
                for (int bj = 0; bj < 2; ++bj) {
                    const f32x4 v0 = acc[ai][bj][m][0] * rs, v1 = acc[ai][bj][m][1] * rs;
                    bf16_t* dst = (bj == 0) ? (K + rowi * 192 + wc * 32 + 8 * fq) : (V + rowi * 128 + wc * 32 + 8 * fq);
                    u32x4 w; w.x = cvt_pk_bf16(v0[0], v0[1]); w.y = cvt_pk_bf16(v0[2], v0[3]); w.z = cvt_pk_bf16(v1[0], v1[1]); w.w = cvt_pk_bf16(v1[2], v1[3]);
                    *(u32x4*)dst = w;
                }
            }
    }
};
template <bool FIRST> struct EpiMerge {
    static constexpr bool PERM = true, AFTER_DRAIN = false;
    const bf16_t* G; bf16_t* MG; bf16_t* MGA;
    __device__ __forceinline__ void operator()(const f32x4 (&acc)[2][2][4][2], const Unit& u, int wr, int wc, int fr, int fq) const {
#pragma unroll
        for (int ai = 0; ai < 2; ++ai)
#pragma unroll
            for (int m = 0; m < 4; ++m) {
                const size_t off = (size_t)(u.pm * BM + ai * HALF + wr * 64 + m * 16 + fr) * 2048 + u.pn * BM + wc * 32 + 8 * fq;
#pragma unroll
                for (int bj = 0; bj < 2; ++bj) {
                    const u32x4 g = *(const u32x4*)(G + off + bj * HALF);
                    float gv[8] = {__uint_as_float(g.x << 16), __uint_as_float(g.x & 0xffff0000u), __uint_as_float(g.y << 16), __uint_as_float(g.y & 0xffff0000u),
                                   __uint_as_float(g.z << 16), __uint_as_float(g.z & 0xffff0000u), __uint_as_float(g.w << 16), __uint_as_float(g.w & 0xffff0000u)};
                    float o[8];
#pragma unroll
                    for (int e = 0; e < 8; ++e) o[e] = sigm(gv[e]) * acc[ai][bj][m][e >> 2][e & 3];
                    if (!FIRST) { const u32x4 p = *(const u32x4*)(MG + off + bj * HALF);
                        o[0] += __uint_as_float(p.x << 16); o[1] += __uint_as_float(p.x & 0xffff0000u); o[2] += __uint_as_float(p.y << 16); o[3] += __uint_as_float(p.y & 0xffff0000u);
                        o[4] += __uint_as_float(p.z << 16); o[5] += __uint_as_float(p.z & 0xffff0000u); o[6] += __uint_as_float(p.w << 16); o[7] += __uint_as_float(p.w & 0xffff0000u); }
                    u32x4 w; w.x = cvt_pk_bf16(o[0], o[1]); w.y = cvt_pk_bf16(o[2], o[3]); w.z = cvt_pk_bf16(o[4], o[5]); w.w = cvt_pk_bf16(o[6], o[7]);
                    *(u32x4*)(MG + off + bj * HALF) = w;
                    if (FIRST && MGA) *(u32x4*)(MGA + off + bj * HALF) = w;
                }
            }
    }
};
struct EpiOut {
    static constexpr bool PERM = false, AFTER_DRAIN = false;
    const float* X; const float* G1  ; float* X1;
    __device__ __forceinline__ void operator()(const f32x4 (&acc)[2][2][4][2], const Unit& u, int wr, int wc, int fr, int fq) const {
        const int b = u.pm >> 5;
        const int col0 = u.pn * BM + wc * 32 + 4 * fq;
#pragma unroll
        for (int bj = 0; bj < 2; ++bj)
#pragma unroll
            for (int n = 0; n < 2; ++n) { const int c = col0 + bj * HALF + n * 16; const f32x4 g = *(const f32x4*)(G1 + b * 12288 + c);
#pragma unroll
                for (int ai = 0; ai < 2; ++ai)
#pragma unroll
                    for (int m = 0; m < 4; ++m) { const size_t off = (size_t)(u.pm * BM + ai * HALF + wr * 64 + m * 16 + fr) * 2048 + c;
                        *(f32x4*)(X1 + off) = *(const f32x4*)(X + off) + g * acc[ai][bj][m][n]; } }
    }
};
struct EpiDelta {
    static constexpr bool PERM = true, AFTER_DRAIN = false;
    const float* G1; bf16_t* DA;
    __device__ __forceinline__ void operator()(const f32x4 (&acc)[2][2][4][2], const Unit& u, int wr, int wc, int fr, int fq) const {
        const int b = u.pm >> 5;
#pragma unroll
        for (int ai = 0; ai < 2; ++ai)
#pragma unroll
            for (int m = 0; m < 4; ++m) {
                const size_t off = (size_t)(u.pm * BM + ai * HALF + wr * 64 + m * 16 + fr) * 2048 + u.pn * BM + wc * 32 + 8 * fq;
#pragma unroll
                for (int bj = 0; bj < 2; ++bj) { const int c = u.pn * BM + wc * 32 + 8 * fq + bj * HALF;
                    const f32x4 g0 = *(const f32x4*)(G1 + b * 12288 + c), g1v = *(const f32x4*)(G1 + b * 12288 + c + 4);
                    const f32x4 v0 = acc[ai][bj][m][0] * g0, v1 = acc[ai][bj][m][1] * g1v;
                    u32x4 w; w.x = cvt_pk_bf16(v0[0], v0[1]); w.y = cvt_pk_bf16(v0[2], v0[3]); w.z = cvt_pk_bf16(v1[0], v1[1]); w.w = cvt_pk_bf16(v1[2], v1[3]);
                    *(u32x4*)(DA + off + bj * HALF) = w; }
            }
    }
};
struct EpiScore {
    static constexpr bool PERM = false, AFTER_DRAIN = false;
    float* SC;
    __device__ __forceinline__ void operator()(const f32x4 (&acc)[2][2][4][2], const Unit& u, int wr, int wc, int fr, int fq) const {
        const int col0 = u.pn * BM + wc * 32 + 4 * fq;
#pragma unroll
        for (int ai = 0; ai < 2; ++ai)
#pragma unroll
            for (int m = 0; m < 4; ++m) { const size_t off = (size_t)(u.pm * BM + ai * HALF + wr * 64 + m * 16 + fr) * 2048 + col0;
#pragma unroll
                for (int bj = 0; bj < 2; ++bj)
#pragma unroll
                    for (int n = 0; n < 2; ++n) *(f32x4*)(SC + off + bj * HALF + n * 16) = acc[ai][bj][m][n]; }
    }
};
}
namespace attn {
using bf16x8 = __attribute__((ext_vector_type(8))) short;
using s16x4  = __attribute__((ext_vector_type(4))) short;
using f32x16 = __attribute__((ext_vector_type(16))) float;
using u32x4  = __attribute__((ext_vector_type(4))) unsigned;
typedef unsigned short bf16_t;
constexpr int DQK = 192, DV = 128, NW = 8, QBLK = 32, KVBLK = 64;
constexpr int SHM_V = KVBLK * DV * 2  , SHM_K = KVBLK * DQK * 2  , SHM_QR = 2 * SHM_V + 2 * SHM_K + NW * 64 * 4, SHM_ATTN = SHM_QR + NW * 4096;
constexpr float THR = 8.0f;
#define KSWZ(row, colB) ((row) * 384 + ((colB) ^ (((row) & 7) << 4)))
#define SBAR() __builtin_amdgcn_sched_barrier(0)
__device__ __forceinline__ int crow(int r, int hi) { return (r & 3) + 8 * (r >> 2) + 4 * hi; }
__device__ __forceinline__ unsigned cvtpk(float lo, float hi) { unsigned r; asm volatile("v_cvt_pk_bf16_f32 %0, %1, %2" : "=v"(r) : "v"(lo), "v"(hi)); return r; }
__device__ __forceinline__ void partialSM(f32x16& p0, f32x16& p1, float& m_reg, float& mn, float& alpha) {
  float pmax = p0[0];
#pragma unroll
  for (int r = 1; r < 16; ++r) pmax = fmaxf(pmax, p0[r]);
#pragma unroll
  for (int r = 0; r < 16; ++r) pmax = fmaxf(pmax, p1[r]);
  { auto rr = __builtin_amdgcn_permlane32_swap(__float_as_uint(pmax), __float_as_uint(pmax), false, false);
    pmax = fmaxf(__uint_as_float(rr[0]), __uint_as_float(rr[1])); }
  if (__builtin_expect(__all(pmax - m_reg <= THR), 1)) { mn = m_reg; alpha = 1.f; }
  else { mn = fmaxf(m_reg, pmax); alpha = __builtin_amdgcn_exp2f(m_reg - mn); m_reg = mn; }
#pragma unroll
  for (int r = 0; r < 16; ++r) p0[r] = p0[r] - mn;
#pragma unroll
  for (int r = 0; r < 16; ++r) p1[r] = p1[r] - mn;
#pragma unroll
  for (int r = 0; r < 16; ++r) p0[r] = __builtin_amdgcn_exp2f(p0[r]);
}
__device__ __forceinline__ void finishSM(f32x16& p0, f32x16& p1, float alpha, float& l_reg, bf16x8& pa0, bf16x8& pa1, bf16x8& pa2, bf16x8& pa3) {
#pragma unroll
  for (int r = 0; r < 16; ++r) p1[r] = __builtin_amdgcn_exp2f(p1[r]);
  float ps = 0;
#pragma unroll
  for (int r = 0; r < 16; ++r) ps += p0[r];
#pragma unroll
  for (int r = 0; r < 16; ++r) ps += p1[r];
  { auto rr = __builtin_amdgcn_permlane32_swap(__float_as_uint(ps), __float_as_uint(ps), false, false);
    ps = __uint_as_float(rr[0]) + __uint_as_float(rr[1]); }
  l_reg = l_reg * alpha + ps;
#define PK4(P, BASE, OUT) do { unsigned a0 = cvtpk(P[BASE + 0], P[BASE + 1]), a1 = cvtpk(P[BASE + 2], P[BASE + 3]);   \
    unsigned b0 = cvtpk(P[BASE + 4], P[BASE + 5]), b1 = cvtpk(P[BASE + 6], P[BASE + 7]);                              \
    auto r0 = __builtin_amdgcn_permlane32_swap(a0, b0, false, false); auto r1 = __builtin_amdgcn_permlane32_swap(a1, b1, false, false); \
    u32x4 w = {r0[0], r1[0], r0[1], r1[1]}; OUT = *reinterpret_cast<bf16x8*>(&w); } while (0)
  PK4(p0, 0, pa0); PK4(p0, 8, pa1); PK4(p1, 0, pa2); PK4(p1, 8, pa3);
#undef PK4
}
__device__ __forceinline__ void qkt(f32x16& p0, f32x16& p1, const char* Ks, const bf16x8* qr, const char* qrow, int qx, int r32, int hi) {
  p0 = f32x16{}; p1 = f32x16{};
#pragma unroll
  for (int d0 = 0; d0 < 12; ++d0) { const int cb = (d0 * 16 + hi * 8) * 2;
    bf16x8 b0 = *reinterpret_cast<const bf16x8*>(Ks + KSWZ(r32, cb));
    bf16x8 b1 = *reinterpret_cast<const bf16x8*>(Ks + KSWZ(32 + r32, cb));
    const bf16x8 q = (d0 < 8) ? qr[d0 < 8 ? d0 : 0] : *reinterpret_cast<const bf16x8*>(qrow + (qx ^ ((d0 - 8) << 5)));
    p0 = __builtin_amdgcn_mfma_f32_32x32x16_bf16(b0, q, p0, 0, 0, 0);
    p1 = __builtin_amdgcn_mfma_f32_32x32x16_bf16(b1, q, p1, 0, 0, 0); }
}
__device__ __forceinline__ int v_st(int k, int c) { const int kk = (k & ~0xC) | ((k & 4) << 1) | ((k & 8) >> 1); return ((kk >> 3) * 4 + (c >> 5)) * 512 + ((kk & 7) * 32 + (c & 31)) * 2; }
__device__ __forceinline__ int v_rd_base(int lane) { return ((lane & 3) << 3) | (((lane >> 2) & 3) << 6) | (((lane >> 4) & 1) << 5) | (((lane >> 5) & 1) << 8); }
constexpr int v_rd_off(int d0, int ks, int half) { return d0 * 512 + ks * 4096 + half * 2048; }
template <int OFF> __device__ __forceinline__ s16x4 tr_read(int vb) {
  s16x4 r; asm volatile("ds_read_b64_tr_b16 %0, %1 offset:%2" : "=&v"(r) : "v"(vb), "i"(OFF) : "memory"); return r;
}
template <int D0> __device__ __forceinline__ void pv_one(f32x16& od, int vb, bf16x8 pa0, bf16x8 pa1, bf16x8 pa2, bf16x8 pa3) {
  const s16x4 l0 = tr_read<v_rd_off(D0, 0, 0)>(vb), h0 = tr_read<v_rd_off(D0, 0, 1)>(vb), l1 = tr_read<v_rd_off(D0, 1, 0)>(vb), h1 = tr_read<v_rd_off(D0, 1, 1)>(vb);
  const s16x4 l2 = tr_read<v_rd_off(D0, 2, 0)>(vb), h2 = tr_read<v_rd_off(D0, 2, 1)>(vb), l3 = tr_read<v_rd_off(D0, 3, 0)>(vb), h3 = tr_read<v_rd_off(D0, 3, 1)>(vb);
  asm volatile("s_waitcnt lgkmcnt(0)" ::: "memory"); SBAR();
#define PK(L, H) (bf16x8){L[0], L[1], L[2], L[3], H[0], H[1], H[2], H[3]}
  od = __builtin_amdgcn_mfma_f32_32x32x16_bf16(pa0, PK(l0, h0), od, 0, 0, 0);
  od = __builtin_amdgcn_mfma_f32_32x32x16_bf16(pa1, PK(l1, h1), od, 0, 0, 0);
  od = __builtin_amdgcn_mfma_f32_32x32x16_bf16(pa2, PK(l2, h2), od, 0, 0, 0);
  od = __builtin_amdgcn_mfma_f32_32x32x16_bf16(pa3, PK(l3, h3), od, 0, 0, 0);
#undef PK
}
__device__ __forceinline__ void pv_d0(f32x16* o, int vb, bf16x8 pa0, bf16x8 pa1, bf16x8 pa2, bf16x8 pa3) {
  pv_one<0>(o[0], vb, pa0, pa1, pa2, pa3); pv_one<1>(o[1], vb, pa0, pa1, pa2, pa3); pv_one<2>(o[2], vb, pa0, pa1, pa2, pa3); pv_one<3>(o[3], vb, pa0, pa1, pa2, pa3);
}
__device__ __forceinline__ void attn_unit(const bf16_t* __restrict__ Qb, const bf16_t* __restrict__ Kh, const bf16_t* __restrict__ Vh, bf16_t* __restrict__ Ob, int ldo, int seq, char* lds, int tid_in) {
  int tid_ = tid_in; asm volatile("" : "+v"(tid_));
  const int tid = tid_, wid = tid >> 6, lane = tid & 63, r32 = lane & 31, hi = lane >> 5;
  char* V_lds = lds; char* K_lds = lds + 2 * SHM_V;
  float* ws = (float*)(lds + 2 * SHM_V + 2 * SHM_K) + wid * 64; float* li_l = ws; float* al_l = ws + 32;
  float m_reg = -1e30f, l_reg = 0; f32x16 o[4] = {}; bf16x8 qr[8];
  const bf16_t* Qw = Qb + (long)(wid * QBLK + r32) * DQK + hi * 8;
#pragma unroll
  for (int d0 = 0; d0 < 8; ++d0) qr[d0] = *reinterpret_cast<const bf16x8*>(Qw + d0 * 16);
  char* qrow = lds + SHM_QR + wid * 4096 + r32 * 128; const int qx = (hi ^ (r32 & 7)) << 4;
#pragma unroll
  for (int d0 = 8; d0 < 12; ++d0) *reinterpret_cast<bf16x8*>(qrow + (qx ^ ((d0 - 8) << 5))) = *reinterpret_cast<const bf16x8*>(Qw + d0 * 16);
  const int sr = tid >> 4, sc = (tid & 15) * 8, vst0 = v_st(sr, sc), vst1 = v_st(32 + sr, sc);
  unsigned kgo[3], klo[3];
#pragma unroll
  for (int i = 0; i < 3; ++i) { const int id = tid + 512 * i, kr_ = id / 24, kc_ = (id % 24) * 16; kgo[i] = (unsigned)(kr_ * 384 + kc_); klo[i] = (unsigned)KSWZ(kr_, kc_); }
  const unsigned vgo0 = (unsigned)((sr * DV + sc) * 2), vgo1 = (unsigned)(((32 + sr) * DV + sc) * 2);
  const int vb0 = (int)(uintptr_t)V_lds + v_rd_base(lane);
  bf16x8 vs0, vs1, ks0, ks1, ks2;
#define SLOAD(k0) do { const char* Kt_ = (const char*)Kh + (size_t)(k0) * (DQK * 2); const char* Vt_ = (const char*)Vh + (size_t)(k0) * (DV * 2); \
    vs0 = *reinterpret_cast<const bf16x8*>(Vt_ + vgo0); vs1 = *reinterpret_cast<const bf16x8*>(Vt_ + vgo1); \
    ks0 = *reinterpret_cast<const bf16x8*>(Kt_ + kgo[0]); ks1 = *reinterpret_cast<const bf16x8*>(Kt_ + kgo[1]); ks2 = *reinterpret_cast<const bf16x8*>(Kt_ + kgo[2]); } while (0)
#define SWRITE(b) do { *(bf16x8*)(V_lds + (b) * SHM_V + vst0) = vs0; *(bf16x8*)(V_lds + (b) * SHM_V + vst1) = vs1; \
    *(bf16x8*)(K_lds + (b) * SHM_K + klo[0]) = ks0; *(bf16x8*)(K_lds + (b) * SHM_K + klo[1]) = ks1; *(bf16x8*)(K_lds + (b) * SHM_K + klo[2]) = ks2; } while (0)
#define RESC(a) do { if (__any((a) < 1.f)) { if (hi == 0) al_l[r32] = (a); asm volatile("s_waitcnt lgkmcnt(0)" ::: "memory"); \
    _Pragma("unroll") for (int d = 0; d < 4; ++d) _Pragma("unroll") for (int r = 0; r < 16; ++r) o[d][r] *= al_l[crow(r, hi)]; } } while (0)
  f32x16 pA0, pA1, pB0, pB1; float mnA, mnB, alA, alB; bf16x8 pa0, pa1, pa2, pa3; const int NT = seq / KVBLK;
  SLOAD(0); SWRITE(0); __syncthreads();
  qkt(pA0, pA1, K_lds, qr, qrow, qx, r32, hi); partialSM(pA0, pA1, m_reg, mnA, alA);
  SLOAD(KVBLK);
  SWRITE(1); __syncthreads();
  for (int j = 1; j + 1 < NT; j += 2) {
    SBAR(); qkt(pB0, pB1, K_lds + SHM_K, qr, qrow, qx, r32, hi);
    finishSM(pA0, pA1, alA, l_reg, pa0, pa1, pa2, pa3); SBAR();
    SLOAD((j + 1) * KVBLK); SBAR();
    pv_d0(o, vb0, pa0, pa1, pa2, pa3); partialSM(pB0, pB1, m_reg, mnB, alB);
    __syncthreads(); SWRITE(0);
    RESC(alB); __syncthreads();
    SBAR(); qkt(pA0, pA1, K_lds, qr, qrow, qx, r32, hi);
    finishSM(pB0, pB1, alB, l_reg, pa0, pa1, pa2, pa3); SBAR();
    SLOAD((j + 2) * KVBLK); SBAR();
    pv_d0(o, vb0 + SHM_V, pa0, pa1, pa2, pa3); partialSM(pA0, pA1, m_reg, mnA, alA);
    __syncthreads(); SWRITE(1);
    RESC(alA); __syncthreads();
  }
  SBAR(); qkt(pB0, pB1, K_lds + SHM_K, qr, qrow, qx, r32, hi);
  finishSM(pA0, pA1, alA, l_reg, pa0, pa1, pa2, pa3); SBAR();
  pv_d0(o, vb0, pa0, pa1, pa2, pa3); partialSM(pB0, pB1, m_reg, mnB, alB);
  __syncthreads(); RESC(alB);
  finishSM(pB0, pB1, alB, l_reg, pa0, pa1, pa2, pa3); SBAR();
  pv_d0(o, vb0 + SHM_V, pa0, pa1, pa2, pa3);
  if (hi == 0) li_l[r32] = l_reg; asm volatile("s_waitcnt lgkmcnt(0)" ::: "memory");
  float rli[16];
#pragma unroll
  for (int r = 0; r < 16; ++r) rli[r] = __builtin_amdgcn_rcpf(li_l[crow(r, hi)]);
  { int t2 = tid_in; asm volatile("" : "+v"(t2));
    const int w2 = t2 >> 6, l2 = t2 & 63, c2 = l2 & 31, h2 = l2 >> 5;
    bf16_t* Ow = Ob + (unsigned)((w2 * QBLK + 4 * h2) * ldo + c2);
#pragma unroll
    for (int r = 0; r < 16; ++r) { const unsigned ro = (unsigned)(((r & 3) + 8 * (r >> 2)) * ldo);
#pragma unroll
      for (int d0 = 0; d0 < 4; ++d0) { const float v = o[d0][r] * rli[r]; Ow[ro + d0 * 32] = (bf16_t)(cvtpk(v, v) & 0xffffu); } } }
  __syncthreads();
#undef SLOAD
#undef SWRITE
#undef RESC
}
#undef KSWZ
#undef SBAR
}
#define GAS __attribute__((address_space(1)))
#define LAS __attribute__((address_space(3)))
typedef unsigned short bf16_t;
typedef unsigned v4u __attribute__((ext_vector_type(4)));
typedef unsigned v2u __attribute__((ext_vector_type(2)));
typedef float f32x4 __attribute__((ext_vector_type(4)));
typedef short bf16x8 __attribute__((ext_vector_type(8)));
constexpr int NT_ = 512;
constexpr int BATCH = 2, SEQ = 8192, DM = 2048, CTXL = 256;
constexpr int ML = BATCH * SEQ  , MC = BATCH * CTXL  , M1 = ML + MC  ;
constexpr int NIN_PAD = 9216;
constexpr int LKV = CTXL + SEQ;
constexpr int NCH = 132;
constexpr float EPS = 1e-6f;
constexpr float QSCALE = 0.07216878364870322f * 1.4426950408889634f;
constexpr size_t MiB = 1u << 20;
constexpr size_t WS_CTL = 0, CTL_BYTES = 1 * MiB;
constexpr size_t CTL_BAR = 4096;
static_assert(CTL_BAR + 3456 * 4 <= CTL_BYTES, "ctl");
constexpr size_t WS_WUQ = 1 * MiB, WS_WUKV = WS_WUQ + 1536 * 512 * 2, WS_WBA = WS_WUKV + 2048 * 256 * 2, WS_WBB = WS_WBA + 4 * MiB, WS_WOUT = WS_WBB + 4 * MiB, WS_WPQ = WS_WOUT + 8 * MiB;
static_assert(WS_WPQ + 8 * MiB <= 28 * MiB, "small weights");
constexpr size_t WS_C = 28 * MiB;
constexpr size_t WS_D = 66 * MiB;
constexpr size_t WS_E1 = 132 * MiB;
constexpr size_t WS_CQ = WS_E1, WS_CKV = WS_CQ + 16 * MiB, WS_KR = WS_CKV + (size_t)M1 * 256 * 2, WS_AB = WS_KR + (size_t)M1 * 64 * 4;
static_assert(WS_AB + (size_t)M1 * 32 * 4 <= 164 * MiB, "E1");
constexpr size_t WS_Z = 164 * MiB, WS_GA = 196 * MiB, WS_GB = 260 * MiB;
constexpr size_t WS_QKV = 324 * MiB;
constexpr size_t WS_K = 423 * MiB;
constexpr size_t WS_DNQ = 473 * MiB;
constexpr size_t WS_GBETA = 572 * MiB;
constexpr size_t WS_EG = 575 * MiB;
constexpr size_t CTL_MOD = 27 * MiB + 512 * 1024;
constexpr size_t CTL_SSQQ = 575 * MiB, CTL_SSQKV = CTL_SSQQ + (size_t)16384 * 8 * 4;
static_assert(CTL_SSQKV + (size_t)16896 * 4 * 4 <= 577 * MiB && CTL_MOD + 3 * 12288 * 4 <= 28 * MiB && WS_WPQ + 8 * MiB <= CTL_MOD, "mod/ssq");
constexpr size_t WS_W = WS_QKV, WS_U = WS_QKV + 66 * MiB, WS_ATT = WS_C, WS_OF = WS_D, WS_OB = WS_D + 32 * MiB, WS_YA = WS_E1, WS_YB = WS_C;
constexpr size_t WS_MG = 324 * MiB, WS_H2 = 388 * MiB, WS_UB = 452 * MiB, WS_VB = 484 * MiB, WS_USC = 516 * MiB, WS_VSC = 517 * MiB, WS_SC = 196 * MiB, WS_END = 580 * MiB;
static_assert(WS_EG + (size_t)4224 * 132 * 4 <= WS_END && WS_K + (size_t)16 * LKV * 192 * 2 <= WS_DNQ && WS_DNQ + (size_t)M1 * 3072 * 2 <= WS_GBETA, "ws map");

__device__ __forceinline__ unsigned f2bf(float f) { unsigned u = __builtin_bit_cast(unsigned, f); return (u + 0x7fffu + ((u >> 16) & 1u)) >> 16; }
__device__ __forceinline__ unsigned pk2(float lo, float hi) { unsigned r; asm volatile("v_cvt_pk_bf16_f32 %0, %1, %2" : "=v"(r) : "v"(lo), "v"(hi)); return r; }
__device__ __forceinline__ float bflo(unsigned w) { return __uint_as_float(w << 16); }
__device__ __forceinline__ float bfhi(unsigned w) { return __uint_as_float(w & 0xffff0000u); }
__device__ __forceinline__ float wave_sum(float v) {
#pragma unroll
    for (int o = 1; o < 64; o <<= 1) v += __shfl_xor(v, o);
    return v;
}
__device__ __forceinline__ float siluf(float v) { return v / (1.0f + __expf(-v)); }

struct Params {
    const float *x, *c, *ctx, *c_ctx, *w_mod, *b_mod, *norm1_w, *w_in, *qn_w, *kvn_w, *w_uq, *w_ukv, *conv_w, *a_log, *dt_bias, *dn_norm_w,
                *w_ba, *w_bb, *w_out, *norm2_w, *peer_wq, *sub_keys, *peer_u, *peer_v, *final_w;
    float* out; unsigned char* ws;
    int ph_lo, ph_hi;
};
#define XB_TMO      128
#define XB_XCNT(j)  (256  + 64 * (j))
#define XB_XSUB(j)  (1280 + 64 * (j))
#define XB_XGEN(j)  (2304 + 64 * (j))
#define XB_TOP      3328
#define XB_TOPGEN   3392
#define XCD_BAR_WORDS 3456
#define XB_SPIN_CAP (1u << 18)

__device__ __forceinline__ unsigned xb_ld(unsigned* p)              { return __hip_atomic_load(p, __ATOMIC_RELAXED, __HIP_MEMORY_SCOPE_AGENT); }
__device__ __forceinline__ unsigned xb_add(unsigned* p, unsigned v) { return __hip_atomic_fetch_add(p, v, __ATOMIC_RELAXED, __HIP_MEMORY_SCOPE_AGENT); }
__device__ __forceinline__ unsigned xb_xcc_id() { return (unsigned)__builtin_amdgcn_s_getreg((3 << 11) | 20) & 0xFu; }
#define XB_SPIN(cond, bar) do { unsigned _sp = 0; while (cond) { __builtin_amdgcn_s_sleep(1); \
    if ((++_sp & 255u) == 0u) { if (xb_ld(&(bar)[XB_TMO])) break; if (_sp > XB_SPIN_CAP) { atomicAdd(&(bar)[XB_TMO], 1u); break; } } } } while (0)

struct XcdBarrier {
    unsigned* bar; unsigned x;
    volatile LAS unsigned* st;
};

__device__ __forceinline__ XcdBarrier xcd_barrier_post(unsigned* bar, volatile LAS unsigned* st, int tid) {
    XcdBarrier b; b.bar = bar; b.x = xb_xcc_id(); b.st = st;
    if (tid == 0) (void)xb_add(&bar[XB_XCNT(b.x)], 1u);
    return b;
}
__device__ __forceinline__ void xcd_barrier_complete(unsigned* bar, unsigned x, unsigned& nloc, unsigned& nx) {
    const unsigned G = gridDim.x * gridDim.y * gridDim.z;
    unsigned sum, cnt, mine, sp = 0u;
    for (;;) {
        sum = 0u; cnt = 0u; mine = 0u;
#pragma unroll
        for (unsigned j = 0; j < 16; ++j) { const unsigned c = xb_ld(&bar[XB_XCNT(j)]); sum += c; cnt += (c > 0u) ? 1u : 0u; mine = (j == x) ? c : mine; }
        if (sum == G) break;
        __builtin_amdgcn_s_sleep(1);
        if ((++sp & 255u) == 0u) { if (xb_ld(&bar[XB_TMO])) break; if (sp > XB_SPIN_CAP) { atomicAdd(&bar[XB_TMO], 1u); break; } }
    }
    nloc = mine > 0u ? mine : 1u; nx = cnt > 0u ? cnt : 1u;
}

__device__ __forceinline__ void xcd_barrier(const XcdBarrier& b, int tid) {
    asm volatile("s_waitcnt vmcnt(0)" ::: "memory");
    __syncthreads();
    if (tid == 0) {
        unsigned* bar = b.bar;
        __builtin_amdgcn_s_waitcnt(0);
        unsigned nloc = b.st[0], nx = b.st[1];
        if (nloc == 0u) { xcd_barrier_complete(bar, b.x, nloc, nx); b.st[0] = nloc; b.st[1] = nx; }
        const unsigned old = xb_add(&bar[XB_XSUB(b.x)], 1u);
        const unsigned gen = old / nloc;
        if (old + 1u == (gen + 1u) * nloc) {
            __builtin_amdgcn_fence(__ATOMIC_RELEASE, "agent");
            asm volatile("s_waitcnt vmcnt(0)" ::: "memory");
            const unsigned og = xb_add(&bar[XB_TOP], 1u);
            const unsigned tg = og / nx;
            if (og + 1u == (tg + 1u) * nx) xb_add(&bar[XB_TOPGEN], 1u);
            else XB_SPIN(xb_ld(&bar[XB_TOPGEN]) == tg, bar);
            __builtin_amdgcn_fence(__ATOMIC_ACQUIRE, "agent");
            xb_add(&bar[XB_XGEN(b.x)], 1u);
            asm volatile("s_waitcnt vmcnt(0)" ::: "memory");
        } else {
            XB_SPIN(xb_ld(&bar[XB_XGEN(b.x)]) == gen, bar);
            __builtin_amdgcn_fence(__ATOMIC_ACQUIRE, "agent");
            asm volatile("s_waitcnt vmcnt(0)" ::: "memory");
        }
    }
    __syncthreads();
}
struct Ctx { LAS unsigned char* lds; int tid, lane, wave, vcu, G; };

__device__ __forceinline__ void p0_mod_item(const Params& p, const Ctx& C, int it) {
    LAS float* sl = (LAS float*)C.lds;
    LAS float* red = sl + 3 * 2048;
    for (int e = C.tid; e < 3 * 2048; e += NT_) { const int i = e >> 11, k = e & 2047; const float v = (i < 2) ? p.c[i * DM + k] : p.c_ctx[k]; sl[e] = siluf(v); }
    __syncthreads();
    typedef float f32x2_ __attribute__((ext_vector_type(2)));
    f32x2_ a0 = {0, 0}, a1 = {0, 0}, a2 = {0, 0};
    const int col = it * 128 + C.lane * 2, k0 = C.wave * 256;
    const float* wp = p.w_mod + (size_t)k0 * 12288 + col;
#pragma unroll 8
    for (int k = 0; k < 256; ++k) { const f32x2_ w = *(const f32x2_*)(wp + (size_t)k * 12288); a0 += w * sl[k0 + k]; a1 += w * sl[2048 + k0 + k]; a2 += w * sl[4096 + k0 + k]; }
    LAS float* rw = red + C.wave * 384 + C.lane * 2;
    rw[0] = a0[0]; rw[1] = a0[1]; rw[128] = a1[0]; rw[129] = a1[1]; rw[256] = a2[0]; rw[257] = a2[1];
    __syncthreads();
    if (C.tid < 384) { float s = p.b_mod[it * 128 + (C.tid & 127)];
#pragma unroll
        for (int w = 0; w < 8; ++w) s += red[w * 384 + C.tid];
        ((float*)(p.ws + CTL_MOD))[(C.tid >> 7) * 12288 + it * 128 + (C.tid & 127)] = s; }
    __syncthreads();
}
__device__ __forceinline__ void p0_wprime_item(const Params& p, const Ctx& C, int it) {
    LAS float* As = (LAS float*)C.lds;
    LAS float* Ss = As + 64 * 129;
    const int hp = it >> 5, i0 = (it & 31) * 64, pp = hp & 1;
    for (int e = C.tid; e < 64 * 128; e += NT_) { const int i = e >> 7, d = e & 127; As[i * 129 + d] = p.peer_wq[(size_t)(i0 + i) * 2048 + hp * 128 + d]; }
    for (int e = C.tid; e < 128 * 128; e += NT_) { const int k = e >> 7, d = e & 127; Ss[k * 129 + d] = p.sub_keys[(size_t)(pp * 128 + k) * 128 + d]; }
    __syncthreads();
    const int k = C.tid & 127, ig = C.tid >> 7;
    float acc[16];
#pragma unroll
    for (int ii = 0; ii < 16; ++ii) acc[ii] = 0.f;
    for (int d = 0; d < 128; ++d) { const float s = Ss[k * 129 + d];
#pragma unroll
        for (int ii = 0; ii < 16; ++ii) acc[ii] += As[(ig * 16 + ii) * 129 + d] * s; }
    bf16_t* dst = (bf16_t*)(p.ws + WS_WPQ) + (size_t)(hp * 128 + k) * 2048 + i0 + ig * 16;
    v4u w0, w1; w0.x = pk2(acc[0], acc[1]); w0.y = pk2(acc[2], acc[3]); w0.z = pk2(acc[4], acc[5]); w0.w = pk2(acc[6], acc[7]);
    w1.x = pk2(acc[8], acc[9]); w1.y = pk2(acc[10], acc[11]); w1.z = pk2(acc[12], acc[13]); w1.w = pk2(acc[14], acc[15]);
    *(v4u*)dst = w0; *(v4u*)(dst + 8) = w1;
    __syncthreads();
}
__device__ __forceinline__ void p0_transpose_item(const float* W, int K, int N, int k0, int n0, bf16_t* WT, int drow0, const float* kscale, LAS float* scr, int lane) {
#pragma unroll 8
    for (int i = 0; i < 32; ++i) { const int kk = 2 * i + (lane >> 5); float v = W[(size_t)(k0 + kk) * N + n0 + (lane & 31)]; if (kscale) v *= kscale[k0 + kk]; scr[kk * 33 + (lane & 31)] = v; }
    asm volatile("s_waitcnt lgkmcnt(0)" ::: "memory");
    const int c = lane & 7;
#pragma unroll
    for (int j = 0; j < 4; ++j) { const int n = (lane >> 3) + 8 * j; const LAS float* s = scr + (8 * c) * 33 + n;
        v4u o; o.x = pk2(s[0 * 33], s[1 * 33]); o.y = pk2(s[2 * 33], s[3 * 33]); o.z = pk2(s[4 * 33], s[5 * 33]); o.w = pk2(s[6 * 33], s[7 * 33]);
        *(v4u*)(WT + (size_t)(drow0 + n) * K + k0 + 8 * c) = o; }
    asm volatile("s_waitcnt lgkmcnt(0)" ::: "memory");
}
__device__ __forceinline__ int win_dest_row(int n0) {
    if (n0 < 768) return n0;
    if (n0 < 832) return 8960 + (n0 - 768);
    if (n0 < 3904) return 768 + (n0 - 832);
    if (n0 < 4928) return 3840 + (n0 - 3904);
    if (n0 < 4960) return 9024 + (n0 - 4928);
    if (n0 < 7008) return 4864 + (n0 - 4960);
    return 6912 + (n0 - 7008);
}
__device__ __forceinline__ void p0_prologue(const Params& p, const Ctx& C) {
    for (int it = C.vcu; it < 96; it += C.G) p0_mod_item(p, C, it);
    for (int it = C.vcu; it < 512; it += C.G) p0_wprime_item(p, C, it);
    LAS float* scr = (LAS float*)(C.lds + C.wave * 16384);
    const int gw = C.vcu * 8 + C.wave, NGW = C.G * 8;
    constexpr int I_IN = 32 * 283, I_UQ = 8 * 48, I_UKV = 4 * 64, I_BA = 16 * 64, I_BB = 16 * 64, I_OUT = 32 * 64;
    constexpr int NITEMS = I_IN + I_UQ + I_UKV + I_BA + I_BB + I_OUT;
    unsigned char* ws = p.ws;
    for (int it = gw; it < NITEMS; it += NGW) {
        int r = it;
        if (r < I_IN) { const int kb = r / 283, nb = r % 283; p0_transpose_item(p.w_in, 2048, 9056, kb * 64, nb * 32, (bf16_t*)(ws + WS_C), win_dest_row(nb * 32), nullptr, scr, C.lane); continue; } r -= I_IN;
        if (r < I_UQ) { const int kb = r / 48, nb = r % 48, n0 = nb * 32, h = n0 / 192, j0 = n0 % 192; const int dr = (j0 < 128) ? (h * 128 + j0) : (1024 + h * 64 + (j0 - 128));
            p0_transpose_item(p.w_uq, 512, 1536, kb * 64, n0, (bf16_t*)(ws + WS_WUQ), dr, p.qn_w, scr, C.lane); continue; } r -= I_UQ;
        if (r < I_UKV) { const int kb = r / 64, nb = r % 64; p0_transpose_item(p.w_ukv, 256, 2048, kb * 64, nb * 32, (bf16_t*)(ws + WS_WUKV), nb * 32, p.kvn_w, scr, C.lane); continue; } r -= I_UKV;
        if (r < I_BA) { const int kb = r / 64, nb = r % 64; p0_transpose_item(p.w_ba, 1024, 2048, kb * 64, nb * 32, (bf16_t*)(ws + WS_WBA), nb * 32, nullptr, scr, C.lane); continue; } r -= I_BA;
        if (r < I_BB) { const int kb = r / 64, nb = r % 64; p0_transpose_item(p.w_bb, 1024, 2048, kb * 64, nb * 32, (bf16_t*)(ws + WS_WBB), nb * 32, nullptr, scr, C.lane); continue; } r -= I_BB;
        { const int kb = r / 64, nb = r % 64; p0_transpose_item(p.w_out, 2048, 2048, kb * 64, nb * 32, (bf16_t*)(ws + WS_WOUT), nb * 32, nullptr, scr, C.lane); }
    }
    { v4u* z = (v4u*)((bf16_t*)(ws + WS_C) + (size_t)9056 * 2048); const int n16 = 160 * 2048 * 2 / 16;
      for (int i = C.vcu * NT_ + C.tid; i < n16; i += C.G * NT_) z[i] = (v4u){0u, 0u, 0u, 0u}; }
}

__device__ __forceinline__ void mod_norm_rows(const Ctx& C, const float* X, int nrows, const float* nw, const float* sh, const float* sc, bf16_t* O) {
    f32x4 a[8], s[8];
#pragma unroll
    for (int j = 0; j < 8; ++j) { const int c = 4 * C.lane + 256 * j; const f32x4 w = *(const f32x4*)(nw + c), q = *(const f32x4*)(sc + c); a[j] = w * (q + 1.0f); s[j] = *(const f32x4*)(sh + c); }
    const int gw = C.vcu * 8 + C.wave, NGW = C.G * 8;
    for (int r = gw; r < nrows; r += NGW) {
        const f32x4* xr = (const f32x4*)(X + (size_t)r * DM) + C.lane; f32x4 v[8]; float ss = 0.f;
#pragma unroll
        for (int j = 0; j < 8; ++j) { v[j] = xr[64 * j]; ss += (v[j].x * v[j].x + v[j].y * v[j].y) + (v[j].z * v[j].z + v[j].w * v[j].w); }
        const float rstd = rsqrtf(wave_sum(ss) * (1.0f / DM) + EPS);
        v2u* o8 = (v2u*)(O + (size_t)r * DM) + C.lane;
#pragma unroll
        for (int j = 0; j < 8; ++j) { const f32x4 y = v[j] * rstd * a[j] + s[j]; v2u w; w.x = pk2(y.x, y.y); w.y = pk2(y.z, y.w); o8[64 * j] = w; }
    }
}
__device__ __forceinline__ void p3_conv(const Params& p, const Ctx& C) {
    const bf16_t* QKV = (const bf16_t*)(p.ws + WS_QKV); bf16_t* DNQ = (bf16_t*)(p.ws + WS_DNQ);
    const long total = (long)M1 * 384;
    for (long it = (long)C.vcu * NT_ + C.tid; it < total; it += (long)C.G * NT_) {
        const int r = (int)(it / 384), c8 = (int)(it % 384), ch = c8 * 8;
        int seg0, segn, t;
        if (r < ML) { seg0 = r & ~8191; segn = SEQ; t = r & 8191; } else { seg0 = ML + ((r - ML) & ~255); segn = CTXL; t = (r - ML) & 255; }
        float acc[8];
#pragma unroll
        for (int e = 0; e < 8; ++e) acc[e] = 0.f;
#pragma unroll
        for (int j = 0; j < 5; ++j) { const int tt = t + j - 2;
            if (tt >= 0 && tt < segn) { const v4u xv = *(const v4u*)(QKV + (size_t)(seg0 + tt) * 3072 + ch);
                const f32x4 w0 = *(const f32x4*)(p.conv_w + j * 3072 + ch), w1 = *(const f32x4*)(p.conv_w + j * 3072 + ch + 4);
                acc[0] += bflo(xv.x) * w0.x; acc[1] += bfhi(xv.x) * w0.y; acc[2] += bflo(xv.y) * w0.z; acc[3] += bfhi(xv.y) * w0.w;
                acc[4] += bflo(xv.z) * w1.x; acc[5] += bfhi(xv.z) * w1.y; acc[6] += bflo(xv.w) * w1.z; acc[7] += bfhi(xv.w) * w1.w; } }
        float ss = 0.f;
#pragma unroll
        for (int e = 0; e < 8; ++e) { acc[e] = siluf(acc[e]); ss += acc[e] * acc[e]; }
        ss += __shfl_xor(ss, 1); ss += __shfl_xor(ss, 2); ss += __shfl_xor(ss, 4); ss += __shfl_xor(ss, 8);
        float sc = 1.0f;
        if (ch < 2048) { sc = rsqrtf(ss + EPS); if (ch < 1024) sc *= 0.08838834764831845f; }
        v4u w; w.x = pk2(acc[0] * sc, acc[1] * sc); w.y = pk2(acc[2] * sc, acc[3] * sc); w.z = pk2(acc[4] * sc, acc[5] * sc); w.w = pk2(acc[6] * sc, acc[7] * sc);
        *(v4u*)(DNQ + (size_t)r * 3072 + ch) = w;
    }
}
__device__ __forceinline__ void p3_krope_gbeta(const Params& p, const Ctx& C) {
    const float* KR = (const float*)(p.ws + WS_KR); bf16_t* K = (bf16_t*)(p.ws + WS_K);
    for (int it = C.vcu * NT_ + C.tid; it < M1 * 4; it += C.G * NT_) {
        const int r = it >> 2, q = it & 3, half = q >> 1, part = q & 1;
        int b, l, t; bool lat = r < ML;
        if (lat) { b = r >> 13; t = r & 8191; l = CTXL + t; } else { b = (r - ML) >> 8; t = 0; l = (r - ML) & 255; }
        const float* x1p = KR + (size_t)r * 64 + half * 32; const float* x2p = x1p + 16;
        float o[16];
        if (lat) { const float pos = (float)(half == 0 ? (t >> 6) : (t & 63));
#pragma unroll
            for (int i = 0; i < 16; ++i) { const float invf = exp2f(-(float)i * (13.287712379549449f / 16.0f)); float sn, cs; pg8::fast_sincos(pos * invf, sn, cs);
                const float x1 = x1p[i], x2 = x2p[i]; o[i] = part == 0 ? (x1 * cs - x2 * sn) : (x1 * sn + x2 * cs); } }
        else {
#pragma unroll
            for (int i = 0; i < 16; ++i) o[i] = part == 0 ? x1p[i] : x2p[i]; }
        v4u w0, w1; w0.x = pk2(o[0], o[1]); w0.y = pk2(o[2], o[3]); w0.z = pk2(o[4], o[5]); w0.w = pk2(o[6], o[7]);
        w1.x = pk2(o[8], o[9]); w1.y = pk2(o[10], o[11]); w1.z = pk2(o[12], o[13]); w1.w = pk2(o[14], o[15]);
#pragma unroll
        for (int h = 0; h < 8; ++h) { bf16_t* dst = K + ((size_t)(b * 8 + h) * LKV + l) * 192 + 128 + half * 32 + part * 16; *(v4u*)dst = w0; *(v4u*)(dst + 8) = w1; }
    }
    const float* AB = (const float*)(p.ws + WS_AB); float* Gd = (float*)(p.ws + WS_GBETA); float* Bd = Gd + (size_t)2 * M1 * 8;
    for (int it = C.vcu * NT_ + C.tid; it < M1 * 16; it += C.G * NT_) {
        const int r = it >> 4, dh = it & 15, dir = dh >> 3, h = dh & 7;
        const float a = AB[(size_t)r * 32 + dir * 8 + h] + p.dt_bias[dir * 8 + h], bl = AB[(size_t)r * 32 + 16 + dir * 8 + h];
        const float sp = (a > 20.f) ? a : log1pf(__expf(a));
        Gd[((size_t)dir * M1 + r) * 8 + h] = -__expf(p.a_log[dir * 8 + h]) * sp;
        Bd[((size_t)dir * M1 + r) * 8 + h] = 1.0f / (1.0f + __expf(-bl));
    }
}
constexpr int CP_LD = 136;
constexpr int CP_K = 0, CP_Q = CP_K + 64 * CP_LD * 2, CP_V = CP_Q + 64 * CP_LD * 2, CP_KK = CP_V + 64 * CP_LD * 2, CP_QK = CP_KK + 64 * 65 * 4,
              CP_M = CP_QK + 64 * 65 * 4  , CP_VEC = CP_M + 2 * 64 * 64 * 4  , CP_END = CP_VEC + 10 * 64 * 4;
static_assert(CP_END <= 131072 && (CP_M % 16) == 0, "chunk-prep LDS");
__device__ __forceinline__ void p5_chunk_prep(const Params& p, const Ctx& C) {
    const bf16_t* DNQ = (const bf16_t*)(p.ws + WS_DNQ); const float* Gd = (const float*)(p.ws + WS_GBETA); const float* Bd = Gd + (size_t)2 * M1 * 8;
    bf16_t* Wd = (bf16_t*)(p.ws + WS_W); bf16_t* Ud = (bf16_t*)(p.ws + WS_U); bf16_t* ATd = (bf16_t*)(p.ws + WS_ATT);
    float* EG = (float*)(p.ws + WS_EG); float* EKD = EG + (size_t)4224 * 64; float* EGL = EKD + (size_t)4224 * 64;
    LAS unsigned char* L = C.lds;
    LAS bf16_t* Ks = (LAS bf16_t*)(L + CP_K); LAS bf16_t* Qs = (LAS bf16_t*)(L + CP_Q); LAS bf16_t* Vs = (LAS bf16_t*)(L + CP_V);
    LAS float* KKs = (LAS float*)(L + CP_KK); LAS float* QKs = (LAS float*)(L + CP_QK); LAS float* Ms = (LAS float*)(L + CP_M); LAS float* Vec = (LAS float*)(L + CP_VEC);
    const int tid = C.tid, lane = C.lane, wave = C.wave;
    for (int task = C.vcu; task < 16 * NCH; task += C.G) {
        const int bh = task / NCH, tc = task % NCH, b = bh >> 3, h = bh & 7;
        const int row0 = (tc < 4) ? (ML + b * CTXL + tc * 64) : (b * SEQ + (tc - 4) * 64);
        for (int e = tid; e < 3 * 1024; e += NT_) { const int which = e >> 10, id = e & 1023, i = id >> 4, chn = id & 15;
            const v4u v = *(const v4u*)(DNQ + (size_t)(row0 + i) * 3072 + which * 1024 + h * 128 + chn * 8);
            LAS bf16_t* dst = (which == 0 ? Qs : (which == 1 ? Ks : Vs)) + i * CP_LD + chn * 8; *(LAS v4u*)dst = v; }
        if (tid < 256) { const int which = tid >> 6, i = tid & 63, dir = which & 1; const float* src = (which < 2) ? Gd : Bd; Vec[tid] = src[((size_t)dir * M1 + row0 + i) * 8 + h]; }
        __syncthreads();
        {
#pragma unroll
            for (int q = 0; q < 4; ++q) { const int t16 = wave * 2 + (q & 1), tm = t16 >> 2, tn = t16 & 3; const bool isq = q >= 2;
                const LAS bf16_t* Ab = (isq ? Qs : Ks) + (tm * 16 + (lane & 15)) * CP_LD + 8 * (lane >> 4); const LAS bf16_t* Bb = Ks + (tn * 16 + (lane & 15)) * CP_LD + 8 * (lane >> 4);
                f32x4 acc = {0.f, 0.f, 0.f, 0.f};
#pragma unroll
                for (int kk = 0; kk < 4; ++kk) acc = __builtin_amdgcn_mfma_f32_16x16x32_bf16(*(const LAS bf16x8*)(Ab + kk * 32), *(const LAS bf16x8*)(Bb + kk * 32), acc, 0, 0, 0);
                LAS float* dst = (isq ? QKs : KKs) + (tm * 16 + 4 * (lane >> 4)) * 65 + tn * 16 + (lane & 15);
#pragma unroll
                for (int rg = 0; rg < 4; ++rg) dst[rg * 65] = acc[rg]; }
            if (wave < 2) { float v = (wave == 0) ? Vec[lane] : Vec[64 + 63 - lane];
#pragma unroll
                for (int o = 1; o < 64; o <<= 1) { const float u = __shfl_up(v, o); if (lane >= o) v += u; }
                Vec[256 + wave * 64 + lane] = v; }
        }
        __syncthreads();
        for (int e = tid; e < 2 * 4096; e += NT_) { const int dir = e >> 12, i = (e >> 6) & 63, j = e & 63, pi = dir ? 63 - i : i, pj = dir ? 63 - j : j;
            const float gi = Vec[256 + dir * 64 + i], gj = Vec[256 + dir * 64 + j], beta_i = Vec[128 + dir * 64 + pi];
            const float dec = (i >= j) ? __expf(gi - gj) : 0.f;
            Ms[dir * 4096 + i * 64 + j] = (i > j) ? beta_i * KKs[pi * 65 + pj] * dec : 0.f;
            const size_t cidx = (size_t)(bh * 2 + dir) * NCH + (dir ? (tc < 4 ? 3 - tc : 135 - tc) : tc);
            ATd[cidx * 4096 + i * 64 + j] = (bf16_t)f2bf(QKs[pi * 65 + pj] * dec); }
        if (tid < 128) { const int dir = tid >> 6, i = tid & 63; const size_t cidx = (size_t)(bh * 2 + dir) * NCH + (dir ? (tc < 4 ? 3 - tc : 135 - tc) : tc);
            const float gi = Vec[256 + dir * 64 + i], gl = Vec[256 + dir * 64 + 63], egi = __expf(gi);
            EG[cidx * 64 + i] = egi; EKD[cidx * 64 + i] = __expf(gl - gi); if (i == 0) EGL[cidx] = __expf(gl);
            Vec[384 + dir * 128 + i] = Vec[128 + dir * 64 + (dir ? 63 - i : i)]; Vec[384 + dir * 128 + 64 + i] = egi; }
        __syncthreads();
        {
            const int dir = tid >> 8, c = tid & 255; const LAS float* Mr = Ms + dir * 4096;
            const LAS bf16_t* sp = ((c < 128) ? (Vs + c) : (Ks + (c - 128))) + (dir ? 63 * CP_LD : 0); const int sstep = dir ? -CP_LD : CP_LD;
            const LAS float* bsc = Vec + 384 + dir * 128;
            const size_t cidx = (size_t)(bh * 2 + dir) * NCH + (dir ? (tc < 4 ? 3 - tc : 135 - tc) : tc);
            bf16_t* dp = ((c < 128) ? Ud : Wd) + cidx * 8192 + (c & 127);
            const bool isw = c >= 128;
            float x[64];
#pragma unroll
            for (int i = 0; i < 64; ++i) {
                float r = __uint_as_float(((unsigned)sp[0]) << 16) * bsc[i];
                if (isw) r *= bsc[64 + i];
#pragma unroll
                for (int j4 = 0; j4 < (i + 3) / 4; ++j4) { const f32x4 mv = *(const LAS f32x4*)(Mr + i * 64 + j4 * 4);
#pragma unroll
                    for (int e = 0; e < 4; ++e) if (j4 * 4 + e < i) r -= mv[e] * x[j4 * 4 + e]; }
                x[i] = r; *dp = (bf16_t)f2bf(r); dp += 128; sp += sstep; asm volatile("" : "+v"(dp), "+v"(sp) :: "memory"); }
        }
        __syncthreads();
    }
}
constexpr int SC_WLD = 136, SC_TLD = 72;
constexpr int SC_W = 0, SC_QG = SC_W + 64 * SC_WLD * 2, SC_KDT = SC_QG + 64 * SC_WLD * 2, SC_ATT = SC_KDT + 128 * SC_TLD * 2, SC_U = SC_ATT + 64 * SC_TLD * 2,
              SC_SBT = SC_U + 64 * 16 * 4, SC_VNT = SC_SBT + 16 * SC_WLD * 2, SC_END = SC_VNT + 16 * SC_TLD * 2;
static_assert(SC_END <= 131072 && SC_QG % 16 == 0 && SC_KDT % 16 == 0 && SC_ATT % 16 == 0 && SC_U % 16 == 0 && SC_SBT % 16 == 0 && SC_VNT % 16 == 0, "scan LDS");
__device__ __forceinline__ void p6_scan(const Params& p, const Ctx& C) {
    const bf16_t* DNQ = (const bf16_t*)(p.ws + WS_DNQ); const bf16_t* Wd = (const bf16_t*)(p.ws + WS_W); const bf16_t* Ud = (const bf16_t*)(p.ws + WS_U); const bf16_t* ATd = (const bf16_t*)(p.ws + WS_ATT);
    const float* EG = (const float*)(p.ws + WS_EG); const float* EKD = EG + (size_t)4224 * 64; const float* EGL = EKD + (size_t)4224 * 64;
    LAS unsigned char* L = C.lds;
    LAS bf16_t* Ws = (LAS bf16_t*)(L + SC_W); LAS bf16_t* QGs = (LAS bf16_t*)(L + SC_QG); LAS bf16_t* KDT = (LAS bf16_t*)(L + SC_KDT); LAS bf16_t* ATs = (LAS bf16_t*)(L + SC_ATT);
    LAS float* Us = (LAS float*)(L + SC_U); LAS bf16_t* SBT = (LAS bf16_t*)(L + SC_SBT); LAS bf16_t* VNT = (LAS bf16_t*)(L + SC_VNT);
    const int tid = C.tid, lane = C.lane, wave = C.wave, l15 = lane & 15, lq = lane >> 4;
    for (int task = C.vcu; task < 256; task += C.G) {
        const int bhd = task >> 3, cb = task & 7, bh = bhd >> 1, dir = bhd & 1, b = bh >> 3, h = bh & 7, n0 = cb * 16;
        bf16_t* Od = (bf16_t*)(p.ws + (dir ? WS_OB : WS_OF));
        f32x4 S = {0.f, 0.f, 0.f, 0.f};
        if (tid < 16 * SC_WLD / 2) ((LAS unsigned*)SBT)[tid] = 0u;
        for (int e = tid; e < 16 * SC_WLD / 2; e += NT_) ((LAS unsigned*)SBT)[e] = 0u;
        for (int s = 0; s < NCH; ++s) {
            const size_t cidx = (size_t)bhd * NCH + s;
            int base; if (dir == 0) base = (s < 4) ? (ML + b * CTXL + s * 64) : (b * SEQ + (s - 4) * 64); else base = (s < 4) ? (ML + b * CTXL + (3 - s) * 64) : (b * SEQ + (131 - s) * 64);
            __syncthreads();
#pragma unroll
            for (int e2 = 0; e2 < 2; ++e2) { const int id = tid + NT_ * e2, i = id >> 4, chn = id & 15; const int row = base + (dir ? 63 - i : i);
                *(LAS v4u*)(Ws + i * SC_WLD + chn * 8) = *(const v4u*)(Wd + cidx * 8192 + i * 128 + chn * 8);
                const v4u qv = *(const v4u*)(DNQ + (size_t)row * 3072 + h * 128 + chn * 8); const float eg = EG[cidx * 64 + i];
                v4u qo; qo.x = pk2(bflo(qv.x) * eg, bfhi(qv.x) * eg); qo.y = pk2(bflo(qv.y) * eg, bfhi(qv.y) * eg); qo.z = pk2(bflo(qv.z) * eg, bfhi(qv.z) * eg); qo.w = pk2(bflo(qv.w) * eg, bfhi(qv.w) * eg);
                *(LAS v4u*)(QGs + i * SC_WLD + chn * 8) = qo;
                const v4u kv = *(const v4u*)(DNQ + (size_t)row * 3072 + 1024 + h * 128 + chn * 8); const float ek = EKD[cidx * 64 + i];
                const unsigned k0 = pk2(bflo(kv.x) * ek, bfhi(kv.x) * ek), k1 = pk2(bflo(kv.y) * ek, bfhi(kv.y) * ek), k2 = pk2(bflo(kv.z) * ek, bfhi(kv.z) * ek), k3 = pk2(bflo(kv.w) * ek, bfhi(kv.w) * ek);
                LAS bf16_t* kd = KDT + (chn * 8) * SC_TLD + i;
                kd[0 * SC_TLD] = (bf16_t)k0; kd[1 * SC_TLD] = (bf16_t)(k0 >> 16); kd[2 * SC_TLD] = (bf16_t)k1; kd[3 * SC_TLD] = (bf16_t)(k1 >> 16);
                kd[4 * SC_TLD] = (bf16_t)k2; kd[5 * SC_TLD] = (bf16_t)(k2 >> 16); kd[6 * SC_TLD] = (bf16_t)k3; kd[7 * SC_TLD] = (bf16_t)(k3 >> 16); }
            { const int i = tid >> 3, chn = tid & 7; *(LAS v4u*)(ATs + i * SC_TLD + chn * 8) = *(const v4u*)(ATd + cidx * 4096 + i * 64 + chn * 8); }
            if (tid < 128) { const int i = tid >> 1, hf = tid & 1; const v4u uv = *(const v4u*)(Ud + cidx * 8192 + i * 128 + n0 + hf * 8);
                LAS float* ud = Us + i * 16 + hf * 8; *(LAS f32x4*)ud = (f32x4){bflo(uv.x), bfhi(uv.x), bflo(uv.y), bfhi(uv.y)}; *(LAS f32x4*)(ud + 4) = (f32x4){bflo(uv.z), bfhi(uv.z), bflo(uv.w), bfhi(uv.w)}; }
            const float egl = EGL[cidx];
            __syncthreads();
            const int mt = wave & 3;
            f32x4 acc = {0.f, 0.f, 0.f, 0.f};
            { const LAS bf16_t* Ab = ((wave < 4) ? Ws : QGs) + (mt * 16 + l15) * SC_WLD + 8 * lq; const LAS bf16_t* Bb = SBT + l15 * SC_WLD + 8 * lq;
#pragma unroll
              for (int kk = 0; kk < 4; ++kk) acc = __builtin_amdgcn_mfma_f32_16x16x32_bf16(*(const LAS bf16x8*)(Ab + kk * 32), *(const LAS bf16x8*)(Bb + kk * 32), acc, 0, 0, 0); }
            if (wave < 4) { const int i0 = mt * 16 + 4 * lq;
                const float v0 = Us[(i0 + 0) * 16 + l15] - acc[0], v1 = Us[(i0 + 1) * 16 + l15] - acc[1], v2 = Us[(i0 + 2) * 16 + l15] - acc[2], v3 = Us[(i0 + 3) * 16 + l15] - acc[3];
                v2u w; w.x = pk2(v0, v1); w.y = pk2(v2, v3); *(LAS v2u*)(VNT + l15 * SC_TLD + i0) = w; }
            __syncthreads();
            if (wave >= 4) { const LAS bf16_t* Ab = ATs + (mt * 16 + l15) * SC_TLD + 8 * lq; const LAS bf16_t* Bb = VNT + l15 * SC_TLD + 8 * lq;
#pragma unroll
                for (int kk = 0; kk < 2; ++kk) acc = __builtin_amdgcn_mfma_f32_16x16x32_bf16(*(const LAS bf16x8*)(Ab + kk * 32), *(const LAS bf16x8*)(Bb + kk * 32), acc, 0, 0, 0);
                if (s >= 4) {
#pragma unroll
                    for (int rg = 0; rg < 4; ++rg) { const int i = mt * 16 + 4 * lq + rg; const int row = base + (dir ? 63 - i : i);
                        Od[(size_t)row * 1024 + h * 128 + n0 + l15] = (bf16_t)f2bf(acc[rg]); } } }
            { f32x4 sn = S * egl; const LAS bf16_t* Ab = KDT + (wave * 16 + l15) * SC_TLD + 8 * lq; const LAS bf16_t* Bb = VNT + l15 * SC_TLD + 8 * lq;
#pragma unroll
              for (int kk = 0; kk < 2; ++kk) sn = __builtin_amdgcn_mfma_f32_16x16x32_bf16(*(const LAS bf16x8*)(Ab + kk * 32), *(const LAS bf16x8*)(Bb + kk * 32), sn, 0, 0, 0);
              S = sn; }
            __syncthreads();
            { v2u w; w.x = pk2(S[0], S[1]); w.y = pk2(S[2], S[3]); *(LAS v2u*)(SBT + l15 * SC_WLD + wave * 16 + 4 * lq) = w; }
        }
        __syncthreads();
    }
}
__device__ __forceinline__ void p7_yb(const Params& p, const Ctx& C) {
    const bf16_t* OF = (const bf16_t*)(p.ws + WS_OF); const bf16_t* OB = (const bf16_t*)(p.ws + WS_OB); const bf16_t* Z = (const bf16_t*)(p.ws + WS_Z); bf16_t* YB = (bf16_t*)(p.ws + WS_YB);
    const long total = (long)ML * 128;
    for (long it = (long)C.vcu * NT_ + C.tid; it < total; it += (long)C.G * NT_) {
        const size_t off = (size_t)it * 8; const int d0 = (int)(off & 127);
        const v4u a = *(const v4u*)(OF + off), bq = *(const v4u*)(OB + off), zz = *(const v4u*)(Z + off);
        float o[8] = {bflo(a.x) + bflo(bq.x), bfhi(a.x) + bfhi(bq.x), bflo(a.y) + bflo(bq.y), bfhi(a.y) + bfhi(bq.y), bflo(a.z) + bflo(bq.z), bfhi(a.z) + bfhi(bq.z), bflo(a.w) + bflo(bq.w), bfhi(a.w) + bfhi(bq.w)};
        float zf[8] = {bflo(zz.x), bfhi(zz.x), bflo(zz.y), bfhi(zz.y), bflo(zz.z), bfhi(zz.z), bflo(zz.w), bfhi(zz.w)};
        float ss = 0.f;
#pragma unroll
        for (int e = 0; e < 8; ++e) ss += o[e] * o[e];
        ss += __shfl_xor(ss, 1); ss += __shfl_xor(ss, 2); ss += __shfl_xor(ss, 4); ss += __shfl_xor(ss, 8);
        const float rstd = rsqrtf(ss * (1.0f / 128.0f) + EPS);
        const f32x4 w0 = *(const f32x4*)(p.dn_norm_w + d0), w1 = *(const f32x4*)(p.dn_norm_w + d0 + 4);
        float y[8];
#pragma unroll
        for (int e = 0; e < 8; ++e) y[e] = o[e] * rstd * (e < 4 ? w0[e] : w1[e - 4]) * siluf(zf[e]);
        v4u w; w.x = pk2(y[0], y[1]); w.y = pk2(y[2], y[3]); w.z = pk2(y[4], y[5]); w.w = pk2(y[6], y[7]);
        *(v4u*)(YB + off) = w;
    }
}
typedef float f32x2_t __attribute__((ext_vector_type(2)));
__device__ __forceinline__ float gelu_erf(float v) { return 0.5f * v * (1.0f + erff(v * 0.7071067811865476f)); }
__device__ __forceinline__ float dot8(v4u a, v4u b, float acc) {
    acc += bflo(a.x) * bflo(b.x); acc += bfhi(a.x) * bfhi(b.x); acc += bflo(a.y) * bflo(b.y); acc += bfhi(a.y) * bfhi(b.y);
    acc += bflo(a.z) * bflo(b.z); acc += bfhi(a.z) * bfhi(b.z); acc += bflo(a.w) * bflo(b.w); acc += bfhi(a.w) * bfhi(b.w); return acc;
}
__device__ __forceinline__ unsigned ord_u32(float f) { const unsigned u = __float_as_uint(f); return u ^ ((u >> 31) ? 0xffffffffu : 0x80000000u); }
#define INS16(k, x) do { unsigned x_ = (x); _Pragma("unroll") for (int i_ = 0; i_ < 16; ++i_) { const unsigned lo_ = min(k[i_], x_); k[i_] = max(k[i_], x_); x_ = lo_; } } while (0)
constexpr int P12_SC = 0, P12_TOPS = 128 * 129 * 4, P12_TOPI = P12_TOPS + 128 * 16 * 4, P12_IDX = P12_TOPI + 128 * 16 * 4, P12_PW = P12_IDX + 8 * 128 * 4, P12_CF = P12_PW + 8 * 128 * 4, P12_END = P12_CF + 8 * 128 * 4;
static_assert(P12_END <= 131072, "p12 lds");
__device__ __forceinline__ void p12_peer(const Params& p, const Ctx& C, const bool do_final) {
    const float* SCp = (const float*)(p.ws + WS_SC); const bf16_t* H2 = (const bf16_t*)(p.ws + WS_H2);
    const unsigned char* UB = (const unsigned char*)(p.ws + WS_UB); const unsigned char* VB = (const unsigned char*)(p.ws + WS_VB); const float* USC = (const float*)(p.ws + WS_USC); const float* VSC = (const float*)(p.ws + WS_VSC);
    const float* MOD = (const float*)(p.ws + CTL_MOD);
    LAS float* SCs = (LAS float*)(C.lds + P12_SC); LAS float* TOPS = (LAS float*)(C.lds + P12_TOPS); LAS int* TOPI = (LAS int*)(C.lds + P12_TOPI);
    LAS int* IDX = (LAS int*)(C.lds + P12_IDX) + C.wave * 128; LAS float* PW = (LAS float*)(C.lds + P12_PW) + C.wave * 128; LAS float* CF = (LAS float*)(C.lds + P12_CF) + C.wave * 128;
    const int lane = C.lane, tid = C.tid;
    for (int tile = C.vcu; tile < ML / 8; tile += C.G) {
        const int t = tile * 8 + C.wave;
        { const float* src = SCp + (size_t)tile * 8 * 2048;
#pragma unroll 4
          for (int e4 = tid; e4 < 8 * 2048 / 4; e4 += NT_) { const f32x4 v = *(const f32x4*)(src + e4 * 4); const int L = e4 >> 5, k = (e4 & 31) * 4; LAS float* d = SCs + L * 129 + k; d[0] = v.x; d[1] = v.y; d[2] = v.z; d[3] = v.w; } }
        __syncthreads();
        if (tid < 256) {
            const int L = tid >> 1, hf = tid & 1; const LAS float* s = SCs + L * 129 + hf * 64;
            unsigned k[16];
#pragma unroll
            for (int i = 0; i < 16; ++i) k[i] = 0u;
#pragma unroll 8
            for (int j = 0; j < 64; ++j) { const unsigned key = (ord_u32(s[j]) & ~127u) | (unsigned)(127 - (hf * 64 + j)); INS16(k, key); }
#pragma unroll
            for (int i = 0; i < 16; ++i) { const unsigned o = __shfl_xor(k[i], 1); if (hf == 0) INS16(k, o); }
            if (hf == 0) {
#pragma unroll
                for (int i = 0; i < 16; ++i) { const int ki = 127 - (int)(k[i] & 127u); TOPI[L * 16 + i] = ki; TOPS[L * 16 + i] = SCs[L * 129 + ki]; } }
        }
        __syncthreads();
        if (tid < 64) {
            const int tt = tid >> 3, h = tid & 7, L0 = tt * 16 + h * 2, L1 = L0 + 1;
            float s0[16], s1[16];
#pragma unroll
            for (int i = 0; i < 16; ++i) { s0[i] = TOPS[L0 * 16 + i]; s1[i] = TOPS[L1 * 16 + i]; }
            unsigned k[16];
#pragma unroll
            for (int i = 0; i < 16; ++i) k[i] = 0u;
#pragma unroll
            for (int a = 0; a < 16; ++a)
#pragma unroll
                for (int b2 = 0; b2 < 16; ++b2) if ((a + 1) * (b2 + 1) <= 16) { const unsigned key = (ord_u32(s0[a] + s1[b2]) & ~255u) | (unsigned)(255 - (a * 16 + b2)); INS16(k, key); }
            float bs[16]; float mx = -3.0e38f;
#pragma unroll
            for (int i = 0; i < 16; ++i) { const int pos = 255 - (int)(k[i] & 255u), a = pos >> 4, b2 = pos & 15;
                bs[i] = TOPS[L0 * 16 + a] + TOPS[L1 * 16 + b2]; mx = fmaxf(mx, bs[i]);
                (LAS int&)(((LAS int*)(C.lds + P12_IDX))[tt * 128 + h * 16 + i]) = TOPI[L0 * 16 + a] * 128 + TOPI[L1 * 16 + b2]; }
            float sm = 0.f;
#pragma unroll
            for (int i = 0; i < 16; ++i) { bs[i] = __expf(bs[i] - mx); sm += bs[i]; }
            const float inv = 1.0f / sm;
#pragma unroll
            for (int i = 0; i < 16; ++i) ((LAS float*)(C.lds + P12_PW))[tt * 128 + h * 16 + i] = bs[i] * inv;
        }
        __syncthreads();
        float hxf[32];
        { const bf16_t* hp = H2 + (size_t)t * 2048 + 16 * lane;
#pragma unroll
          for (int j = 0; j < 2; ++j) { const v4u a = *(const v4u*)(hp + 1024 * j), b2 = *(const v4u*)(hp + 1024 * j + 8);
            hxf[16 * j + 0] = bflo(a.x); hxf[16 * j + 1] = bfhi(a.x); hxf[16 * j + 2] = bflo(a.y); hxf[16 * j + 3] = bfhi(a.y); hxf[16 * j + 4] = bflo(a.z); hxf[16 * j + 5] = bfhi(a.z); hxf[16 * j + 6] = bflo(a.w); hxf[16 * j + 7] = bfhi(a.w);
            hxf[16 * j + 8] = bflo(b2.x); hxf[16 * j + 9] = bfhi(b2.x); hxf[16 * j + 10] = bflo(b2.y); hxf[16 * j + 11] = bfhi(b2.y); hxf[16 * j + 12] = bflo(b2.z); hxf[16 * j + 13] = bfhi(b2.z); hxf[16 * j + 14] = bflo(b2.w); hxf[16 * j + 15] = bfhi(b2.w); } }
        for (int s8 = 0; s8 < 128; s8 += 8) {
            v4u ur[8][2]; float us[8];
#pragma unroll
            for (int q = 0; q < 8; ++q) { const size_t ex = (size_t)IDX[s8 + q]; us[q] = USC[ex];
                ur[q][0] = *(const v4u*)(UB + ex * 2048 + 16 * lane); ur[q][1] = *(const v4u*)(UB + ex * 2048 + 1024 + 16 * lane); }
            float dq[8];
#pragma unroll
            for (int q = 0; q < 8; ++q) { float d = 0.f;
#pragma unroll
                for (int j = 0; j < 2; ++j)
#pragma unroll
                    for (int w4 = 0; w4 < 4; ++w4) { const int wd = (int)ur[q][j][w4]; const f32x2_t lo = __builtin_amdgcn_cvt_pk_f32_fp8(wd, false), hi2 = __builtin_amdgcn_cvt_pk_f32_fp8(wd, true);
                        d += lo.x * hxf[16 * j + 4 * w4 + 0]; d += lo.y * hxf[16 * j + 4 * w4 + 1]; d += hi2.x * hxf[16 * j + 4 * w4 + 2]; d += hi2.y * hxf[16 * j + 4 * w4 + 3]; }
                dq[q] = d; }
            float r4[4], r2[2], r1;
#pragma unroll
            for (int i = 0; i < 4; ++i) { const bool up = (lane & 32) != 0; const float keep = up ? dq[4 + i] : dq[i], send = up ? dq[i] : dq[4 + i]; r4[i] = keep + __shfl_xor(send, 32); }
#pragma unroll
            for (int i = 0; i < 2; ++i) { const bool up = (lane & 16) != 0; const float keep = up ? r4[2 + i] : r4[i], send = up ? r4[i] : r4[2 + i]; r2[i] = keep + __shfl_xor(send, 16); }
            { const bool up = (lane & 8) != 0; const float keep = up ? r2[1] : r2[0], send = up ? r2[0] : r2[1]; r1 = keep + __shfl_xor(send, 8); }
            r1 += __shfl_xor(r1, 4); r1 += __shfl_xor(r1, 2); r1 += __shfl_xor(r1, 1);
            { const int row = ((lane >> 5) & 1) * 4 + ((lane >> 4) & 1) * 2 + ((lane >> 3) & 1);
              float usr = us[0];
#pragma unroll
              for (int q = 1; q < 8; ++q) usr = (row == q) ? us[q] : usr;
              if ((lane & 7) == 0) CF[s8 + row] = PW[s8 + row] * gelu_erf(r1 * usr); }
        }
        asm volatile("s_waitcnt lgkmcnt(0)" ::: "memory");
        float acc[32];
#pragma unroll
        for (int i = 0; i < 32; ++i) acc[i] = 0.f;
        for (int s8 = 0; s8 < 128; s8 += 8) {
            v4u vr[8][2]; float cf[8];
#pragma unroll
            for (int q = 0; q < 8; ++q) { const size_t ex = (size_t)IDX[s8 + q]; cf[q] = CF[s8 + q] * VSC[ex];
                vr[q][0] = *(const v4u*)(VB + ex * 2048 + 16 * lane); vr[q][1] = *(const v4u*)(VB + ex * 2048 + 1024 + 16 * lane); }
#pragma unroll
            for (int q = 0; q < 8; ++q)
#pragma unroll
                for (int j = 0; j < 2; ++j)
#pragma unroll
                    for (int w4 = 0; w4 < 4; ++w4) { const int wd = (int)vr[q][j][w4]; const f32x2_t lo = __builtin_amdgcn_cvt_pk_f32_fp8(wd, false), hi2 = __builtin_amdgcn_cvt_pk_f32_fp8(wd, true); const float c = cf[q];
                        acc[16 * j + 4 * w4 + 0] += c * lo.x; acc[16 * j + 4 * w4 + 1] += c * lo.y; acc[16 * j + 4 * w4 + 2] += c * hi2.x; acc[16 * j + 4 * w4 + 3] += c * hi2.y; }
        }
        if (!do_final) { asm volatile("" :: "v"(acc[0]), "v"(acc[7]), "v"(acc[13]), "v"(acc[31])); __syncthreads(); continue; }
        const int b = t >> 13; const float* g2 = MOD + b * 12288 + 10240;
        float* orow = p.out + (size_t)t * 2048; float ss = 0.f;
#pragma unroll
        for (int j = 0; j < 2; ++j)
#pragma unroll
            for (int q4 = 0; q4 < 4; ++q4) { const int c = 16 * lane + 1024 * j + 4 * q4; const f32x4 xv = *(const f32x4*)(orow + c), gv = *(const f32x4*)(g2 + c);
#pragma unroll
                for (int e = 0; e < 4; ++e) { float y = xv[e] + gv[e] * acc[16 * j + 4 * q4 + e];
#ifdef PROBE_ATTN_ALPHA
                    y += ((float)(PROBE_ATTN_ALPHA) - 1.0f) * __uint_as_float(((unsigned)((const bf16_t*)(p.ws + 124 * MiB))[(size_t)t * 2048 + c + e]) << 16);
#endif
                    acc[16 * j + 4 * q4 + e] = y; ss += y * y; } }
        const float rstd = rsqrtf(wave_sum(ss) * (1.0f / DM) + EPS);
#pragma unroll
        for (int j = 0; j < 2; ++j)
#pragma unroll
            for (int q4 = 0; q4 < 4; ++q4) { const int c = 16 * lane + 1024 * j + 4 * q4; const f32x4 fw = *(const f32x4*)(p.final_w + c);
                f32x4 o;
#pragma unroll
                for (int e = 0; e < 4; ++e) o[e] = acc[16 * j + 4 * q4 + e] * rstd * fw[e];
                *(f32x4*)(orow + c) = o; }
        __syncthreads();
    }
}
__device__ __forceinline__ void cvt_fp8_rows(const Ctx& C, const float* src, unsigned char* dst, float* scl, int nrows) {
    const int gw = C.vcu * 8 + C.wave, NGW = C.G * 8, lane = C.lane;
    for (int r = gw; r < nrows; r += NGW) {
        const float* sp = src + (size_t)r * 2048 + 16 * lane; f32x4 v[8]; float mx = 0.f;
#pragma unroll
        for (int j = 0; j < 2; ++j)
#pragma unroll
            for (int q = 0; q < 4; ++q) { v[j * 4 + q] = *(const f32x4*)(sp + 1024 * j + 4 * q); const f32x4 a = v[j * 4 + q]; mx = fmaxf(mx, fmaxf(fmaxf(fabsf(a.x), fabsf(a.y)), fmaxf(fabsf(a.z), fabsf(a.w)))); }
#pragma unroll
        for (int o = 1; o < 64; o <<= 1) mx = fmaxf(mx, __shfl_xor(mx, o));
        mx = fmaxf(mx, 1e-30f); const float inv = 440.0f / mx;
        if (lane == 0) scl[r] = mx * (1.0f / 440.0f);
#pragma unroll
        for (int j = 0; j < 2; ++j) { v4u w;
#pragma unroll
            for (int q = 0; q < 4; ++q) { const f32x4 a = v[j * 4 + q] * inv; int wd = 0; wd = __builtin_amdgcn_cvt_pk_fp8_f32(a.x, a.y, wd, false); wd = __builtin_amdgcn_cvt_pk_fp8_f32(a.z, a.w, wd, true); w[q] = (unsigned)wd; }
            *(v4u*)(dst + (size_t)r * 2048 + 1024 * j + 16 * lane) = w; }
    }
}
__device__ __forceinline__ void cvt_rows(const Ctx& C, const float* src, bf16_t* dst, long n8) {
    for (long i = (long)C.vcu * NT_ + C.tid; i < n8; i += (long)C.G * NT_) { const f32x4 a = *(const f32x4*)(src + i * 8), b = *(const f32x4*)(src + i * 8 + 4);
        v4u w; w.x = pk2(a.x, a.y); w.y = pk2(a.z, a.w); w.z = pk2(b.x, b.y); w.w = pk2(b.z, b.w); *(v4u*)(dst + i * 8) = w; }
}
#ifdef PROBE_ATTN_ALPHA
#define PROBE_MGA(ws) ((bf16_t*)((ws) + 60 * MiB))
#else
#define PROBE_MGA(ws) ((bf16_t*)nullptr)
#endif
constexpr int LDS_BYTES = 147456;
constexpr int N_PHASES = 13;
constexpr int LDS_MISC = LDS_BYTES - 64;
__global__ void __launch_bounds__(NT_, 2) mega_fwd(Params p_arg) {
    extern __shared__ __attribute__((aligned(16))) unsigned char lds_raw[];
    const int wave_s = __builtin_amdgcn_readfirstlane((int)threadIdx.x >> 6);
    const int G_s = gridDim.x, bx_s = blockIdx.x, vcu_s = (G_s % 8 == 0) ? (bx_s % 8) * (G_s / 8) + bx_s / 8 : bx_s;
#define MKCTX() Ctx C; { unsigned m_ = ~0u; asm volatile("" : "+s"(m_)); C.lane = (int)__builtin_amdgcn_mbcnt_hi(m_, __builtin_amdgcn_mbcnt_lo(m_, 0u)); } \
    C.lds = (LAS unsigned char*)lds_raw; C.wave = wave_s; C.tid = wave_s * 64 + C.lane; C.G = G_s; C.vcu = vcu_s
    const int lo = p_arg.ph_lo, hi = p_arg.ph_hi;
#if defined(__HIP_DEVICE_COMPILE__)
#define LOADP() MKCTX(); typedef const __attribute__((address_space(4))) Params* CPP_; CPP_ kp_ = (CPP_)__builtin_amdgcn_kernarg_segment_ptr(); asm volatile("" : "+s"(kp_)); const Params p = *kp_; \
    unsigned char* ws = p.ws; const float* MOD = (const float*)(ws + CTL_MOD); (void)MOD
#else
#define LOADP() MKCTX(); const Params p = p_arg; unsigned char* ws = p.ws; const float* MOD = (const float*)(ws + CTL_MOD); (void)MOD
#endif
#ifndef PH_MASK
#define PH_MASK 0xffff
#endif
#define IN(k) (((PH_MASK >> (k)) & 1) && lo <= (k) && (k) < hi)
#ifndef PROBE_REP
#define PROBE_REP -1
#endif
#define NREP(k) ((PROBE_REP == (k)) ? 2 : 1)
#define BAR_() do { LOADP(); XcdBarrier b_; b_.bar = (unsigned*)(ws + CTL_BAR); b_.x = xb_xcc_id(); b_.st = (volatile LAS unsigned*)(C.lds + LDS_MISC); xcd_barrier(b_, C.tid); } while (0)
#define SEAM(k) do { if (IN(k) && IN((k) + 1)) { LOADP(); XcdBarrier b_; b_.bar = (unsigned*)(ws + CTL_BAR); b_.x = xb_xcc_id(); b_.st = (volatile LAS unsigned*)(C.lds + LDS_MISC); xcd_barrier(b_, C.tid); } } while (0)
    if (hi - lo > 1) { LOADP(); if (C.tid < 2) ((volatile LAS unsigned*)(C.lds + LDS_MISC))[C.tid] = 0u; __syncthreads();
        (void)xcd_barrier_post((unsigned*)(ws + CTL_BAR), (volatile LAS unsigned*)(C.lds + LDS_MISC), C.tid); }
    for (int rep_ = 0; rep_ < NREP(0); ++rep_) if (IN(0)) { if (rep_) BAR_(); LOADP(); p0_prologue(p, C); } SEAM(0);
    for (int rep_ = 0; rep_ < NREP(1); ++rep_) if (IN(1)) { if (rep_) BAR_(); LOADP();
        bf16_t* H = (bf16_t*)(ws + WS_D);
        mod_norm_rows(C, p.x, SEQ, p.norm1_w, MOD, MOD + 2048, H);
        mod_norm_rows(C, p.x + (size_t)SEQ * DM, SEQ, p.norm1_w, MOD + 12288, MOD + 12288 + 2048, H + (size_t)SEQ * DM);
        mod_norm_rows(C, p.ctx, MC, p.norm1_w, MOD + 2 * 12288, MOD + 2 * 12288 + 2048, H + (size_t)ML * DM);
    } SEAM(1);
    for (int rep_ = 0; rep_ < NREP(2); ++rep_) if (IN(2)) { if (rep_) BAR_(); LOADP();
        pg8::Gemm g{(const bf16_t*)(ws + WS_D), (const bf16_t*)(ws + WS_C), M1, NIN_PAD, DM}; pg8::StaticOrder S; S.init(M1, NIN_PAD, C.G, (int)blockIdx.x);
        pg8::EpiIn E{(bf16_t*)(ws + WS_CQ), (bf16_t*)(ws + WS_CKV), (bf16_t*)(ws + WS_QKV), (bf16_t*)(ws + WS_Z), (bf16_t*)(ws + WS_GA), (bf16_t*)(ws + WS_GB),
                     (float*)(ws + WS_KR), (float*)(ws + WS_AB), (float*)(ws + CTL_SSQQ), (float*)(ws + CTL_SSQKV)};
        pg8::gemm_phase<pg8::EpiIn, pg8::StaticOrder, true, true>(C.lds, g, S, E, C.tid);
    } SEAM(2);
    for (int rep_ = 0; rep_ < NREP(3); ++rep_) if (IN(3)) { if (rep_) BAR_();
        { LOADP(); pg8::Gemm g{(const bf16_t*)(ws + WS_CQ), (const bf16_t*)(ws + WS_WUQ), ML, 1536, 512}; pg8::StaticOrder S; S.init(ML, 1536, C.G, (int)blockIdx.x);
          pg8::EpiQ E{(bf16_t*)(ws + WS_D), (const float*)(ws + CTL_SSQQ), QSCALE};
          pg8::gemm_phase<pg8::EpiQ, pg8::StaticOrder, true, true>(C.lds, g, S, E, C.tid); }
        { LOADP(); pg8::Gemm g{(const bf16_t*)(ws + WS_CKV), (const bf16_t*)(ws + WS_WUKV), M1, 2048, 256}; pg8::StaticOrder S; S.init(M1, 2048, C.G, (int)blockIdx.x);
          pg8::EpiKV E{(bf16_t*)(ws + WS_K), (bf16_t*)(ws + WS_C), (const float*)(ws + CTL_SSQKV)};
          pg8::gemm_phase<pg8::EpiKV, pg8::StaticOrder, true, true>(C.lds, g, S, E, C.tid); }
        { LOADP(); p3_conv(p, C); }
        { LOADP(); p3_krope_gbeta(p, C); }
    } SEAM(3);
    for (int rep_ = 0; rep_ < NREP(4); ++rep_) if (IN(4)) { if (rep_) BAR_(); LOADP();
        const bf16_t* Q = (const bf16_t*)(ws + WS_D); const bf16_t* K = (const bf16_t*)(ws + WS_K); const bf16_t* V = (const bf16_t*)(ws + WS_C); bf16_t* YA = (bf16_t*)(ws + WS_YA);
        for (int u = C.vcu; u < 512; u += C.G) { const int bh = u >> 5, qb = u & 31, b = bh >> 3, h = bh & 7;
            attn::attn_unit(Q + ((size_t)bh * SEQ + qb * 256) * 192, K + (size_t)bh * LKV * 192, V + (size_t)bh * LKV * 128,
                            YA + ((size_t)b * SEQ + qb * 256) * 1024 + h * 128, 1024, LKV, (char*)lds_raw, C.tid); }
    } SEAM(4);
    for (int rep_ = 0; rep_ < NREP(5); ++rep_) if (IN(5)) { if (rep_) BAR_(); LOADP(); p5_chunk_prep(p, C); } SEAM(5);
    for (int rep_ = 0; rep_ < NREP(6); ++rep_) if (IN(6)) { if (rep_) BAR_(); LOADP(); p6_scan(p, C); } SEAM(6);
    for (int rep_ = 0; rep_ < NREP(7); ++rep_) if (IN(7)) { if (rep_) BAR_(); LOADP(); p7_yb(p, C); } SEAM(7);
    for (int rep_ = 0; rep_ < NREP(8); ++rep_) if (IN(8)) { if (rep_) BAR_();
        { LOADP(); pg8::Gemm g{(const bf16_t*)(ws + WS_YA), (const bf16_t*)(ws + WS_WBA), ML, 2048, 1024}; pg8::StaticOrder S; S.init(ML, 2048, C.G, (int)blockIdx.x);
          pg8::EpiMerge<true> E{(const bf16_t*)(ws + WS_GA), (bf16_t*)(ws + WS_MG), PROBE_MGA(ws)};
          pg8::gemm_phase<pg8::EpiMerge<true>, pg8::StaticOrder, true, true>(C.lds, g, S, E, C.tid); }
        { LOADP(); pg8::Gemm g{(const bf16_t*)(ws + WS_YB), (const bf16_t*)(ws + WS_WBB), ML, 2048, 1024}; pg8::StaticOrder S; S.init(ML, 2048, C.G, (int)blockIdx.x);
          pg8::EpiMerge<false> E{(const bf16_t*)(ws + WS_GB), (bf16_t*)(ws + WS_MG), nullptr};
          pg8::gemm_phase<pg8::EpiMerge<false>, pg8::StaticOrder, true, true>(C.lds, g, S, E, C.tid); }
    } SEAM(8);
    for (int rep_ = 0; rep_ < NREP(9); ++rep_) if (IN(9)) { if (rep_) BAR_(); LOADP();
        pg8::Gemm g{(const bf16_t*)(ws + WS_MG), (const bf16_t*)(ws + WS_WOUT), ML, 2048, 2048}; pg8::StaticOrder S; S.init(ML, 2048, C.G, (int)blockIdx.x);
        pg8::EpiOut E{p.x, MOD + 4096, p.out};
        pg8::gemm_phase<pg8::EpiOut, pg8::StaticOrder, true, true>(C.lds, g, S, E, C.tid);
    } SEAM(9);
#ifdef PROBE_ATTN_ALPHA
    if (IN(9)) { BAR_(); LOADP();
        pg8::Gemm g{(const bf16_t*)(ws + 60 * MiB), (const bf16_t*)(ws + WS_WOUT), ML, 2048, 2048}; pg8::StaticOrder S; S.init(ML, 2048, C.G, (int)blockIdx.x);
        pg8::EpiDelta E{MOD + 4096, (bf16_t*)(ws + 124 * MiB)};
        pg8::gemm_phase<pg8::EpiDelta, pg8::StaticOrder, true, true>(C.lds, g, S, E, C.tid);
    }
#endif
    for (int rep_ = 0; rep_ < NREP(10); ++rep_) if (IN(10)) { if (rep_) BAR_(); LOADP();
        bf16_t* H2 = (bf16_t*)(ws + WS_H2);
        mod_norm_rows(C, p.out, SEQ, p.norm2_w, MOD + 6144, MOD + 8192, H2);
        mod_norm_rows(C, p.out + (size_t)SEQ * DM, SEQ, p.norm2_w, MOD + 12288 + 6144, MOD + 12288 + 8192, H2 + (size_t)SEQ * DM);
        cvt_fp8_rows(C, p.peer_u, ws + WS_UB, (float*)(ws + WS_USC), 16384);
        cvt_fp8_rows(C, p.peer_v, ws + WS_VB, (float*)(ws + WS_VSC), 16384);
    } SEAM(10);
    for (int rep_ = 0; rep_ < NREP(11); ++rep_) if (IN(11)) { if (rep_) BAR_(); LOADP();
        pg8::Gemm g{(const bf16_t*)(ws + WS_H2), (const bf16_t*)(ws + WS_WPQ), ML, 2048, 2048}; pg8::StaticOrder S; S.init(ML, 2048, C.G, (int)blockIdx.x);
        pg8::EpiScore E{(float*)(ws + WS_SC)};
        pg8::gemm_phase<pg8::EpiScore, pg8::StaticOrder, true, true>(C.lds, g, S, E, C.tid);
    } SEAM(11);
    for (int rep_ = 0; rep_ < NREP(12); ++rep_) if (IN(12)) { if (rep_) BAR_(); LOADP(); p12_peer(p, C, rep_ == NREP(12) - 1); }
#undef IN
#undef SEAM
}

#ifndef MK_SINGLE
#define MK_SINGLE 1
#endif
extern "C" void kernel_launch(void* const* d_in, const int* in_sizes, int n_in, void* d_out, int out_size, void* d_ws, size_t ws_size, hipStream_t stream) {
    static int grid = 0;
    if (grid == 0) {
        if (n_in != 25 || out_size != ML * DM || ws_size < WS_END) { fprintf(stderr, "kernel_launch: unexpected shapes: n_in %d out %d ws %zu (need %zu)\n", n_in, out_size, ws_size, (size_t)WS_END); grid = -1; return; }
        int dev = 0, cus = 0, per_cu = 0;
        if (hipGetDevice(&dev) != hipSuccess || hipDeviceGetAttribute(&cus, hipDeviceAttributeMultiprocessorCount, dev) != hipSuccess) { grid = -1; return; }
        if (hipFuncSetAttribute((const void*)mega_fwd, hipFuncAttributeMaxDynamicSharedMemorySize, LDS_BYTES) != hipSuccess) { fprintf(stderr, "kernel_launch: hipFuncSetAttribute failed\n"); grid = -1; return; }
        if (hipOccupancyMaxActiveBlocksPerMultiprocessor(&per_cu, (const void*)mega_fwd, NT_, LDS_BYTES) != hipSuccess || per_cu < 1) { fprintf(stderr, "kernel_launch: occupancy query says %d\n", per_cu); per_cu = 1; }
        (void)hipGetLastError();
        grid = cus;
    }
    if (grid < 0) return;
    (void)hipMemsetAsync((char*)d_ws + WS_CTL, 0, CTL_BYTES, stream);
    Params p{};
    const float** pp = (const float**)&p;
    for (int i = 0; i < 25; ++i) pp[i] = (const float*)d_in[i];
    p.out = (float*)d_out; p.ws = (unsigned char*)d_ws;
#if MK_SINGLE
    p.ph_lo = 0; p.ph_hi = N_PHASES;
    hipLaunchKernelGGL(mega_fwd, dim3(grid), dim3(NT_), LDS_BYTES, stream, p);
#else
    for (int ph = 0; ph < N_PHASES; ++ph) { p.ph_lo = ph; p.ph_hi = ph + 1; hipLaunchKernelGGL(mega_fwd, dim3(grid), dim3(NT_), LDS_BYTES, stream, p); }
#endif
}
```

```cpp
#include <hip/hip_runtime.h>
#include <hip/hip_bf16.h>
#include <cstdio>
#include <cstdint>
#include <cmath>
namespace pg8 {
#define PG8_LAS __attribute__((address_space(3)))
typedef unsigned short bf16_t;
typedef short bf16x8 __attribute__((ext_vector_type(8)));
typedef float f32x4 __attribute__((ext_vector_type(4)));
typedef unsigned u32x4 __attribute__((ext_vector_type(4)));
constexpr int BM = 256, BK = 64, HALF = 128, HTB = HALF * BK * 2  , STAGE_BYTES = 8 * HTB, NXCD = 8, WGM = 8;

__host__ __device__ __forceinline__ int lds_byte(int r, int c) { const int st = (r >> 4) * 2 + (c >> 5), rr = r & 15, cc = c & 31, ob = rr * 64 + cc * 2; return st * 1024 + (ob ^ (((ob >> 9) & 1) << 5)); }
__host__ __device__ __forceinline__ void stage_rc(int b, int& R, int& C) { const int st = b / 1024, sb = b % 1024, swz = sb ^ (((sb >> 9) & 1) << 5); R = (st >> 1) * 16 + swz / 64; C = (st & 1) * 32 + (swz % 64) / 2; }
__host__ __device__ __forceinline__ int perm32(int rho) { const int n = rho >> 4, i = rho & 15; return 8 * (i >> 2) + 4 * n + (i & 3); }

struct Unit { int pm, pn; };
struct Gemm { const bf16_t* A; const bf16_t* Bt; int M, N, K; };

struct StaticOrder {
    int nM, nN, nwg, G, c;
    __host__ __device__ void init(int M, int N, int G_, int c_) { nM = M / BM; nN = N / BM; nwg = nM * nN; G = G_; c = c_; }
    __host__ __device__ bool next(int i, Unit& u) const {
        const long L = (long)i * G + c; if (L >= nwg) return false;
        int wgid = (int)L; { const int q = nwg / NXCD, r = nwg % NXCD, xcd = wgid % NXCD, off = wgid / NXCD; wgid = (xcd < r ? xcd * (q + 1) : r * (q + 1) + (xcd - r) * q) + off; }
        const int nig = WGM * nN, gid = wgid / nig, fm = gid * WGM, gsz = (nM - fm) < WGM ? (nM - fm) : WGM;
        u.pm = fm + ((wgid % nig) % gsz); u.pn = (wgid % nig) / gsz; return true;
    }
    __device__ __forceinline__ void a_ready(const Unit&) const {}
    __device__ __forceinline__ void done(const Unit&) const {}
};
typedef float f32x2 __attribute__((ext_vector_type(2)));
typedef __bf16 bf16x2_g __attribute__((ext_vector_type(2)));
__device__ __forceinline__ unsigned cvt_pk_bf16(float lo, float hi) { f32x2 v = {lo, hi}; bf16x2_g b = __builtin_convertvector(v, bf16x2_g); return __builtin_bit_cast(unsigned, b); }
template <class Epi, class Sched, bool ALIGN_EPI = false, bool SP2 = false>
__device__ __forceinline__ void gemm_phase(PG8_LAS unsigned char* lds, const Gemm g, const Sched& S, const Epi& E, const int tid) {
    const int wid = __builtin_amdgcn_readfirstlane(tid >> 6), lane = tid & 63, wr = wid >> 2, wc = wid & 3, fr = lane & 15, fq = lane >> 4;
    const int K = g.K, nt = K / BK;
    unsigned voffA[2], voffB[2];
#pragma unroll
    for (int i = 0; i < 2; ++i) { int R, C; stage_rc(tid * 16 + i * 8192, R, C); const int Rb = Epi::PERM ? ((R & ~31) + perm32(R & 31)) : R;
        voffA[i] = (unsigned)(R * K + C) * 2u; voffB[i] = (unsigned)(Rb * K + C) * 2u; }
    const size_t kstep = (size_t)(BK * 2);
    const size_t hstep = (size_t)HALF * K * 2;
    const size_t tstep = 2 * hstep;
    const unsigned ldsw = (unsigned)wid * 1024u;
    const int aoff = lds_byte(wr * 64 + fr, fq * 8), boff = lds_byte(wc * 32 + fr, fq * 8);
#define PG8_SA(b, h) (((b) * 2 + (h)) * HTB)
#define PG8_SB(b, h) ((4 + (b) * 2 + (h)) * HTB)
#define PG8_STAGE(bufoff, gbase, voff) do { _Pragma("unroll") for (int _i = 0; _i < 2; ++_i) \
        __builtin_amdgcn_global_load_lds((const unsigned*)((const char*)(gbase) + (voff)[_i]), (PG8_LAS unsigned*)(lds + (bufoff) + ldsw + _i * 8192), 16, 0, 0); } while (0)
#define PG8_LDA(dst, b, h) do { _Pragma("unroll") for (int m = 0; m < 4; ++m) _Pragma("unroll") for (int k = 0; k < 2; ++k) dst[m][k] = *(const PG8_LAS bf16x8*)(lds + PG8_SA(b, h) + aoff + m * 2048 + k * 1024); } while (0)
#define PG8_LDB(dst, b, h) do { _Pragma("unroll") for (int n = 0; n < 2; ++n) _Pragma("unroll") for (int k = 0; k < 2; ++k) dst[n][k] = *(const PG8_LAS bf16x8*)(lds + PG8_SB(b, h) + boff + n * 2048 + k * 1024); } while (0)
#define PG8_MMA(ai, bj, At, Bt) do { __builtin_amdgcn_s_setprio(1); _Pragma("unroll") for (int m = 0; m < 4; ++m) _Pragma("unroll") for (int n = 0; n < 2; ++n) _Pragma("unroll") for (int k = 0; k < 2; ++k) \
        acc[ai][bj][m][n] = __builtin_amdgcn_mfma_f32_16x16x32_bf16(Bt[n][k], At[m][k], acc[ai][bj][m][n], 0, 0, 0); __builtin_amdgcn_s_setprio(0); } while (0)
#define PG8_WAIT_V(n) asm volatile("s_waitcnt vmcnt(" #n ")" ::: "memory")
#define PG8_WAIT_L(n) asm volatile("s_waitcnt lgkmcnt(" #n ")" ::: "memory")
#define PG8_BAR __builtin_amdgcn_s_barrier()
#define PG8_SCHED __builtin_amdgcn_sched_barrier(0)
    Unit cur, nxt; int ui = 0;
    if (!S.next(0, cur)) return;
    f32x4 acc[2][2][4][2];
#pragma unroll
    for (int a = 0; a < 2; ++a)
#pragma unroll
        for (int b = 0; b < 2; ++b)
#pragma unroll
            for (int m = 0; m < 4; ++m)
#pragma unroll
                for (int n = 0; n < 2; ++n) acc[a][b][m][n] = (f32x4){0.f, 0.f, 0.f, 0.f};
    bf16x8 At[4][2], B0[2][2], B1[2][2];
    const char* cA = (const char*)g.A + (size_t)cur.pm * tstep; const char* cB = (const char*)g.Bt + (size_t)cur.pn * tstep;
    S.a_ready(cur);
    if constexpr (SP2) {
        PG8_STAGE(PG8_SB(0, 0), cB, voffB); PG8_STAGE(PG8_SB(0, 1), cB + hstep, voffB); PG8_STAGE(PG8_SA(0, 0), cA, voffA); PG8_STAGE(PG8_SA(0, 1), cA + hstep, voffA);
        if (wr == 1) PG8_BAR;
        PG8_WAIT_V(2); PG8_BAR;
        PG8_STAGE(PG8_SB(1, 0), cB + kstep, voffB); PG8_STAGE(PG8_SA(1, 0), cA + kstep, voffA); PG8_STAGE(PG8_SB(1, 1), cB + hstep + kstep, voffB);
        PG8_WAIT_V(6); PG8_BAR;
    } else {
        PG8_STAGE(PG8_SB(0, 0), cB, voffB); PG8_STAGE(PG8_SA(0, 0), cA, voffA); PG8_STAGE(PG8_SB(0, 1), cB + hstep, voffB); PG8_STAGE(PG8_SA(0, 1), cA + hstep, voffA);
        if (wr == 1) PG8_BAR;
        PG8_WAIT_V(4); PG8_BAR;
        PG8_STAGE(PG8_SB(1, 0), cB + kstep, voffB); PG8_STAGE(PG8_SA(1, 0), cA + kstep, voffA); PG8_STAGE(PG8_SB(1, 1), cB + hstep + kstep, voffB);
        PG8_WAIT_V(6); PG8_BAR;
    }
    for (;;) {
        const bool has_next = S.next(ui + 1, nxt);
        const char* nA = has_next ? (const char*)g.A + (size_t)nxt.pm * tstep : cA; const char* nB = has_next ? (const char*)g.Bt + (size_t)nxt.pn * tstep : cB;
        for (int t = 0; t < nt; t += 2) {
            const bool last = (t == nt - 2);
            const char* a1 = cA + (size_t)(t + 1) * kstep;
            const char* a2 = last ? nA : cA + (size_t)(t + 2) * kstep; const char* b2 = last ? nB : cB + (size_t)(t + 2) * kstep;
            const char* a3 = a2 + kstep; const char* b3 = b2 + kstep;
            if (last && has_next) S.a_ready(nxt);
            if constexpr (SP2) {
            PG8_LDB(B0, 0, 0); PG8_LDB(B1, 0, 1); PG8_SCHED; PG8_LDA(At, 0, 0); PG8_STAGE(PG8_SA(1, 1), a1 + hstep, voffA);
            PG8_WAIT_V(8); PG8_WAIT_L(0); PG8_BAR; PG8_MMA(0, 0, At, B0); PG8_MMA(0, 1, At, B1); PG8_BAR; PG8_SCHED;
            PG8_LDA(At, 0, 1); PG8_STAGE(PG8_SB(0, 0), b2, voffB); PG8_STAGE(PG8_SB(0, 1), b2 + hstep, voffB); PG8_STAGE(PG8_SA(0, 0), a2, voffA);
            PG8_WAIT_V(8); PG8_WAIT_L(0); PG8_BAR; PG8_MMA(1, 0, At, B0); PG8_MMA(1, 1, At, B1); PG8_BAR; PG8_SCHED;
            PG8_LDB(B0, 1, 0); PG8_LDB(B1, 1, 1); PG8_SCHED; PG8_LDA(At, 1, 0); PG8_STAGE(PG8_SA(0, 1), a2 + hstep, voffA);
            PG8_WAIT_V(8); PG8_WAIT_L(0); PG8_BAR; PG8_MMA(0, 0, At, B0); PG8_MMA(0, 1, At, B1); PG8_BAR; PG8_SCHED;
            PG8_LDA(At, 1, 1); PG8_STAGE(PG8_SB(1, 0), b3, voffB); PG8_STAGE(PG8_SB(1, 1), b3 + hstep, voffB); PG8_STAGE(PG8_SA(1, 0), a3, voffA);
            PG8_WAIT_V(8); PG8_WAIT_L(0); PG8_BAR; PG8_MMA(1, 0, At, B0); PG8_MMA(1, 1, At, B1); PG8_BAR; PG8_SCHED;
            } else {
            PG8_LDB(B0, 0, 0); PG8_SCHED; PG8_LDA(At, 0, 0); PG8_STAGE(PG8_SA(1, 1), a1 + hstep, voffA);
            PG8_WAIT_L(8); PG8_BAR; PG8_WAIT_L(0); PG8_MMA(0, 0, At, B0); PG8_BAR; PG8_SCHED;
            PG8_LDB(B1, 0, 1); PG8_STAGE(PG8_SB(0, 0), b2, voffB);
            PG8_BAR; PG8_WAIT_L(0); PG8_MMA(0, 1, At, B1); PG8_BAR;
            PG8_LDA(At, 0, 1); PG8_STAGE(PG8_SA(0, 0), a2, voffA);
            PG8_BAR; PG8_WAIT_L(0); PG8_MMA(1, 0, At, B0); PG8_BAR; PG8_SCHED;
            PG8_STAGE(PG8_SB(0, 1), b2 + hstep, voffB);
            PG8_WAIT_V(6); PG8_BAR; PG8_MMA(1, 1, At, B1); PG8_BAR;
            PG8_LDB(B0, 1, 0); PG8_SCHED; PG8_LDA(At, 1, 0); PG8_STAGE(PG8_SA(0, 1), a2 + hstep, voffA);
            PG8_WAIT_L(8); PG8_BAR; PG8_WAIT_L(0); PG8_MMA(0, 0, At, B0); PG8_BAR; PG8_SCHED;
            PG8_LDB(B1, 1, 1); PG8_STAGE(PG8_SB(1, 0), b3, voffB);
            PG8_BAR; PG8_WAIT_L(0); PG8_MMA(0, 1, At, B1); PG8_BAR;
            PG8_LDA(At, 1, 1); PG8_STAGE(PG8_SA(1, 0), a3, voffA);
            PG8_BAR; PG8_WAIT_L(0); PG8_MMA(1, 0, At, B0); PG8_BAR; PG8_SCHED;
            PG8_STAGE(PG8_SB(1, 1), b3 + hstep, voffB);
            PG8_WAIT_V(6); PG8_BAR; PG8_MMA(1, 1, At, B1); PG8_BAR;
            }
        }
        if constexpr (ALIGN_EPI) { if (wr == 0) PG8_BAR; }
        if constexpr (!Epi::AFTER_DRAIN) { E(acc, cur, wr, wc, fr, fq); S.done(cur); }
        if (!has_next) break;
#pragma unroll
        for (int a = 0; a < 2; ++a)
#pragma unroll
            for (int b = 0; b < 2; ++b)
#pragma unroll
                for (int m = 0; m < 4; ++m)
#pragma unroll
                    for (int n = 0; n < 2; ++n) acc[a][b][m][n] = (f32x4){0.f, 0.f, 0.f, 0.f};
        cur = nxt; cA = nA; cB = nB; ++ui;
        if constexpr (ALIGN_EPI) { if (wr == 1) PG8_BAR; }
    }
    PG8_WAIT_V(0);
    if constexpr (!ALIGN_EPI) { if (wr == 0) PG8_BAR; }
    PG8_BAR;
    if constexpr (Epi::AFTER_DRAIN) { E.fused(acc, cur, wr, wc, fr, fq, lds, wid, lane); S.done(cur); }
#undef PG8_SA
#undef PG8_SB
#undef PG8_STAGE
#undef PG8_LDA
#undef PG8_LDB
#undef PG8_MMA
#undef PG8_WAIT_V
#undef PG8_WAIT_L
#undef PG8_BAR
#undef PG8_SCHED
}
__device__ __forceinline__ float bfu(unsigned short v) { return __uint_as_float(((unsigned)v) << 16); }
__device__ __forceinline__ void fast_sincos(float x, float& sn, float& cs) {
    float rev = x * 0.15915494309189535f; rev -= rintf(rev); sn = __builtin_amdgcn_sinf(rev); cs = __builtin_amdgcn_cosf(rev); }
__device__ __forceinline__ float sigm(float v) { return 1.0f / (1.0f + __expf(-v)); }
__device__ __forceinline__ void store_tile_bf16(const f32x4 (&acc)[2][2][4][2], bf16_t* tile  , int ld, int wr, int wc, int fr, int fq) {
#pragma unroll
    for (int ai = 0; ai < 2; ++ai)
#pragma unroll
        for (int m = 0; m < 4; ++m) { bf16_t* rowp = tile + (size_t)(ai * HALF + wr * 64 + m * 16 + fr) * ld + wc * 32 + 8 * fq;
#pragma unroll
            for (int bj = 0; bj < 2; ++bj) { const f32x4 v0 = acc[ai][bj][m][0], v1 = acc[ai][bj][m][1];
                u32x4 w; w.x = cvt_pk_bf16(v0[0], v0[1]); w.y = cvt_pk_bf16(v0[2], v0[3]); w.z = cvt_pk_bf16(v1[0], v1[1]); w.w = cvt_pk_bf16(v1[2], v1[3]);
                *(u32x4*)(rowp + bj * HALF) = w; } }
}
__device__ __forceinline__ void tile_ssq(const f32x4 (&acc)[2][2][4][2], float* ssq  , int nslot, int slot, int wr, int fr, int fq) {
#pragma unroll
    for (int ai = 0; ai < 2; ++ai)
#pragma unroll
        for (int m = 0; m < 4; ++m) { float s = 0.f;
#pragma unroll
            for (int bj = 0; bj < 2; ++bj)
#pragma unroll
                for (int n = 0; n < 2; ++n) { const f32x4 x = acc[ai][bj][m][n]; s += (x[0] * x[0] + x[1] * x[1]) + (x[2] * x[2] + x[3] * x[3]); }
            s += __shfl_xor(s, 16); s += __shfl_xor(s, 32);
            if (fq == 0) ssq[(size_t)(ai * HALF + wr * 64 + m * 16 + fr) * nslot + slot] = s; }
}
struct EpiIn {
    static constexpr bool PERM = true, AFTER_DRAIN = false;
    bf16_t *CQ, *CKV, *QKV, *Z, *GA, *GB; float *KR, *AB, *ssq_q, *ssq_kv;
    __device__ __forceinline__ void operator()(const f32x4 (&acc)[2][2][4][2], const Unit& u, int wr, int wc, int fr, int fq) const {
        const int pn = u.pn, pm = u.pm; const size_t r0 = (size_t)pm * BM;
        const bool lat = pm < 64;
        if (pn == 35) {
            const int cl = wc * 32 + 8 * fq;
            if (cl < 96) {
#pragma unroll
                for (int ai = 0; ai < 2; ++ai)
#pragma unroll
                    for (int m = 0; m < 4; ++m) { const size_t r = r0 + ai * HALF + wr * 64 + m * 16 + fr;
                        float* dst = (cl < 64) ? (KR + r * 64 + cl) : (AB + r * 32 + (cl - 64));
                        *(f32x4*)dst = acc[ai][0][m][0]; *(f32x4*)(dst + 4) = acc[ai][0][m][1]; }
            }
            return;
        }
        bf16_t* base; int ld; bool latonly = true; float* ssq = nullptr; int nslot = 4, slot = wc;
        if (pn < 2) { base = CQ + pn * 256; ld = 512; ssq = ssq_q; nslot = 8; slot = pn * 4 + wc; }
        else if (pn == 2) { base = CKV; ld = 256; ssq = ssq_kv; latonly = false; }
        else if (pn < 15) { base = QKV + (pn - 3) * 256; ld = 3072; latonly = false; }
        else if (pn < 19) { base = Z + (pn - 15) * 256; ld = 1024; }
        else if (pn < 27) { base = GA + (pn - 19) * 256; ld = 2048; }
        else { base = GB + (pn - 27) * 256; ld = 2048; }
        if (latonly && !lat) return;
        store_tile_bf16(acc, base + r0 * ld, ld, wr, wc, fr, fq);
        if (ssq) tile_ssq(acc, ssq + r0 * nslot, nslot, slot, wr, fr, fq);
    }
};
struct EpiQ {
    static constexpr bool PERM = true, AFTER_DRAIN = false;
    bf16_t* Q; const float* ssq_q; float qscale;
    __device__ __forceinline__ void operator()(const f32x4 (&acc)[2][2][4][2], const Unit& u, int wr, int wc, int fr, int fq) const {
        const int pn = u.pn;
#pragma unroll
        for (int ai = 0; ai < 2; ++ai)
#pragma unroll
            for (int m = 0; m < 4; ++m) {
                const int r = u.pm * BM + ai * HALF + wr * 64 + m * 16 + fr; const int b = r >> 13, t = r & 8191;
                const f32x4 sa = *(const f32x4*)(ssq_q + (size_t)r * 8), sb = *(const f32x4*)(ssq_q + (size_t)r * 8 + 4);
                const float rs = rsqrtf((((sa[0] + sa[1]) + (sa[2] + sa[3])) + ((sb[0] + sb[1]) + (sb[2] + sb[3]))) * (1.0f / 512.0f) + 1e-6f) * qscale;
#pragma unroll
                for (int bj = 0; bj < 2; ++bj) {
                    f32x4 v0 = acc[ai][bj][m][0] * rs, v1 = acc[ai][bj][m][1] * rs;
                    bf16_t* dst;
                    if (pn < 4) { const int head = pn * 2 + bj; dst = Q + ((size_t)(b * 8 + head) * 8192 + t) * 192 + wc * 32 + 8 * fq; }
                    else {
                        const int head = (pn - 4) * 4 + bj * 2 + (wc >> 1), half = wc & 1;
                        const float pos = (float)(half == 0 ? (t >> 6) : (t & 63));
                        const int i0 = (8 * fq) & 15;
                        float xs[8] = {v0[0], v0[1], v0[2], v0[3], v1[0], v1[1], v1[2], v1[3]};
#pragma unroll
                        for (int e = 0; e < 8; ++e) {
                            const float other = __shfl_xor(xs[e], 32);
                            const float invf = exp2f(-(float)(i0 + e) * (13.287712379549449f / 16.0f));
                            float sn, cs; fast_sincos(pos * invf, sn, cs);
                            xs[e] = (fq < 2) ? (xs[e] * cs - other * sn) : (other * sn + xs[e] * cs);
                        }
                        v0 = (f32x4){xs[0], xs[1], xs[2], xs[3]}; v1 = (f32x4){xs[4], xs[5], xs[6], xs[7]};
                        dst = Q + ((size_t)(b * 8 + head) * 8192 + t) * 192 + 128 + half * 32 + 8 * fq;
                    }
                    u32x4 w; w.x = cvt_pk_bf16(v0[0], v0[1]); w.y = cvt_pk_bf16(v0[2], v0[3]); w.z = cvt_pk_bf16(v1[0], v1[1]); w.w = cvt_pk_bf16(v1[2], v1[3]);
                    *(u32x4*)dst = w;
                }
            }
    }
};
struct EpiKV {
    static constexpr bool PERM = true, AFTER_DRAIN = false;
    bf16_t *K, *V; const float* ssq_kv;
    __device__ __forceinline__ void operator()(const f32x4 (&acc)[2][2][4][2], const Unit& u, int wr, int wc, int fr, int fq) const {
        const int head = u.pn;
#pragma unroll
        for (int ai = 0; ai < 2; ++ai)
#pragma unroll
            for (int m = 0; m < 4; ++m) {
                const int r = u.pm * BM + ai * HALF + wr * 64 + m * 16 + fr;
                int b, l; if (r < 16384) { b = r >> 13; l = 256 + (r & 8191); } else { b = (r - 16384) >> 8; l = (r - 16384) & 255; }
                const f32x4 sa = *(const f32x4*)(ssq_kv + (size_t)r * 4);
                const float rs = rsqrtf(((sa[0] + sa[1]) + (sa[2] + sa[3])) * (1.0f / 256.0f) + 1e-6f);
                const size_t rowi = (size_t)(b * 8 + head) * 8448 + l;
#pragma unroll
                for (int bj = 0; bj < 2; ++bj) {
                    const f32x4 v0 = acc[ai][bj][m][0] * rs, v1 = acc[ai][bj][m][1] * rs;
                    bf16_t* dst = (bj == 0) ? (K + rowi * 192 + wc * 32 + 8 * fq) : (V + rowi * 128 + wc * 32 + 8 * fq);
                    u32x4 w; w.x = cvt_pk_bf16(v0[0], v0[1]); w.y = cvt_pk_bf16(v0[2], v0[3]); w.z = cvt_pk_bf16(v1[0], v1[1]); w.w = cvt_pk_bf16(v1[2], v1[3]);
                    *(u32x4*)dst = w;
                }
            }
    }
};
template <bool FIRST> struct EpiMerge {
    static constexpr bool PERM = true, AFTER_DRAIN = false;
    const bf16_t* G; bf16_t* MG; bf16_t* MGA;
    __device__ __forceinline__ void operator()(const f32x4 (&acc)[2][2][4][2], const Unit& u, int wr, int wc, int fr, int fq) const {
#pragma unroll
        for (int ai = 0; ai < 2; ++ai)
#pragma unroll
            for (int m = 0; m < 4; ++m) {
                const size_t off = (size_t)(u.pm * BM + ai * HALF + wr * 64 + m * 16 + fr) * 2048 + u.pn * BM + wc * 32 + 8 * fq;
#pragma unroll
                for (int bj = 0; bj < 2; ++bj) {
                    const u32x4 g = *(const u32x4*)(G + off + bj * HALF);
                    float gv[8] = {__uint_as_float(g.x << 16), __uint_as_float(g.x & 0xffff0000u), __uint_as_float(g.y << 16), __uint_as_float(g.y & 0xffff0000u),
                                   __uint_as_float(g.z << 16), __uint_as_float(g.z & 0xffff0000u), __uint_as_float(g.w << 16), __uint_as_float(g.w & 0xffff0000u)};
                    float o[8];
#pragma unroll
                    for (int e = 0; e < 8; ++e) o[e] = sigm(gv[e]) * acc[ai][bj][m][e >> 2][e & 3];
                    if (!FIRST) { const u32x4 p = *(const u32x4*)(MG + off + bj * HALF);
                        o[0] += __uint_as_float(p.x << 16); o[1] += __uint_as_float(p.x & 0xffff0000u); o[2] += __uint_as_float(p.y << 16); o[3] += __uint_as_float(p.y & 0xffff0000u);
                        o[4] += __uint_as_float(p.z << 16); o[5] += __uint_as_float(p.z & 0xffff0000u); o[6] += __uint_as_float(p.w << 16); o[7] += __uint_as_float(p.w & 0xffff0000u); }
                    u32x4 w; w.x = cvt_pk_bf16(o[0], o[1]); w.y = cvt_pk_bf16(o[2], o[3]); w.z = cvt_pk_bf16(o[4], o[5]); w.w = cvt_pk_bf16(o[6], o[7]);
                    *(u32x4*)(MG + off + bj * HALF) = w;
                    if (FIRST && MGA) *(u32x4*)(MGA + off + bj * HALF) = w;
                }
            }
    }
};
struct EpiOut {
    static constexpr bool PERM = false, AFTER_DRAIN = false;
    const float* X; const float* G1  ; float* X1;
    __device__ __forceinline__ void operator()(const f32x4 (&acc)[2][2][4][2], const Unit& u, int wr, int wc, int fr, int fq) const {
        const int b = u.pm >> 5;
        const int col0 = u.pn * BM + wc * 32 + 4 * fq;
#pragma unroll
        for (int bj = 0; bj < 2; ++bj)
#pragma unroll
            for (int n = 0; n < 2; ++n) { const int c = col0 + bj * HALF + n * 16; const f32x4 g = *(const f32x4*)(G1 + b * 12288 + c);
#pragma unroll
                for (int ai = 0; ai < 2; ++ai)
#pragma unroll
                    for (int m = 0; m < 4; ++m) { const size_t off = (size_t)(u.pm * BM + ai * HALF + wr * 64 + m * 16 + fr) * 2048 + c;
                        *(f32x4*)(X1 + off) = *(const f32x4*)(X + off) + g * acc[ai][bj][m][n]; } }
    }
};
struct EpiDelta {
    static constexpr bool PERM = true, AFTER_DRAIN = false;
    const float* G1; bf16_t* DA;
    __device__ __forceinline__ void operator()(const f32x4 (&acc)[2][2][4][2], const Unit& u, int wr, int wc, int fr, int fq) const {
        const int b = u.pm >> 5;
#pragma unroll
        for (int ai = 0; ai < 2; ++ai)
#pragma unroll
            for (int m = 0; m < 4; ++m) {
                const size_t off = (size_t)(u.pm * BM + ai * HALF + wr * 64 + m * 16 + fr) * 2048 + u.pn * BM + wc * 32 + 8 * fq;
#pragma unroll
                for (int bj = 0; bj < 2; ++bj) { const int c = u.pn * BM + wc * 32 + 8 * fq + bj * HALF;
                    const f32x4 g0 = *(const f32x4*)(G1 + b * 12288 + c), g1v = *(const f32x4*)(G1 + b * 12288 + c + 4);
                    const f32x4 v0 = acc[ai][bj][m][0] * g0, v1 = acc[ai][bj][m][1] * g1v;
                    u32x4 w; w.x = cvt_pk_bf16(v0[0], v0[1]); w.y = cvt_pk_bf16(v0[2], v0[3]); w.z = cvt_pk_bf16(v1[0], v1[1]); w.w = cvt_pk_bf16(v1[2], v1[3]);
                    *(u32x4*)(DA + off + bj * HALF) = w; }
            }
    }
};
struct EpiScore {
    static constexpr bool PERM = false, AFTER_DRAIN = false;
    float* SC;
    __device__ __forceinline__ void operator()(const f32x4 (&acc)[2][2][4][2], const Unit& u, int wr, int wc, int fr, int fq) const {
        const int col0 = u.pn * BM + wc * 32 + 4 * fq;
#pragma unroll
        for (int ai = 0; ai < 2; ++ai)
#pragma unroll
            for (int m = 0; m < 4; ++m) { const size_t off = (size_t)(u.pm * BM + ai * HALF + wr * 64 + m * 16 + fr) * 2048 + col0;
#pragma unroll
                for (int bj = 0; bj < 2; ++bj)
#pragma unroll
                    for (int n = 0; n < 2; ++n) *(f32x4*)(SC + off + bj * HALF + n * 16) = acc[ai][bj][m][n]; }
    }
};
}
namespace attn {
using bf16x8 = __attribute__((ext_vector_type(8))) short;
using s16x4  = __attribute__((ext_vector_type(4))) short;
using f32x16 = __attribute__((ext_vector_type(16))) float;
using u32x4  = __attribute__((ext_vector_type(4))) unsigned;
typedef unsigned short bf16_t;
constexpr int DQK = 192, DV = 128, NW = 8, QBLK = 32, KVBLK = 64;
constexpr int SHM_V = KVBLK * DV * 2  , SHM_K = KVBLK * DQK * 2  , SHM_QR = 2 * SHM_V + 2 * SHM_K + NW * 64 * 4, SHM_ATTN = SHM_QR + NW * 4096;
constexpr float THR = 8.0f;
#define KSWZ(row, colB) ((row) * 384 + ((colB) ^ (((row) & 7) << 4)))
#define SBAR() __builtin_amdgcn_sched_barrier(0)
__device__ __forceinline__ int crow(int r, int hi) { return (r & 3) + 8 * (r >> 2) + 4 * hi; }
__device__ __forceinline__ unsigned cvtpk(float lo, float hi) { unsigned r; asm volatile("v_cvt_pk_bf16_f32 %0, %1, %2" : "=v"(r) : "v"(lo), "v"(hi)); return r; }
__device__ __forceinline__ void partialSM(f32x16& p0, f32x16& p1, float& m_reg, float& mn, float& alpha) {
  float pmax = p0[0];
#pragma unroll
  for (int r = 1; r < 16; ++r) pmax = fmaxf(pmax, p0[r]);
#pragma unroll
  for (int r = 0; r < 16; ++r) pmax = fmaxf(pmax, p1[r]);
  { auto rr = __builtin_amdgcn_permlane32_swap(__float_as_uint(pmax), __float_as_uint(pmax), false, false);
    pmax = fmaxf(__uint_as_float(rr[0]), __uint_as_float(rr[1])); }
  if (__builtin_expect(__all(pmax - m_reg <= THR), 1)) { mn = m_reg; alpha = 1.f; }
  else { mn = fmaxf(m_reg, pmax); alpha = __builtin_amdgcn_exp2f(m_reg - mn); m_reg = mn; }
#pragma unroll
  for (int r = 0; r < 16; ++r) p0[r] = p0[r] - mn;
#pragma unroll
  for (int r = 0; r < 16; ++r) p1[r] = p1[r] - mn;
#pragma unroll
  for (int r = 0; r < 16; ++r) p0[r] = __builtin_amdgcn_exp2f(p0[r]);
}
__device__ __forceinline__ void finishSM(f32x16& p0, f32x16& p1, float alpha, float& l_reg, bf16x8& pa0, bf16x8& pa1, bf16x8& pa2, bf16x8& pa3) {
#pragma unroll
  for (int r = 0; r < 16; ++r) p1[r] = __builtin_amdgcn_exp2f(p1[r]);
  float ps = 0;
#pragma unroll
  for (int r = 0; r < 16; ++r) ps += p0[r];
#pragma unroll
  for (int r = 0; r < 16; ++r) ps += p1[r];
  { auto rr = __builtin_amdgcn_permlane32_swap(__float_as_uint(ps), __float_as_uint(ps), false, false);
    ps = __uint_as_float(rr[0]) + __uint_as_float(rr[1]); }
  l_reg = l_reg * alpha + ps;
#define PK4(P, BASE, OUT) do { unsigned a0 = cvtpk(P[BASE + 0], P[BASE + 1]), a1 = cvtpk(P[BASE + 2], P[BASE + 3]);   \
    unsigned b0 = cvtpk(P[BASE + 4], P[BASE + 5]), b1 = cvtpk(P[BASE + 6], P[BASE + 7]);                              \
    auto r0 = __builtin_amdgcn_permlane32_swap(a0, b0, false, false); auto r1 = __builtin_amdgcn_permlane32_swap(a1, b1, false, false); \
    u32x4 w = {r0[0], r1[0], r0[1], r1[1]}; OUT = *reinterpret_cast<bf16x8*>(&w); } while (0)
  PK4(p0, 0, pa0); PK4(p0, 8, pa1); PK4(p1, 0, pa2); PK4(p1, 8, pa3);
#undef PK4
}
__device__ __forceinline__ void qkt(f32x16& p0, f32x16& p1, const char* Ks, const bf16x8* qr, const char* qrow, int qx, int r32, int hi) {
  p0 = f32x16{}; p1 = f32x16{};
#pragma unroll
  for (int d0 = 0; d0 < 12; ++d0) { const int cb = (d0 * 16 + hi * 8) * 2;
    bf16x8 b0 = *reinterpret_cast<const bf16x8*>(Ks + KSWZ(r32, cb));
    bf16x8 b1 = *reinterpret_cast<const bf16x8*>(Ks + KSWZ(32 + r32, cb));
    const bf16x8 q = (d0 < 8) ? qr[d0 < 8 ? d0 : 0] : *reinterpret_cast<const bf16x8*>(qrow + (qx ^ ((d0 - 8) << 5)));
    p0 = __builtin_amdgcn_mfma_f32_32x32x16_bf16(b0, q, p0, 0, 0, 0);
    p1 = __builtin_amdgcn_mfma_f32_32x32x16_bf16(b1, q, p1, 0, 0, 0); }
}
__device__ __forceinline__ int v_st(int k, int c) { const int kk = (k & ~0xC) | ((k & 4) << 1) | ((k & 8) >> 1); return ((kk >> 3) * 4 + (c >> 5)) * 512 + ((kk & 7) * 32 + (c & 31)) * 2; }
__device__ __forceinline__ int v_rd_base(int lane) { return ((lane & 3) << 3) | (((lane >> 2) & 3) << 6) | (((lane >> 4) & 1) << 5) | (((lane >> 5) & 1) << 8); }
constexpr int v_rd_off(int d0, int ks, int half) { return d0 * 512 + ks * 4096 + half * 2048; }
template <int OFF> __device__ __forceinline__ s16x4 tr_read(int vb) {
  s16x4 r; asm volatile("ds_read_b64_tr_b16 %0, %1 offset:%2" : "=&v"(r) : "v"(vb), "i"(OFF) : "memory"); return r;
}
template <int D0> __device__ __forceinline__ void pv_one(f32x16& od, int vb, bf16x8 pa0, bf16x8 pa1, bf16x8 pa2, bf16x8 pa3) {
  const s16x4 l0 = tr_read<v_rd_off(D0, 0, 0)>(vb), h0 = tr_read<v_rd_off(D0, 0, 1)>(vb), l1 = tr_read<v_rd_off(D0, 1, 0)>(vb), h1 = tr_read<v_rd_off(D0, 1, 1)>(vb);
  const s16x4 l2 = tr_read<v_rd_off(D0, 2, 0)>(vb), h2 = tr_read<v_rd_off(D0, 2, 1)>(vb), l3 = tr_read<v_rd_off(D0, 3, 0)>(vb), h3 = tr_read<v_rd_off(D0, 3, 1)>(vb);
  asm volatile("s_waitcnt lgkmcnt(0)" ::: "memory"); SBAR();
#define PK(L, H) (bf16x8){L[0], L[1], L[2], L[3], H[0], H[1], H[2], H[3]}
  od = __builtin_amdgcn_mfma_f32_32x32x16_bf16(pa0, PK(l0, h0), od, 0, 0, 0);
  od = __builtin_amdgcn_mfma_f32_32x32x16_bf16(pa1, PK(l1, h1), od, 0, 0, 0);
  od = __builtin_amdgcn_mfma_f32_32x32x16_bf16(pa2, PK(l2, h2), od, 0, 0, 0);
  od = __builtin_amdgcn_mfma_f32_32x32x16_bf16(pa3, PK(l3, h3), od, 0, 0, 0);
#undef PK
}
__device__ __forceinline__ void pv_d0(f32x16* o, int vb, bf16x8 pa0, bf16x8 pa1, bf16x8 pa2, bf16x8 pa3) {
  pv_one<0>(o[0], vb, pa0, pa1, pa2, pa3); pv_one<1>(o[1], vb, pa0, pa1, pa2, pa3); pv_one<2>(o[2], vb, pa0, pa1, pa2, pa3); pv_one<3>(o[3], vb, pa0, pa1, pa2, pa3);
}
__device__ __forceinline__ void attn_unit(const bf16_t* __restrict__ Qb, const bf16_t* __restrict__ Kh, const bf16_t* __restrict__ Vh, bf16_t* __restrict__ Ob, int ldo, int seq, char* lds, int tid_in) {
  int tid_ = tid_in; asm volatile("" : "+v"(tid_));
  const int tid = tid_, wid = tid >> 6, lane = tid & 63, r32 = lane & 31, hi = lane >> 5;
  char* V_lds = lds; char* K_lds = lds + 2 * SHM_V;
  float* ws = (float*)(lds + 2 * SHM_V + 2 * SHM_K) + wid * 64; float* li_l = ws; float* al_l = ws + 32;
  float m_reg = -1e30f, l_reg = 0; f32x16 o[4] = {}; bf16x8 qr[8];
  const bf16_t* Qw = Qb + (long)(wid * QBLK + r32) * DQK + hi * 8;
#pragma unroll
  for (int d0 = 0; d0 < 8; ++d0) qr[d0] = *reinterpret_cast<const bf16x8*>(Qw + d0 * 16);
  char* qrow = lds + SHM_QR + wid * 4096 + r32 * 128; const int qx = (hi ^ (r32 & 7)) << 4;
#pragma unroll
  for (int d0 = 8; d0 < 12; ++d0) *reinterpret_cast<bf16x8*>(qrow + (qx ^ ((d0 - 8) << 5))) = *reinterpret_cast<const bf16x8*>(Qw + d0 * 16);
  const int sr = tid >> 4, sc = (tid & 15) * 8, vst0 = v_st(sr, sc), vst1 = v_st(32 + sr, sc);
  unsigned kgo[3], klo[3];
#pragma unroll
  for (int i = 0; i < 3; ++i) { const int id = tid + 512 * i, kr_ = id / 24, kc_ = (id % 24) * 16; kgo[i] = (unsigned)(kr_ * 384 + kc_); klo[i] = (unsigned)KSWZ(kr_, kc_); }
  const unsigned vgo0 = (unsigned)((sr * DV + sc) * 2), vgo1 = (unsigned)(((32 + sr) * DV + sc) * 2);
  const int vb0 = (int)(uintptr_t)V_lds + v_rd_base(lane);
  bf16x8 vs0, vs1, ks0, ks1, ks2;
#define SLOAD(k0) do { const char* Kt_ = (const char*)Kh + (size_t)(k0) * (DQK * 2); const char* Vt_ = (const char*)Vh + (size_t)(k0) * (DV * 2); \
    vs0 = *reinterpret_cast<const bf16x8*>(Vt_ + vgo0); vs1 = *reinterpret_cast<const bf16x8*>(Vt_ + vgo1); \
    ks0 = *reinterpret_cast<const bf16x8*>(Kt_ + kgo[0]); ks1 = *reinterpret_cast<const bf16x8*>(Kt_ + kgo[1]); ks2 = *reinterpret_cast<const bf16x8*>(Kt_ + kgo[2]); } while (0)
#define SWRITE(b) do { *(bf16x8*)(V_lds + (b) * SHM_V + vst0) = vs0; *(bf16x8*)(V_lds + (b) * SHM_V + vst1) = vs1; \
    *(bf16x8*)(K_lds + (b) * SHM_K + klo[0]) = ks0; *(bf16x8*)(K_lds + (b) * SHM_K + klo[1]) = ks1; *(bf16x8*)(K_lds + (b) * SHM_K + klo[2]) = ks2; } while (0)
#define RESC(a) do { if (__any((a) < 1.f)) { if (hi == 0) al_l[r32] = (a); asm volatile("s_waitcnt lgkmcnt(0)" ::: "memory"); \
    _Pragma("unroll") for (int d = 0; d < 4; ++d) _Pragma("unroll") for (int r = 0; r < 16; ++r) o[d][r] *= al_l[crow(r, hi)]; } } while (0)
  f32x16 pA0, pA1, pB0, pB1; float mnA, mnB, alA, alB; bf16x8 pa0, pa1, pa2, pa3; const int NT = seq / KVBLK;
  SLOAD(0); SWRITE(0); __syncthreads();
  qkt(pA0, pA1, K_lds, qr, qrow, qx, r32, hi); partialSM(pA0, pA1, m_reg, mnA, alA);
  SLOAD(KVBLK);
  SWRITE(1); __syncthreads();
  for (int j = 1; j + 1 < NT; j += 2) {
    SBAR(); qkt(pB0, pB1, K_lds + SHM_K, qr, qrow, qx, r32, hi);
    finishSM(pA0, pA1, alA, l_reg, pa0, pa1, pa2, pa3); SBAR();
    SLOAD((j + 1) * KVBLK); SBAR();
    pv_d0(o, vb0, pa0, pa1, pa2, pa3); partialSM(pB0, pB1, m_reg, mnB, alB);
    __syncthreads(); SWRITE(0);
    RESC(alB); __syncthreads();
    SBAR(); qkt(pA0, pA1, K_lds, qr, qrow, qx, r32, hi);
    finishSM(pB0, pB1, alB, l_reg, pa0, pa1, pa2, pa3); SBAR();
    SLOAD((j + 2) * KVBLK); SBAR();
    pv_d0(o, vb0 + SHM_V, pa0, pa1, pa2, pa3); partialSM(pA0, pA1, m_reg, mnA, alA);
    __syncthreads(); SWRITE(1);
    RESC(alA); __syncthreads();
  }
  SBAR(); qkt(pB0, pB1, K_lds + SHM_K, qr, qrow, qx, r32, hi);
  finishSM(pA0, pA1, alA, l_reg, pa0, pa1, pa2, pa3); SBAR();
  pv_d0(o, vb0, pa0, pa1, pa2, pa3); partialSM(pB0, pB1, m_reg, mnB, alB);
  __syncthreads(); RESC(alB);
  finishSM(pB0, pB1, alB, l_reg, pa0, pa1, pa2, pa3); SBAR();
  pv_d0(o, vb0 + SHM_V, pa0, pa1, pa2, pa3);
  if (hi == 0) li_l[r32] = l_reg; asm volatile("s_waitcnt lgkmcnt(0)" ::: "memory");
  float rli[16];
#pragma unroll
  for (int r = 0; r < 16; ++r) rli[r] = __builtin_amdgcn_rcpf(li_l[crow(r, hi)]);
  { int t2 = tid_in; asm volatile("" : "+v"(t2));
    const int w2 = t2 >> 6, l2 = t2 & 63, c2 = l2 & 31, h2 = l2 >> 5;
    bf16_t* Ow = Ob + (unsigned)((w2 * QBLK + 4 * h2) * ldo + c2);
#pragma unroll
    for (int r = 0; r < 16; ++r) { const unsigned ro = (unsigned)(((r & 3) + 8 * (r >> 2)) * ldo);
#pragma unroll
      for (int d0 = 0; d0 < 4; ++d0) { const float v = o[d0][r] * rli[r]; Ow[ro + d0 * 32] = (bf16_t)(cvtpk(v, v) & 0xffffu); } } }
  __syncthreads();
#undef SLOAD
#undef SWRITE
#undef RESC
}
#undef KSWZ
#undef SBAR
}
#define GAS __attribute__((address_space(1)))
#define LAS __attribute__((address_space(3)))
typedef unsigned short bf16_t;
typedef unsigned v4u __attribute__((ext_vector_type(4)));
typedef unsigned v2u __attribute__((ext_vector_type(2)));
typedef float f32x4 __attribute__((ext_vector_type(4)));
typedef short bf16x8 __attribute__((ext_vector_type(8)));
constexpr int NT_ = 512;
constexpr int BATCH = 2, SEQ = 8192, DM = 2048, CTXL = 256;
constexpr int ML = BATCH * SEQ  , MC = BATCH * CTXL  , M1 = ML + MC  ;
constexpr int NIN_PAD = 9216;
constexpr int LKV = CTXL + SEQ;
constexpr int NCH = 132;
constexpr float EPS = 1e-6f;
constexpr float QSCALE = 0.07216878364870322f * 1.4426950408889634f;
constexpr size_t MiB = 1u << 20;
constexpr size_t WS_CTL = 0, CTL_BYTES = 1 * MiB;
constexpr size_t CTL_BAR = 4096;
static_assert(CTL_BAR + 3456 * 4 <= CTL_BYTES, "ctl");
constexpr size_t WS_WUQ = 1 * MiB, WS_WUKV = WS_WUQ + 1536 * 512 * 2, WS_WBA = WS_WUKV + 2048 * 256 * 2, WS_WBB = WS_WBA + 4 * MiB, WS_WOUT = WS_WBB + 4 * MiB, WS_WPQ = WS_WOUT + 8 * MiB;
static_assert(WS_WPQ + 8 * MiB <= 28 * MiB, "small weights");
constexpr size_t WS_C = 28 * MiB;
constexpr size_t WS_D = 66 * MiB;
constexpr size_t WS_E1 = 132 * MiB;
constexpr size_t WS_CQ = WS_E1, WS_CKV = WS_CQ + 16 * MiB, WS_KR = WS_CKV + (size_t)M1 * 256 * 2, WS_AB = WS_KR + (size_t)M1 * 64 * 4;
static_assert(WS_AB + (size_t)M1 * 32 * 4 <= 164 * MiB, "E1");
constexpr size_t WS_Z = 164 * MiB, WS_GA = 196 * MiB, WS_GB = 260 * MiB;
constexpr size_t WS_QKV = 324 * MiB;
constexpr size_t WS_K = 423 * MiB;
constexpr size_t WS_DNQ = 473 * MiB;
constexpr size_t WS_GBETA = 572 * MiB;
constexpr size_t WS_EG = 575 * MiB;
constexpr size_t CTL_MOD = 27 * MiB + 512 * 1024;
constexpr size_t CTL_SSQQ = 575 * MiB, CTL_SSQKV = CTL_SSQQ + (size_t)16384 * 8 * 4;
static_assert(CTL_SSQKV + (size_t)16896 * 4 * 4 <= 577 * MiB && CTL_MOD + 3 * 12288 * 4 <= 28 * MiB && WS_WPQ + 8 * MiB <= CTL_MOD, "mod/ssq");
constexpr size_t WS_W = WS_QKV, WS_U = WS_QKV + 66 * MiB, WS_ATT = WS_C, WS_OF = WS_D, WS_OB = WS_D + 32 * MiB, WS_YA = WS_E1, WS_YB = WS_C;
constexpr size_t WS_MG = 324 * MiB, WS_H2 = 388 * MiB, WS_UB = 452 * MiB, WS_VB = 484 * MiB, WS_USC = 516 * MiB, WS_VSC = 517 * MiB, WS_SC = 196 * MiB, WS_END = 580 * MiB;
static_assert(WS_EG + (size_t)4224 * 132 * 4 <= WS_END && WS_K + (size_t)16 * LKV * 192 * 2 <= WS_DNQ && WS_DNQ + (size_t)M1 * 3072 * 2 <= WS_GBETA, "ws map");

__device__ __forceinline__ unsigned f2bf(float f) { unsigned u = __builtin_bit_cast(unsigned, f); return (u + 0x7fffu + ((u >> 16) & 1u)) >> 16; }
typedef float f32x2_c __attribute__((ext_vector_type(2))); typedef __bf16 bf16x2_c __attribute__((ext_vector_type(2)));
__device__ __forceinline__ unsigned pk2(float lo, float hi) { f32x2_c v = {lo, hi}; bf16x2_c b = __builtin_convertvector(v, bf16x2_c); return __builtin_bit_cast(unsigned, b); }
__device__ __forceinline__ float bflo(unsigned w) { return __uint_as_float(w << 16); }
__device__ __forceinline__ float bfhi(unsigned w) { return __uint_as_float(w & 0xffff0000u); }
__device__ __forceinline__ float wave_sum(float v) {
#pragma unroll
    for (int o = 1; o < 64; o <<= 1) v += __shfl_xor(v, o);
    return v;
}
__device__ __forceinline__ float siluf(float v) { return v / (1.0f + __expf(-v)); }

struct Params {
    const float *x, *c, *ctx, *c_ctx, *w_mod, *b_mod, *norm1_w, *w_in, *qn_w, *kvn_w, *w_uq, *w_ukv, *conv_w, *a_log, *dt_bias, *dn_norm_w,
                *w_ba, *w_bb, *w_out, *norm2_w, *peer_wq, *sub_keys, *peer_u, *peer_v, *final_w;
    float* out; unsigned char* ws;
    int ph_lo, ph_hi;
};
#define XB_TMO      128
#define XB_XCNT(j)  (256  + 64 * (j))
#define XB_XSUB(j)  (1280 + 64 * (j))
#define XB_XGEN(j)  (2304 + 64 * (j))
#define XB_TOP      3328
#define XB_TOPGEN   3392
#define XCD_BAR_WORDS 3456
#define XB_SPIN_CAP (1u << 18)

__device__ __forceinline__ unsigned xb_ld(unsigned* p)              { return __hip_atomic_load(p, __ATOMIC_RELAXED, __HIP_MEMORY_SCOPE_AGENT); }
__device__ __forceinline__ unsigned xb_add(unsigned* p, unsigned v) { return __hip_atomic_fetch_add(p, v, __ATOMIC_RELAXED, __HIP_MEMORY_SCOPE_AGENT); }
__device__ __forceinline__ unsigned xb_xcc_id() { return (unsigned)__builtin_amdgcn_s_getreg((3 << 11) | 20) & 0xFu; }
#define XB_SPIN(cond, bar) do { unsigned _sp = 0; while (cond) { __builtin_amdgcn_s_sleep(1); \
    if ((++_sp & 255u) == 0u) { if (xb_ld(&(bar)[XB_TMO])) break; if (_sp > XB_SPIN_CAP) { atomicAdd(&(bar)[XB_TMO], 1u); break; } } } } while (0)

struct XcdBarrier {
    unsigned* bar; unsigned x;
    volatile LAS unsigned* st;
};

__device__ __forceinline__ XcdBarrier xcd_barrier_post(unsigned* bar, volatile LAS unsigned* st, int tid) {
    XcdBarrier b; b.bar = bar; b.x = xb_xcc_id(); b.st = st;
    if (tid == 0) (void)xb_add(&bar[XB_XCNT(b.x)], 1u);
    return b;
}
__device__ __forceinline__ void xcd_barrier_complete(unsigned* bar, unsigned x, unsigned& nloc, unsigned& nx) {
    const unsigned G = gridDim.x * gridDim.y * gridDim.z;
    unsigned sum, cnt, mine, sp = 0u;
    for (;;) {
        sum = 0u; cnt = 0u; mine = 0u;
#pragma unroll
        for (unsigned j = 0; j < 16; ++j) { const unsigned c = xb_ld(&bar[XB_XCNT(j)]); sum += c; cnt += (c > 0u) ? 1u : 0u; mine = (j == x) ? c : mine; }
        if (sum == G) break;
        __builtin_amdgcn_s_sleep(1);
        if ((++sp & 255u) == 0u) { if (xb_ld(&bar[XB_TMO])) break; if (sp > XB_SPIN_CAP) { atomicAdd(&bar[XB_TMO], 1u); break; } }
    }
    nloc = mine > 0u ? mine : 1u; nx = cnt > 0u ? cnt : 1u;
}

__device__ __forceinline__ void xcd_barrier(const XcdBarrier& b, int tid) {
    asm volatile("s_waitcnt vmcnt(0)" ::: "memory");
    __syncthreads();
    if (tid == 0) {
        unsigned* bar = b.bar;
        __builtin_amdgcn_s_waitcnt(0);
        unsigned nloc = b.st[0], nx = b.st[1];
        if (nloc == 0u) { xcd_barrier_complete(bar, b.x, nloc, nx); b.st[0] = nloc; b.st[1] = nx; }
        const unsigned old = xb_add(&bar[XB_XSUB(b.x)], 1u);
        const unsigned gen = old / nloc;
        if (old + 1u == (gen + 1u) * nloc) {
            __builtin_amdgcn_fence(__ATOMIC_RELEASE, "agent");
            asm volatile("s_waitcnt vmcnt(0)" ::: "memory");
            const unsigned og = xb_add(&bar[XB_TOP], 1u);
            const unsigned tg = og / nx;
            if (og + 1u == (tg + 1u) * nx) xb_add(&bar[XB_TOPGEN], 1u);
            else XB_SPIN(xb_ld(&bar[XB_TOPGEN]) == tg, bar);
            __builtin_amdgcn_fence(__ATOMIC_ACQUIRE, "agent");
            xb_add(&bar[XB_XGEN(b.x)], 1u);
            asm volatile("s_waitcnt vmcnt(0)" ::: "memory");
        } else {
            XB_SPIN(xb_ld(&bar[XB_XGEN(b.x)]) == gen, bar);
            __builtin_amdgcn_fence(__ATOMIC_ACQUIRE, "agent");
            asm volatile("s_waitcnt vmcnt(0)" ::: "memory");
        }
    }
    __syncthreads();
}
struct Ctx { LAS unsigned char* lds; int tid, lane, wave, vcu, G; };

__device__ __forceinline__ void p0_mod_item(const Params& p, const Ctx& C, int it) {
    LAS float* sl = (LAS float*)C.lds;
    LAS float* red = sl + 3 * 2048;
    for (int e = C.tid; e < 3 * 2048; e += NT_) { const int i = e >> 11, k = e & 2047; const float v = (i < 2) ? p.c[i * DM + k] : p.c_ctx[k]; sl[e] = siluf(v); }
    __syncthreads();
    typedef float f32x2_ __attribute__((ext_vector_type(2)));
    f32x2_ a0 = {0, 0}, a1 = {0, 0}, a2 = {0, 0};
    const int col = it * 128 + C.lane * 2, k0 = C.wave * 256;
    const float* wp = p.w_mod + (size_t)k0 * 12288 + col;
#pragma unroll 8
    for (int k = 0; k < 256; ++k) { const f32x2_ w = *(const f32x2_*)(wp + (size_t)k * 12288); a0 += w * sl[k0 + k]; a1 += w * sl[2048 + k0 + k]; a2 += w * sl[4096 + k0 + k]; }
    LAS float* rw = red + C.wave * 384 + C.lane * 2;
    rw[0] = a0[0]; rw[1] = a0[1]; rw[128] = a1[0]; rw[129] = a1[1]; rw[256] = a2[0]; rw[257] = a2[1];
    __syncthreads();
    if (C.tid < 384) { float s = p.b_mod[it * 128 + (C.tid & 127)];
#pragma unroll
        for (int w = 0; w < 8; ++w) s += red[w * 384 + C.tid];
        ((float*)(p.ws + CTL_MOD))[(C.tid >> 7) * 12288 + it * 128 + (C.tid & 127)] = s; }
    __syncthreads();
}
__device__ __forceinline__ void p0_wprime_item(const Params& p, const Ctx& C, int it) {
    LAS float* As = (LAS float*)C.lds;
    LAS float* Ss = As + 64 * 129;
    const int hp = it >> 5, i0 = (it & 31) * 64, pp = hp & 1;
    for (int e = C.tid; e < 64 * 128; e += NT_) { const int i = e >> 7, d = e & 127; As[i * 129 + d] = p.peer_wq[(size_t)(i0 + i) * 2048 + hp * 128 + d]; }
    for (int e = C.tid; e < 128 * 128; e += NT_) { const int k = e >> 7, d = e & 127; Ss[k * 129 + d] = p.sub_keys[(size_t)(pp * 128 + k) * 128 + d]; }
    __syncthreads();
    const int k = C.tid & 127, ig = C.tid >> 7;
    float acc[16];
#pragma unroll
    for (int ii = 0; ii < 16; ++ii) acc[ii] = 0.f;
    for (int d = 0; d < 128; ++d) { const float s = Ss[k * 129 + d];
#pragma unroll
        for (int ii = 0; ii < 16; ++ii) acc[ii] += As[(ig * 16 + ii) * 129 + d] * s; }
    bf16_t* dst = (bf16_t*)(p.ws + WS_WPQ) + (size_t)(hp * 128 + k) * 2048 + i0 + ig * 16;
    v4u w0, w1; w0.x = pk2(acc[0], acc[1]); w0.y = pk2(acc[2], acc[3]); w0.z = pk2(acc[4], acc[5]); w0.w = pk2(acc[6], acc[7]);
    w1.x = pk2(acc[8], acc[9]); w1.y = pk2(acc[10], acc[11]); w1.z = pk2(acc[12], acc[13]); w1.w = pk2(acc[14], acc[15]);
    *(v4u*)dst = w0; *(v4u*)(dst + 8) = w1;
    __syncthreads();
}
__device__ __forceinline__ void p0_transpose_item(const float* W, int K, int N, int k0, int n0, bf16_t* WT, int drow0, const float* kscale, LAS float* scr, int lane) {
#pragma unroll 8
    for (int i = 0; i < 32; ++i) { const int kk = 2 * i + (lane >> 5); float v = W[(size_t)(k0 + kk) * N + n0 + (lane & 31)]; if (kscale) v *= kscale[k0 + kk]; scr[kk * 33 + (lane & 31)] = v; }
    asm volatile("s_waitcnt lgkmcnt(0)" ::: "memory");
    const int c = lane & 7;
#pragma unroll
    for (int j = 0; j < 4; ++j) { const int n = (lane >> 3) + 8 * j; const LAS float* s = scr + (8 * c) * 33 + n;
        v4u o; o.x = pk2(s[0 * 33], s[1 * 33]); o.y = pk2(s[2 * 33], s[3 * 33]); o.z = pk2(s[4 * 33], s[5 * 33]); o.w = pk2(s[6 * 33], s[7 * 33]);
        *(v4u*)(WT + (size_t)(drow0 + n) * K + k0 + 8 * c) = o; }
    asm volatile("s_waitcnt lgkmcnt(0)" ::: "memory");
}
__device__ __forceinline__ int win_dest_row(int n0) {
    if (n0 < 768) return n0;
    if (n0 < 832) return 8960 + (n0 - 768);
    if (n0 < 3904) return 768 + (n0 - 832);
    if (n0 < 4928) return 3840 + (n0 - 3904);
    if (n0 < 4960) return 9024 + (n0 - 4928);
    if (n0 < 7008) return 4864 + (n0 - 4960);
    return 6912 + (n0 - 7008);
}
__device__ __forceinline__ void p0_prologue(const Params& p, const Ctx& C) {
    for (int it = C.vcu; it < 96; it += C.G) p0_mod_item(p, C, it);
    for (int it = C.vcu; it < 512; it += C.G) p0_wprime_item(p, C, it);
    LAS float* scr = (LAS float*)(C.lds + C.wave * 16384);
    const int gw = C.vcu * 8 + C.wave, NGW = C.G * 8;
    constexpr int I_IN = 32 * 283, I_UQ = 8 * 48, I_UKV = 4 * 64, I_BA = 16 * 64, I_BB = 16 * 64, I_OUT = 32 * 64;
    constexpr int NITEMS = I_IN + I_UQ + I_UKV + I_BA + I_BB + I_OUT;
    unsigned char* ws = p.ws;
    for (int it = gw; it < NITEMS; it += NGW) {
        int r = it;
        if (r < I_IN) { const int kb = r / 283, nb = r % 283; p0_transpose_item(p.w_in, 2048, 9056, kb * 64, nb * 32, (bf16_t*)(ws + WS_C), win_dest_row(nb * 32), nullptr, scr, C.lane); continue; } r -= I_IN;
        if (r < I_UQ) { const int kb = r / 48, nb = r % 48, n0 = nb * 32, h = n0 / 192, j0 = n0 % 192; const int dr = (j0 < 128) ? (h * 128 + j0) : (1024 + h * 64 + (j0 - 128));
            p0_transpose_item(p.w_uq, 512, 1536, kb * 64, n0, (bf16_t*)(ws + WS_WUQ), dr, p.qn_w, scr, C.lane); continue; } r -= I_UQ;
        if (r < I_UKV) { const int kb = r / 64, nb = r % 64; p0_transpose_item(p.w_ukv, 256, 2048, kb * 64, nb * 32, (bf16_t*)(ws + WS_WUKV), nb * 32, p.kvn_w, scr, C.lane); continue; } r -= I_UKV;
        if (r < I_BA) { const int kb = r / 64, nb = r % 64; p0_transpose_item(p.w_ba, 1024, 2048, kb * 64, nb * 32, (bf16_t*)(ws + WS_WBA), nb * 32, nullptr, scr, C.lane); continue; } r -= I_BA;
        if (r < I_BB) { const int kb = r / 64, nb = r % 64; p0_transpose_item(p.w_bb, 1024, 2048, kb * 64, nb * 32, (bf16_t*)(ws + WS_WBB), nb * 32, nullptr, scr, C.lane); continue; } r -= I_BB;
        { const int kb = r / 64, nb = r % 64; p0_transpose_item(p.w_out, 2048, 2048, kb * 64, nb * 32, (bf16_t*)(ws + WS_WOUT), nb * 32, nullptr, scr, C.lane); }
    }
    { v4u* z = (v4u*)((bf16_t*)(ws + WS_C) + (size_t)9056 * 2048); const int n16 = 160 * 2048 * 2 / 16;
      for (int i = C.vcu * NT_ + C.tid; i < n16; i += C.G * NT_) z[i] = (v4u){0u, 0u, 0u, 0u}; }
}

__device__ __forceinline__ void mod_norm_rows(const Ctx& C, const float* X, int nrows, const float* nw, const float* sh, const float* sc, bf16_t* O) {
    f32x4 a[8], s[8];
#pragma unroll
    for (int j = 0; j < 8; ++j) { const int c = 4 * C.lane + 256 * j; const f32x4 w = *(const f32x4*)(nw + c), q = *(const f32x4*)(sc + c); a[j] = w * (q + 1.0f); s[j] = *(const f32x4*)(sh + c); }
    const int gw = C.vcu * 8 + C.wave, NGW = C.G * 8;
    for (int r = gw; r < nrows; r += NGW) {
        const f32x4* xr = (const f32x4*)(X + (size_t)r * DM) + C.lane; f32x4 v[8]; float ss = 0.f;
#pragma unroll
        for (int j = 0; j < 8; ++j) { v[j] = xr[64 * j]; ss += (v[j].x * v[j].x + v[j].y * v[j].y) + (v[j].z * v[j].z + v[j].w * v[j].w); }
        const float rstd = rsqrtf(wave_sum(ss) * (1.0f / DM) + EPS);
        v2u* o8 = (v2u*)(O + (size_t)r * DM) + C.lane;
#pragma unroll
        for (int j = 0; j < 8; ++j) { const f32x4 y = v[j] * rstd * a[j] + s[j]; v2u w; w.x = pk2(y.x, y.y); w.y = pk2(y.z, y.w); o8[64 * j] = w; }
    }
}
__device__ __forceinline__ void p3_conv(const Params& p, const Ctx& C) {
    const bf16_t* QKV = (const bf16_t*)(p.ws + WS_QKV); bf16_t* DNQ = (bf16_t*)(p.ws + WS_DNQ);
    const long total = (long)M1 * 384;
    for (long it = (long)C.vcu * NT_ + C.tid; it < total; it += (long)C.G * NT_) {
        const int r = (int)(it / 384), c8 = (int)(it % 384), ch = c8 * 8;
        int seg0, segn, t;
        if (r < ML) { seg0 = r & ~8191; segn = SEQ; t = r & 8191; } else { seg0 = ML + ((r - ML) & ~255); segn = CTXL; t = (r - ML) & 255; }
        float acc[8];
#pragma unroll
        for (int e = 0; e < 8; ++e) acc[e] = 0.f;
#pragma unroll
        for (int j = 0; j < 5; ++j) { const int tt = t + j - 2;
            if (tt >= 0 && tt < segn) { const v4u xv = *(const v4u*)(QKV + (size_t)(seg0 + tt) * 3072 + ch);
                const f32x4 w0 = *(const f32x4*)(p.conv_w + j * 3072 + ch), w1 = *(const f32x4*)(p.conv_w + j * 3072 + ch + 4);
                acc[0] += bflo(xv.x) * w0.x; acc[1] += bfhi(xv.x) * w0.y; acc[2] += bflo(xv.y) * w0.z; acc[3] += bfhi(xv.y) * w0.w;
                acc[4] += bflo(xv.z) * w1.x; acc[5] += bfhi(xv.z) * w1.y; acc[6] += bflo(xv.w) * w1.z; acc[7] += bfhi(xv.w) * w1.w; } }
        float ss = 0.f;
#pragma unroll
        for (int e = 0; e < 8; ++e) { acc[e] = siluf(acc[e]); ss += acc[e] * acc[e]; }
        ss += __shfl_xor(ss, 1); ss += __shfl_xor(ss, 2); ss += __shfl_xor(ss, 4); ss += __shfl_xor(ss, 8);
        float sc = 1.0f;
        if (ch < 2048) { sc = rsqrtf(ss + EPS); if (ch < 1024) sc *= 0.08838834764831845f; }
        v4u w; w.x = pk2(acc[0] * sc, acc[1] * sc); w.y = pk2(acc[2] * sc, acc[3] * sc); w.z = pk2(acc[4] * sc, acc[5] * sc); w.w = pk2(acc[6] * sc, acc[7] * sc);
        *(v4u*)(DNQ + (size_t)r * 3072 + ch) = w;
    }
}
__device__ __forceinline__ void p3_krope_gbeta(const Params& p, const Ctx& C) {
    const float* KR = (const float*)(p.ws + WS_KR); bf16_t* K = (bf16_t*)(p.ws + WS_K);
    for (int it = C.vcu * NT_ + C.tid; it < M1 * 4; it += C.G * NT_) {
        const int r = it >> 2, q = it & 3, half = q >> 1, part = q & 1;
        int b, l, t; bool lat = r < ML;
        if (lat) { b = r >> 13; t = r & 8191; l = CTXL + t; } else { b = (r - ML) >> 8; t = 0; l = (r - ML) & 255; }
        const float* x1p = KR + (size_t)r * 64 + half * 32; const float* x2p = x1p + 16;
        float o[16];
        if (lat) { const float pos = (float)(half == 0 ? (t >> 6) : (t & 63));
#pragma unroll
            for (int i = 0; i < 16; ++i) { const float invf = exp2f(-(float)i * (13.287712379549449f / 16.0f)); float sn, cs; pg8::fast_sincos(pos * invf, sn, cs);
                const float x1 = x1p[i], x2 = x2p[i]; o[i] = part == 0 ? (x1 * cs - x2 * sn) : (x1 * sn + x2 * cs); } }
        else {
#pragma unroll
            for (int i = 0; i < 16; ++i) o[i] = part == 0 ? x1p[i] : x2p[i]; }
        v4u w0, w1; w0.x = pk2(o[0], o[1]); w0.y = pk2(o[2], o[3]); w0.z = pk2(o[4], o[5]); w0.w = pk2(o[6], o[7]);
        w1.x = pk2(o[8], o[9]); w1.y = pk2(o[10], o[11]); w1.z = pk2(o[12], o[13]); w1.w = pk2(o[14], o[15]);
#pragma unroll
        for (int h = 0; h < 8; ++h) { bf16_t* dst = K + ((size_t)(b * 8 + h) * LKV + l) * 192 + 128 + half * 32 + part * 16; *(v4u*)dst = w0; *(v4u*)(dst + 8) = w1; }
    }
    const float* AB = (const float*)(p.ws + WS_AB); float* Gd = (float*)(p.ws + WS_GBETA); float* Bd = Gd + (size_t)2 * M1 * 8;
    for (int it = C.vcu * NT_ + C.tid; it < M1 * 16; it += C.G * NT_) {
        const int r = it >> 4, dh = it & 15, dir = dh >> 3, h = dh & 7;
        const float a = AB[(size_t)r * 32 + dir * 8 + h] + p.dt_bias[dir * 8 + h], bl = AB[(size_t)r * 32 + 16 + dir * 8 + h];
        const float sp = (a > 20.f) ? a : log1pf(__expf(a));
        Gd[((size_t)dir * M1 + r) * 8 + h] = -__expf(p.a_log[dir * 8 + h]) * sp;
        Bd[((size_t)dir * M1 + r) * 8 + h] = 1.0f / (1.0f + __expf(-bl));
    }
}
constexpr int CP_LD = 136;
constexpr int CP_K = 0, CP_Q = CP_K + 64 * CP_LD * 2, CP_V = CP_Q + 64 * CP_LD * 2, CP_KK = CP_V + 64 * CP_LD * 2, CP_QK = CP_KK + 64 * 65 * 4,
              CP_M = CP_QK + 64 * 65 * 4  , CP_VEC = CP_M + 2 * 64 * 64 * 4  , CP_END = CP_VEC + 10 * 64 * 4;
static_assert(CP_END <= 131072 && (CP_M % 16) == 0, "chunk-prep LDS");
__device__ __forceinline__ void p5_chunk_prep(const Params& p, const Ctx& C) {
    const bf16_t* DNQ = (const bf16_t*)(p.ws + WS_DNQ); const float* Gd = (const float*)(p.ws + WS_GBETA); const float* Bd = Gd + (size_t)2 * M1 * 8;
    bf16_t* Wd = (bf16_t*)(p.ws + WS_W); bf16_t* Ud = (bf16_t*)(p.ws + WS_U); bf16_t* ATd = (bf16_t*)(p.ws + WS_ATT);
    float* EG = (float*)(p.ws + WS_EG); float* EKD = EG + (size_t)4224 * 64; float* EGL = EKD + (size_t)4224 * 64;
    LAS unsigned char* L = C.lds;
    LAS bf16_t* Ks = (LAS bf16_t*)(L + CP_K); LAS bf16_t* Qs = (LAS bf16_t*)(L + CP_Q); LAS bf16_t* Vs = (LAS bf16_t*)(L + CP_V);
    LAS float* KKs = (LAS float*)(L + CP_KK); LAS float* QKs = (LAS float*)(L + CP_QK); LAS float* Ms = (LAS float*)(L + CP_M); LAS float* Vec = (LAS float*)(L + CP_VEC);
    const int tid = C.tid, lane = C.lane, wave = C.wave;
    for (int task = C.vcu; task < 16 * NCH; task += C.G) {
        const int bh = task / NCH, tc = task % NCH, b = bh >> 3, h = bh & 7;
        const int row0 = (tc < 4) ? (ML + b * CTXL + tc * 64) : (b * SEQ + (tc - 4) * 64);
        for (int e = tid; e < 3 * 1024; e += NT_) { const int which = e >> 10, id = e & 1023, i = id >> 4, chn = id & 15;
            const v4u v = *(const v4u*)(DNQ + (size_t)(row0 + i) * 3072 + which * 1024 + h * 128 + chn * 8);
            LAS bf16_t* dst = (which == 0 ? Qs : (which == 1 ? Ks : Vs)) + i * CP_LD + chn * 8; *(LAS v4u*)dst = v; }
        if (tid < 256) { const int which = tid >> 6, i = tid & 63, dir = which & 1; const float* src = (which < 2) ? Gd : Bd; Vec[tid] = src[((size_t)dir * M1 + row0 + i) * 8 + h]; }
        __syncthreads();
        {
#pragma unroll
            for (int q = 0; q < 4; ++q) { const int t16 = wave * 2 + (q & 1), tm = t16 >> 2, tn = t16 & 3; const bool isq = q >= 2;
                const LAS bf16_t* Ab = (isq ? Qs : Ks) + (tm * 16 + (lane & 15)) * CP_LD + 8 * (lane >> 4); const LAS bf16_t* Bb = Ks + (tn * 16 + (lane & 15)) * CP_LD + 8 * (lane >> 4);
                f32x4 acc = {0.f, 0.f, 0.f, 0.f};
#pragma unroll
                for (int kk = 0; kk < 4; ++kk) acc = __builtin_amdgcn_mfma_f32_16x16x32_bf16(*(const LAS bf16x8*)(Ab + kk * 32), *(const LAS bf16x8*)(Bb + kk * 32), acc, 0, 0, 0);
                LAS float* dst = (isq ? QKs : KKs) + (tm * 16 + 4 * (lane >> 4)) * 65 + tn * 16 + (lane & 15);
#pragma unroll
                for (int rg = 0; rg < 4; ++rg) dst[rg * 65] = acc[rg]; }
            if (wave < 2) { float v = (wave == 0) ? Vec[lane] : Vec[64 + 63 - lane];
#pragma unroll
                for (int o = 1; o < 64; o <<= 1) { const float u = __shfl_up(v, o); if (lane >= o) v += u; }
                Vec[256 + wave * 64 + lane] = v; }
        }
        __syncthreads();
        for (int e = tid; e < 2 * 4096; e += NT_) { const int dir = e >> 12, i = (e >> 6) & 63, j = e & 63, pi = dir ? 63 - i : i, pj = dir ? 63 - j : j;
            const float gi = Vec[256 + dir * 64 + i], gj = Vec[256 + dir * 64 + j], beta_i = Vec[128 + dir * 64 + pi];
            const float dec = (i >= j) ? __expf(gi - gj) : 0.f;
            Ms[dir * 4096 + i * 64 + j] = (i > j) ? beta_i * KKs[pi * 65 + pj] * dec : 0.f;
            const size_t cidx = (size_t)(bh * 2 + dir) * NCH + (dir ? (tc < 4 ? 3 - tc : 135 - tc) : tc);
            ATd[cidx * 4096 + i * 64 + j] = (bf16_t)f2bf(QKs[pi * 65 + pj] * dec); }
        if (tid < 128) { const int dir = tid >> 6, i = tid & 63; const size_t cidx = (size_t)(bh * 2 + dir) * NCH + (dir ? (tc < 4 ? 3 - tc : 135 - tc) : tc);
            const float gi = Vec[256 + dir * 64 + i], gl = Vec[256 + dir * 64 + 63], egi = __expf(gi);
            EG[cidx * 64 + i] = egi; EKD[cidx * 64 + i] = __expf(gl - gi); if (i == 0) EGL[cidx] = __expf(gl);
            Vec[384 + dir * 128 + i] = Vec[128 + dir * 64 + (dir ? 63 - i : i)]; Vec[384 + dir * 128 + 64 + i] = egi; }
        __syncthreads();
        {
            const int dir = tid >> 8, c = tid & 255; const LAS float* Mr = Ms + dir * 4096;
            const LAS bf16_t* sp = ((c < 128) ? (Vs + c) : (Ks + (c - 128))) + (dir ? 63 * CP_LD : 0); const int sstep = dir ? -CP_LD : CP_LD;
            const LAS float* bsc = Vec + 384 + dir * 128;
            const size_t cidx = (size_t)(bh * 2 + dir) * NCH + (dir ? (tc < 4 ? 3 - tc : 135 - tc) : tc);
            bf16_t* dp = ((c < 128) ? Ud : Wd) + cidx * 8192 + (c & 127);
            const bool isw = c >= 128;
            float x[64];
#pragma unroll
            for (int i = 0; i < 64; ++i) {
                float r = __uint_as_float(((unsigned)sp[0]) << 16) * bsc[i];
                if (isw) r *= bsc[64 + i];
#pragma unroll
                for (int j4 = 0; j4 < (i + 3) / 4; ++j4) { const f32x4 mv = *(const LAS f32x4*)(Mr + i * 64 + j4 * 4);
#pragma unroll
                    for (int e = 0; e < 4; ++e) if (j4 * 4 + e < i) r -= mv[e] * x[j4 * 4 + e]; }
                x[i] = r; *dp = (bf16_t)f2bf(r); dp += 128; sp += sstep; asm volatile("" : "+v"(dp), "+v"(sp) :: "memory"); }
        }
        __syncthreads();
    }
}
constexpr int SC_WLD = 136, SC_TLD = 72;
constexpr int SC_W = 0, SC_QG = SC_W + 64 * SC_WLD * 2, SC_KDT = SC_QG + 64 * SC_WLD * 2, SC_ATT = SC_KDT + 64 * SC_WLD * 2, SC_U = SC_ATT + 64 * SC_TLD * 2,
              SC_SBT = SC_U + 64 * 16 * 4, SC_VNT = SC_SBT + 16 * SC_WLD * 2, SC_END = SC_VNT + 16 * SC_TLD * 2;
static_assert(SC_END <= 131072 && SC_QG % 16 == 0 && SC_KDT % 16 == 0 && SC_ATT % 16 == 0 && SC_U % 16 == 0 && SC_SBT % 16 == 0 && SC_VNT % 16 == 0, "scan LDS");
typedef short s16x4_ __attribute__((ext_vector_type(4))); typedef short v4i16_ __attribute__((ext_vector_type(4)));
struct ScanRegs { v4u w0, w1, q0, q1, k0, k1, at, u; float eg0, eg1, ek0, ek1, egl; };
struct ScanPtrs { const bf16_t *DNQ, *Wd, *Ud, *ATd; const float *EG, *EKD, *EGL; };
__device__ __forceinline__ int scan_base(int s, int b, int dir) { return dir == 0 ? ((s < 4) ? (ML + b * CTXL + s * 64) : (b * SEQ + (s - 4) * 64)) : ((s < 4) ? (ML + b * CTXL + (3 - s) * 64) : (b * SEQ + (131 - s) * 64)); }
__device__ __forceinline__ void scan_load(ScanRegs& R, const ScanPtrs& P, int s, int bhd, int b, int h, int dir, int n0, int tid) {
    const size_t cidx = (size_t)bhd * NCH + s; const int base = scan_base(s, b, dir);
    { const int i = tid >> 4, chn = tid & 15, row = base + (dir ? 63 - i : i);
      R.w0 = *(const v4u*)(P.Wd + cidx * 8192 + i * 128 + chn * 8); R.q0 = *(const v4u*)(P.DNQ + (size_t)row * 3072 + h * 128 + chn * 8); R.k0 = *(const v4u*)(P.DNQ + (size_t)row * 3072 + 1024 + h * 128 + chn * 8);
      R.eg0 = P.EG[cidx * 64 + i]; R.ek0 = P.EKD[cidx * 64 + i]; }
    { const int i = 32 + (tid >> 4), chn = tid & 15, row = base + (dir ? 63 - i : i);
      R.w1 = *(const v4u*)(P.Wd + cidx * 8192 + i * 128 + chn * 8); R.q1 = *(const v4u*)(P.DNQ + (size_t)row * 3072 + h * 128 + chn * 8); R.k1 = *(const v4u*)(P.DNQ + (size_t)row * 3072 + 1024 + h * 128 + chn * 8);
      R.eg1 = P.EG[cidx * 64 + i]; R.ek1 = P.EKD[cidx * 64 + i]; }
    R.at = *(const v4u*)(P.ATd + cidx * 4096 + (tid >> 3) * 64 + (tid & 7) * 8);
    if (tid < 128) R.u = *(const v4u*)(P.Ud + cidx * 8192 + (tid >> 1) * 128 + n0 + (tid & 1) * 8);
    R.egl = P.EGL[cidx];
}
__device__ __forceinline__ v4u scale_bf8(v4u v, float s) { v4u o; o.x = pk2(bflo(v.x) * s, bfhi(v.x) * s); o.y = pk2(bflo(v.y) * s, bfhi(v.y) * s); o.z = pk2(bflo(v.z) * s, bfhi(v.z) * s); o.w = pk2(bflo(v.w) * s, bfhi(v.w) * s); return o; }
__device__ __forceinline__ void scan_store(const ScanRegs& R, LAS bf16_t* Ws, LAS bf16_t* QGs, LAS bf16_t* KDT, LAS bf16_t* ATs, LAS float* Us, int tid) {
    const int chn = tid & 15;
    { const int i = tid >> 4; *(LAS v4u*)(Ws + i * SC_WLD + chn * 8) = R.w0; *(LAS v4u*)(QGs + i * SC_WLD + chn * 8) = scale_bf8(R.q0, R.eg0); *(LAS v4u*)(KDT + i * SC_WLD + chn * 8) = scale_bf8(R.k0, R.ek0); }
    { const int i = 32 + (tid >> 4); *(LAS v4u*)(Ws + i * SC_WLD + chn * 8) = R.w1; *(LAS v4u*)(QGs + i * SC_WLD + chn * 8) = scale_bf8(R.q1, R.eg1); *(LAS v4u*)(KDT + i * SC_WLD + chn * 8) = scale_bf8(R.k1, R.ek1); }
    *(LAS v4u*)(ATs + (tid >> 3) * SC_TLD + (tid & 7) * 8) = R.at;
    if (tid < 128) { LAS float* ud = Us + (tid >> 1) * 16 + (tid & 1) * 8; *(LAS f32x4*)ud = (f32x4){bflo(R.u.x), bfhi(R.u.x), bflo(R.u.y), bfhi(R.u.y)}; *(LAS f32x4*)(ud + 4) = (f32x4){bflo(R.u.z), bfhi(R.u.z), bflo(R.u.w), bfhi(R.u.w)}; }
}
__device__ __forceinline__ void p6_scan(const Params& p, const Ctx& C) {
    ScanPtrs P; P.DNQ = (const bf16_t*)(p.ws + WS_DNQ); P.Wd = (const bf16_t*)(p.ws + WS_W); P.Ud = (const bf16_t*)(p.ws + WS_U); P.ATd = (const bf16_t*)(p.ws + WS_ATT);
    P.EG = (const float*)(p.ws + WS_EG); P.EKD = P.EG + (size_t)4224 * 64; P.EGL = P.EKD + (size_t)4224 * 64;
    LAS unsigned char* L = C.lds;
    LAS bf16_t* Ws = (LAS bf16_t*)(L + SC_W); LAS bf16_t* QGs = (LAS bf16_t*)(L + SC_QG); LAS bf16_t* KDT = (LAS bf16_t*)(L + SC_KDT); LAS bf16_t* ATs = (LAS bf16_t*)(L + SC_ATT);
    LAS float* Us = (LAS float*)(L + SC_U); LAS bf16_t* SBT = (LAS bf16_t*)(L + SC_SBT); LAS bf16_t* VNT = (LAS bf16_t*)(L + SC_VNT);
    const int tid = C.tid, lane = C.lane, wave = C.wave, l15 = lane & 15, lq = lane >> 4;
    for (int task = C.vcu; task < 256; task += C.G) {
        const int bhd = task >> 3, cb = task & 7, bh = bhd >> 1, dir = bhd & 1, b = bh >> 3, h = bh & 7, n0 = cb * 16;
        bf16_t* Od = (bf16_t*)(p.ws + (dir ? WS_OB : WS_OF));
        f32x4 S = {0.f, 0.f, 0.f, 0.f};
        for (int e = tid; e < 16 * SC_WLD / 2; e += NT_) ((LAS unsigned*)SBT)[e] = 0u;
        ScanRegs RA, RB;
        scan_load(RA, P, 0, bhd, b, h, dir, n0, tid); scan_load(RB, P, 1, bhd, b, h, dir, n0, tid);
#define SCAN_STEP(R, s_) do { const int s = (s_); const int base = scan_base(s, b, dir); \
            scan_store(R, Ws, QGs, KDT, ATs, Us, tid); const float egl = R.egl; \
            __syncthreads(); \
            if (s + 2 < NCH) scan_load(R, P, s + 2, bhd, b, h, dir, n0, tid);                   \
            const int mt = wave & 3; f32x4 acc = {0.f, 0.f, 0.f, 0.f}; \
            { const LAS bf16_t* Ab = ((wave < 4) ? Ws : QGs) + (mt * 16 + l15) * SC_WLD + 8 * lq; const LAS bf16_t* Bb = SBT + l15 * SC_WLD + 8 * lq; \
              _Pragma("unroll") for (int kk = 0; kk < 4; ++kk) acc = __builtin_amdgcn_mfma_f32_16x16x32_bf16(*(const LAS bf16x8*)(Ab + kk * 32), *(const LAS bf16x8*)(Bb + kk * 32), acc, 0, 0, 0); } \
            if (wave < 4) { const int i0 = mt * 16 + 4 * lq; \
                const float v0 = Us[(i0 + 0) * 16 + l15] - acc[0], v1 = Us[(i0 + 1) * 16 + l15] - acc[1], v2 = Us[(i0 + 2) * 16 + l15] - acc[2], v3 = Us[(i0 + 3) * 16 + l15] - acc[3]; \
                v2u w; w.x = pk2(v0, v1); w.y = pk2(v2, v3); *(LAS v2u*)(VNT + l15 * SC_TLD + i0) = w; } \
            __syncthreads(); \
            if (wave >= 4) { const LAS bf16_t* Ab = ATs + (mt * 16 + l15) * SC_TLD + 8 * lq; const LAS bf16_t* Bb = VNT + l15 * SC_TLD + 8 * lq; \
                _Pragma("unroll") for (int kk = 0; kk < 2; ++kk) acc = __builtin_amdgcn_mfma_f32_16x16x32_bf16(*(const LAS bf16x8*)(Ab + kk * 32), *(const LAS bf16x8*)(Bb + kk * 32), acc, 0, 0, 0); \
                if (s >= 4) { _Pragma("unroll") for (int rg = 0; rg < 4; ++rg) { const int i = mt * 16 + 4 * lq + rg; const int row = base + (dir ? 63 - i : i); \
                        Od[(size_t)row * 1024 + h * 128 + n0 + l15] = (bf16_t)f2bf(acc[rg]); } } } \
            { f32x4 sn = S * egl; const LAS bf16_t* Bb = VNT + l15 * SC_TLD + 8 * lq; \
                \
              const LAS bf16_t* Ta = KDT + (8 * lq + (l15 >> 2)) * SC_WLD + wave * 16 + 4 * (l15 & 3); \
              _Pragma("unroll") for (int kk = 0; kk < 2; ++kk) { \
                  const s16x4_ t0 = __builtin_bit_cast(s16x4_, __builtin_amdgcn_ds_read_tr16_b64_v4i16((LAS v4i16_*)(Ta + (kk * 32) * SC_WLD))); \
                  const s16x4_ t1 = __builtin_bit_cast(s16x4_, __builtin_amdgcn_ds_read_tr16_b64_v4i16((LAS v4i16_*)(Ta + (kk * 32 + 4) * SC_WLD))); \
                  const bf16x8 af = (bf16x8){t0[0], t0[1], t0[2], t0[3], t1[0], t1[1], t1[2], t1[3]}; \
                  sn = __builtin_amdgcn_mfma_f32_16x16x32_bf16(af, *(const LAS bf16x8*)(Bb + kk * 32), sn, 0, 0, 0); } \
              S = sn; } \
            __syncthreads(); \
            { v2u w; w.x = pk2(S[0], S[1]); w.y = pk2(S[2], S[3]); *(LAS v2u*)(SBT + l15 * SC_WLD + wave * 16 + 4 * lq) = w; } \
        } while (0)
        for (int s2 = 0; s2 < NCH; s2 += 2) { SCAN_STEP(RA, s2); SCAN_STEP(RB, s2 + 1); }
#undef SCAN_STEP
        __syncthreads();
    }
}
__device__ __forceinline__ void p7_yb(const Params& p, const Ctx& C) {
    const bf16_t* OF = (const bf16_t*)(p.ws + WS_OF); const bf16_t* OB = (const bf16_t*)(p.ws + WS_OB); const bf16_t* Z = (const bf16_t*)(p.ws + WS_Z); bf16_t* YB = (bf16_t*)(p.ws + WS_YB);
    const long total = (long)ML * 128;
    for (long it = (long)C.vcu * NT_ + C.tid; it < total; it += (long)C.G * NT_) {
        const size_t off = (size_t)it * 8; const int d0 = (int)(off & 127);
        const v4u a = *(const v4u*)(OF + off), bq = *(const v4u*)(OB + off), zz = *(const v4u*)(Z + off);
        float o[8] = {bflo(a.x) + bflo(bq.x), bfhi(a.x) + bfhi(bq.x), bflo(a.y) + bflo(bq.y), bfhi(a.y) + bfhi(bq.y), bflo(a.z) + bflo(bq.z), bfhi(a.z) + bfhi(bq.z), bflo(a.w) + bflo(bq.w), bfhi(a.w) + bfhi(bq.w)};
        float zf[8] = {bflo(zz.x), bfhi(zz.x), bflo(zz.y), bfhi(zz.y), bflo(zz.z), bfhi(zz.z), bflo(zz.w), bfhi(zz.w)};
        float ss = 0.f;
#pragma unroll
        for (int e = 0; e < 8; ++e) ss += o[e] * o[e];
        ss += __shfl_xor(ss, 1); ss += __shfl_xor(ss, 2); ss += __shfl_xor(ss, 4); ss += __shfl_xor(ss, 8);
        const float rstd = rsqrtf(ss * (1.0f / 128.0f) + EPS);
        const f32x4 w0 = *(const f32x4*)(p.dn_norm_w + d0), w1 = *(const f32x4*)(p.dn_norm_w + d0 + 4);
        float y[8];
#pragma unroll
        for (int e = 0; e < 8; ++e) y[e] = o[e] * rstd * (e < 4 ? w0[e] : w1[e - 4]) * siluf(zf[e]);
        v4u w; w.x = pk2(y[0], y[1]); w.y = pk2(y[2], y[3]); w.z = pk2(y[4], y[5]); w.w = pk2(y[6], y[7]);
        *(v4u*)(YB + off) = w;
    }
}
typedef float f32x2_t __attribute__((ext_vector_type(2)));
__device__ __forceinline__ float gelu_erf(float v) { return 0.5f * v * (1.0f + erff(v * 0.7071067811865476f)); }
__device__ __forceinline__ float dot8(v4u a, v4u b, float acc) {
    acc += bflo(a.x) * bflo(b.x); acc += bfhi(a.x) * bfhi(b.x); acc += bflo(a.y) * bflo(b.y); acc += bfhi(a.y) * bfhi(b.y);
    acc += bflo(a.z) * bflo(b.z); acc += bfhi(a.z) * bfhi(b.z); acc += bflo(a.w) * bflo(b.w); acc += bfhi(a.w) * bfhi(b.w); return acc;
}
__device__ __forceinline__ unsigned ord_u32(float f) { const unsigned u = __float_as_uint(f); return u ^ ((u >> 31) ? 0xffffffffu : 0x80000000u); }
#define INS16(k, x) do { unsigned x_ = (x); _Pragma("unroll") for (int i_ = 0; i_ < 16; ++i_) { const unsigned lo_ = min(k[i_], x_); k[i_] = max(k[i_], x_); x_ = lo_; } } while (0)
constexpr int P12_SC = 0, P12_TOPS = 128 * 129 * 4, P12_TOPI = P12_TOPS + 128 * 16 * 4, P12_IDX = P12_TOPI + 128 * 16 * 4  , P12_PW = P12_IDX + 64 * 128 * 2  , P12_END = P12_PW + 64 * 128 * 4;
static_assert(P12_END <= 147456 - 64 && P12_IDX % 16 == 0 && P12_PW % 16 == 0, "p12 lds");
__device__ __forceinline__ float octet_sum(float d) {
    d += __builtin_bit_cast(float, __builtin_amdgcn_update_dpp(0, __builtin_bit_cast(int, d), 0xB1, 0xF, 0xF, true));
    d += __builtin_bit_cast(float, __builtin_amdgcn_update_dpp(0, __builtin_bit_cast(int, d), 0x4E, 0xF, 0xF, true));
    d += __builtin_bit_cast(float, __builtin_amdgcn_update_dpp(0, __builtin_bit_cast(int, d), 0x141, 0xF, 0xF, true));
    return d;
}
__device__ __forceinline__ void p12_peer(const Params& p, const Ctx& C, const bool do_final) {
    const float* SCp = (const float*)(p.ws + WS_SC); const bf16_t* H2 = (const bf16_t*)(p.ws + WS_H2);
    const unsigned char* UB = (const unsigned char*)(p.ws + WS_UB); const unsigned char* VB = (const unsigned char*)(p.ws + WS_VB); const float* USC = (const float*)(p.ws + WS_USC); const float* VSC = (const float*)(p.ws + WS_VSC);
    const float* MOD = (const float*)(p.ws + CTL_MOD);
    LAS float* SCs = (LAS float*)(C.lds + P12_SC); LAS float* TOPS = (LAS float*)(C.lds + P12_TOPS); LAS int* TOPI = (LAS int*)(C.lds + P12_TOPI);
    LAS unsigned short* IDXs = (LAS unsigned short*)(C.lds + P12_IDX); LAS float* PWs = (LAS float*)(C.lds + P12_PW);
    const int lane = C.lane, tid = C.tid;
    for (int blk = C.vcu; blk < ML / 64; blk += C.G) {
        for (int sub = 0; sub < 8; ++sub) {
            { const float* src = SCp + ((size_t)blk * 64 + sub * 8) * 2048;
#pragma unroll 4
              for (int e4 = tid; e4 < 8 * 2048 / 4; e4 += NT_) { const f32x4 v = *(const f32x4*)(src + e4 * 4); const int L = e4 >> 5, k = (e4 & 31) * 4; LAS float* d = SCs + L * 129 + k; d[0] = v.x; d[1] = v.y; d[2] = v.z; d[3] = v.w; } }
            __syncthreads();
            if (tid < 256) {
                const int L = tid >> 1, hf = tid & 1; const LAS float* s = SCs + L * 129 + hf * 64;
                unsigned k[16];
#pragma unroll
                for (int i = 0; i < 16; ++i) k[i] = 0u;
#pragma unroll 8
                for (int j = 0; j < 64; ++j) { const unsigned key = (ord_u32(s[j]) & ~127u) | (unsigned)(127 - (hf * 64 + j)); INS16(k, key); }
#pragma unroll
                for (int i = 0; i < 16; ++i) { const unsigned o = __shfl_xor(k[i], 1); if (hf == 0) INS16(k, o); }
                if (hf == 0) {
#pragma unroll
                    for (int i = 0; i < 16; ++i) { const int ki = 127 - (int)(k[i] & 127u); TOPI[L * 16 + i] = ki; TOPS[L * 16 + i] = SCs[L * 129 + ki]; } }
            }
            __syncthreads();
            if (tid < 64) {
                const int tt = tid >> 3, h = tid & 7, L0 = tt * 16 + h * 2, L1 = L0 + 1;
                float s0[16], s1[16];
#pragma unroll
                for (int i = 0; i < 16; ++i) { s0[i] = TOPS[L0 * 16 + i]; s1[i] = TOPS[L1 * 16 + i]; }
                unsigned k[16];
#pragma unroll
                for (int i = 0; i < 16; ++i) k[i] = 0u;
#pragma unroll
                for (int a = 0; a < 16; ++a)
#pragma unroll
                    for (int b2 = 0; b2 < 16; ++b2) if ((a + 1) * (b2 + 1) <= 16) { const unsigned key = (ord_u32(s0[a] + s1[b2]) & ~255u) | (unsigned)(255 - (a * 16 + b2)); INS16(k, key); }
                float bs[16]; float mx = -3.0e38f; const int orow = (sub * 8 + tt) * 128 + h * 16;
#pragma unroll
                for (int i = 0; i < 16; ++i) { const int pos = 255 - (int)(k[i] & 255u), a = pos >> 4, b2 = pos & 15;
                    bs[i] = TOPS[L0 * 16 + a] + TOPS[L1 * 16 + b2]; mx = fmaxf(mx, bs[i]);
                    IDXs[orow + i] = (unsigned short)(TOPI[L0 * 16 + a] * 128 + TOPI[L1 * 16 + b2]); }
                float sm = 0.f;
#pragma unroll
                for (int i = 0; i < 16; ++i) { bs[i] = __expf(bs[i] - mx); sm += bs[i]; }
                const float inv = 1.0f / sm;
#pragma unroll
                for (int i = 0; i < 16; ++i) PWs[orow + i] = bs[i] * inv;
            }
            __syncthreads();
        }
        const int tl = C.wave * 8 + (lane >> 3), piece = lane & 7; const size_t t = (size_t)blk * 64 + tl;
        const LAS unsigned short* idxrow = IDXs + tl * 128; LAS float* pwrow = PWs + tl * 128;
        LAS float* actrow = (LAS float*)(C.lds + P12_SC) + tl * 128;
#pragma unroll
        for (int i = 0; i < 16; ++i) actrow[i * 8 + piece] = 0.f;
#define P12_LOAD(R, TAB, it_) do { const int itx = (it_); const v4u i8 = *(const LAS v4u*)(idxrow + (itx & 15) * 8); const unsigned off_ = (unsigned)((itx >> 4) * 128 + piece * 16); \
            _Pragma("unroll") for (int j = 0; j < 8; ++j) { const unsigned ex = (i8[j >> 1] >> (16 * (j & 1))) & 0xffffu; R[j] = *(const v4u*)(TAB + (ex * 2048u + off_)); } } while (0)
#define P12_HXLOAD(cb_) do { const bf16_t* hp = H2 + t * 2048 + (cb_) * 128 + piece * 16; hra = *(const v4u*)hp; hrb = *(const v4u*)(hp + 8); } while (0)
#define P12_BCOMP(R, it_) do { const int s8x = (it_) & 15; float mine = 0.f; \
            _Pragma("unroll") for (int j = 0; j < 8; ++j) { f32x2_t d2 = {0.f, 0.f}; \
                _Pragma("unroll") for (int w4 = 0; w4 < 4; ++w4) { const int wd = (int)R[j][w4]; const f32x2_t lo = __builtin_amdgcn_cvt_pk_f32_fp8(wd, false), hi2 = __builtin_amdgcn_cvt_pk_f32_fp8(wd, true); \
                    d2 += lo * hx2[2 * w4]; d2 += hi2 * hx2[2 * w4 + 1]; } \
                const float d = octet_sum(d2.x + d2.y); mine = (piece == j) ? d : mine; } \
            actrow[s8x * 8 + piece] += mine; } while (0)
        {
            v4u rA[8], rB[8], rC[8], rD[8], hra, hrb; f32x2_t hx2[8];
            P12_HXLOAD(0);
            P12_LOAD(rA, UB, 0); P12_LOAD(rB, UB, 1); P12_LOAD(rC, UB, 2); P12_LOAD(rD, UB, 3);
            for (int it = 0; it < 256; it += 4) {
                if ((it & 15) == 0) {
                    hx2[0] = (f32x2_t){bflo(hra.x), bfhi(hra.x)}; hx2[1] = (f32x2_t){bflo(hra.y), bfhi(hra.y)}; hx2[2] = (f32x2_t){bflo(hra.z), bfhi(hra.z)}; hx2[3] = (f32x2_t){bflo(hra.w), bfhi(hra.w)};
                    hx2[4] = (f32x2_t){bflo(hrb.x), bfhi(hrb.x)}; hx2[5] = (f32x2_t){bflo(hrb.y), bfhi(hrb.y)}; hx2[6] = (f32x2_t){bflo(hrb.z), bfhi(hrb.z)}; hx2[7] = (f32x2_t){bflo(hrb.w), bfhi(hrb.w)};
                    P12_HXLOAD(min((it >> 4) + 1, 15));
                }
                P12_BCOMP(rA, it);     P12_LOAD(rA, UB, min(it + 4, 255));
                P12_BCOMP(rB, it + 1); P12_LOAD(rB, UB, min(it + 5, 255));
                P12_BCOMP(rC, it + 2); P12_LOAD(rC, UB, min(it + 6, 255));
                P12_BCOMP(rD, it + 3); P12_LOAD(rD, UB, min(it + 7, 255));
            }
        }
#pragma unroll
        for (int s8 = 0; s8 < 16; ++s8) { const int sel = s8 * 8 + piece; const unsigned ex = idxrow[sel];
            pwrow[sel] = pwrow[sel] * gelu_erf(actrow[sel] * USC[ex]) * VSC[ex]; }
        asm volatile("s_waitcnt lgkmcnt(0)" ::: "memory");
        const int bsel = (int)(t >> 13); const float* g2 = MOD + bsel * 12288 + 10240;
        float* orow = p.out + t * 2048; float ssq = 0.f;
#define P12_CCOMP(R, it_) do { const int s8x = (it_) & 15; const f32x4 c0 = *(const LAS f32x4*)(pwrow + s8x * 8), c1 = *(const LAS f32x4*)(pwrow + s8x * 8 + 4); \
            _Pragma("unroll") for (int j = 0; j < 8; ++j) { const float c = (j < 4) ? c0[j & 3] : c1[j & 3]; const f32x2_t cc = {c, c}; \
                _Pragma("unroll") for (int w4 = 0; w4 < 4; ++w4) { const int wd = (int)R[j][w4]; const f32x2_t lo = __builtin_amdgcn_cvt_pk_f32_fp8(wd, false), hi2 = __builtin_amdgcn_cvt_pk_f32_fp8(wd, true); \
                    a2[2 * w4] += cc * lo; a2[2 * w4 + 1] += cc * hi2; } } } while (0)
        {
            v4u rA[8], rB[8], rC[8], rD[8]; f32x2_t a2[8];
            P12_LOAD(rA, VB, 0); P12_LOAD(rB, VB, 1); P12_LOAD(rC, VB, 2); P12_LOAD(rD, VB, 3);
            for (int it = 0; it < 256; it += 4) {
                if ((it & 15) == 0) {
#pragma unroll
                    for (int i = 0; i < 8; ++i) a2[i] = (f32x2_t){0.f, 0.f}; }
                P12_CCOMP(rA, it);     P12_LOAD(rA, VB, min(it + 4, 255));
                P12_CCOMP(rB, it + 1); P12_LOAD(rB, VB, min(it + 5, 255));
                P12_CCOMP(rC, it + 2); P12_LOAD(rC, VB, min(it + 6, 255));
                P12_CCOMP(rD, it + 3); P12_LOAD(rD, VB, min(it + 7, 255));
                if ((it & 15) == 12) {
                    if (do_final) {
                        const int c0i = (it >> 4) * 128 + piece * 16;
#pragma unroll
                        for (int q4 = 0; q4 < 4; ++q4) { const f32x4 xv = *(const f32x4*)(orow + c0i + 4 * q4), gv = *(const f32x4*)(g2 + c0i + 4 * q4);
                            f32x4 y; y[0] = xv[0] + gv[0] * a2[2 * q4].x; y[1] = xv[1] + gv[1] * a2[2 * q4].y; y[2] = xv[2] + gv[2] * a2[2 * q4 + 1].x; y[3] = xv[3] + gv[3] * a2[2 * q4 + 1].y;
                            ssq += (y[0] * y[0] + y[1] * y[1]) + (y[2] * y[2] + y[3] * y[3]);
                            *(f32x4*)(orow + c0i + 4 * q4) = y; }
                    } else { asm volatile("" :: "v"(a2[0]), "v"(a2[3]), "v"(a2[5]), "v"(a2[7])); }
                }
            }
        }
        if (do_final) {
            const float rstd = rsqrtf(octet_sum(ssq) * (1.0f / DM) + EPS);
            for (int cb = 0; cb < 16; ++cb) { const int c0i = cb * 128 + piece * 16;
#pragma unroll
                for (int q4 = 0; q4 < 4; ++q4) { const f32x4 y = *(const f32x4*)(orow + c0i + 4 * q4), fw = *(const f32x4*)(p.final_w + c0i + 4 * q4); *(f32x4*)(orow + c0i + 4 * q4) = y * rstd * fw; } }
        }
        __syncthreads();
    }
}
__device__ __forceinline__ void cvt_fp8_rows(const Ctx& C, const float* src, unsigned char* dst, float* scl, int nrows) {
    const int gw = C.vcu * 8 + C.wave, NGW = C.G * 8, lane = C.lane;
    for (int r = gw; r < nrows; r += NGW) {
        const float* sp = src + (size_t)r * 2048 + 16 * lane; f32x4 v[8]; float mx = 0.f;
#pragma unroll
        for (int j = 0; j < 2; ++j)
#pragma unroll
            for (int q = 0; q < 4; ++q) { v[j * 4 + q] = *(const f32x4*)(sp + 1024 * j + 4 * q); const f32x4 a = v[j * 4 + q]; mx = fmaxf(mx, fmaxf(fmaxf(fabsf(a.x), fabsf(a.y)), fmaxf(fabsf(a.z), fabsf(a.w)))); }
#pragma unroll
        for (int o = 1; o < 64; o <<= 1) mx = fmaxf(mx, __shfl_xor(mx, o));
        mx = fmaxf(mx, 1e-30f); const float inv = 440.0f / mx;
        if (lane == 0) scl[r] = mx * (1.0f / 440.0f);
#pragma unroll
        for (int j = 0; j < 2; ++j) { v4u w;
#pragma unroll
            for (int q = 0; q < 4; ++q) { const f32x4 a = v[j * 4 + q] * inv; int wd = 0; wd = __builtin_amdgcn_cvt_pk_fp8_f32(a.x, a.y, wd, false); wd = __builtin_amdgcn_cvt_pk_fp8_f32(a.z, a.w, wd, true); w[q] = (unsigned)wd; }
            *(v4u*)(dst + (size_t)r * 2048 + 1024 * j + 16 * lane) = w; }
    }
}
__device__ __forceinline__ void cvt_rows(const Ctx& C, const float* src, bf16_t* dst, long n8) {
    for (long i = (long)C.vcu * NT_ + C.tid; i < n8; i += (long)C.G * NT_) { const f32x4 a = *(const f32x4*)(src + i * 8), b = *(const f32x4*)(src + i * 8 + 4);
        v4u w; w.x = pk2(a.x, a.y); w.y = pk2(a.z, a.w); w.z = pk2(b.x, b.y); w.w = pk2(b.z, b.w); *(v4u*)(dst + i * 8) = w; }
}
#ifdef PROBE_ATTN_ALPHA
#define PROBE_MGA(ws) ((bf16_t*)((ws) + 60 * MiB))
#else
#define PROBE_MGA(ws) ((bf16_t*)nullptr)
#endif
constexpr int LDS_BYTES = 147456;
constexpr int N_PHASES = 13;
constexpr int LDS_MISC = LDS_BYTES - 64;
__global__ void __launch_bounds__(NT_, 2) mega_fwd(Params p_arg) {
    extern __shared__ __attribute__((aligned(16))) unsigned char lds_raw[];
    const int wave_s = __builtin_amdgcn_readfirstlane((int)threadIdx.x >> 6);
    const int G_s = gridDim.x, bx_s = blockIdx.x, vcu_s = (G_s % 8 == 0) ? (bx_s % 8) * (G_s / 8) + bx_s / 8 : bx_s;
#define MKCTX() Ctx C; { unsigned m_ = ~0u; asm volatile("" : "+s"(m_)); C.lane = (int)__builtin_amdgcn_mbcnt_hi(m_, __builtin_amdgcn_mbcnt_lo(m_, 0u)); } \
    C.lds = (LAS unsigned char*)lds_raw; C.wave = wave_s; C.tid = wave_s * 64 + C.lane; C.G = G_s; C.vcu = vcu_s
    const int lo = p_arg.ph_lo, hi = p_arg.ph_hi;
#if defined(__HIP_DEVICE_COMPILE__)
#define LOADP() MKCTX(); typedef const __attribute__((address_space(4))) Params* CPP_; CPP_ kp_ = (CPP_)__builtin_amdgcn_kernarg_segment_ptr(); asm volatile("" : "+s"(kp_)); const Params p = *kp_; \
    unsigned char* ws = p.ws; const float* MOD = (const float*)(ws + CTL_MOD); (void)MOD
#else
#define LOADP() MKCTX(); const Params p = p_arg; unsigned char* ws = p.ws; const float* MOD = (const float*)(ws + CTL_MOD); (void)MOD
#endif
#ifndef PH_MASK
#define PH_MASK 0xffff
#endif
#define IN(k) (((PH_MASK >> (k)) & 1) && lo <= (k) && (k) < hi)
#ifndef PROBE_REP
#define PROBE_REP -1
#endif
#define NREP(k) ((PROBE_REP == (k)) ? 2 : 1)
#define BAR_() do { LOADP(); XcdBarrier b_; b_.bar = (unsigned*)(ws + CTL_BAR); b_.x = xb_xcc_id(); b_.st = (volatile LAS unsigned*)(C.lds + LDS_MISC); xcd_barrier(b_, C.tid); } while (0)
#define SEAM(k) do { if (IN(k) && IN((k) + 1)) { LOADP(); XcdBarrier b_; b_.bar = (unsigned*)(ws + CTL_BAR); b_.x = xb_xcc_id(); b_.st = (volatile LAS unsigned*)(C.lds + LDS_MISC); xcd_barrier(b_, C.tid); } } while (0)
    if (hi - lo > 1) { LOADP(); if (C.tid < 2) ((volatile LAS unsigned*)(C.lds + LDS_MISC))[C.tid] = 0u; __syncthreads();
        (void)xcd_barrier_post((unsigned*)(ws + CTL_BAR), (volatile LAS unsigned*)(C.lds + LDS_MISC), C.tid); }
    for (int rep_ = 0; rep_ < NREP(0); ++rep_) if (IN(0)) { if (rep_) BAR_(); LOADP(); p0_prologue(p, C); } SEAM(0);
    for (int rep_ = 0; rep_ < NREP(1); ++rep_) if (IN(1)) { if (rep_) BAR_(); LOADP();
        bf16_t* H = (bf16_t*)(ws + WS_D);
        mod_norm_rows(C, p.x, SEQ, p.norm1_w, MOD, MOD + 2048, H);
        mod_norm_rows(C, p.x + (size_t)SEQ * DM, SEQ, p.norm1_w, MOD + 12288, MOD + 12288 + 2048, H + (size_t)SEQ * DM);
        mod_norm_rows(C, p.ctx, MC, p.norm1_w, MOD + 2 * 12288, MOD + 2 * 12288 + 2048, H + (size_t)ML * DM);
    } SEAM(1);
    for (int rep_ = 0; rep_ < NREP(2); ++rep_) if (IN(2)) { if (rep_) BAR_(); LOADP();
        pg8::Gemm g{(const bf16_t*)(ws + WS_D), (const bf16_t*)(ws + WS_C), M1, NIN_PAD, DM}; pg8::StaticOrder S; S.init(M1, NIN_PAD, C.G, (int)blockIdx.x);
        pg8::EpiIn E{(bf16_t*)(ws + WS_CQ), (bf16_t*)(ws + WS_CKV), (bf16_t*)(ws + WS_QKV), (bf16_t*)(ws + WS_Z), (bf16_t*)(ws + WS_GA), (bf16_t*)(ws + WS_GB),
                     (float*)(ws + WS_KR), (float*)(ws + WS_AB), (float*)(ws + CTL_SSQQ), (float*)(ws + CTL_SSQKV)};
        pg8::gemm_phase<pg8::EpiIn, pg8::StaticOrder, true, true>(C.lds, g, S, E, C.tid);
    } SEAM(2);
    for (int rep_ = 0; rep_ < NREP(3); ++rep_) if (IN(3)) { if (rep_) BAR_();
        { LOADP(); pg8::Gemm g{(const bf16_t*)(ws + WS_CQ), (const bf16_t*)(ws + WS_WUQ), ML, 1536, 512}; pg8::StaticOrder S; S.init(ML, 1536, C.G, (int)blockIdx.x);
          pg8::EpiQ E{(bf16_t*)(ws + WS_D), (const float*)(ws + CTL_SSQQ), QSCALE};
          pg8::gemm_phase<pg8::EpiQ, pg8::StaticOrder, true, true>(C.lds, g, S, E, C.tid); }
        { LOADP(); pg8::Gemm g{(const bf16_t*)(ws + WS_CKV), (const bf16_t*)(ws + WS_WUKV), M1, 2048, 256}; pg8::StaticOrder S; S.init(M1, 2048, C.G, (int)blockIdx.x);
          pg8::EpiKV E{(bf16_t*)(ws + WS_K), (bf16_t*)(ws + WS_C), (const float*)(ws + CTL_SSQKV)};
          pg8::gemm_phase<pg8::EpiKV, pg8::StaticOrder, true, true>(C.lds, g, S, E, C.tid); }
        { LOADP(); p3_conv(p, C); }
        { LOADP(); p3_krope_gbeta(p, C); }
    } SEAM(3);
    for (int rep_ = 0; rep_ < NREP(4); ++rep_) if (IN(4)) { if (rep_) BAR_(); LOADP();
        const bf16_t* Q = (const bf16_t*)(ws + WS_D); const bf16_t* K = (const bf16_t*)(ws + WS_K); const bf16_t* V = (const bf16_t*)(ws + WS_C); bf16_t* YA = (bf16_t*)(ws + WS_YA);
        for (int u = C.vcu; u < 512; u += C.G) { const int bh = u >> 5, qb = u & 31, b = bh >> 3, h = bh & 7;
            attn::attn_unit(Q + ((size_t)bh * SEQ + qb * 256) * 192, K + (size_t)bh * LKV * 192, V + (size_t)bh * LKV * 128,
                            YA + ((size_t)b * SEQ + qb * 256) * 1024 + h * 128, 1024, LKV, (char*)lds_raw, C.tid); }
    } SEAM(4);
    for (int rep_ = 0; rep_ < NREP(5); ++rep_) if (IN(5)) { if (rep_) BAR_(); LOADP(); p5_chunk_prep(p, C); } SEAM(5);
    for (int rep_ = 0; rep_ < NREP(6); ++rep_) if (IN(6)) { if (rep_) BAR_(); LOADP(); p6_scan(p, C); } SEAM(6);
    for (int rep_ = 0; rep_ < NREP(7); ++rep_) if (IN(7)) { if (rep_) BAR_(); LOADP(); p7_yb(p, C); } SEAM(7);
    for (int rep_ = 0; rep_ < NREP(8); ++rep_) if (IN(8)) { if (rep_) BAR_();
        { LOADP(); pg8::Gemm g{(const bf16_t*)(ws + WS_YA), (const bf16_t*)(ws + WS_WBA), ML, 2048, 1024}; pg8::StaticOrder S; S.init(ML, 2048, C.G, (int)blockIdx.x);
          pg8::EpiMerge<true> E{(const bf16_t*)(ws + WS_GA), (bf16_t*)(ws + WS_MG), PROBE_MGA(ws)};
          pg8::gemm_phase<pg8::EpiMerge<true>, pg8::StaticOrder, true, true>(C.lds, g, S, E, C.tid); }
        { LOADP(); pg8::Gemm g{(const bf16_t*)(ws + WS_YB), (const bf16_t*)(ws + WS_WBB), ML, 2048, 1024}; pg8::StaticOrder S; S.init(ML, 2048, C.G, (int)blockIdx.x);
          pg8::EpiMerge<false> E{(const bf16_t*)(ws + WS_GB), (bf16_t*)(ws + WS_MG), nullptr};
          pg8::gemm_phase<pg8::EpiMerge<false>, pg8::StaticOrder, true, true>(C.lds, g, S, E, C.tid); }
    } SEAM(8);
    for (int rep_ = 0; rep_ < NREP(9); ++rep_) if (IN(9)) { if (rep_) BAR_(); LOADP();
        pg8::Gemm g{(const bf16_t*)(ws + WS_MG), (const bf16_t*)(ws + WS_WOUT), ML, 2048, 2048}; pg8::StaticOrder S; S.init(ML, 2048, C.G, (int)blockIdx.x);
        pg8::EpiOut E{p.x, MOD + 4096, p.out};
        pg8::gemm_phase<pg8::EpiOut, pg8::StaticOrder, true, true>(C.lds, g, S, E, C.tid);
    } SEAM(9);
#ifdef PROBE_ATTN_ALPHA
    if (IN(9)) { BAR_(); LOADP();
        pg8::Gemm g{(const bf16_t*)(ws + 60 * MiB), (const bf16_t*)(ws + WS_WOUT), ML, 2048, 2048}; pg8::StaticOrder S; S.init(ML, 2048, C.G, (int)blockIdx.x);
        pg8::EpiDelta E{MOD + 4096, (bf16_t*)(ws + 124 * MiB)};
        pg8::gemm_phase<pg8::EpiDelta, pg8::StaticOrder, true, true>(C.lds, g, S, E, C.tid);
    }
#endif
    for (int rep_ = 0; rep_ < NREP(10); ++rep_) if (IN(10)) { if (rep_) BAR_(); LOADP();
        bf16_t* H2 = (bf16_t*)(ws + WS_H2);
        mod_norm_rows(C, p.out, SEQ, p.norm2_w, MOD + 6144, MOD + 8192, H2);
        mod_norm_rows(C, p.out + (size_t)SEQ * DM, SEQ, p.norm2_w, MOD + 12288 + 6144, MOD + 12288 + 8192, H2 + (size_t)SEQ * DM);
        cvt_fp8_rows(C, p.peer_u, ws + WS_UB, (float*)(ws + WS_USC), 16384);
        cvt_fp8_rows(C, p.peer_v, ws + WS_VB, (float*)(ws + WS_VSC), 16384);
    } SEAM(10);
    for (int rep_ = 0; rep_ < NREP(11); ++rep_) if (IN(11)) { if (rep_) BAR_(); LOADP();
        pg8::Gemm g{(const bf16_t*)(ws + WS_H2), (const bf16_t*)(ws + WS_WPQ), ML, 2048, 2048}; pg8::StaticOrder S; S.init(ML, 2048, C.G, (int)blockIdx.x);
        pg8::EpiScore E{(float*)(ws + WS_SC)};
        pg8::gemm_phase<pg8::EpiScore, pg8::StaticOrder, true, true>(C.lds, g, S, E, C.tid);
    } SEAM(11);
    for (int rep_ = 0; rep_ < NREP(12); ++rep_) if (IN(12)) { if (rep_) BAR_(); LOADP(); p12_peer(p, C, rep_ == NREP(12) - 1); }
#undef IN
#undef SEAM
}

#ifndef MK_SINGLE
#define MK_SINGLE 1
#endif
extern "C" void kernel_launch(void* const* d_in, const int* in_sizes, int n_in, void* d_out, int out_size, void* d_ws, size_t ws_size, hipStream_t stream) {
    static int grid = 0;
    if (grid == 0) {
        if (n_in != 25 || out_size != ML * DM || ws_size < WS_END) { fprintf(stderr, "kernel_launch: unexpected shapes: n_in %d out %d ws %zu (need %zu)\n", n_in, out_size, ws_size, (size_t)WS_END); grid = -1; return; }
        int dev = 0, cus = 0, per_cu = 0;
        if (hipGetDevice(&dev) != hipSuccess || hipDeviceGetAttribute(&cus, hipDeviceAttributeMultiprocessorCount, dev) != hipSuccess) { grid = -1; return; }
        if (hipFuncSetAttribute((const void*)mega_fwd, hipFuncAttributeMaxDynamicSharedMemorySize, LDS_BYTES) != hipSuccess) { fprintf(stderr, "kernel_launch: hipFuncSetAttribute failed\n"); grid = -1; return; }
        if (hipOccupancyMaxActiveBlocksPerMultiprocessor(&per_cu, (const void*)mega_fwd, NT_, LDS_BYTES) != hipSuccess || per_cu < 1) { fprintf(stderr, "kernel_launch: occupancy query says %d\n", per_cu); per_cu = 1; }
        (void)hipGetLastError();
        grid = cus;
    }
    if (grid < 0) return;
    (void)hipMemsetAsync((char*)d_ws + WS_CTL, 0, CTL_BYTES, stream);
    Params p{};
    const float** pp = (const float**)&p;
    for (int i = 0; i < 25; ++i) pp[i] = (const float*)d_in[i];
    p.out = (float*)d_out; p.ws = (unsigned char*)d_ws;
#if MK_SINGLE
    p.ph_lo = 0; p.ph_hi = N_PHASES;
    hipLaunchKernelGGL(mega_fwd, dim3(grid), dim3(NT_), LDS_BYTES, stream, p);
#else
    for (int ph = 0; ph < N_PHASES; ++ph) { p.ph_lo = ph; p.ph_hi = ph + 1; hipLaunchKernelGGL(mega_fwd, dim3(grid), dim3(NT_), LDS_BYTES, stream, p); }
#endif
}
```

```cpp
#include <hip/hip_runtime.h>
#include <hip/hip_bf16.h>
#include <cstdio>
#include <cstdint>
#include <cmath>
namespace pg8 {
#define PG8_LAS __attribute__((address_space(3)))
typedef unsigned short bf16_t;
typedef short bf16x8 __attribute__((ext_vector_type(8)));
typedef float f32x4 __attribute__((ext_vector_type(4)));
typedef unsigned u32x4 __attribute__((ext_vector_type(4)));
constexpr int BM = 256, BK = 64, HALF = 128, HTB = HALF * BK * 2  , STAGE_BYTES = 8 * HTB, NXCD = 8, WGM = 8;

__host__ __device__ __forceinline__ int lds_byte(int r, int c) { const int st = (r >> 4) * 2 + (c >> 5), rr = r & 15, cc = c & 31, ob = rr * 64 + cc * 2; return st * 1024 + (ob ^ (((ob >> 9) & 1) << 5)); }
__host__ __device__ __forceinline__ void stage_rc(int b, int& R, int& C) { const int st = b / 1024, sb = b % 1024, swz = sb ^ (((sb >> 9) & 1) << 5); R = (st >> 1) * 16 + swz / 64; C = (st & 1) * 32 + (swz % 64) / 2; }
__host__ __device__ __forceinline__ int perm32(int rho) { const int n = rho >> 4, i = rho & 15; return 8 * (i >> 2) + 4 * n + (i & 3); }

struct Unit { int pm, pn; };
struct Gemm { const bf16_t* A; const bf16_t* Bt; int M, N, K; };

struct StaticOrder {
    int nM, nN, nwg, G, c;
    __host__ __device__ void init(int M, int N, int G_, int c_) { nM = M / BM; nN = N / BM; nwg = nM * nN; G = G_; c = c_; }
    __host__ __device__ bool next(int i, Unit& u) const {
        const long L = (long)i * G + c; if (L >= nwg) return false;
        int wgid = (int)L; { const int q = nwg / NXCD, r = nwg % NXCD, xcd = wgid % NXCD, off = wgid / NXCD; wgid = (xcd < r ? xcd * (q + 1) : r * (q + 1) + (xcd - r) * q) + off; }
        const int nig = WGM * nN, gid = wgid / nig, fm = gid * WGM, gsz = (nM - fm) < WGM ? (nM - fm) : WGM;
        u.pm = fm + ((wgid % nig) % gsz); u.pn = (wgid % nig) / gsz; return true;
    }
    __device__ __forceinline__ void a_ready(const Unit&) const {}
    __device__ __forceinline__ void done(const Unit&) const {}
};
typedef float f32x2 __attribute__((ext_vector_type(2)));
typedef __bf16 bf16x2_g __attribute__((ext_vector_type(2)));
__device__ __forceinline__ unsigned cvt_pk_bf16(float lo, float hi) { f32x2 v = {lo, hi}; bf16x2_g b = __builtin_convertvector(v, bf16x2_g); return __builtin_bit_cast(unsigned, b); }
template <class Epi, class Sched, bool ALIGN_EPI = false, bool SP2 = false>
__device__ __forceinline__ void gemm_phase(PG8_LAS unsigned char* lds, const Gemm g, const Sched& S, const Epi& E, const int tid) {
    const int wid = __builtin_amdgcn_readfirstlane(tid >> 6), lane = tid & 63, wr = wid >> 2, wc = wid & 3, fr = lane & 15, fq = lane >> 4;
    const int K = g.K, nt = K / BK;
    unsigned voffA[2], voffB[2];
#pragma unroll
    for (int i = 0; i < 2; ++i) { int R, C; stage_rc(tid * 16 + i * 8192, R, C); const int Rb = Epi::PERM ? ((R & ~31) + perm32(R & 31)) : R;
        voffA[i] = (unsigned)(R * K + C) * 2u; voffB[i] = (unsigned)(Rb * K + C) * 2u; }
    const size_t kstep = (size_t)(BK * 2);
    const size_t hstep = (size_t)HALF * K * 2;
    const size_t tstep = 2 * hstep;
    const unsigned ldsw = (unsigned)wid * 1024u;
    const int aoff = lds_byte(wr * 64 + fr, fq * 8), boff = lds_byte(wc * 32 + fr, fq * 8);
#define PG8_SA(b, h) (((b) * 2 + (h)) * HTB)
#define PG8_SB(b, h) ((4 + (b) * 2 + (h)) * HTB)
#define PG8_STAGE(bufoff, gbase, voff) do { _Pragma("unroll") for (int _i = 0; _i < 2; ++_i) \
        __builtin_amdgcn_global_load_lds((const unsigned*)((const char*)(gbase) + (voff)[_i]), (PG8_LAS unsigned*)(lds + (bufoff) + ldsw + _i * 8192), 16, 0, 0); } while (0)
#define PG8_LDA(dst, b, h) do { _Pragma("unroll") for (int m = 0; m < 4; ++m) _Pragma("unroll") for (int k = 0; k < 2; ++k) dst[m][k] = *(const PG8_LAS bf16x8*)(lds + PG8_SA(b, h) + aoff + m * 2048 + k * 1024); } while (0)
#define PG8_LDB(dst, b, h) do { _Pragma("unroll") for (int n = 0; n < 2; ++n) _Pragma("unroll") for (int k = 0; k < 2; ++k) dst[n][k] = *(const PG8_LAS bf16x8*)(lds + PG8_SB(b, h) + boff + n * 2048 + k * 1024); } while (0)
#define PG8_MMA(ai, bj, At, Bt) do { __builtin_amdgcn_s_setprio(1); _Pragma("unroll") for (int m = 0; m < 4; ++m) _Pragma("unroll") for (int n = 0; n < 2; ++n) _Pragma("unroll") for (int k = 0; k < 2; ++k) \
        acc[ai][bj][m][n] = __builtin_amdgcn_mfma_f32_16x16x32_bf16(Bt[n][k], At[m][k], acc[ai][bj][m][n], 0, 0, 0); __builtin_amdgcn_s_setprio(0); } while (0)
#define PG8_WAIT_V(n) asm volatile("s_waitcnt vmcnt(" #n ")" ::: "memory")
#define PG8_WAIT_L(n) asm volatile("s_waitcnt lgkmcnt(" #n ")" ::: "memory")
#define PG8_BAR __builtin_amdgcn_s_barrier()
#define PG8_SCHED __builtin_amdgcn_sched_barrier(0)
    Unit cur, nxt; int ui = 0;
    if (!S.next(0, cur)) return;
    f32x4 acc[2][2][4][2];
#pragma unroll
    for (int a = 0; a < 2; ++a)
#pragma unroll
        for (int b = 0; b < 2; ++b)
#pragma unroll
            for (int m = 0; m < 4; ++m)
#pragma unroll
                for (int n = 0; n < 2; ++n) acc[a][b][m][n] = (f32x4){0.f, 0.f, 0.f, 0.f};
    bf16x8 At[4][2], B0[2][2], B1[2][2];
    const char* cA = (const char*)g.A + (size_t)cur.pm * tstep; const char* cB = (const char*)g.Bt + (size_t)cur.pn * tstep;
    S.a_ready(cur);
    if constexpr (SP2) {
        PG8_STAGE(PG8_SB(0, 0), cB, voffB); PG8_STAGE(PG8_SB(0, 1), cB + hstep, voffB); PG8_STAGE(PG8_SA(0, 0), cA, voffA); PG8_STAGE(PG8_SA(0, 1), cA + hstep, voffA);
        if (wr == 1) PG8_BAR;
        PG8_WAIT_V(2); PG8_BAR;
        PG8_STAGE(PG8_SB(1, 0), cB + kstep, voffB); PG8_STAGE(PG8_SA(1, 0), cA + kstep, voffA); PG8_STAGE(PG8_SB(1, 1), cB + hstep + kstep, voffB);
        PG8_WAIT_V(6); PG8_BAR;
    } else {
        PG8_STAGE(PG8_SB(0, 0), cB, voffB); PG8_STAGE(PG8_SA(0, 0), cA, voffA); PG8_STAGE(PG8_SB(0, 1), cB + hstep, voffB); PG8_STAGE(PG8_SA(0, 1), cA + hstep, voffA);
        if (wr == 1) PG8_BAR;
        PG8_WAIT_V(4); PG8_BAR;
        PG8_STAGE(PG8_SB(1, 0), cB + kstep, voffB); PG8_STAGE(PG8_SA(1, 0), cA + kstep, voffA); PG8_STAGE(PG8_SB(1, 1), cB + hstep + kstep, voffB);
        PG8_WAIT_V(6); PG8_BAR;
    }
    for (;;) {
        const bool has_next = S.next(ui + 1, nxt);
        const char* nA = has_next ? (const char*)g.A + (size_t)nxt.pm * tstep : cA; const char* nB = has_next ? (const char*)g.Bt + (size_t)nxt.pn * tstep : cB;
        for (int t = 0; t < nt; t += 2) {
            const bool last = (t == nt - 2);
            const char* a1 = cA + (size_t)(t + 1) * kstep;
            const char* a2 = last ? nA : cA + (size_t)(t + 2) * kstep; const char* b2 = last ? nB : cB + (size_t)(t + 2) * kstep;
            const char* a3 = a2 + kstep; const char* b3 = b2 + kstep;
            if (last && has_next) S.a_ready(nxt);
            if constexpr (SP2) {
            PG8_LDB(B0, 0, 0); PG8_LDB(B1, 0, 1); PG8_SCHED; PG8_LDA(At, 0, 0); PG8_STAGE(PG8_SA(1, 1), a1 + hstep, voffA);
            PG8_WAIT_V(8); PG8_WAIT_L(0); PG8_BAR; PG8_MMA(0, 0, At, B0); PG8_MMA(0, 1, At, B1); PG8_BAR; PG8_SCHED;
            PG8_LDA(At, 0, 1); PG8_STAGE(PG8_SB(0, 0), b2, voffB); PG8_STAGE(PG8_SB(0, 1), b2 + hstep, voffB); PG8_STAGE(PG8_SA(0, 0), a2, voffA);
            PG8_WAIT_V(8); PG8_WAIT_L(0); PG8_BAR; PG8_MMA(1, 0, At, B0); PG8_MMA(1, 1, At, B1); PG8_BAR; PG8_SCHED;
            PG8_LDB(B0, 1, 0); PG8_LDB(B1, 1, 1); PG8_SCHED; PG8_LDA(At, 1, 0); PG8_STAGE(PG8_SA(0, 1), a2 + hstep, voffA);
            PG8_WAIT_V(8); PG8_WAIT_L(0); PG8_BAR; PG8_MMA(0, 0, At, B0); PG8_MMA(0, 1, At, B1); PG8_BAR; PG8_SCHED;
            PG8_LDA(At, 1, 1); PG8_STAGE(PG8_SB(1, 0), b3, voffB); PG8_STAGE(PG8_SB(1, 1), b3 + hstep, voffB); PG8_STAGE(PG8_SA(1, 0), a3, voffA);
            PG8_WAIT_V(8); PG8_WAIT_L(0); PG8_BAR; PG8_MMA(1, 0, At, B0); PG8_MMA(1, 1, At, B1); PG8_BAR; PG8_SCHED;
            } else {
            PG8_LDB(B0, 0, 0); PG8_SCHED; PG8_LDA(At, 0, 0); PG8_STAGE(PG8_SA(1, 1), a1 + hstep, voffA);
            PG8_WAIT_L(8); PG8_BAR; PG8_WAIT_L(0); PG8_MMA(0, 0, At, B0); PG8_BAR; PG8_SCHED;
            PG8_LDB(B1, 0, 1); PG8_STAGE(PG8_SB(0, 0), b2, voffB);
            PG8_BAR; PG8_WAIT_L(0); PG8_MMA(0, 1, At, B1); PG8_BAR;
            PG8_LDA(At, 0, 1); PG8_STAGE(PG8_SA(0, 0), a2, voffA);
            PG8_BAR; PG8_WAIT_L(0); PG8_MMA(1, 0, At, B0); PG8_BAR; PG8_SCHED;
            PG8_STAGE(PG8_SB(0, 1), b2 + hstep, voffB);
            PG8_WAIT_V(6); PG8_BAR; PG8_MMA(1, 1, At, B1); PG8_BAR;
            PG8_LDB(B0, 1, 0); PG8_SCHED; PG8_LDA(At, 1, 0); PG8_STAGE(PG8_SA(0, 1), a2 + hstep, voffA);
            PG8_WAIT_L(8); PG8_BAR; PG8_WAIT_L(0); PG8_MMA(0, 0, At, B0); PG8_BAR; PG8_SCHED;
            PG8_LDB(B1, 1, 1); PG8_STAGE(PG8_SB(1, 0), b3, voffB);
            PG8_BAR; PG8_WAIT_L(0); PG8_MMA(0, 1, At, B1); PG8_BAR;
            PG8_LDA(At, 1, 1); PG8_STAGE(PG8_SA(1, 0), a3, voffA);
            PG8_BAR; PG8_WAIT_L(0); PG8_MMA(1, 0, At, B0); PG8_BAR; PG8_SCHED;
            PG8_STAGE(PG8_SB(1, 1), b3 + hstep, voffB);
            PG8_WAIT_V(6); PG8_BAR; PG8_MMA(1, 1, At, B1); PG8_BAR;
            }
        }
        if constexpr (ALIGN_EPI) { if (wr == 0) PG8_BAR; }
        if constexpr (!Epi::AFTER_DRAIN) { E(acc, cur, wr, wc, fr, fq); S.done(cur); }
        if (!has_next) break;
#pragma unroll
        for (int a = 0; a < 2; ++a)
#pragma unroll
            for (int b = 0; b < 2; ++b)
#pragma unroll
                for (int m = 0; m < 4; ++m)
#pragma unroll
                    for (int n = 0; n < 2; ++n) acc[a][b][m][n] = (f32x4){0.f, 0.f, 0.f, 0.f};
        cur = nxt; cA = nA; cB = nB; ++ui;
        if constexpr (ALIGN_EPI) { if (wr == 1) PG8_BAR; }
    }
    PG8_WAIT_V(0);
    if constexpr (!ALIGN_EPI) { if (wr == 0) PG8_BAR; }
    PG8_BAR;
    if constexpr (Epi::AFTER_DRAIN) { E.fused(acc, cur, wr, wc, fr, fq, lds, wid, lane); S.done(cur); }
#undef PG8_SA
#undef PG8_SB
#undef PG8_STAGE
#undef PG8_LDA
#undef PG8_LDB
#undef PG8_MMA
#undef PG8_WAIT_V
#undef PG8_WAIT_L
#undef PG8_BAR
#undef PG8_SCHED
}
__device__ __forceinline__ float bfu(unsigned short v) { return __uint_as_float(((unsigned)v) << 16); }
__device__ __forceinline__ void fast_sincos(float x, float& sn, float& cs) {
    float rev = x * 0.15915494309189535f; rev -= rintf(rev); sn = __builtin_amdgcn_sinf(rev); cs = __builtin_amdgcn_cosf(rev); }
__device__ __forceinline__ float sigm(float v) { return 1.0f / (1.0f + __expf(-v)); }
__device__ __forceinline__ void store_tile_bf16(const f32x4 (&acc)[2][2][4][2], bf16_t* tile  , int ld, int wr, int wc, int fr, int fq) {
#pragma unroll
    for (int ai = 0; ai < 2; ++ai)
#pragma unroll
        for (int m = 0; m < 4; ++m) { bf16_t* rowp = tile + (size_t)(ai * HALF + wr * 64 + m * 16 + fr) * ld + wc * 32 + 8 * fq;
#pragma unroll
            for (int bj = 0; bj < 2; ++bj) { const f32x4 v0 = acc[ai][bj][m][0], v1 = acc[ai][bj][m][1];
                u32x4 w; w.x = cvt_pk_bf16(v0[0], v0[1]); w.y = cvt_pk_bf16(v0[2], v0[3]); w.z = cvt_pk_bf16(v1[0], v1[1]); w.w = cvt_pk_bf16(v1[2], v1[3]);
                *(u32x4*)(rowp + bj * HALF) = w; } }
}
__device__ __forceinline__ void tile_ssq(const f32x4 (&acc)[2][2][4][2], float* ssq  , int nslot, int slot, int wr, int fr, int fq) {
#pragma unroll
    for (int ai = 0; ai < 2; ++ai)
#pragma unroll
        for (int m = 0; m < 4; ++m) { float s = 0.f;
#pragma unroll
            for (int bj = 0; bj < 2; ++bj)
#pragma unroll
                for (int n = 0; n < 2; ++n) { const f32x4 x = acc[ai][bj][m][n]; s += (x[0] * x[0] + x[1] * x[1]) + (x[2] * x[2] + x[3] * x[3]); }
            s += __shfl_xor(s, 16); s += __shfl_xor(s, 32);
            if (fq == 0) ssq[(size_t)(ai * HALF + wr * 64 + m * 16 + fr) * nslot + slot] = s; }
}
struct EpiIn {
    static constexpr bool PERM = true, AFTER_DRAIN = false;
    bf16_t *CQ, *CKV, *QKV, *Z, *GA, *GB; float *KR, *AB, *ssq_q, *ssq_kv;
    __device__ __forceinline__ void operator()(const f32x4 (&acc)[2][2][4][2], const Unit& u, int wr, int wc, int fr, int fq) const {
        const int pn = u.pn, pm = u.pm; const size_t r0 = (size_t)pm * BM;
        const bool lat = pm < 64;
        if (pn == 35) {
            const int cl = wc * 32 + 8 * fq;
            if (cl < 96) {
#pragma unroll
                for (int ai = 0; ai < 2; ++ai)
#pragma unroll
                    for (int m = 0; m < 4; ++m) { const size_t r = r0 + ai * HALF + wr * 64 + m * 16 + fr;
                        float* dst = (cl < 64) ? (KR + r * 64 + cl) : (AB + r * 32 + (cl - 64));
                        *(f32x4*)dst = acc[ai][0][m][0]; *(f32x4*)(dst + 4) = acc[ai][0][m][1]; }
            }
            return;
        }
        bf16_t* base; int ld; bool latonly = true; float* ssq = nullptr; int nslot = 4, slot = wc;
        if (pn < 2) { base = CQ + pn * 256; ld = 512; ssq = ssq_q; nslot = 8; slot = pn * 4 + wc; }
        else if (pn == 2) { base = CKV; ld = 256; ssq = ssq_kv; latonly = false; }
        else if (pn < 15) { base = QKV + (pn - 3) * 256; ld = 3072; latonly = false; }
        else if (pn < 19) { base = Z + (pn - 15) * 256; ld = 1024; }
        else if (pn < 27) { base = GA + (pn - 19) * 256; ld = 2048; }
        else { base = GB + (pn - 27) * 256; ld = 2048; }
        if (latonly && !lat) return;
        store_tile_bf16(acc, base + r0 * ld, ld, wr, wc, fr, fq);
        if (ssq) tile_ssq(acc, ssq + r0 * nslot, nslot, slot, wr, fr, fq);
    }
};
struct EpiQ {
    static constexpr bool PERM = true, AFTER_DRAIN = false;
    bf16_t* Q; const float* ssq_q; float qscale;
    __device__ __forceinline__ void operator()(const f32x4 (&acc)[2][2][4][2], const Unit& u, int wr, int wc, int fr, int fq) const {
        const int pn = u.pn;
#pragma unroll
        for (int ai = 0; ai < 2; ++ai)
#pragma unroll
            for (int m = 0; m < 4; ++m) {
                const int r = u.pm * BM + ai * HALF + wr * 64 + m * 16 + fr; const int b = r >> 13, t = r & 8191;
                const f32x4 sa = *(const f32x4*)(ssq_q + (size_t)r * 8), sb = *(const f32x4*)(ssq_q + (size_t)r * 8 + 4);
                const float rs = rsqrtf((((sa[0] + sa[1]) + (sa[2] + sa[3])) + ((sb[0] + sb[1]) + (sb[2] + sb[3]))) * (1.0f / 512.0f) + 1e-6f) * qscale;
#pragma unroll
                for (int bj = 0; bj < 2; ++bj) {
                    f32x4 v0 = acc[ai][bj][m][0] * rs, v1 = acc[ai][bj][m][1] * rs;
                    bf16_t* dst;
                    if (pn < 4) { const int head = pn * 2 + bj; dst = Q + ((size_t)(b * 8 + head) * 8192 + t) * 192 + wc * 32 + 8 * fq; }
                    else {
                        const int head = (pn - 4) * 4 + bj * 2 + (wc >> 1), half = wc & 1;
                        const float pos = (float)(half == 0 ? (t >> 6) : (t & 63));
                        const int i0 = (8 * fq) & 15;
                        float xs[8] = {v0[0], v0[1], v0[2], v0[3], v1[0], v1[1], v1[2], v1[3]};
#pragma unroll
                        for (int e = 0; e < 8; ++e) {
                            const float other = __shfl_xor(xs[e], 32);
                            const float invf = exp2f(-(float)(i0 + e) * (13.287712379549449f / 16.0f));
                            float sn, cs; fast_sincos(pos * invf, sn, cs);
                            xs[e] = (fq < 2) ? (xs[e] * cs - other * sn) : (other * sn + xs[e] * cs);
                        }
                        v0 = (f32x4){xs[0], xs[1], xs[2], xs[3]}; v1 = (f32x4){xs[4], xs[5], xs[6], xs[7]};
                        dst = Q + ((size_t)(b * 8 + head) * 8192 + t) * 192 + 128 + half * 32 + 8 * fq;
                    }
                    u32x4 w; w.x = cvt_pk_bf16(v0[0], v0[1]); w.y = cvt_pk_bf16(v0[2], v0[3]); w.z = cvt_pk_bf16(v1[0], v1[1]); w.w = cvt_pk_bf16(v1[2], v1[3]);
                    *(u32x4*)dst = w;
                }
            }
    }
};
struct EpiKV {
    static constexpr bool PERM = true, AFTER_DRAIN = false;
    bf16_t *K, *V; const float* ssq_kv;
    __device__ __forceinline__ void operator()(const f32x4 (&acc)[2][2][4][2], const Unit& u, int wr, int wc, int fr, int fq) const {
        const int head = u.pn;
#pragma unroll
        for (int ai = 0; ai < 2; ++ai)
#pragma unroll
            for (int m = 0; m < 4; ++m) {
                const int r = u.pm * BM + ai * HALF + wr * 64 + m * 16 + fr;
                int b, l; if (r < 16384) { b = r >> 13; l = 256 + (r & 8191); } else { b = (r - 16384) >> 8; l = (r - 16384) & 255; }
                const f32x4 sa = *(const f32x4*)(ssq_kv + (size_t)r * 4);
                const float rs = rsqrtf(((sa[0] + sa[1]) + (sa[2] + sa[3])) * (1.0f / 256.0f) + 1e-6f);
                const size_t rowi = (size_t)(b * 8 + head) * 8448 + l;
#pragma unroll
                for (int bj = 0; bj < 2; ++bj) {
                    const f32x4 v0 = acc[ai][bj][m][0] * rs, v1 = acc[ai][bj][m][1] * rs;
                    bf16_t* dst = (bj == 0) ? (K + rowi * 192 + wc * 32 + 8 * fq) : (V + rowi * 128 + wc * 32 + 8 * fq);
                    u32x4 w; w.x = cvt_pk_bf16(v0[0], v0[1]); w.y = cvt_pk_bf16(v0[2], v0[3]); w.z = cvt_pk_bf16(v1[0], v1[1]); w.w = cvt_pk_bf16(v1[2], v1[3]);
                    *(u32x4*)dst = w;
                }
            }
    }
};
template <bool FIRST> struct EpiMerge {
    static constexpr bool PERM = true, AFTER_DRAIN = false;
    const bf16_t* G; bf16_t* MG; bf16_t* MGA;
    __device__ __forceinline__ void operator()(const f32x4 (&acc)[2][2][4][2], const Unit& u, int wr, int wc, int fr, int fq) const {
#pragma unroll
        for (int ai = 0; ai < 2; ++ai)
#pragma unroll
            for (int m = 0; m < 4; ++m) {
                const size_t off = (size_t)(u.pm * BM + ai * HALF + wr * 64 + m * 16 + fr) * 2048 + u.pn * BM + wc * 32 + 8 * fq;
#pragma unroll
                for (int bj = 0; bj < 2; ++bj) {
                    const u32x4 g = *(const u32x4*)(G + off + bj * HALF);
                    float gv[8] = {__uint_as_float(g.x << 16), __uint_as_float(g.x & 0xffff0000u), __uint_as_float(g.y << 16), __uint_as_float(g.y & 0xffff0000u),
                                   __uint_as_float(g.z << 16), __uint_as_float(g.z & 0xffff0000u), __uint_as_float(g.w << 16), __uint_as_float(g.w & 0xffff0000u)};
                    float o[8];
#pragma unroll
                    for (int e = 0; e < 8; ++e) o[e] = sigm(gv[e]) * acc[ai][bj][m][e >> 2][e & 3];
                    if (!FIRST) { const u32x4 p = *(const u32x4*)(MG + off + bj * HALF);
                        o[0] += __uint_as_float(p.x << 16); o[1] += __uint_as_float(p.x & 0xffff0000u); o[2] += __uint_as_float(p.y << 16); o[3] += __uint_as_float(p.y & 0xffff0000u);
                        o[4] += __uint_as_float(p.z << 16); o[5] += __uint_as_float(p.z & 0xffff0000u); o[6] += __uint_as_float(p.w << 16); o[7] += __uint_as_float(p.w & 0xffff0000u); }
                    u32x4 w; w.x = cvt_pk_bf16(o[0], o[1]); w.y = cvt_pk_bf16(o[2], o[3]); w.z = cvt_pk_bf16(o[4], o[5]); w.w = cvt_pk_bf16(o[6], o[7]);
                    *(u32x4*)(MG + off + bj * HALF) = w;
                    if (FIRST && MGA) *(u32x4*)(MGA + off + bj * HALF) = w;
                }
            }
    }
};
struct EpiOut {
    static constexpr bool PERM = false, AFTER_DRAIN = false;
    const float* X; const float* G1  ; float* X1;
    __device__ __forceinline__ void operator()(const f32x4 (&acc)[2][2][4][2], const Unit& u, int wr, int wc, int fr, int fq) const {
        const int b = u.pm >> 5;
        const int col0 = u.pn * BM + wc * 32 + 4 * fq;
#pragma unroll
        for (int bj = 0; bj < 2; ++bj)
#pragma unroll
            for (int n = 0; n < 2; ++n) { const int c = col0 + bj * HALF + n * 16; const f32x4 g = *(const f32x4*)(G1 + b * 12288 + c);
#pragma unroll
                for (int ai = 0; ai < 2; ++ai)
#pragma unroll
                    for (int m = 0; m < 4; ++m) { const size_t off = (size_t)(u.pm * BM + ai * HALF + wr * 64 + m * 16 + fr) * 2048 + c;
                        *(f32x4*)(X1 + off) = *(const f32x4*)(X + off) + g * acc[ai][bj][m][n]; } }
    }
};
struct EpiDelta {
    static constexpr bool PERM = true, AFTER_DRAIN = false;
    const float* G1; bf16_t* DA;
    __device__ __forceinline__ void operator()(const f32x4 (&acc)[2][2][4][2], const Unit& u, int wr, int wc, int fr, int fq) const {
        const int b = u.pm >> 5;
#pragma unroll
        for (int ai = 0; ai < 2; ++ai)
#pragma unroll
            for (int m = 0; m < 4; ++m) {
                const size_t off = (size_t)(u.pm * BM + ai * HALF + wr * 64 + m * 16 + fr) * 2048 + u.pn * BM + wc * 32 + 8 * fq;
#pragma unroll
                for (int bj = 0; bj < 2; ++bj) { const int c = u.pn * BM + wc * 32 + 8 * fq + bj * HALF;
                    const f32x4 g0 = *(const f32x4*)(G1 + b * 12288 + c), g1v = *(const f32x4*)(G1 + b * 12288 + c + 4);
                    const f32x4 v0 = acc[ai][bj][m][0] * g0, v1 = acc[ai][bj][m][1] * g1v;
                    u32x4 w; w.x = cvt_pk_bf16(v0[0], v0[1]); w.y = cvt_pk_bf16(v0[2], v0[3]); w.z = cvt_pk_bf16(v1[0], v1[1]); w.w = cvt_pk_bf16(v1[2], v1[3]);
                    *(u32x4*)(DA + off + bj * HALF) = w; }
            }
    }
};
struct EpiScore {
    static constexpr bool PERM = false, AFTER_DRAIN = false;
    float* SC;
    __device__ __forceinline__ void operator()(const f32x4 (&acc)[2][2][4][2], const Unit& u, int wr, int wc, int fr, int fq) const {
        const int col0 = u.pn * BM + wc * 32 + 4 * fq;
#pragma unroll
        for (int ai = 0; ai < 2; ++ai)
#pragma unroll
            for (int m = 0; m < 4; ++m) { const size_t off = (size_t)(u.pm * BM + ai * HALF + wr * 64 + m * 16 + fr) * 2048 + col0;
#pragma unroll
                for (int bj = 0; bj < 2; ++bj)
#pragma unroll
                    for (int n = 0; n < 2; ++n) *(f32x4*)(SC + off + bj * HALF + n * 16) = acc[ai][bj][m][n]; }
    }
};
}
namespace attn {
using bf16x8 = __attribute__((ext_vector_type(8))) short;
using s16x4  = __attribute__((ext_vector_type(4))) short;
using f32x16 = __attribute__((ext_vector_type(16))) float;
using u32x4  = __attribute__((ext_vector_type(4))) unsigned;
typedef unsigned short bf16_t;
constexpr int DQK = 192, DV = 128, NW = 8, QBLK = 32, KVBLK = 64;
constexpr int SHM_V = KVBLK * DV * 2  , SHM_K = KVBLK * DQK * 2  , SHM_QR = 2 * SHM_V + 2 * SHM_K + NW * 64 * 4, SHM_ATTN = SHM_QR + NW * 4096;
constexpr float THR = 8.0f;
#define KSWZ(row, colB) ((row) * 384 + ((colB) ^ (((row) & 7) << 4)))
#define SBAR() __builtin_amdgcn_sched_barrier(0)
__device__ __forceinline__ int crow(int r, int hi) { return (r & 3) + 8 * (r >> 2) + 4 * hi; }
__device__ __forceinline__ unsigned cvtpk(float lo, float hi) { unsigned r; asm volatile("v_cvt_pk_bf16_f32 %0, %1, %2" : "=v"(r) : "v"(lo), "v"(hi)); return r; }
__device__ __forceinline__ void partialSM(f32x16& p0, f32x16& p1, float& m_reg, float& mn, float& alpha) {
  float pmax = p0[0];
#pragma unroll
  for (int r = 1; r < 16; ++r) pmax = fmaxf(pmax, p0[r]);
#pragma unroll
  for (int r = 0; r < 16; ++r) pmax = fmaxf(pmax, p1[r]);
  { auto rr = __builtin_amdgcn_permlane32_swap(__float_as_uint(pmax), __float_as_uint(pmax), false, false);
    pmax = fmaxf(__uint_as_float(rr[0]), __uint_as_float(rr[1])); }
  if (__builtin_expect(__all(pmax - m_reg <= THR), 1)) { mn = m_reg; alpha = 1.f; }
  else { mn = fmaxf(m_reg, pmax); alpha = __builtin_amdgcn_exp2f(m_reg - mn); m_reg = mn; }
#pragma unroll
  for (int r = 0; r < 16; ++r) p0[r] = p0[r] - mn;
#pragma unroll
  for (int r = 0; r < 16; ++r) p1[r] = p1[r] - mn;
#pragma unroll
  for (int r = 0; r < 16; ++r) p0[r] = __builtin_amdgcn_exp2f(p0[r]);
}
__device__ __forceinline__ void finishSM(f32x16& p0, f32x16& p1, float alpha, float& l_reg, bf16x8& pa0, bf16x8& pa1, bf16x8& pa2, bf16x8& pa3) {
#pragma unroll
  for (int r = 0; r < 16; ++r) p1[r] = __builtin_amdgcn_exp2f(p1[r]);
  float ps = 0;
#pragma unroll
  for (int r = 0; r < 16; ++r) ps += p0[r];
#pragma unroll
  for (int r = 0; r < 16; ++r) ps += p1[r];
  { auto rr = __builtin_amdgcn_permlane32_swap(__float_as_uint(ps), __float_as_uint(ps), false, false);
    ps = __uint_as_float(rr[0]) + __uint_as_float(rr[1]); }
  l_reg = l_reg * alpha + ps;
#define PK4(P, BASE, OUT) do { unsigned a0 = cvtpk(P[BASE + 0], P[BASE + 1]), a1 = cvtpk(P[BASE + 2], P[BASE + 3]);   \
    unsigned b0 = cvtpk(P[BASE + 4], P[BASE + 5]), b1 = cvtpk(P[BASE + 6], P[BASE + 7]);                              \
    auto r0 = __builtin_amdgcn_permlane32_swap(a0, b0, false, false); auto r1 = __builtin_amdgcn_permlane32_swap(a1, b1, false, false); \
    u32x4 w = {r0[0], r1[0], r0[1], r1[1]}; OUT = *reinterpret_cast<bf16x8*>(&w); } while (0)
  PK4(p0, 0, pa0); PK4(p0, 8, pa1); PK4(p1, 0, pa2); PK4(p1, 8, pa3);
#undef PK4
}
__device__ __forceinline__ void qkt(f32x16& p0, f32x16& p1, const char* Ks, const bf16x8* qr, const char* qrow, int qx, int r32, int hi) {
  p0 = f32x16{}; p1 = f32x16{};
#pragma unroll
  for (int d0 = 0; d0 < 12; ++d0) { const int cb = (d0 * 16 + hi * 8) * 2;
    bf16x8 b0 = *reinterpret_cast<const bf16x8*>(Ks + KSWZ(r32, cb));
    bf16x8 b1 = *reinterpret_cast<const bf16x8*>(Ks + KSWZ(32 + r32, cb));
    const bf16x8 q = (d0 < 8) ? qr[d0 < 8 ? d0 : 0] : *reinterpret_cast<const bf16x8*>(qrow + (qx ^ ((d0 - 8) << 5)));
    p0 = __builtin_amdgcn_mfma_f32_32x32x16_bf16(b0, q, p0, 0, 0, 0);
    p1 = __builtin_amdgcn_mfma_f32_32x32x16_bf16(b1, q, p1, 0, 0, 0); }
}
__device__ __forceinline__ int v_st(int k, int c) { const int kk = (k & ~0xC) | ((k & 4) << 1) | ((k & 8) >> 1); return ((kk >> 3) * 4 + (c >> 5)) * 512 + ((kk & 7) * 32 + (c & 31)) * 2; }
__device__ __forceinline__ int v_rd_base(int lane) { return ((lane & 3) << 3) | (((lane >> 2) & 3) << 6) | (((lane >> 4) & 1) << 5) | (((lane >> 5) & 1) << 8); }
constexpr int v_rd_off(int d0, int ks, int half) { return d0 * 512 + ks * 4096 + half * 2048; }
template <int OFF> __device__ __forceinline__ s16x4 tr_read(int vb) {
  s16x4 r; asm volatile("ds_read_b64_tr_b16 %0, %1 offset:%2" : "=&v"(r) : "v"(vb), "i"(OFF) : "memory"); return r;
}
template <int D0> __device__ __forceinline__ void pv_one(f32x16& od, int vb, bf16x8 pa0, bf16x8 pa1, bf16x8 pa2, bf16x8 pa3) {
  const s16x4 l0 = tr_read<v_rd_off(D0, 0, 0)>(vb), h0 = tr_read<v_rd_off(D0, 0, 1)>(vb), l1 = tr_read<v_rd_off(D0, 1, 0)>(vb), h1 = tr_read<v_rd_off(D0, 1, 1)>(vb);
  const s16x4 l2 = tr_read<v_rd_off(D0, 2, 0)>(vb), h2 = tr_read<v_rd_off(D0, 2, 1)>(vb), l3 = tr_read<v_rd_off(D0, 3, 0)>(vb), h3 = tr_read<v_rd_off(D0, 3, 1)>(vb);
  asm volatile("s_waitcnt lgkmcnt(0)" ::: "memory"); SBAR();
#define PK(L, H) (bf16x8){L[0], L[1], L[2], L[3], H[0], H[1], H[2], H[3]}
  od = __builtin_amdgcn_mfma_f32_32x32x16_bf16(pa0, PK(l0, h0), od, 0, 0, 0);
  od = __builtin_amdgcn_mfma_f32_32x32x16_bf16(pa1, PK(l1, h1), od, 0, 0, 0);
  od = __builtin_amdgcn_mfma_f32_32x32x16_bf16(pa2, PK(l2, h2), od, 0, 0, 0);
  od = __builtin_amdgcn_mfma_f32_32x32x16_bf16(pa3, PK(l3, h3), od, 0, 0, 0);
#undef PK
}
__device__ __forceinline__ void pv_d0(f32x16* o, int vb, bf16x8 pa0, bf16x8 pa1, bf16x8 pa2, bf16x8 pa3) {
  pv_one<0>(o[0], vb, pa0, pa1, pa2, pa3); pv_one<1>(o[1], vb, pa0, pa1, pa2, pa3); pv_one<2>(o[2], vb, pa0, pa1, pa2, pa3); pv_one<3>(o[3], vb, pa0, pa1, pa2, pa3);
}
__device__ __forceinline__ void attn_unit(const bf16_t* __restrict__ Qb, const bf16_t* __restrict__ Kh, const bf16_t* __restrict__ Vh, bf16_t* __restrict__ Ob, int ldo, int seq, char* lds, int tid_in) {
  int tid_ = tid_in; asm volatile("" : "+v"(tid_));
  const int tid = tid_, wid = tid >> 6, lane = tid & 63, r32 = lane & 31, hi = lane >> 5;
  char* V_lds = lds; char* K_lds = lds + 2 * SHM_V;
  float* ws = (float*)(lds + 2 * SHM_V + 2 * SHM_K) + wid * 64; float* li_l = ws; float* al_l = ws + 32;
  float m_reg = -1e30f, l_reg = 0; f32x16 o[4] = {}; bf16x8 qr[8];
  const bf16_t* Qw = Qb + (long)(wid * QBLK + r32) * DQK + hi * 8;
#pragma unroll
  for (int d0 = 0; d0 < 8; ++d0) qr[d0] = *reinterpret_cast<const bf16x8*>(Qw + d0 * 16);
  char* qrow = lds + SHM_QR + wid * 4096 + r32 * 128; const int qx = (hi ^ (r32 & 7)) << 4;
#pragma unroll
  for (int d0 = 8; d0 < 12; ++d0) *reinterpret_cast<bf16x8*>(qrow + (qx ^ ((d0 - 8) << 5))) = *reinterpret_cast<const bf16x8*>(Qw + d0 * 16);
  const int sr = tid >> 4, sc = (tid & 15) * 8, vst0 = v_st(sr, sc), vst1 = v_st(32 + sr, sc);
  unsigned kgo[3], klo[3];
#pragma unroll
  for (int i = 0; i < 3; ++i) { const int id = tid + 512 * i, kr_ = id / 24, kc_ = (id % 24) * 16; kgo[i] = (unsigned)(kr_ * 384 + kc_); klo[i] = (unsigned)KSWZ(kr_, kc_); }
  const unsigned vgo0 = (unsigned)((sr * DV + sc) * 2), vgo1 = (unsigned)(((32 + sr) * DV + sc) * 2);
  const int vb0 = (int)(uintptr_t)V_lds + v_rd_base(lane);
  bf16x8 vs0, vs1, ks0, ks1, ks2;
#define SLOAD(k0) do { const char* Kt_ = (const char*)Kh + (size_t)(k0) * (DQK * 2); const char* Vt_ = (const char*)Vh + (size_t)(k0) * (DV * 2); \
    vs0 = *reinterpret_cast<const bf16x8*>(Vt_ + vgo0); vs1 = *reinterpret_cast<const bf16x8*>(Vt_ + vgo1); \
    ks0 = *reinterpret_cast<const bf16x8*>(Kt_ + kgo[0]); ks1 = *reinterpret_cast<const bf16x8*>(Kt_ + kgo[1]); ks2 = *reinterpret_cast<const bf16x8*>(Kt_ + kgo[2]); } while (0)
#define SWRITE(b) do { *(bf16x8*)(V_lds + (b) * SHM_V + vst0) = vs0; *(bf16x8*)(V_lds + (b) * SHM_V + vst1) = vs1; \
    *(bf16x8*)(K_lds + (b) * SHM_K + klo[0]) = ks0; *(bf16x8*)(K_lds + (b) * SHM_K + klo[1]) = ks1; *(bf16x8*)(K_lds + (b) * SHM_K + klo[2]) = ks2; } while (0)
#define RESC(a) do { if (__any((a) < 1.f)) { if (hi == 0) al_l[r32] = (a); asm volatile("s_waitcnt lgkmcnt(0)" ::: "memory"); \
    _Pragma("unroll") for (int d = 0; d < 4; ++d) _Pragma("unroll") for (int r = 0; r < 16; ++r) o[d][r] *= al_l[crow(r, hi)]; } } while (0)
  f32x16 pA0, pA1, pB0, pB1; float mnA, mnB, alA, alB; bf16x8 pa0, pa1, pa2, pa3; const int NT = seq / KVBLK;
  SLOAD(0); SWRITE(0); __syncthreads();
  qkt(pA0, pA1, K_lds, qr, qrow, qx, r32, hi); partialSM(pA0, pA1, m_reg, mnA, alA);
  SLOAD(KVBLK);
  SWRITE(1); __syncthreads();
  for (int j = 1; j + 1 < NT; j += 2) {
    SBAR(); qkt(pB0, pB1, K_lds + SHM_K, qr, qrow, qx, r32, hi);
    finishSM(pA0, pA1, alA, l_reg, pa0, pa1, pa2, pa3); SBAR();
    SLOAD((j + 1) * KVBLK); SBAR();
    pv_d0(o, vb0, pa0, pa1, pa2, pa3); partialSM(pB0, pB1, m_reg, mnB, alB);
    __syncthreads(); SWRITE(0);
    RESC(alB); __syncthreads();
    SBAR(); qkt(pA0, pA1, K_lds, qr, qrow, qx, r32, hi);
    finishSM(pB0, pB1, alB, l_reg, pa0, pa1, pa2, pa3); SBAR();
    SLOAD((j + 2) * KVBLK); SBAR();
    pv_d0(o, vb0 + SHM_V, pa0, pa1, pa2, pa3); partialSM(pA0, pA1, m_reg, mnA, alA);
    __syncthreads(); SWRITE(1);
    RESC(alA); __syncthreads();
  }
  SBAR(); qkt(pB0, pB1, K_lds + SHM_K, qr, qrow, qx, r32, hi);
  finishSM(pA0, pA1, alA, l_reg, pa0, pa1, pa2, pa3); SBAR();
  pv_d0(o, vb0, pa0, pa1, pa2, pa3); partialSM(pB0, pB1, m_reg, mnB, alB);
  __syncthreads(); RESC(alB);
  finishSM(pB0, pB1, alB, l_reg, pa0, pa1, pa2, pa3); SBAR();
  pv_d0(o, vb0 + SHM_V, pa0, pa1, pa2, pa3);
  if (hi == 0) li_l[r32] = l_reg; asm volatile("s_waitcnt lgkmcnt(0)" ::: "memory");
  float rli[16];
#pragma unroll
  for (int r = 0; r < 16; ++r) rli[r] = __builtin_amdgcn_rcpf(li_l[crow(r, hi)]);
  { int t2 = tid_in; asm volatile("" : "+v"(t2));
    const int w2 = t2 >> 6, l2 = t2 & 63, c2 = l2 & 31, h2 = l2 >> 5;
    bf16_t* Ow = Ob + (unsigned)((w2 * QBLK + 4 * h2) * ldo + c2);
#pragma unroll
    for (int r = 0; r < 16; ++r) { const unsigned ro = (unsigned)(((r & 3) + 8 * (r >> 2)) * ldo);
#pragma unroll
      for (int d0 = 0; d0 < 4; ++d0) { const float v = o[d0][r] * rli[r]; Ow[ro + d0 * 32] = (bf16_t)(cvtpk(v, v) & 0xffffu); } } }
  __syncthreads();
#undef SLOAD
#undef SWRITE
#undef RESC
}
#undef KSWZ
#undef SBAR
}
#define GAS __attribute__((address_space(1)))
#define LAS __attribute__((address_space(3)))
typedef unsigned short bf16_t;
typedef unsigned v4u __attribute__((ext_vector_type(4)));
typedef unsigned v2u __attribute__((ext_vector_type(2)));
typedef float f32x4 __attribute__((ext_vector_type(4)));
typedef short bf16x8 __attribute__((ext_vector_type(8)));
constexpr int NT_ = 512;
constexpr int BATCH = 2, SEQ = 8192, DM = 2048, CTXL = 256;
constexpr int ML = BATCH * SEQ  , MC = BATCH * CTXL  , M1 = ML + MC  ;
constexpr int NIN_PAD = 9216;
constexpr int LKV = CTXL + SEQ;
constexpr int NCH = 132;
constexpr float EPS = 1e-6f;
constexpr float QSCALE = 0.07216878364870322f * 1.4426950408889634f;
constexpr size_t MiB = 1u << 20;
constexpr size_t WS_CTL = 0, CTL_BYTES = 1 * MiB;
constexpr size_t CTL_BAR = 4096;
static_assert(CTL_BAR + 3456 * 4 <= CTL_BYTES, "ctl");
constexpr size_t WS_WUQ = 1 * MiB, WS_WUKV = WS_WUQ + 1536 * 512 * 2, WS_WBA = WS_WUKV + 2048 * 256 * 2, WS_WBB = WS_WBA + 4 * MiB, WS_WOUT = WS_WBB + 4 * MiB, WS_WPQ = WS_WOUT + 8 * MiB;
static_assert(WS_WPQ + 8 * MiB <= 28 * MiB, "small weights");
constexpr size_t WS_C = 28 * MiB;
constexpr size_t WS_D = 66 * MiB;
constexpr size_t WS_E1 = 132 * MiB;
constexpr size_t WS_CQ = WS_E1, WS_CKV = WS_CQ + 16 * MiB, WS_KR = WS_CKV + (size_t)M1 * 256 * 2, WS_AB = WS_KR + (size_t)M1 * 64 * 4;
static_assert(WS_AB + (size_t)M1 * 32 * 4 <= 164 * MiB, "E1");
constexpr size_t WS_Z = 164 * MiB, WS_GA = 196 * MiB, WS_GB = 260 * MiB;
constexpr size_t WS_QKV = 324 * MiB;
constexpr size_t WS_K = 423 * MiB;
constexpr size_t WS_DNQ = 473 * MiB;
constexpr size_t WS_GBETA = 572 * MiB;
constexpr size_t WS_EG = 575 * MiB;
constexpr size_t CTL_MOD = 27 * MiB + 512 * 1024;
constexpr size_t CTL_SSQQ = 575 * MiB, CTL_SSQKV = CTL_SSQQ + (size_t)16384 * 8 * 4;
static_assert(CTL_SSQKV + (size_t)16896 * 4 * 4 <= 577 * MiB && CTL_MOD + 3 * 12288 * 4 <= 28 * MiB && WS_WPQ + 8 * MiB <= CTL_MOD, "mod/ssq");
constexpr size_t WS_W = WS_QKV, WS_U = WS_QKV + 66 * MiB, WS_ATT = WS_C, WS_OF = WS_D, WS_OB = WS_D + 32 * MiB, WS_YA = WS_E1, WS_YB = WS_C;
constexpr size_t WS_MG = 324 * MiB, WS_H2 = 388 * MiB, WS_UB = 452 * MiB, WS_VB = 484 * MiB, WS_USC = 516 * MiB, WS_VSC = 517 * MiB, WS_SC = 196 * MiB, WS_END = 580 * MiB;
static_assert(WS_EG + (size_t)4224 * 132 * 4 <= WS_END && WS_K + (size_t)16 * LKV * 192 * 2 <= WS_DNQ && WS_DNQ + (size_t)M1 * 3072 * 2 <= WS_GBETA, "ws map");

__device__ __forceinline__ unsigned f2bf(float f) { unsigned u = __builtin_bit_cast(unsigned, f); return (u + 0x7fffu + ((u >> 16) & 1u)) >> 16; }
typedef float f32x2_c __attribute__((ext_vector_type(2))); typedef __bf16 bf16x2_c __attribute__((ext_vector_type(2)));
__device__ __forceinline__ unsigned pk2(float lo, float hi) { f32x2_c v = {lo, hi}; bf16x2_c b = __builtin_convertvector(v, bf16x2_c); return __builtin_bit_cast(unsigned, b); }
__device__ __forceinline__ float bflo(unsigned w) { return __uint_as_float(w << 16); }
__device__ __forceinline__ float bfhi(unsigned w) { return __uint_as_float(w & 0xffff0000u); }
__device__ __forceinline__ float wave_sum(float v) {
#pragma unroll
    for (int o = 1; o < 64; o <<= 1) v += __shfl_xor(v, o);
    return v;
}
__device__ __forceinline__ float siluf(float v) { return v / (1.0f + __expf(-v)); }

struct Params {
    const float *x, *c, *ctx, *c_ctx, *w_mod, *b_mod, *norm1_w, *w_in, *qn_w, *kvn_w, *w_uq, *w_ukv, *conv_w, *a_log, *dt_bias, *dn_norm_w,
                *w_ba, *w_bb, *w_out, *norm2_w, *peer_wq, *sub_keys, *peer_u, *peer_v, *final_w;
    float* out; unsigned char* ws;
    int ph_lo, ph_hi;
};
#define XB_TMO      128
#define XB_XCNT(j)  (256  + 64 * (j))
#define XB_XSUB(j)  (1280 + 64 * (j))
#define XB_XGEN(j)  (2304 + 64 * (j))
#define XB_TOP      3328
#define XB_TOPGEN   3392
#define XCD_BAR_WORDS 3456
#define XB_SPIN_CAP (1u << 18)

__device__ __forceinline__ unsigned xb_ld(unsigned* p)              { return __hip_atomic_load(p, __ATOMIC_RELAXED, __HIP_MEMORY_SCOPE_AGENT); }
__device__ __forceinline__ unsigned xb_add(unsigned* p, unsigned v) { return __hip_atomic_fetch_add(p, v, __ATOMIC_RELAXED, __HIP_MEMORY_SCOPE_AGENT); }
__device__ __forceinline__ unsigned xb_xcc_id() { return (unsigned)__builtin_amdgcn_s_getreg((3 << 11) | 20) & 0xFu; }
#define XB_SPIN(cond, bar) do { unsigned _sp = 0; while (cond) { __builtin_amdgcn_s_sleep(1); \
    if ((++_sp & 255u) == 0u) { if (xb_ld(&(bar)[XB_TMO])) break; if (_sp > XB_SPIN_CAP) { atomicAdd(&(bar)[XB_TMO], 1u); break; } } } } while (0)

struct XcdBarrier {
    unsigned* bar; unsigned x;
    volatile LAS unsigned* st;
};

__device__ __forceinline__ XcdBarrier xcd_barrier_post(unsigned* bar, volatile LAS unsigned* st, int tid) {
    XcdBarrier b; b.bar = bar; b.x = xb_xcc_id(); b.st = st;
    if (tid == 0) (void)xb_add(&bar[XB_XCNT(b.x)], 1u);
    return b;
}
__device__ __forceinline__ void xcd_barrier_complete(unsigned* bar, unsigned x, unsigned& nloc, unsigned& nx) {
    const unsigned G = gridDim.x * gridDim.y * gridDim.z;
    unsigned sum, cnt, mine, sp = 0u;
    for (;;) {
        sum = 0u; cnt = 0u; mine = 0u;
#pragma unroll
        for (unsigned j = 0; j < 16; ++j) { const unsigned c = xb_ld(&bar[XB_XCNT(j)]); sum += c; cnt += (c > 0u) ? 1u : 0u; mine = (j == x) ? c : mine; }
        if (sum == G) break;
        __builtin_amdgcn_s_sleep(1);
        if ((++sp & 255u) == 0u) { if (xb_ld(&bar[XB_TMO])) break; if (sp > XB_SPIN_CAP) { atomicAdd(&bar[XB_TMO], 1u); break; } }
    }
    nloc = mine > 0u ? mine : 1u; nx = cnt > 0u ? cnt : 1u;
}

__device__ __forceinline__ void xcd_barrier(const XcdBarrier& b, int tid) {
    asm volatile("s_waitcnt vmcnt(0)" ::: "memory");
    __syncthreads();
    if (tid == 0) {
        unsigned* bar = b.bar;
        __builtin_amdgcn_s_waitcnt(0);
        unsigned nloc = b.st[0], nx = b.st[1];
        if (nloc == 0u) { xcd_barrier_complete(bar, b.x, nloc, nx); b.st[0] = nloc; b.st[1] = nx; }
        const unsigned old = xb_add(&bar[XB_XSUB(b.x)], 1u);
        const unsigned gen = old / nloc;
        if (old + 1u == (gen + 1u) * nloc) {
            __builtin_amdgcn_fence(__ATOMIC_RELEASE, "agent");
            asm volatile("s_waitcnt vmcnt(0)" ::: "memory");
            const unsigned og = xb_add(&bar[XB_TOP], 1u);
            const unsigned tg = og / nx;
            if (og + 1u == (tg + 1u) * nx) xb_add(&bar[XB_TOPGEN], 1u);
            else XB_SPIN(xb_ld(&bar[XB_TOPGEN]) == tg, bar);
            __builtin_amdgcn_fence(__ATOMIC_ACQUIRE, "agent");
            xb_add(&bar[XB_XGEN(b.x)], 1u);
            asm volatile("s_waitcnt vmcnt(0)" ::: "memory");
        } else {
            XB_SPIN(xb_ld(&bar[XB_XGEN(b.x)]) == gen, bar);
            __builtin_amdgcn_fence(__ATOMIC_ACQUIRE, "agent");
            asm volatile("s_waitcnt vmcnt(0)" ::: "memory");
        }
    }
    __syncthreads();
}
struct Ctx { LAS unsigned char* lds; int tid, lane, wave, vcu, G; };

__device__ __forceinline__ void p0_mod_item(const Params& p, const Ctx& C, int it) {
    LAS float* sl = (LAS float*)C.lds;
    LAS float* red = sl + 3 * 2048;
    for (int e = C.tid; e < 3 * 2048; e += NT_) { const int i = e >> 11, k = e & 2047; const float v = (i < 2) ? p.c[i * DM + k] : p.c_ctx[k]; sl[e] = siluf(v); }
    __syncthreads();
    typedef float f32x2_ __attribute__((ext_vector_type(2)));
    f32x2_ a0 = {0, 0}, a1 = {0, 0}, a2 = {0, 0};
    const int col = it * 128 + C.lane * 2, k0 = C.wave * 256;
    const float* wp = p.w_mod + (size_t)k0 * 12288 + col;
#pragma unroll 8
    for (int k = 0; k < 256; ++k) { const f32x2_ w = *(const f32x2_*)(wp + (size_t)k * 12288); a0 += w * sl[k0 + k]; a1 += w * sl[2048 + k0 + k]; a2 += w * sl[4096 + k0 + k]; }
    LAS float* rw = red + C.wave * 384 + C.lane * 2;
    rw[0] = a0[0]; rw[1] = a0[1]; rw[128] = a1[0]; rw[129] = a1[1]; rw[256] = a2[0]; rw[257] = a2[1];
    __syncthreads();
    if (C.tid < 384) { float s = p.b_mod[it * 128 + (C.tid & 127)];
#pragma unroll
        for (int w = 0; w < 8; ++w) s += red[w * 384 + C.tid];
        ((float*)(p.ws + CTL_MOD))[(C.tid >> 7) * 12288 + it * 128 + (C.tid & 127)] = s; }
    __syncthreads();
}
__device__ __forceinline__ void p0_wprime_item(const Params& p, const Ctx& C, int it) {
    LAS float* As = (LAS float*)C.lds;
    LAS float* Ss = As + 64 * 129;
    const int hp = it >> 5, i0 = (it & 31) * 64, pp = hp & 1;
    for (int e = C.tid; e < 64 * 128; e += NT_) { const int i = e >> 7, d = e & 127; As[i * 129 + d] = p.peer_wq[(size_t)(i0 + i) * 2048 + hp * 128 + d]; }
    for (int e = C.tid; e < 128 * 128; e += NT_) { const int k = e >> 7, d = e & 127; Ss[k * 129 + d] = p.sub_keys[(size_t)(pp * 128 + k) * 128 + d]; }
    __syncthreads();
    const int k = C.tid & 127, ig = C.tid >> 7;
    float acc[16];
#pragma unroll
    for (int ii = 0; ii < 16; ++ii) acc[ii] = 0.f;
    for (int d = 0; d < 128; ++d) { const float s = Ss[k * 129 + d];
#pragma unroll
        for (int ii = 0; ii < 16; ++ii) acc[ii] += As[(ig * 16 + ii) * 129 + d] * s; }
    bf16_t* dst = (bf16_t*)(p.ws + WS_WPQ) + (size_t)(hp * 128 + k) * 2048 + i0 + ig * 16;
    v4u w0, w1; w0.x = pk2(acc[0], acc[1]); w0.y = pk2(acc[2], acc[3]); w0.z = pk2(acc[4], acc[5]); w0.w = pk2(acc[6], acc[7]);
    w1.x = pk2(acc[8], acc[9]); w1.y = pk2(acc[10], acc[11]); w1.z = pk2(acc[12], acc[13]); w1.w = pk2(acc[14], acc[15]);
    *(v4u*)dst = w0; *(v4u*)(dst + 8) = w1;
    __syncthreads();
}
__device__ __forceinline__ void p0_transpose_item(const float* W, int K, int N, int k0, int n0, bf16_t* WT, int drow0, const float* kscale, LAS float* scr, int lane) {
#pragma unroll 8
    for (int i = 0; i < 32; ++i) { const int kk = 2 * i + (lane >> 5); float v = W[(size_t)(k0 + kk) * N + n0 + (lane & 31)]; if (kscale) v *= kscale[k0 + kk]; scr[kk * 33 + (lane & 31)] = v; }
    asm volatile("s_waitcnt lgkmcnt(0)" ::: "memory");
    const int c = lane & 7;
#pragma unroll
    for (int j = 0; j < 4; ++j) { const int n = (lane >> 3) + 8 * j; const LAS float* s = scr + (8 * c) * 33 + n;
        v4u o; o.x = pk2(s[0 * 33], s[1 * 33]); o.y = pk2(s[2 * 33], s[3 * 33]); o.z = pk2(s[4 * 33], s[5 * 33]); o.w = pk2(s[6 * 33], s[7 * 33]);
        *(v4u*)(WT + (size_t)(drow0 + n) * K + k0 + 8 * c) = o; }
    asm volatile("s_waitcnt lgkmcnt(0)" ::: "memory");
}
__device__ __forceinline__ int win_dest_row(int n0) {
    if (n0 < 768) return n0;
    if (n0 < 832) return 8960 + (n0 - 768);
    if (n0 < 3904) return 768 + (n0 - 832);
    if (n0 < 4928) return 3840 + (n0 - 3904);
    if (n0 < 4960) return 9024 + (n0 - 4928);
    if (n0 < 7008) return 4864 + (n0 - 4960);
    return 6912 + (n0 - 7008);
}
__device__ __forceinline__ void p0_prologue(const Params& p, const Ctx& C) {
    for (int it = C.vcu; it < 96; it += C.G) p0_mod_item(p, C, it);
    for (int it = C.vcu; it < 512; it += C.G) p0_wprime_item(p, C, it);
    LAS float* scr = (LAS float*)(C.lds + C.wave * 16384);
    const int gw = C.vcu * 8 + C.wave, NGW = C.G * 8;
    constexpr int I_IN = 32 * 283, I_UQ = 8 * 48, I_UKV = 4 * 64, I_BA = 16 * 64, I_BB = 16 * 64, I_OUT = 32 * 64;
    constexpr int NITEMS = I_IN + I_UQ + I_UKV + I_BA + I_BB + I_OUT;
    unsigned char* ws = p.ws;
    for (int it = gw; it < NITEMS; it += NGW) {
        int r = it;
        if (r < I_IN) { const int kb = r / 283, nb = r % 283; p0_transpose_item(p.w_in, 2048, 9056, kb * 64, nb * 32, (bf16_t*)(ws + WS_C), win_dest_row(nb * 32), nullptr, scr, C.lane); continue; } r -= I_IN;
        if (r < I_UQ) { const int kb = r / 48, nb = r % 48, n0 = nb * 32, h = n0 / 192, j0 = n0 % 192; const int dr = (j0 < 128) ? (h * 128 + j0) : (1024 + h * 64 + (j0 - 128));
            p0_transpose_item(p.w_uq, 512, 1536, kb * 64, n0, (bf16_t*)(ws + WS_WUQ), dr, p.qn_w, scr, C.lane); continue; } r -= I_UQ;
        if (r < I_UKV) { const int kb = r / 64, nb = r % 64; p0_transpose_item(p.w_ukv, 256, 2048, kb * 64, nb * 32, (bf16_t*)(ws + WS_WUKV), nb * 32, p.kvn_w, scr, C.lane); continue; } r -= I_UKV;
        if (r < I_BA) { const int kb = r / 64, nb = r % 64; p0_transpose_item(p.w_ba, 1024, 2048, kb * 64, nb * 32, (bf16_t*)(ws + WS_WBA), nb * 32, nullptr, scr, C.lane); continue; } r -= I_BA;
        if (r < I_BB) { const int kb = r / 64, nb = r % 64; p0_transpose_item(p.w_bb, 1024, 2048, kb * 64, nb * 32, (bf16_t*)(ws + WS_WBB), nb * 32, nullptr, scr, C.lane); continue; } r -= I_BB;
        { const int kb = r / 64, nb = r % 64; p0_transpose_item(p.w_out, 2048, 2048, kb * 64, nb * 32, (bf16_t*)(ws + WS_WOUT), nb * 32, nullptr, scr, C.lane); }
    }
    { v4u* z = (v4u*)((bf16_t*)(ws + WS_C) + (size_t)9056 * 2048); const int n16 = 160 * 2048 * 2 / 16;
      for (int i = C.vcu * NT_ + C.tid; i < n16; i += C.G * NT_) z[i] = (v4u){0u, 0u, 0u, 0u}; }
}

__device__ __forceinline__ void mod_norm_rows(const Ctx& C, const float* X, int nrows, const float* nw, const float* sh, const float* sc, bf16_t* O) {
    f32x4 a[8], s[8];
#pragma unroll
    for (int j = 0; j < 8; ++j) { const int c = 4 * C.lane + 256 * j; const f32x4 w = *(const f32x4*)(nw + c), q = *(const f32x4*)(sc + c); a[j] = w * (q + 1.0f); s[j] = *(const f32x4*)(sh + c); }
    const int gw = C.vcu * 8 + C.wave, NGW = C.G * 8;
    for (int r = gw; r < nrows; r += NGW) {
        const f32x4* xr = (const f32x4*)(X + (size_t)r * DM) + C.lane; f32x4 v[8]; float ss = 0.f;
#pragma unroll
        for (int j = 0; j < 8; ++j) { v[j] = xr[64 * j]; ss += (v[j].x * v[j].x + v[j].y * v[j].y) + (v[j].z * v[j].z + v[j].w * v[j].w); }
        const float rstd = rsqrtf(wave_sum(ss) * (1.0f / DM) + EPS);
        v2u* o8 = (v2u*)(O + (size_t)r * DM) + C.lane;
#pragma unroll
        for (int j = 0; j < 8; ++j) { const f32x4 y = v[j] * rstd * a[j] + s[j]; v2u w; w.x = pk2(y.x, y.y); w.y = pk2(y.z, y.w); o8[64 * j] = w; }
    }
}
__device__ __forceinline__ void p3_conv(const Params& p, const Ctx& C) {
    const bf16_t* QKV = (const bf16_t*)(p.ws + WS_QKV); bf16_t* DNQ = (bf16_t*)(p.ws + WS_DNQ);
    const int total = (M1 / 16) * 384;
    for (int it = C.vcu * NT_ + C.tid; it < total; it += C.G * NT_) {
        const int rb = it / 384, c8 = it % 384, ch = c8 * 8, r0 = rb * 16;
        int seg0, segn, t0;
        if (r0 < ML) { seg0 = r0 & ~8191; segn = SEQ; t0 = r0 & 8191; } else { seg0 = ML + ((r0 - ML) & ~255); segn = CTXL; t0 = (r0 - ML) & 255; }
        f32x4 wlo[5], whi[5];
#pragma unroll
        for (int j = 0; j < 5; ++j) { wlo[j] = *(const f32x4*)(p.conv_w + j * 3072 + ch); whi[j] = *(const f32x4*)(p.conv_w + j * 3072 + ch + 4); }
        const float qs = (ch < 1024) ? 0.08838834764831845f : 1.0f; const bool nrm = ch < 2048;
        v4u win[5];
#pragma unroll
        for (int j = 0; j < 4; ++j) { const int tt = t0 + j - 2; win[j + 1] = (tt >= 0 && tt < segn) ? *(const v4u*)(QKV + (size_t)(seg0 + tt) * 3072 + ch) : (v4u){0u, 0u, 0u, 0u}; }
#pragma unroll
        for (int i = 0; i < 16; ++i) {
#pragma unroll
            for (int j = 0; j < 4; ++j) win[j] = win[j + 1];
            { const int tt = t0 + i + 2; win[4] = (tt < segn) ? *(const v4u*)(QKV + (size_t)(seg0 + tt) * 3072 + ch) : (v4u){0u, 0u, 0u, 0u}; }
            float acc[8];
#pragma unroll
            for (int e = 0; e < 8; ++e) acc[e] = 0.f;
#pragma unroll
            for (int j = 0; j < 5; ++j) { const v4u xv = win[j];
                acc[0] += bflo(xv.x) * wlo[j].x; acc[1] += bfhi(xv.x) * wlo[j].y; acc[2] += bflo(xv.y) * wlo[j].z; acc[3] += bfhi(xv.y) * wlo[j].w;
                acc[4] += bflo(xv.z) * whi[j].x; acc[5] += bfhi(xv.z) * whi[j].y; acc[6] += bflo(xv.w) * whi[j].z; acc[7] += bfhi(xv.w) * whi[j].w; }
            float ss = 0.f;
#pragma unroll
            for (int e = 0; e < 8; ++e) { acc[e] = siluf(acc[e]); ss += acc[e] * acc[e]; }
            ss += __shfl_xor(ss, 1); ss += __shfl_xor(ss, 2); ss += __shfl_xor(ss, 4); ss += __shfl_xor(ss, 8);
            const float sc = nrm ? rsqrtf(ss + EPS) * qs : 1.0f;
            v4u w; w.x = pk2(acc[0] * sc, acc[1] * sc); w.y = pk2(acc[2] * sc, acc[3] * sc); w.z = pk2(acc[4] * sc, acc[5] * sc); w.w = pk2(acc[6] * sc, acc[7] * sc);
            *(v4u*)(DNQ + (size_t)(r0 + i) * 3072 + ch) = w;
        }
    }
}
__device__ __forceinline__ void p3_krope_gbeta(const Params& p, const Ctx& C) {
    const float* KR = (const float*)(p.ws + WS_KR); bf16_t* K = (bf16_t*)(p.ws + WS_K);
    for (int it = C.vcu * NT_ + C.tid; it < M1 * 4; it += C.G * NT_) {
        const int r = it >> 2, q = it & 3, half = q >> 1, part = q & 1;
        int b, l, t; bool lat = r < ML;
        if (lat) { b = r >> 13; t = r & 8191; l = CTXL + t; } else { b = (r - ML) >> 8; t = 0; l = (r - ML) & 255; }
        const float* x1p = KR + (size_t)r * 64 + half * 32; const float* x2p = x1p + 16;
        float o[16];
        if (lat) { const float pos = (float)(half == 0 ? (t >> 6) : (t & 63));
#pragma unroll
            for (int i = 0; i < 16; ++i) { const float invf = exp2f(-(float)i * (13.287712379549449f / 16.0f)); float sn, cs; pg8::fast_sincos(pos * invf, sn, cs);
                const float x1 = x1p[i], x2 = x2p[i]; o[i] = part == 0 ? (x1 * cs - x2 * sn) : (x1 * sn + x2 * cs); } }
        else {
#pragma unroll
            for (int i = 0; i < 16; ++i) o[i] = part == 0 ? x1p[i] : x2p[i]; }
        v4u w0, w1; w0.x = pk2(o[0], o[1]); w0.y = pk2(o[2], o[3]); w0.z = pk2(o[4], o[5]); w0.w = pk2(o[6], o[7]);
        w1.x = pk2(o[8], o[9]); w1.y = pk2(o[10], o[11]); w1.z = pk2(o[12], o[13]); w1.w = pk2(o[14], o[15]);
#pragma unroll
        for (int h = 0; h < 8; ++h) { bf16_t* dst = K + ((size_t)(b * 8 + h) * LKV + l) * 192 + 128 + half * 32 + part * 16; *(v4u*)dst = w0; *(v4u*)(dst + 8) = w1; }
    }
    const float* AB = (const float*)(p.ws + WS_AB); float* Gd = (float*)(p.ws + WS_GBETA); float* Bd = Gd + (size_t)2 * M1 * 8;
    for (int it = C.vcu * NT_ + C.tid; it < M1 * 16; it += C.G * NT_) {
        const int r = it >> 4, dh = it & 15, dir = dh >> 3, h = dh & 7;
        const float a = AB[(size_t)r * 32 + dir * 8 + h] + p.dt_bias[dir * 8 + h], bl = AB[(size_t)r * 32 + 16 + dir * 8 + h];
        const float sp = (a > 20.f) ? a : log1pf(__expf(a));
        Gd[((size_t)dir * M1 + r) * 8 + h] = -__expf(p.a_log[dir * 8 + h]) * sp;
        Bd[((size_t)dir * M1 + r) * 8 + h] = 1.0f / (1.0f + __expf(-bl));
    }
}
typedef short s16x4c __attribute__((ext_vector_type(4)));
constexpr int CP_LD = 136;
constexpr int CP_K = 0, CP_Q = CP_K + 64 * CP_LD * 2, CP_V = CP_Q + 64 * CP_LD * 2, CP_VEC = CP_V + 64 * CP_LD * 2  , CP_MLO = CP_VEC + 640 * 4  ,
              CP_DG = CP_MLO + 2 * 64 * 72 * 2  , CP_DB = CP_DG + 2 * 4 * 16 * 17 * 4  , CP_ATS = CP_DB + 2 * 4 * 16 * 24 * 2  ,
              CP_XW = CP_ATS + 2 * 64 * 72 * 2  , CP_END = CP_XW + 8 * 16 * 72 * 2;
static_assert(CP_END <= 147456 - 64 && CP_MLO % 16 == 0 && CP_DB % 16 == 0 && CP_ATS % 16 == 0 && CP_XW % 16 == 0 && CP_DG % 16 == 0, "chunk-prep LDS");
__device__ __forceinline__ unsigned short bf1(float f) { return (unsigned short)(pk2(f, f) & 0xffffu); }
__device__ __forceinline__ void p5_chunk_prep(const Params& p, const Ctx& C) {
    const bf16_t* DNQ = (const bf16_t*)(p.ws + WS_DNQ); const float* Gd = (const float*)(p.ws + WS_GBETA); const float* Bd = Gd + (size_t)2 * M1 * 8;
    bf16_t* Wd = (bf16_t*)(p.ws + WS_W); bf16_t* Ud = (bf16_t*)(p.ws + WS_U); bf16_t* ATd = (bf16_t*)(p.ws + WS_ATT);
    float* EG = (float*)(p.ws + WS_EG); float* EKD = EG + (size_t)4224 * 64; float* EGL = EKD + (size_t)4224 * 64;
    LAS unsigned char* L = C.lds;
    LAS bf16_t* Ks = (LAS bf16_t*)(L + CP_K); LAS bf16_t* Qs = (LAS bf16_t*)(L + CP_Q); LAS bf16_t* Vs = (LAS bf16_t*)(L + CP_V);
    LAS float* Vec = (LAS float*)(L + CP_VEC); LAS bf16_t* MLO = (LAS bf16_t*)(L + CP_MLO); LAS float* DG = (LAS float*)(L + CP_DG); LAS bf16_t* DB = (LAS bf16_t*)(L + CP_DB);
    LAS bf16_t* ATS = (LAS bf16_t*)(L + CP_ATS); LAS bf16_t* XW = (LAS bf16_t*)(L + CP_XW) + C.wave * (16 * 72);
    const int tid = C.tid, lane = C.lane, wave = C.wave, l15 = lane & 15, lq = lane >> 4;
    for (int task = C.vcu; task < 16 * NCH; task += C.G) {
        const int bh = task / NCH, tc = task % NCH, b = bh >> 3, h = bh & 7;
        const int row0 = (tc < 4) ? (ML + b * CTXL + tc * 64) : (b * SEQ + (tc - 4) * 64);
        const size_t cidx0 = (size_t)(bh * 2 + 0) * NCH + tc, cidx1 = (size_t)(bh * 2 + 1) * NCH + (tc < 4 ? 3 - tc : 135 - tc);
        for (int e = tid; e < 3 * 1024; e += NT_) { const int which = e >> 10, id = e & 1023, i = id >> 4, chn = id & 15;
            const v4u v = *(const v4u*)(DNQ + (size_t)(row0 + i) * 3072 + which * 1024 + h * 128 + chn * 8);
            LAS bf16_t* dst = (which == 0 ? Qs : (which == 1 ? Ks : Vs)) + i * CP_LD + chn * 8; *(LAS v4u*)dst = v; }
        if (wave < 2) { const int dir = wave, pi = dir ? 63 - lane : lane;
            const float g = Gd[((size_t)dir * M1 + row0 + pi) * 8 + h], be = Bd[((size_t)dir * M1 + row0 + pi) * 8 + h];
            float v = g;
#pragma unroll
            for (int o = 1; o < 64; o <<= 1) { const float u = __shfl_up(v, o); if (lane >= o) v += u; }
            const float gl = __shfl(v, 63), eg = __expf(v);
            Vec[256 + dir * 64 + lane] = v; Vec[384 + dir * 128 + lane] = be; Vec[384 + dir * 128 + 64 + lane] = eg;
            const size_t cidx = dir ? cidx1 : cidx0;
            EG[cidx * 64 + lane] = eg; EKD[cidx * 64 + lane] = __expf(gl - v); if (lane == 0) EGL[cidx] = __expf(gl); }
        __syncthreads();
        {
#pragma unroll
            for (int q = 0; q < 4; ++q) { const int t16 = wave * 2 + (q & 1), tm = t16 >> 2, tn = t16 & 3; const bool isq = q >= 2;
                const LAS bf16_t* Ab = (isq ? Qs : Ks) + (tm * 16 + l15) * CP_LD + 8 * lq; const LAS bf16_t* Bb = Ks + (tn * 16 + l15) * CP_LD + 8 * lq;
                f32x4 acc = {0.f, 0.f, 0.f, 0.f};
#pragma unroll
                for (int kk = 0; kk < 4; ++kk) acc = __builtin_amdgcn_mfma_f32_16x16x32_bf16(*(const LAS bf16x8*)(Ab + kk * 32), *(const LAS bf16x8*)(Bb + kk * 32), acc, 0, 0, 0);
                const int j = tn * 16 + l15, jb = 63 - j; const float gfj = Vec[256 + j], gbj = Vec[320 + jb];
#pragma unroll
                for (int rg = 0; rg < 4; ++rg) { const int i = tm * 16 + 4 * lq + rg, ib = 63 - i; const float a = acc[rg];
                    const float df = __expf(Vec[256 + i] - gfj), db = __expf(Vec[320 + ib] - gbj);
                    if (isq) { ATS[i * 72 + j] = bf1(i >= j ? a * df : 0.f); ATS[64 * 72 + ib * 72 + jb] = bf1(i <= j ? a * db : 0.f); }
                    else if (i > j) { const float m = Vec[384 + i] * a * df;
                        if (tm == tn) DG[(tm * 16 + (i & 15)) * 17 + (j & 15)] = m; else MLO[i * 72 + j] = bf1(-m); }
                    else if (i < j) { const float m = Vec[384 + 128 + ib] * a * db;
                        if (tm == tn) DG[((4 + (3 - tm)) * 16 + (ib & 15)) * 17 + (jb & 15)] = m; else MLO[64 * 72 + ib * 72 + jb] = bf1(-m); }
                }
            }
        }
        __syncthreads();
        if (tid < 128) { const int blk = tid >> 4, cc = tid & 15; const LAS float* Mb = DG + blk * 16 * 17;
            float d[16];
#pragma unroll
            for (int r = 0; r < 16; ++r) { float v = (r == cc) ? 1.f : 0.f;
#pragma unroll
                for (int k = 0; k < r; ++k) v -= Mb[r * 17 + k] * d[k];
                d[r] = v; DB[(blk * 16 + r) * 24 + cc] = bf1(v); }
        } else { for (int e = tid - 128; e < 2 * 64 * 8; e += NT_ - 128) { const int dir = e >> 9, i = (e >> 3) & 63, chn = e & 7;
                *(v4u*)(ATd + (dir ? cidx1 : cidx0) * 4096 + i * 64 + chn * 8) = *(const LAS v4u*)(ATS + dir * (64 * 72) + i * 72 + chn * 8); } }
        __syncthreads();
        {
            const int dir = wave >> 2, wq = wave & 3; const bool isw = wq >= 2; const int cb0 = (wq & 1) * 64;
            const LAS bf16_t* src = (isw ? Ks : Vs) + cb0 + l15; const LAS float* bsc = Vec + 384 + dir * 128;
            const LAS bf16_t* Mo = MLO + dir * (64 * 72); const LAS bf16_t* Dd = DB + dir * (4 * 16 * 24);
            s16x4c aoff[6], adg[4];
            { int q = 0;
#pragma unroll
              for (int bb = 1; bb < 4; ++bb)
#pragma unroll
                  for (int j = 0; j < bb; ++j) { aoff[q] = *(const LAS s16x4c*)(Mo + (bb * 16 + l15) * 72 + j * 16 + 4 * lq); ++q; }
#pragma unroll
              for (int bb = 0; bb < 4; ++bb) adg[bb] = *(const LAS s16x4c*)(Dd + (bb * 16 + l15) * 24 + 4 * lq); }
            s16x4c xp[4][4];
            bf16_t* gdst = (isw ? Wd : Ud) + (dir ? cidx1 : cidx0) * 8192 + cb0;
#pragma unroll
            for (int bb = 0; bb < 4; ++bb) {
#pragma unroll
                for (int ct = 0; ct < 4; ++ct) {
                    f32x4 acc;
#pragma unroll
                    for (int rg = 0; rg < 4; ++rg) { const int i = bb * 16 + 4 * lq + rg, pi = dir ? 63 - i : i;
                        float v = __uint_as_float(((unsigned)src[pi * CP_LD + ct * 16]) << 16) * bsc[i]; if (isw) v *= bsc[64 + i]; acc[rg] = v; }
#pragma unroll
                    for (int j = 0; j < bb; ++j) acc = __builtin_amdgcn_mfma_f32_16x16x16bf16_1k(aoff[bb * (bb - 1) / 2 + j], xp[ct][j], acc, 0, 0, 0);
                    const unsigned a01 = pk2(acc[0], acc[1]), a23 = pk2(acc[2], acc[3]);
                    const s16x4c accb = {(short)(a01 & 0xffff), (short)(a01 >> 16), (short)(a23 & 0xffff), (short)(a23 >> 16)};
                    const f32x4 x = __builtin_amdgcn_mfma_f32_16x16x16bf16_1k(adg[bb], accb, (f32x4){0.f, 0.f, 0.f, 0.f}, 0, 0, 0);
                    const unsigned x01 = pk2(x[0], x[1]), x23 = pk2(x[2], x[3]);
                    xp[ct][bb] = (s16x4c){(short)(x01 & 0xffff), (short)(x01 >> 16), (short)(x23 & 0xffff), (short)(x23 >> 16)};
                    LAS bf16_t* xw = XW + (4 * lq) * 72 + ct * 16 + l15;
                    xw[0] = (bf16_t)(x01 & 0xffff); xw[72] = (bf16_t)(x01 >> 16); xw[144] = (bf16_t)(x23 & 0xffff); xw[216] = (bf16_t)(x23 >> 16);
                }
                asm volatile("s_waitcnt lgkmcnt(0)" ::: "memory");
#pragma unroll
                for (int e2 = 0; e2 < 2; ++e2) { const int pc = lane + 64 * e2, r = pc >> 3, chn = pc & 7;
                    *(v4u*)(gdst + (size_t)(bb * 16 + r) * 128 + chn * 8) = *(const LAS v4u*)(XW + r * 72 + chn * 8); }
                asm volatile("s_waitcnt lgkmcnt(0)" ::: "memory");
            }
        }
        __syncthreads();
    }
}
constexpr int SC_WLD = 136, SC_TLD = 72;
constexpr int SC_W = 0, SC_QG = SC_W + 64 * SC_WLD * 2, SC_KDT = SC_QG + 64 * SC_WLD * 2, SC_ATT = SC_KDT + 64 * SC_WLD * 2, SC_U = SC_ATT + 64 * SC_TLD * 2,
              SC_SBT = SC_U + 64 * 16 * 4, SC_VNT = SC_SBT + 16 * SC_WLD * 2, SC_END = SC_VNT + 16 * SC_TLD * 2;
static_assert(SC_END <= 131072 && SC_QG % 16 == 0 && SC_KDT % 16 == 0 && SC_ATT % 16 == 0 && SC_U % 16 == 0 && SC_SBT % 16 == 0 && SC_VNT % 16 == 0, "scan LDS");
typedef short s16x4_ __attribute__((ext_vector_type(4))); typedef short v4i16_ __attribute__((ext_vector_type(4)));
struct ScanRegs { v4u w0, w1, q0, q1, k0, k1, at, u; float eg0, eg1, ek0, ek1, egl; };
struct ScanPtrs { const bf16_t *DNQ, *Wd, *Ud, *ATd; const float *EG, *EKD, *EGL; };
__device__ __forceinline__ int scan_base(int s, int b, int dir) { return dir == 0 ? ((s < 4) ? (ML + b * CTXL + s * 64) : (b * SEQ + (s - 4) * 64)) : ((s < 4) ? (ML + b * CTXL + (3 - s) * 64) : (b * SEQ + (131 - s) * 64)); }
__device__ __forceinline__ void scan_load(ScanRegs& R, const ScanPtrs& P, int s, int bhd, int b, int h, int dir, int n0, int tid) {
    const size_t cidx = (size_t)bhd * NCH + s; const int base = scan_base(s, b, dir);
    { const int i = tid >> 4, chn = tid & 15, row = base + (dir ? 63 - i : i);
      R.w0 = *(const v4u*)(P.Wd + cidx * 8192 + i * 128 + chn * 8); R.q0 = *(const v4u*)(P.DNQ + (size_t)row * 3072 + h * 128 + chn * 8); R.k0 = *(const v4u*)(P.DNQ + (size_t)row * 3072 + 1024 + h * 128 + chn * 8);
      R.eg0 = P.EG[cidx * 64 + i]; R.ek0 = P.EKD[cidx * 64 + i]; }
    { const int i = 32 + (tid >> 4), chn = tid & 15, row = base + (dir ? 63 - i : i);
      R.w1 = *(const v4u*)(P.Wd + cidx * 8192 + i * 128 + chn * 8); R.q1 = *(const v4u*)(P.DNQ + (size_t)row * 3072 + h * 128 + chn * 8); R.k1 = *(const v4u*)(P.DNQ + (size_t)row * 3072 + 1024 + h * 128 + chn * 8);
      R.eg1 = P.EG[cidx * 64 + i]; R.ek1 = P.EKD[cidx * 64 + i]; }
    R.at = *(const v4u*)(P.ATd + cidx * 4096 + (tid >> 3) * 64 + (tid & 7) * 8);
    if (tid < 128) R.u = *(const v4u*)(P.Ud + cidx * 8192 + (tid >> 1) * 128 + n0 + (tid & 1) * 8);
    R.egl = P.EGL[cidx];
}
__device__ __forceinline__ v4u scale_bf8(v4u v, float s) { v4u o; o.x = pk2(bflo(v.x) * s, bfhi(v.x) * s); o.y = pk2(bflo(v.y) * s, bfhi(v.y) * s); o.z = pk2(bflo(v.z) * s, bfhi(v.z) * s); o.w = pk2(bflo(v.w) * s, bfhi(v.w) * s); return o; }
__device__ __forceinline__ void scan_store(const ScanRegs& R, LAS bf16_t* Ws, LAS bf16_t* QGs, LAS bf16_t* KDT, LAS bf16_t* ATs, LAS float* Us, int tid) {
    const int chn = tid & 15;
    { const int i = tid >> 4; *(LAS v4u*)(Ws + i * SC_WLD + chn * 8) = R.w0; *(LAS v4u*)(QGs + i * SC_WLD + chn * 8) = scale_bf8(R.q0, R.eg0); *(LAS v4u*)(KDT + i * SC_WLD + chn * 8) = scale_bf8(R.k0, R.ek0); }
    { const int i = 32 + (tid >> 4); *(LAS v4u*)(Ws + i * SC_WLD + chn * 8) = R.w1; *(LAS v4u*)(QGs + i * SC_WLD + chn * 8) = scale_bf8(R.q1, R.eg1); *(LAS v4u*)(KDT + i * SC_WLD + chn * 8) = scale_bf8(R.k1, R.ek1); }
    *(LAS v4u*)(ATs + (tid >> 3) * SC_TLD + (tid & 7) * 8) = R.at;
    if (tid < 128) { LAS float* ud = Us + (tid >> 1) * 16 + (tid & 1) * 8; *(LAS f32x4*)ud = (f32x4){bflo(R.u.x), bfhi(R.u.x), bflo(R.u.y), bfhi(R.u.y)}; *(LAS f32x4*)(ud + 4) = (f32x4){bflo(R.u.z), bfhi(R.u.z), bflo(R.u.w), bfhi(R.u.w)}; }
}
__device__ __forceinline__ void p6_scan(const Params& p, const Ctx& C) {
    ScanPtrs P; P.DNQ = (const bf16_t*)(p.ws + WS_DNQ); P.Wd = (const bf16_t*)(p.ws + WS_W); P.Ud = (const bf16_t*)(p.ws + WS_U); P.ATd = (const bf16_t*)(p.ws + WS_ATT);
    P.EG = (const float*)(p.ws + WS_EG); P.EKD = P.EG + (size_t)4224 * 64; P.EGL = P.EKD + (size_t)4224 * 64;
    LAS unsigned char* L = C.lds;
    LAS bf16_t* Ws = (LAS bf16_t*)(L + SC_W); LAS bf16_t* QGs = (LAS bf16_t*)(L + SC_QG); LAS bf16_t* KDT = (LAS bf16_t*)(L + SC_KDT); LAS bf16_t* ATs = (LAS bf16_t*)(L + SC_ATT);
    LAS float* Us = (LAS float*)(L + SC_U); LAS bf16_t* SBT = (LAS bf16_t*)(L + SC_SBT); LAS bf16_t* VNT = (LAS bf16_t*)(L + SC_VNT);
    const int tid = C.tid, lane = C.lane, wave = C.wave, l15 = lane & 15, lq = lane >> 4;
    for (int task = C.vcu; task < 256; task += C.G) {
        const int bhd = task >> 3, cb = task & 7, bh = bhd >> 1, dir = bhd & 1, b = bh >> 3, h = bh & 7, n0 = cb * 16;
        bf16_t* Od = (bf16_t*)(p.ws + (dir ? WS_OB : WS_OF));
        f32x4 S = {0.f, 0.f, 0.f, 0.f};
        for (int e = tid; e < 16 * SC_WLD / 2; e += NT_) ((LAS unsigned*)SBT)[e] = 0u;
        ScanRegs RA, RB;
        scan_load(RA, P, 0, bhd, b, h, dir, n0, tid); scan_load(RB, P, 1, bhd, b, h, dir, n0, tid);
#define SCAN_STEP(R, s_) do { const int s = (s_); const int base = scan_base(s, b, dir); \
            scan_store(R, Ws, QGs, KDT, ATs, Us, tid); const float egl = R.egl; \
            __syncthreads(); \
            if (s + 2 < NCH) scan_load(R, P, s + 2, bhd, b, h, dir, n0, tid);                   \
            const int mt = wave & 3; f32x4 acc = {0.f, 0.f, 0.f, 0.f}; \
            { const LAS bf16_t* Ab = ((wave < 4) ? Ws : QGs) + (mt * 16 + l15) * SC_WLD + 8 * lq; const LAS bf16_t* Bb = SBT + l15 * SC_WLD + 8 * lq; \
              _Pragma("unroll") for (int kk = 0; kk < 4; ++kk) acc = __builtin_amdgcn_mfma_f32_16x16x32_bf16(*(const LAS bf16x8*)(Ab + kk * 32), *(const LAS bf16x8*)(Bb + kk * 32), acc, 0, 0, 0); } \
            if (wave < 4) { const int i0 = mt * 16 + 4 * lq; \
                const float v0 = Us[(i0 + 0) * 16 + l15] - acc[0], v1 = Us[(i0 + 1) * 16 + l15] - acc[1], v2 = Us[(i0 + 2) * 16 + l15] - acc[2], v3 = Us[(i0 + 3) * 16 + l15] - acc[3]; \
                v2u w; w.x = pk2(v0, v1); w.y = pk2(v2, v3); *(LAS v2u*)(VNT + l15 * SC_TLD + i0) = w; } \
            __syncthreads(); \
            if (wave >= 4) { const LAS bf16_t* Ab = ATs + (mt * 16 + l15) * SC_TLD + 8 * lq; const LAS bf16_t* Bb = VNT + l15 * SC_TLD + 8 * lq; \
                _Pragma("unroll") for (int kk = 0; kk < 2; ++kk) acc = __builtin_amdgcn_mfma_f32_16x16x32_bf16(*(const LAS bf16x8*)(Ab + kk * 32), *(const LAS bf16x8*)(Bb + kk * 32), acc, 0, 0, 0); \
                if (s >= 4) { _Pragma("unroll") for (int rg = 0; rg < 4; ++rg) { const int i = mt * 16 + 4 * lq + rg; const int row = base + (dir ? 63 - i : i); \
                        Od[(size_t)row * 1024 + h * 128 + n0 + l15] = (bf16_t)f2bf(acc[rg]); } } } \
            { f32x4 sn = S * egl; const LAS bf16_t* Bb = VNT + l15 * SC_TLD + 8 * lq; \
                \
              const LAS bf16_t* Ta = KDT + (8 * lq + (l15 >> 2)) * SC_WLD + wave * 16 + 4 * (l15 & 3); \
              _Pragma("unroll") for (int kk = 0; kk < 2; ++kk) { \
                  const s16x4_ t0 = __builtin_bit_cast(s16x4_, __builtin_amdgcn_ds_read_tr16_b64_v4i16((LAS v4i16_*)(Ta + (kk * 32) * SC_WLD))); \
                  const s16x4_ t1 = __builtin_bit_cast(s16x4_, __builtin_amdgcn_ds_read_tr16_b64_v4i16((LAS v4i16_*)(Ta + (kk * 32 + 4) * SC_WLD))); \
                  const bf16x8 af = (bf16x8){t0[0], t0[1], t0[2], t0[3], t1[0], t1[1], t1[2], t1[3]}; \
                  sn = __builtin_amdgcn_mfma_f32_16x16x32_bf16(af, *(const LAS bf16x8*)(Bb + kk * 32), sn, 0, 0, 0); } \
              S = sn; } \
            __syncthreads(); \
            { v2u w; w.x = pk2(S[0], S[1]); w.y = pk2(S[2], S[3]); *(LAS v2u*)(SBT + l15 * SC_WLD + wave * 16 + 4 * lq) = w; } \
        } while (0)
        for (int s2 = 0; s2 < NCH; s2 += 2) { SCAN_STEP(RA, s2); SCAN_STEP(RB, s2 + 1); }
#undef SCAN_STEP
        __syncthreads();
    }
}
__device__ __forceinline__ void p7_yb(const Params& p, const Ctx& C) {
    const bf16_t* OF = (const bf16_t*)(p.ws + WS_OF); const bf16_t* OB = (const bf16_t*)(p.ws + WS_OB); const bf16_t* Z = (const bf16_t*)(p.ws + WS_Z); bf16_t* YB = (bf16_t*)(p.ws + WS_YB);
    const long total = (long)ML * 128;
    for (long it = (long)C.vcu * NT_ + C.tid; it < total; it += (long)C.G * NT_) {
        const size_t off = (size_t)it * 8; const int d0 = (int)(off & 127);
        const v4u a = *(const v4u*)(OF + off), bq = *(const v4u*)(OB + off), zz = *(const v4u*)(Z + off);
        float o[8] = {bflo(a.x) + bflo(bq.x), bfhi(a.x) + bfhi(bq.x), bflo(a.y) + bflo(bq.y), bfhi(a.y) + bfhi(bq.y), bflo(a.z) + bflo(bq.z), bfhi(a.z) + bfhi(bq.z), bflo(a.w) + bflo(bq.w), bfhi(a.w) + bfhi(bq.w)};
        float zf[8] = {bflo(zz.x), bfhi(zz.x), bflo(zz.y), bfhi(zz.y), bflo(zz.z), bfhi(zz.z), bflo(zz.w), bfhi(zz.w)};
        float ss = 0.f;
#pragma unroll
        for (int e = 0; e < 8; ++e) ss += o[e] * o[e];
        ss += __shfl_xor(ss, 1); ss += __shfl_xor(ss, 2); ss += __shfl_xor(ss, 4); ss += __shfl_xor(ss, 8);
        const float rstd = rsqrtf(ss * (1.0f / 128.0f) + EPS);
        const f32x4 w0 = *(const f32x4*)(p.dn_norm_w + d0), w1 = *(const f32x4*)(p.dn_norm_w + d0 + 4);
        float y[8];
#pragma unroll
        for (int e = 0; e < 8; ++e) y[e] = o[e] * rstd * (e < 4 ? w0[e] : w1[e - 4]) * siluf(zf[e]);
        v4u w; w.x = pk2(y[0], y[1]); w.y = pk2(y[2], y[3]); w.z = pk2(y[4], y[5]); w.w = pk2(y[6], y[7]);
        *(v4u*)(YB + off) = w;
    }
}
typedef float f32x2_t __attribute__((ext_vector_type(2)));
__device__ __forceinline__ float gelu_erf(float v) { return 0.5f * v * (1.0f + erff(v * 0.7071067811865476f)); }
__device__ __forceinline__ float dot8(v4u a, v4u b, float acc) {
    acc += bflo(a.x) * bflo(b.x); acc += bfhi(a.x) * bfhi(b.x); acc += bflo(a.y) * bflo(b.y); acc += bfhi(a.y) * bfhi(b.y);
    acc += bflo(a.z) * bflo(b.z); acc += bfhi(a.z) * bfhi(b.z); acc += bflo(a.w) * bflo(b.w); acc += bfhi(a.w) * bfhi(b.w); return acc;
}
__device__ __forceinline__ unsigned ord_u32(float f) { const unsigned u = __float_as_uint(f); return u ^ ((u >> 31) ? 0xffffffffu : 0x80000000u); }
#define INS16(k, x) do { unsigned x_ = (x); _Pragma("unroll") for (int i_ = 0; i_ < 16; ++i_) { const unsigned lo_ = min(k[i_], x_); k[i_] = max(k[i_], x_); x_ = lo_; } } while (0)
constexpr int P12_SC = 0, P12_TOPS = 128 * 129 * 4, P12_TOPI = P12_TOPS + 128 * 16 * 4, P12_IDX = P12_TOPI + 128 * 16 * 4  , P12_PW = P12_IDX + 64 * 128 * 2  , P12_END = P12_PW + 64 * 128 * 4;
static_assert(P12_END <= 147456 - 64 && P12_IDX % 16 == 0 && P12_PW % 16 == 0, "p12 lds");
__device__ __forceinline__ float octet_sum(float d) {
    d += __builtin_bit_cast(float, __builtin_amdgcn_update_dpp(0, __builtin_bit_cast(int, d), 0xB1, 0xF, 0xF, true));
    d += __builtin_bit_cast(float, __builtin_amdgcn_update_dpp(0, __builtin_bit_cast(int, d), 0x4E, 0xF, 0xF, true));
    d += __builtin_bit_cast(float, __builtin_amdgcn_update_dpp(0, __builtin_bit_cast(int, d), 0x141, 0xF, 0xF, true));
    return d;
}
__device__ __forceinline__ void p12_peer(const Params& p, const Ctx& C, const bool do_final) {
    const float* SCp = (const float*)(p.ws + WS_SC); const bf16_t* H2 = (const bf16_t*)(p.ws + WS_H2);
    const unsigned char* UB = (const unsigned char*)(p.ws + WS_UB); const unsigned char* VB = (const unsigned char*)(p.ws + WS_VB); const float* USC = (const float*)(p.ws + WS_USC); const float* VSC = (const float*)(p.ws + WS_VSC);
    const float* MOD = (const float*)(p.ws + CTL_MOD);
    LAS float* SCs = (LAS float*)(C.lds + P12_SC); LAS float* TOPS = (LAS float*)(C.lds + P12_TOPS); LAS int* TOPI = (LAS int*)(C.lds + P12_TOPI);
    LAS unsigned short* IDXs = (LAS unsigned short*)(C.lds + P12_IDX); LAS float* PWs = (LAS float*)(C.lds + P12_PW);
    const int lane = C.lane, tid = C.tid;
    for (int blk = C.vcu; blk < ML / 64; blk += C.G) {
        for (int sub = 0; sub < 8; ++sub) {
            { const float* src = SCp + ((size_t)blk * 64 + sub * 8) * 2048;
#pragma unroll 4
              for (int e4 = tid; e4 < 8 * 2048 / 4; e4 += NT_) { const f32x4 v = *(const f32x4*)(src + e4 * 4); const int L = e4 >> 5, k = (e4 & 31) * 4; LAS float* d = SCs + L * 129 + k; d[0] = v.x; d[1] = v.y; d[2] = v.z; d[3] = v.w; } }
            __syncthreads();
            if (tid < 256) {
                const int L = tid >> 1, hf = tid & 1; const LAS float* s = SCs + L * 129 + hf * 64;
                unsigned k[16];
#pragma unroll
                for (int i = 0; i < 16; ++i) k[i] = 0u;
#pragma unroll 8
                for (int j = 0; j < 64; ++j) { const unsigned key = (ord_u32(s[j]) & ~127u) | (unsigned)(127 - (hf * 64 + j)); INS16(k, key); }
#pragma unroll
                for (int i = 0; i < 16; ++i) { const unsigned o = __shfl_xor(k[i], 1); if (hf == 0) INS16(k, o); }
                if (hf == 0) {
#pragma unroll
                    for (int i = 0; i < 16; ++i) { const int ki = 127 - (int)(k[i] & 127u); TOPI[L * 16 + i] = ki; TOPS[L * 16 + i] = SCs[L * 129 + ki]; } }
            }
            __syncthreads();
            if (tid < 64) {
                const int tt = tid >> 3, h = tid & 7, L0 = tt * 16 + h * 2, L1 = L0 + 1;
                float s0[16], s1[16];
#pragma unroll
                for (int i = 0; i < 16; ++i) { s0[i] = TOPS[L0 * 16 + i]; s1[i] = TOPS[L1 * 16 + i]; }
                unsigned k[16];
#pragma unroll
                for (int i = 0; i < 16; ++i) k[i] = 0u;
#pragma unroll
                for (int a = 0; a < 16; ++a)
#pragma unroll
                    for (int b2 = 0; b2 < 16; ++b2) if ((a + 1) * (b2 + 1) <= 16) { const unsigned key = (ord_u32(s0[a] + s1[b2]) & ~255u) | (unsigned)(255 - (a * 16 + b2)); INS16(k, key); }
                float bs[16]; float mx = -3.0e38f; const int orow = (sub * 8 + tt) * 128 + h * 16;
#pragma unroll
                for (int i = 0; i < 16; ++i) { const int pos = 255 - (int)(k[i] & 255u), a = pos >> 4, b2 = pos & 15;
                    bs[i] = TOPS[L0 * 16 + a] + TOPS[L1 * 16 + b2]; mx = fmaxf(mx, bs[i]);
                    IDXs[orow + i] = (unsigned short)(TOPI[L0 * 16 + a] * 128 + TOPI[L1 * 16 + b2]); }
                float sm = 0.f;
#pragma unroll
                for (int i = 0; i < 16; ++i) { bs[i] = __expf(bs[i] - mx); sm += bs[i]; }
                const float inv = 1.0f / sm;
#pragma unroll
                for (int i = 0; i < 16; ++i) PWs[orow + i] = bs[i] * inv;
            }
            __syncthreads();
        }
        const int tl = C.wave * 8 + (lane >> 3), piece = lane & 7; const size_t t = (size_t)blk * 64 + tl;
        const LAS unsigned short* idxrow = IDXs + tl * 128; LAS float* pwrow = PWs + tl * 128;
        LAS float* actrow = (LAS float*)(C.lds + P12_SC) + tl * 128;
#pragma unroll
        for (int i = 0; i < 16; ++i) actrow[i * 8 + piece] = 0.f;
#define P12_LOAD(R, TAB, it_) do { const int itx = (it_); const v4u i8 = *(const LAS v4u*)(idxrow + (itx & 15) * 8); const unsigned off_ = (unsigned)((itx >> 4) * 128 + piece * 16); \
            _Pragma("unroll") for (int j = 0; j < 8; ++j) { const unsigned ex = (i8[j >> 1] >> (16 * (j & 1))) & 0xffffu; R[j] = *(const v4u*)(TAB + (ex * 2048u + off_)); } } while (0)
#define P12_HXLOAD(cb_) do { const bf16_t* hp = H2 + t * 2048 + (cb_) * 128 + piece * 16; hra = *(const v4u*)hp; hrb = *(const v4u*)(hp + 8); } while (0)
#define P12_BCOMP(R, it_) do { const int s8x = (it_) & 15; float mine = 0.f; \
            _Pragma("unroll") for (int j = 0; j < 8; ++j) { f32x2_t d2 = {0.f, 0.f}; \
                _Pragma("unroll") for (int w4 = 0; w4 < 4; ++w4) { const int wd = (int)R[j][w4]; const f32x2_t lo = __builtin_amdgcn_cvt_pk_f32_fp8(wd, false), hi2 = __builtin_amdgcn_cvt_pk_f32_fp8(wd, true); \
                    d2 += lo * hx2[2 * w4]; d2 += hi2 * hx2[2 * w4 + 1]; } \
                const float d = octet_sum(d2.x + d2.y); mine = (piece == j) ? d : mine; } \
            actrow[s8x * 8 + piece] += mine; } while (0)
        {
            v4u rA[8], rB[8], rC[8], rD[8], hra, hrb; f32x2_t hx2[8];
            P12_HXLOAD(0);
            P12_LOAD(rA, UB, 0); P12_LOAD(rB, UB, 1); P12_LOAD(rC, UB, 2); P12_LOAD(rD, UB, 3);
            for (int it = 0; it < 256; it += 4) {
                if ((it & 15) == 0) {
                    hx2[0] = (f32x2_t){bflo(hra.x), bfhi(hra.x)}; hx2[1] = (f32x2_t){bflo(hra.y), bfhi(hra.y)}; hx2[2] = (f32x2_t){bflo(hra.z), bfhi(hra.z)}; hx2[3] = (f32x2_t){bflo(hra.w), bfhi(hra.w)};
                    hx2[4] = (f32x2_t){bflo(hrb.x), bfhi(hrb.x)}; hx2[5] = (f32x2_t){bflo(hrb.y), bfhi(hrb.y)}; hx2[6] = (f32x2_t){bflo(hrb.z), bfhi(hrb.z)}; hx2[7] = (f32x2_t){bflo(hrb.w), bfhi(hrb.w)};
                    P12_HXLOAD(min((it >> 4) + 1, 15));
                }
                P12_BCOMP(rA, it);     P12_LOAD(rA, UB, min(it + 4, 255));
                P12_BCOMP(rB, it + 1); P12_LOAD(rB, UB, min(it + 5, 255));
                P12_BCOMP(rC, it + 2); P12_LOAD(rC, UB, min(it + 6, 255));
                P12_BCOMP(rD, it + 3); P12_LOAD(rD, UB, min(it + 7, 255));
            }
        }
#pragma unroll
        for (int s8 = 0; s8 < 16; ++s8) { const int sel = s8 * 8 + piece; const unsigned ex = idxrow[sel];
            pwrow[sel] = pwrow[sel] * gelu_erf(actrow[sel] * USC[ex]) * VSC[ex]; }
        asm volatile("s_waitcnt lgkmcnt(0)" ::: "memory");
        const int bsel = (int)(t >> 13); const float* g2 = MOD + bsel * 12288 + 10240;
        float* orow = p.out + t * 2048; float ssq = 0.f;
#define P12_CCOMP(R, it_) do { const int s8x = (it_) & 15; const f32x4 c0 = *(const LAS f32x4*)(pwrow + s8x * 8), c1 = *(const LAS f32x4*)(pwrow + s8x * 8 + 4); \
            _Pragma("unroll") for (int j = 0; j < 8; ++j) { const float c = (j < 4) ? c0[j & 3] : c1[j & 3]; const f32x2_t cc = {c, c}; \
                _Pragma("unroll") for (int w4 = 0; w4 < 4; ++w4) { const int wd = (int)R[j][w4]; const f32x2_t lo = __builtin_amdgcn_cvt_pk_f32_fp8(wd, false), hi2 = __builtin_amdgcn_cvt_pk_f32_fp8(wd, true); \
                    a2[2 * w4] += cc * lo; a2[2 * w4 + 1] += cc * hi2; } } } while (0)
        {
            v4u rA[8], rB[8], rC[8], rD[8]; f32x2_t a2[8];
            P12_LOAD(rA, VB, 0); P12_LOAD(rB, VB, 1); P12_LOAD(rC, VB, 2); P12_LOAD(rD, VB, 3);
            for (int it = 0; it < 256; it += 4) {
                if ((it & 15) == 0) {
#pragma unroll
                    for (int i = 0; i < 8; ++i) a2[i] = (f32x2_t){0.f, 0.f}; }
                P12_CCOMP(rA, it);     P12_LOAD(rA, VB, min(it + 4, 255));
                P12_CCOMP(rB, it + 1); P12_LOAD(rB, VB, min(it + 5, 255));
                P12_CCOMP(rC, it + 2); P12_LOAD(rC, VB, min(it + 6, 255));
                P12_CCOMP(rD, it + 3); P12_LOAD(rD, VB, min(it + 7, 255));
                if ((it & 15) == 12) {
                    if (do_final) {
                        const int c0i = (it >> 4) * 128 + piece * 16;
#pragma unroll
                        for (int q4 = 0; q4 < 4; ++q4) { const f32x4 xv = *(const f32x4*)(orow + c0i + 4 * q4), gv = *(const f32x4*)(g2 + c0i + 4 * q4);
                            f32x4 y; y[0] = xv[0] + gv[0] * a2[2 * q4].x; y[1] = xv[1] + gv[1] * a2[2 * q4].y; y[2] = xv[2] + gv[2] * a2[2 * q4 + 1].x; y[3] = xv[3] + gv[3] * a2[2 * q4 + 1].y;
                            ssq += (y[0] * y[0] + y[1] * y[1]) + (y[2] * y[2] + y[3] * y[3]);
                            *(f32x4*)(orow + c0i + 4 * q4) = y; }
                    } else { asm volatile("" :: "v"(a2[0]), "v"(a2[3]), "v"(a2[5]), "v"(a2[7])); }
                }
            }
        }
        if (do_final) {
            const float rstd = rsqrtf(octet_sum(ssq) * (1.0f / DM) + EPS);
            for (int cb = 0; cb < 16; ++cb) { const int c0i = cb * 128 + piece * 16;
#pragma unroll
                for (int q4 = 0; q4 < 4; ++q4) { const f32x4 y = *(const f32x4*)(orow + c0i + 4 * q4), fw = *(const f32x4*)(p.final_w + c0i + 4 * q4); *(f32x4*)(orow + c0i + 4 * q4) = y * rstd * fw; } }
        }
        __syncthreads();
    }
}
__device__ __forceinline__ void cvt_fp8_rows(const Ctx& C, const float* src, unsigned char* dst, float* scl, int nrows) {
    const int gw = C.vcu * 8 + C.wave, NGW = C.G * 8, lane = C.lane;
    for (int r = gw; r < nrows; r += NGW) {
        const float* sp = src + (size_t)r * 2048 + 16 * lane; f32x4 v[8]; float mx = 0.f;
#pragma unroll
        for (int j = 0; j < 2; ++j)
#pragma unroll
            for (int q = 0; q < 4; ++q) { v[j * 4 + q] = *(const f32x4*)(sp + 1024 * j + 4 * q); const f32x4 a = v[j * 4 + q]; mx = fmaxf(mx, fmaxf(fmaxf(fabsf(a.x), fabsf(a.y)), fmaxf(fabsf(a.z), fabsf(a.w)))); }
#pragma unroll
        for (int o = 1; o < 64; o <<= 1) mx = fmaxf(mx, __shfl_xor(mx, o));
        mx = fmaxf(mx, 1e-30f); const float inv = 440.0f / mx;
        if (lane == 0) scl[r] = mx * (1.0f / 440.0f);
#pragma unroll
        for (int j = 0; j < 2; ++j) { v4u w;
#pragma unroll
            for (int q = 0; q < 4; ++q) { const f32x4 a = v[j * 4 + q] * inv; int wd = 0; wd = __builtin_amdgcn_cvt_pk_fp8_f32(a.x, a.y, wd, false); wd = __builtin_amdgcn_cvt_pk_fp8_f32(a.z, a.w, wd, true); w[q] = (unsigned)wd; }
            *(v4u*)(dst + (size_t)r * 2048 + 1024 * j + 16 * lane) = w; }
    }
}
__device__ __forceinline__ void cvt_rows(const Ctx& C, const float* src, bf16_t* dst, long n8) {
    for (long i = (long)C.vcu * NT_ + C.tid; i < n8; i += (long)C.G * NT_) { const f32x4 a = *(const f32x4*)(src + i * 8), b = *(const f32x4*)(src + i * 8 + 4);
        v4u w; w.x = pk2(a.x, a.y); w.y = pk2(a.z, a.w); w.z = pk2(b.x, b.y); w.w = pk2(b.z, b.w); *(v4u*)(dst + i * 8) = w; }
}
#ifdef PROBE_ATTN_ALPHA
#define PROBE_MGA(ws) ((bf16_t*)((ws) + 60 * MiB))
#else
#define PROBE_MGA(ws) ((bf16_t*)nullptr)
#endif
constexpr int LDS_BYTES = 147456;
constexpr int N_PHASES = 13;
constexpr int LDS_MISC = LDS_BYTES - 64;
__global__ void __launch_bounds__(NT_, 2) mega_fwd(Params p_arg) {
    extern __shared__ __attribute__((aligned(16))) unsigned char lds_raw[];
    const int wave_s = __builtin_amdgcn_readfirstlane((int)threadIdx.x >> 6);
    const int G_s = gridDim.x, bx_s = blockIdx.x, vcu_s = (G_s % 8 == 0) ? (bx_s % 8) * (G_s / 8) + bx_s / 8 : bx_s;
#define MKCTX() Ctx C; { unsigned m_ = ~0u; asm volatile("" : "+s"(m_)); C.lane = (int)__builtin_amdgcn_mbcnt_hi(m_, __builtin_amdgcn_mbcnt_lo(m_, 0u)); } \
    C.lds = (LAS unsigned char*)lds_raw; C.wave = wave_s; C.tid = wave_s * 64 + C.lane; C.G = G_s; C.vcu = vcu_s
    const int lo = p_arg.ph_lo, hi = p_arg.ph_hi;
#if defined(__HIP_DEVICE_COMPILE__)
#define LOADP() MKCTX(); typedef const __attribute__((address_space(4))) Params* CPP_; CPP_ kp_ = (CPP_)__builtin_amdgcn_kernarg_segment_ptr(); asm volatile("" : "+s"(kp_)); const Params p = *kp_; \
    unsigned char* ws = p.ws; const float* MOD = (const float*)(ws + CTL_MOD); (void)MOD
#else
#define LOADP() MKCTX(); const Params p = p_arg; unsigned char* ws = p.ws; const float* MOD = (const float*)(ws + CTL_MOD); (void)MOD
#endif
#ifndef PH_MASK
#define PH_MASK 0xffff
#endif
#define IN(k) (((PH_MASK >> (k)) & 1) && lo <= (k) && (k) < hi)
#ifndef P3DUP
#define P3DUP 0
#endif
#ifndef PROBE_REP
#define PROBE_REP -1
#endif
#define NREP(k) ((PROBE_REP == (k)) ? 2 : 1)
#define BAR_() do { LOADP(); XcdBarrier b_; b_.bar = (unsigned*)(ws + CTL_BAR); b_.x = xb_xcc_id(); b_.st = (volatile LAS unsigned*)(C.lds + LDS_MISC); xcd_barrier(b_, C.tid); } while (0)
#define SEAM(k) do { if (IN(k) && IN((k) + 1)) { LOADP(); XcdBarrier b_; b_.bar = (unsigned*)(ws + CTL_BAR); b_.x = xb_xcc_id(); b_.st = (volatile LAS unsigned*)(C.lds + LDS_MISC); xcd_barrier(b_, C.tid); } } while (0)
    if (hi - lo > 1) { LOADP(); if (C.tid < 2) ((volatile LAS unsigned*)(C.lds + LDS_MISC))[C.tid] = 0u; __syncthreads();
        (void)xcd_barrier_post((unsigned*)(ws + CTL_BAR), (volatile LAS unsigned*)(C.lds + LDS_MISC), C.tid); }
    for (int rep_ = 0; rep_ < NREP(0); ++rep_) if (IN(0)) { if (rep_) BAR_(); LOADP(); p0_prologue(p, C); } SEAM(0);
    for (int rep_ = 0; rep_ < NREP(1); ++rep_) if (IN(1)) { if (rep_) BAR_(); LOADP();
        bf16_t* H = (bf16_t*)(ws + WS_D);
        mod_norm_rows(C, p.x, SEQ, p.norm1_w, MOD, MOD + 2048, H);
        mod_norm_rows(C, p.x + (size_t)SEQ * DM, SEQ, p.norm1_w, MOD + 12288, MOD + 12288 + 2048, H + (size_t)SEQ * DM);
        mod_norm_rows(C, p.ctx, MC, p.norm1_w, MOD + 2 * 12288, MOD + 2 * 12288 + 2048, H + (size_t)ML * DM);
    } SEAM(1);
    for (int rep_ = 0; rep_ < NREP(2); ++rep_) if (IN(2)) { if (rep_) BAR_(); LOADP();
        pg8::Gemm g{(const bf16_t*)(ws + WS_D), (const bf16_t*)(ws + WS_C), M1, NIN_PAD, DM}; pg8::StaticOrder S; S.init(M1, NIN_PAD, C.G, (int)blockIdx.x);
        pg8::EpiIn E{(bf16_t*)(ws + WS_CQ), (bf16_t*)(ws + WS_CKV), (bf16_t*)(ws + WS_QKV), (bf16_t*)(ws + WS_Z), (bf16_t*)(ws + WS_GA), (bf16_t*)(ws + WS_GB),
                     (float*)(ws + WS_KR), (float*)(ws + WS_AB), (float*)(ws + CTL_SSQQ), (float*)(ws + CTL_SSQKV)};
        pg8::gemm_phase<pg8::EpiIn, pg8::StaticOrder, true, true>(C.lds, g, S, E, C.tid);
    } SEAM(2);
    for (int rep_ = 0; rep_ < NREP(3); ++rep_) if (IN(3)) { if (rep_) BAR_();
        for (int d_ = 0; d_ < (P3DUP == 1 ? 2 : 1); ++d_) { LOADP(); pg8::Gemm g{(const bf16_t*)(ws + WS_CQ), (const bf16_t*)(ws + WS_WUQ), ML, 1536, 512}; pg8::StaticOrder S; S.init(ML, 1536, C.G, (int)blockIdx.x);
          pg8::EpiQ E{(bf16_t*)(ws + WS_D), (const float*)(ws + CTL_SSQQ), QSCALE};
          pg8::gemm_phase<pg8::EpiQ, pg8::StaticOrder, true, true>(C.lds, g, S, E, C.tid); }
        for (int d_ = 0; d_ < (P3DUP == 2 ? 2 : 1); ++d_) { LOADP(); pg8::Gemm g{(const bf16_t*)(ws + WS_CKV), (const bf16_t*)(ws + WS_WUKV), M1, 2048, 256}; pg8::StaticOrder S; S.init(M1, 2048, C.G, (int)blockIdx.x);
          pg8::EpiKV E{(bf16_t*)(ws + WS_K), (bf16_t*)(ws + WS_C), (const float*)(ws + CTL_SSQKV)};
          pg8::gemm_phase<pg8::EpiKV, pg8::StaticOrder, true, true>(C.lds, g, S, E, C.tid); }
        for (int d_ = 0; d_ < (P3DUP == 3 ? 2 : 1); ++d_) { LOADP(); p3_conv(p, C); }
        for (int d_ = 0; d_ < (P3DUP == 4 ? 2 : 1); ++d_) { LOADP(); p3_krope_gbeta(p, C); }
    } SEAM(3);
    for (int rep_ = 0; rep_ < NREP(4); ++rep_) if (IN(4)) { if (rep_) BAR_(); LOADP();
        const bf16_t* Q = (const bf16_t*)(ws + WS_D); const bf16_t* K = (const bf16_t*)(ws + WS_K); const bf16_t* V = (const bf16_t*)(ws + WS_C); bf16_t* YA = (bf16_t*)(ws + WS_YA);
        for (int u = C.vcu; u < 512; u += C.G) { const int bh = u >> 5, qb = u & 31, b = bh >> 3, h = bh & 7;
            attn::attn_unit(Q + ((size_t)bh * SEQ + qb * 256) * 192, K + (size_t)bh * LKV * 192, V + (size_t)bh * LKV * 128,
                            YA + ((size_t)b * SEQ + qb * 256) * 1024 + h * 128, 1024, LKV, (char*)lds_raw, C.tid); }
    } SEAM(4);
    for (int rep_ = 0; rep_ < NREP(5); ++rep_) if (IN(5)) { if (rep_) BAR_(); LOADP(); p5_chunk_prep(p, C); } SEAM(5);
    for (int rep_ = 0; rep_ < NREP(6); ++rep_) if (IN(6)) { if (rep_) BAR_(); LOADP(); p6_scan(p, C); } SEAM(6);
    for (int rep_ = 0; rep_ < NREP(7); ++rep_) if (IN(7)) { if (rep_) BAR_(); LOADP(); p7_yb(p, C); } SEAM(7);
    for (int rep_ = 0; rep_ < NREP(8); ++rep_) if (IN(8)) { if (rep_) BAR_();
        { LOADP(); pg8::Gemm g{(const bf16_t*)(ws + WS_YA), (const bf16_t*)(ws + WS_WBA), ML, 2048, 1024}; pg8::StaticOrder S; S.init(ML, 2048, C.G, (int)blockIdx.x);
          pg8::EpiMerge<true> E{(const bf16_t*)(ws + WS_GA), (bf16_t*)(ws + WS_MG), PROBE_MGA(ws)};
          pg8::gemm_phase<pg8::EpiMerge<true>, pg8::StaticOrder, true, true>(C.lds, g, S, E, C.tid); }
        { LOADP(); pg8::Gemm g{(const bf16_t*)(ws + WS_YB), (const bf16_t*)(ws + WS_WBB), ML, 2048, 1024}; pg8::StaticOrder S; S.init(ML, 2048, C.G, (int)blockIdx.x);
          pg8::EpiMerge<false> E{(const bf16_t*)(ws + WS_GB), (bf16_t*)(ws + WS_MG), nullptr};
          pg8::gemm_phase<pg8::EpiMerge<false>, pg8::StaticOrder, true, true>(C.lds, g, S, E, C.tid); }
    } SEAM(8);
    for (int rep_ = 0; rep_ < NREP(9); ++rep_) if (IN(9)) { if (rep_) BAR_(); LOADP();
        pg8::Gemm g{(const bf16_t*)(ws + WS_MG), (const bf16_t*)(ws + WS_WOUT), ML, 2048, 2048}; pg8::StaticOrder S; S.init(ML, 2048, C.G, (int)blockIdx.x);
        pg8::EpiOut E{p.x, MOD + 4096, p.out};
        pg8::gemm_phase<pg8::EpiOut, pg8::StaticOrder, true, true>(C.lds, g, S, E, C.tid);
    } SEAM(9);
#ifdef PROBE_ATTN_ALPHA
    if (IN(9)) { BAR_(); LOADP();
        pg8::Gemm g{(const bf16_t*)(ws + 60 * MiB), (const bf16_t*)(ws + WS_WOUT), ML, 2048, 2048}; pg8::StaticOrder S; S.init(ML, 2048, C.G, (int)blockIdx.x);
        pg8::EpiDelta E{MOD + 4096, (bf16_t*)(ws + 124 * MiB)};
        pg8::gemm_phase<pg8::EpiDelta, pg8::StaticOrder, true, true>(C.lds, g, S, E, C.tid);
    }
#endif
    for (int rep_ = 0; rep_ < NREP(10); ++rep_) if (IN(10)) { if (rep_) BAR_(); LOADP();
        bf16_t* H2 = (bf16_t*)(ws + WS_H2);
        mod_norm_rows(C, p.out, SEQ, p.norm2_w, MOD + 6144, MOD + 8192, H2);
        mod_norm_rows(C, p.out + (size_t)SEQ * DM, SEQ, p.norm2_w, MOD + 12288 + 6144, MOD + 12288 + 8192, H2 + (size_t)SEQ * DM);
        cvt_fp8_rows(C, p.peer_u, ws + WS_UB, (float*)(ws + WS_USC), 16384);
        cvt_fp8_rows(C, p.peer_v, ws + WS_VB, (float*)(ws + WS_VSC), 16384);
    } SEAM(10);
    for (int rep_ = 0; rep_ < NREP(11); ++rep_) if (IN(11)) { if (rep_) BAR_(); LOADP();
        pg8::Gemm g{(const bf16_t*)(ws + WS_H2), (const bf16_t*)(ws + WS_WPQ), ML, 2048, 2048}; pg8::StaticOrder S; S.init(ML, 2048, C.G, (int)blockIdx.x);
        pg8::EpiScore E{(float*)(ws + WS_SC)};
        pg8::gemm_phase<pg8::EpiScore, pg8::StaticOrder, true, true>(C.lds, g, S, E, C.tid);
    } SEAM(11);
    for (int rep_ = 0; rep_ < NREP(12); ++rep_) if (IN(12)) { if (rep_) BAR_(); LOADP(); p12_peer(p, C, rep_ == NREP(12) - 1); }
#undef IN
#undef SEAM
}

#ifndef MK_SINGLE
#define MK_SINGLE 1
#endif
extern "C" void kernel_launch(void* const* d_in, const int* in_sizes, int n_in, void* d_out, int out_size, void* d_ws, size_t ws_size, hipStream_t stream) {
    static int grid = 0;
    if (grid == 0) {
        if (n_in != 25 || out_size != ML * DM || ws_size < WS_END) { fprintf(stderr, "kernel_launch: unexpected shapes: n_in %d out %d ws %zu (need %zu)\n", n_in, out_size, ws_size, (size_t)WS_END); grid = -1; return; }
        int dev = 0, cus = 0, per_cu = 0;
        if (hipGetDevice(&dev) != hipSuccess || hipDeviceGetAttribute(&cus, hipDeviceAttributeMultiprocessorCount, dev) != hipSuccess) { grid = -1; return; }
        if (hipFuncSetAttribute((const void*)mega_fwd, hipFuncAttributeMaxDynamicSharedMemorySize, LDS_BYTES) != hipSuccess) { fprintf(stderr, "kernel_launch: hipFuncSetAttribute failed\n"); grid = -1; return; }
        if (hipOccupancyMaxActiveBlocksPerMultiprocessor(&per_cu, (const void*)mega_fwd, NT_, LDS_BYTES) != hipSuccess || per_cu < 1) { fprintf(stderr, "kernel_launch: occupancy query says %d\n", per_cu); per_cu = 1; }
        (void)hipGetLastError();
        grid = cus;
    }
    if (grid < 0) return;
    (void)hipMemsetAsync((char*)d_ws + WS_CTL, 0, CTL_BYTES, stream);
    Params p{};
    const float** pp = (const float**)&p;
    for (int i = 0; i < 25; ++i) pp[i] = (const float*)d_in[i];
    p.out = (float*)d_out; p.ws = (unsigned char*)d_ws;
#if MK_SINGLE
    p.ph_lo = 0; p.ph_hi = N_PHASES;
    hipLaunchKernelGGL(mega_fwd, dim3(grid), dim3(NT_), LDS_BYTES, stream, p);
#else
    for (int ph = 0; ph < N_PHASES; ++ph) { p.ph_lo = ph; p.ph_hi = ph + 1; hipLaunchKernelGGL(mega_fwd, dim3(grid), dim3(NT_), LDS_BYTES, stream, p); }
#endif
}
```

```cpp
#include <hip/hip_runtime.h>
#include <hip/hip_bf16.h>
#include <cstdio>
#include <cstdint>
#include <cmath>
namespace pg8 {
#define PG8_LAS __attribute__((address_space(3)))
typedef unsigned short bf16_t;
typedef short bf16x8 __attribute__((ext_vector_type(8)));
typedef float f32x4 __attribute__((ext_vector_type(4)));
typedef unsigned u32x4 __attribute__((ext_vector_type(4)));
constexpr int BM = 256, BK = 64, HALF = 128, HTB = HALF * BK * 2  , STAGE_BYTES = 8 * HTB, NXCD = 8, WGM = 8;

__host__ __device__ __forceinline__ int lds_byte(int r, int c) { const int st = (r >> 4) * 2 + (c >> 5), rr = r & 15, cc = c & 31, ob = rr * 64 + cc * 2; return st * 1024 + (ob ^ (((ob >> 9) & 1) << 5)); }
__host__ __device__ __forceinline__ void stage_rc(int b, int& R, int& C) { const int st = b / 1024, sb = b % 1024, swz = sb ^ (((sb >> 9) & 1) << 5); R = (st >> 1) * 16 + swz / 64; C = (st & 1) * 32 + (swz % 64) / 2; }
__host__ __device__ __forceinline__ int perm32(int rho) { const int n = rho >> 4, i = rho & 15; return 8 * (i >> 2) + 4 * n + (i & 3); }

struct Unit { int pm, pn; };
struct Gemm { const bf16_t* A; const bf16_t* Bt; int M, N, K; };

struct StaticOrder {
    int nM, nN, nwg, G, c;
    __host__ __device__ void init(int M, int N, int G_, int c_) { nM = M / BM; nN = N / BM; nwg = nM * nN; G = G_; c = c_; }
    __host__ __device__ bool next(int i, Unit& u) const {
        const long L = (long)i * G + c; if (L >= nwg) return false;
        int wgid = (int)L; { const int q = nwg / NXCD, r = nwg % NXCD, xcd = wgid % NXCD, off = wgid / NXCD; wgid = (xcd < r ? xcd * (q + 1) : r * (q + 1) + (xcd - r) * q) + off; }
        const int nig = WGM * nN, gid = wgid / nig, fm = gid * WGM, gsz = (nM - fm) < WGM ? (nM - fm) : WGM;
        u.pm = fm + ((wgid % nig) % gsz); u.pn = (wgid % nig) / gsz; return true;
    }
    __device__ __forceinline__ void a_ready(const Unit&) const {}
    __device__ __forceinline__ void done(const Unit&) const {}
};
typedef float f32x2 __attribute__((ext_vector_type(2)));
typedef __bf16 bf16x2_g __attribute__((ext_vector_type(2)));
__device__ __forceinline__ unsigned cvt_pk_bf16(float lo, float hi) { f32x2 v = {lo, hi}; bf16x2_g b = __builtin_convertvector(v, bf16x2_g); return __builtin_bit_cast(unsigned, b); }
template <class Epi, class Sched, bool ALIGN_EPI = false, bool SP2 = false>
__device__ __forceinline__ void gemm_phase(PG8_LAS unsigned char* lds, const Gemm g, const Sched& S, const Epi& E, const int tid) {
    const int wid = __builtin_amdgcn_readfirstlane(tid >> 6), lane = tid & 63, wr = wid >> 2, wc = wid & 3, fr = lane & 15, fq = lane >> 4;
    const int K = g.K, nt = K / BK;
    unsigned voffA[2], voffB[2];
#pragma unroll
    for (int i = 0; i < 2; ++i) { int R, C; stage_rc(tid * 16 + i * 8192, R, C); const int Rb = Epi::PERM ? ((R & ~31) + perm32(R & 31)) : R;
        voffA[i] = (unsigned)(R * K + C) * 2u; voffB[i] = (unsigned)(Rb * K + C) * 2u; }
    const size_t kstep = (size_t)(BK * 2);
    const size_t hstep = (size_t)HALF * K * 2;
    const size_t tstep = 2 * hstep;
    const unsigned ldsw = (unsigned)wid * 1024u;
    const int aoff = lds_byte(wr * 64 + fr, fq * 8), boff = lds_byte(wc * 32 + fr, fq * 8);
#define PG8_SA(b, h) (((b) * 2 + (h)) * HTB)
#define PG8_SB(b, h) ((4 + (b) * 2 + (h)) * HTB)
#define PG8_STAGE(bufoff, gbase, voff) do { _Pragma("unroll") for (int _i = 0; _i < 2; ++_i) \
        __builtin_amdgcn_global_load_lds((const unsigned*)((const char*)(gbase) + (voff)[_i]), (PG8_LAS unsigned*)(lds + (bufoff) + ldsw + _i * 8192), 16, 0, 0); } while (0)
#define PG8_LDA(dst, b, h) do { _Pragma("unroll") for (int m = 0; m < 4; ++m) _Pragma("unroll") for (int k = 0; k < 2; ++k) dst[m][k] = *(const PG8_LAS bf16x8*)(lds + PG8_SA(b, h) + aoff + m * 2048 + k * 1024); } while (0)
#define PG8_LDB(dst, b, h) do { _Pragma("unroll") for (int n = 0; n < 2; ++n) _Pragma("unroll") for (int k = 0; k < 2; ++k) dst[n][k] = *(const PG8_LAS bf16x8*)(lds + PG8_SB(b, h) + boff + n * 2048 + k * 1024); } while (0)
#define PG8_MMA(ai, bj, At, Bt) do { __builtin_amdgcn_s_setprio(1); _Pragma("unroll") for (int m = 0; m < 4; ++m) _Pragma("unroll") for (int n = 0; n < 2; ++n) _Pragma("unroll") for (int k = 0; k < 2; ++k) \
        acc[ai][bj][m][n] = __builtin_amdgcn_mfma_f32_16x16x32_bf16(Bt[n][k], At[m][k], acc[ai][bj][m][n], 0, 0, 0); __builtin_amdgcn_s_setprio(0); } while (0)
#define PG8_WAIT_V(n) asm volatile("s_waitcnt vmcnt(" #n ")" ::: "memory")
#define PG8_WAIT_L(n) asm volatile("s_waitcnt lgkmcnt(" #n ")" ::: "memory")
#define PG8_BAR __builtin_amdgcn_s_barrier()
#define PG8_SCHED __builtin_amdgcn_sched_barrier(0)
    Unit cur, nxt; int ui = 0;
    if (!S.next(0, cur)) return;
    f32x4 acc[2][2][4][2];
#pragma unroll
    for (int a = 0; a < 2; ++a)
#pragma unroll
        for (int b = 0; b < 2; ++b)
#pragma unroll
            for (int m = 0; m < 4; ++m)
#pragma unroll
                for (int n = 0; n < 2; ++n) acc[a][b][m][n] = (f32x4){0.f, 0.f, 0.f, 0.f};
    bf16x8 At[4][2], B0[2][2], B1[2][2];
    const char* cA = (const char*)g.A + (size_t)cur.pm * tstep; const char* cB = (const char*)g.Bt + (size_t)cur.pn * tstep;
    S.a_ready(cur);
    if constexpr (SP2) {
        PG8_STAGE(PG8_SB(0, 0), cB, voffB); PG8_STAGE(PG8_SB(0, 1), cB + hstep, voffB); PG8_STAGE(PG8_SA(0, 0), cA, voffA); PG8_STAGE(PG8_SA(0, 1), cA + hstep, voffA);
        if (wr == 1) PG8_BAR;
        PG8_WAIT_V(2); PG8_BAR;
        PG8_STAGE(PG8_SB(1, 0), cB + kstep, voffB); PG8_STAGE(PG8_SA(1, 0), cA + kstep, voffA); PG8_STAGE(PG8_SB(1, 1), cB + hstep + kstep, voffB);
        PG8_WAIT_V(6); PG8_BAR;
    } else {
        PG8_STAGE(PG8_SB(0, 0), cB, voffB); PG8_STAGE(PG8_SA(0, 0), cA, voffA); PG8_STAGE(PG8_SB(0, 1), cB + hstep, voffB); PG8_STAGE(PG8_SA(0, 1), cA + hstep, voffA);
        if (wr == 1) PG8_BAR;
        PG8_WAIT_V(4); PG8_BAR;
        PG8_STAGE(PG8_SB(1, 0), cB + kstep, voffB); PG8_STAGE(PG8_SA(1, 0), cA + kstep, voffA); PG8_STAGE(PG8_SB(1, 1), cB + hstep + kstep, voffB);
        PG8_WAIT_V(6); PG8_BAR;
    }
    for (;;) {
        const bool has_next = S.next(ui + 1, nxt);
        const char* nA = has_next ? (const char*)g.A + (size_t)nxt.pm * tstep : cA; const char* nB = has_next ? (const char*)g.Bt + (size_t)nxt.pn * tstep : cB;
        for (int t = 0; t < nt; t += 2) {
            const bool last = (t == nt - 2);
            const char* a1 = cA + (size_t)(t + 1) * kstep;
            const char* a2 = last ? nA : cA + (size_t)(t + 2) * kstep; const char* b2 = last ? nB : cB + (size_t)(t + 2) * kstep;
            const char* a3 = a2 + kstep; const char* b3 = b2 + kstep;
            if (last && has_next) S.a_ready(nxt);
            if constexpr (SP2) {
            PG8_LDB(B0, 0, 0); PG8_LDB(B1, 0, 1); PG8_SCHED; PG8_LDA(At, 0, 0); PG8_STAGE(PG8_SA(1, 1), a1 + hstep, voffA);
            PG8_WAIT_V(8); PG8_WAIT_L(0); PG8_BAR; PG8_MMA(0, 0, At, B0); PG8_MMA(0, 1, At, B1); PG8_BAR; PG8_SCHED;
            PG8_LDA(At, 0, 1); PG8_STAGE(PG8_SB(0, 0), b2, voffB); PG8_STAGE(PG8_SB(0, 1), b2 + hstep, voffB); PG8_STAGE(PG8_SA(0, 0), a2, voffA);
            PG8_WAIT_V(8); PG8_WAIT_L(0); PG8_BAR; PG8_MMA(1, 0, At, B0); PG8_MMA(1, 1, At, B1); PG8_BAR; PG8_SCHED;
            PG8_LDB(B0, 1, 0); PG8_LDB(B1, 1, 1); PG8_SCHED; PG8_LDA(At, 1, 0); PG8_STAGE(PG8_SA(0, 1), a2 + hstep, voffA);
            PG8_WAIT_V(8); PG8_WAIT_L(0); PG8_BAR; PG8_MMA(0, 0, At, B0); PG8_MMA(0, 1, At, B1); PG8_BAR; PG8_SCHED;
            PG8_LDA(At, 1, 1); PG8_STAGE(PG8_SB(1, 0), b3, voffB); PG8_STAGE(PG8_SB(1, 1), b3 + hstep, voffB); PG8_STAGE(PG8_SA(1, 0), a3, voffA);
            PG8_WAIT_V(8); PG8_WAIT_L(0); PG8_BAR; PG8_MMA(1, 0, At, B0); PG8_MMA(1, 1, At, B1); PG8_BAR; PG8_SCHED;
            } else {
            PG8_LDB(B0, 0, 0); PG8_SCHED; PG8_LDA(At, 0, 0); PG8_STAGE(PG8_SA(1, 1), a1 + hstep, voffA);
            PG8_WAIT_L(8); PG8_BAR; PG8_WAIT_L(0); PG8_MMA(0, 0, At, B0); PG8_BAR; PG8_SCHED;
            PG8_LDB(B1, 0, 1); PG8_STAGE(PG8_SB(0, 0), b2, voffB);
            PG8_BAR; PG8_WAIT_L(0); PG8_MMA(0, 1, At, B1); PG8_BAR;
            PG8_LDA(At, 0, 1); PG8_STAGE(PG8_SA(0, 0), a2, voffA);
            PG8_BAR; PG8_WAIT_L(0); PG8_MMA(1, 0, At, B0); PG8_BAR; PG8_SCHED;
            PG8_STAGE(PG8_SB(0, 1), b2 + hstep, voffB);
            PG8_WAIT_V(6); PG8_BAR; PG8_MMA(1, 1, At, B1); PG8_BAR;
            PG8_LDB(B0, 1, 0); PG8_SCHED; PG8_LDA(At, 1, 0); PG8_STAGE(PG8_SA(0, 1), a2 + hstep, voffA);
            PG8_WAIT_L(8); PG8_BAR; PG8_WAIT_L(0); PG8_MMA(0, 0, At, B0); PG8_BAR; PG8_SCHED;
            PG8_LDB(B1, 1, 1); PG8_STAGE(PG8_SB(1, 0), b3, voffB);
            PG8_BAR; PG8_WAIT_L(0); PG8_MMA(0, 1, At, B1); PG8_BAR;
            PG8_LDA(At, 1, 1); PG8_STAGE(PG8_SA(1, 0), a3, voffA);
            PG8_BAR; PG8_WAIT_L(0); PG8_MMA(1, 0, At, B0); PG8_BAR; PG8_SCHED;
            PG8_STAGE(PG8_SB(1, 1), b3 + hstep, voffB);
            PG8_WAIT_V(6); PG8_BAR; PG8_MMA(1, 1, At, B1); PG8_BAR;
            }
        }
        if constexpr (ALIGN_EPI) { if (wr == 0) PG8_BAR; }
        if constexpr (!Epi::AFTER_DRAIN) { E(acc, cur, wr, wc, fr, fq); S.done(cur); }
        if (!has_next) break;
#pragma unroll
        for (int a = 0; a < 2; ++a)
#pragma unroll
            for (int b = 0; b < 2; ++b)
#pragma unroll
                for (int m = 0; m < 4; ++m)
#pragma unroll
                    for (int n = 0; n < 2; ++n) acc[a][b][m][n] = (f32x4){0.f, 0.f, 0.f, 0.f};
        cur = nxt; cA = nA; cB = nB; ++ui;
        if constexpr (ALIGN_EPI) { if (wr == 1) PG8_BAR; }
    }
    PG8_WAIT_V(0);
    if constexpr (!ALIGN_EPI) { if (wr == 0) PG8_BAR; }
    PG8_BAR;
    if constexpr (Epi::AFTER_DRAIN) { E.fused(acc, cur, wr, wc, fr, fq, lds, wid, lane); S.done(cur); }
#undef PG8_SA
#undef PG8_SB
#undef PG8_STAGE
#undef PG8_LDA
#undef PG8_LDB
#undef PG8_MMA
#undef PG8_WAIT_V
#undef PG8_WAIT_L
#undef PG8_BAR
#undef PG8_SCHED
}
__device__ __forceinline__ float bfu(unsigned short v) { return __uint_as_float(((unsigned)v) << 16); }
__device__ __forceinline__ void fast_sincos(float x, float& sn, float& cs) {
    float rev = x * 0.15915494309189535f; rev -= rintf(rev); sn = __builtin_amdgcn_sinf(rev); cs = __builtin_amdgcn_cosf(rev); }
__device__ __forceinline__ float sigm(float v) { return 1.0f / (1.0f + __expf(-v)); }
__device__ __forceinline__ void store_tile_bf16(const f32x4 (&acc)[2][2][4][2], bf16_t* tile  , int ld, int wr, int wc, int fr, int fq) {
#pragma unroll
    for (int ai = 0; ai < 2; ++ai)
#pragma unroll
        for (int m = 0; m < 4; ++m) { bf16_t* rowp = tile + (size_t)(ai * HALF + wr * 64 + m * 16 + fr) * ld + wc * 32 + 8 * fq;
#pragma unroll
            for (int bj = 0; bj < 2; ++bj) { const f32x4 v0 = acc[ai][bj][m][0], v1 = acc[ai][bj][m][1];
                u32x4 w; w.x = cvt_pk_bf16(v0[0], v0[1]); w.y = cvt_pk_bf16(v0[2], v0[3]); w.z = cvt_pk_bf16(v1[0], v1[1]); w.w = cvt_pk_bf16(v1[2], v1[3]);
                *(u32x4*)(rowp + bj * HALF) = w; } }
}
__device__ __forceinline__ void tile_ssq(const f32x4 (&acc)[2][2][4][2], float* ssq  , int nslot, int slot, int wr, int fr, int fq) {
#pragma unroll
    for (int ai = 0; ai < 2; ++ai)
#pragma unroll
        for (int m = 0; m < 4; ++m) { float s = 0.f;
#pragma unroll
            for (int bj = 0; bj < 2; ++bj)
#pragma unroll
                for (int n = 0; n < 2; ++n) { const f32x4 x = acc[ai][bj][m][n]; s += (x[0] * x[0] + x[1] * x[1]) + (x[2] * x[2] + x[3] * x[3]); }
            s += __shfl_xor(s, 16); s += __shfl_xor(s, 32);
            if (fq == 0) ssq[(size_t)(ai * HALF + wr * 64 + m * 16 + fr) * nslot + slot] = s; }
}
struct EpiIn {
    static constexpr bool PERM = true, AFTER_DRAIN = false;
    bf16_t *CQ, *CKV, *QKV, *Z, *GA, *GB; float *KR, *AB, *ssq_q, *ssq_kv;
    __device__ __forceinline__ void operator()(const f32x4 (&acc)[2][2][4][2], const Unit& u, int wr, int wc, int fr, int fq) const {
        const int pn = u.pn, pm = u.pm; const size_t r0 = (size_t)pm * BM;
        const bool lat = pm < 64;
        if (pn == 35) {
            const int cl = wc * 32 + 8 * fq;
            if (cl < 96) {
#pragma unroll
                for (int ai = 0; ai < 2; ++ai)
#pragma unroll
                    for (int m = 0; m < 4; ++m) { const size_t r = r0 + ai * HALF + wr * 64 + m * 16 + fr;
                        float* dst = (cl < 64) ? (KR + r * 64 + cl) : (AB + r * 32 + (cl - 64));
                        *(f32x4*)dst = acc[ai][0][m][0]; *(f32x4*)(dst + 4) = acc[ai][0][m][1]; }
            }
            return;
        }
        bf16_t* base; int ld; bool latonly = true; float* ssq = nullptr; int nslot = 4, slot = wc;
        if (pn < 2) { base = CQ + pn * 256; ld = 512; ssq = ssq_q; nslot = 8; slot = pn * 4 + wc; }
        else if (pn == 2) { base = CKV; ld = 256; ssq = ssq_kv; latonly = false; }
        else if (pn < 15) { base = QKV + (pn - 3) * 256; ld = 3072; latonly = false; }
        else if (pn < 19) { base = Z + (pn - 15) * 256; ld = 1024; }
        else if (pn < 27) { base = GA + (pn - 19) * 256; ld = 2048; }
        else { base = GB + (pn - 27) * 256; ld = 2048; }
        if (latonly && !lat) return;
        store_tile_bf16(acc, base + r0 * ld, ld, wr, wc, fr, fq);
        if (ssq) tile_ssq(acc, ssq + r0 * nslot, nslot, slot, wr, fr, fq);
    }
};
struct EpiQ {
    static constexpr bool PERM = true, AFTER_DRAIN = false;
    bf16_t* Q; const float* ssq_q; float qscale;
    __device__ __forceinline__ void operator()(const f32x4 (&acc)[2][2][4][2], const Unit& u, int wr, int wc, int fr, int fq) const {
        const int pn = u.pn;
#pragma unroll
        for (int ai = 0; ai < 2; ++ai)
#pragma unroll
            for (int m = 0; m < 4; ++m) {
                const int r = u.pm * BM + ai * HALF + wr * 64 + m * 16 + fr; const int b = r >> 13, t = r & 8191;
                const f32x4 sa = *(const f32x4*)(ssq_q + (size_t)r * 8), sb = *(const f32x4*)(ssq_q + (size_t)r * 8 + 4);
                const float rs = rsqrtf((((sa[0] + sa[1]) + (sa[2] + sa[3])) + ((sb[0] + sb[1]) + (sb[2] + sb[3]))) * (1.0f / 512.0f) + 1e-6f) * qscale;
#pragma unroll
                for (int bj = 0; bj < 2; ++bj) {
                    f32x4 v0 = acc[ai][bj][m][0] * rs, v1 = acc[ai][bj][m][1] * rs;
                    bf16_t* dst;
                    if (pn < 4) { const int head = pn * 2 + bj; dst = Q + ((size_t)(b * 8 + head) * 8192 + t) * 192 + wc * 32 + 8 * fq; }
                    else {
                        const int head = (pn - 4) * 4 + bj * 2 + (wc >> 1), half = wc & 1;
                        const float pos = (float)(half == 0 ? (t >> 6) : (t & 63));
                        const int i0 = (8 * fq) & 15;
                        float xs[8] = {v0[0], v0[1], v0[2], v0[3], v1[0], v1[1], v1[2], v1[3]};
#pragma unroll
                        for (int e = 0; e < 8; ++e) {
                            const float other = __shfl_xor(xs[e], 32);
                            const float invf = exp2f(-(float)(i0 + e) * (13.287712379549449f / 16.0f));
                            float sn, cs; fast_sincos(pos * invf, sn, cs);
                            xs[e] = (fq < 2) ? (xs[e] * cs - other * sn) : (other * sn + xs[e] * cs);
                        }
                        v0 = (f32x4){xs[0], xs[1], xs[2], xs[3]}; v1 = (f32x4){xs[4], xs[5], xs[6], xs[7]};
                        dst = Q + ((size_t)(b * 8 + head) * 8192 + t) * 192 + 128 + half * 32 + 8 * fq;
                    }
                    u32x4 w; w.x = cvt_pk_bf16(v0[0], v0[1]); w.y = cvt_pk_bf16(v0[2], v0[3]); w.z = cvt_pk_bf16(v1[0], v1[1]); w.w = cvt_pk_bf16(v1[2], v1[3]);
                    *(u32x4*)dst = w;
                }
            }
    }
};
struct EpiKV {
    static constexpr bool PERM = true, AFTER_DRAIN = false;
    bf16_t *K, *V; const float* ssq_kv;
    __device__ __forceinline__ void operator()(const f32x4 (&acc)[2][2][4][2], const Unit& u, int wr, int wc, int fr, int fq) const {
        const int head = u.pn;
#pragma unroll
        for (int ai = 0; ai < 2; ++ai)
#pragma unroll
            for (int m = 0; m < 4; ++m) {
                const int r = u.pm * BM + ai * HALF + wr * 64 + m * 16 + fr;
                int b, l; if (r < 16384) { b = r >> 13; l = 256 + (r & 8191); } else { b = (r - 16384) >> 8; l = (r - 16384) & 255; }
                const f32x4 sa = *(const f32x4*)(ssq_kv + (size_t)r * 4);
                const float rs = rsqrtf(((sa[0] + sa[1]) + (sa[2] + sa[3])) * (1.0f / 256.0f) + 1e-6f);
                const size_t rowi = (size_t)(b * 8 + head) * 8448 + l;
#pragma unroll
                for (int bj = 0; bj < 2; ++bj) {
                    const f32x4 v0 = acc[ai][bj][m][0] * rs, v1 = acc[ai][bj][m][1] * rs;
                    bf16_t* dst = (bj == 0) ? (K + rowi * 192 + wc * 32 + 8 * fq) : (V + rowi * 128 + wc * 32 + 8 * fq);
                    u32x4 w; w.x = cvt_pk_bf16(v0[0], v0[1]); w.y = cvt_pk_bf16(v0[2], v0[3]); w.z = cvt_pk_bf16(v1[0], v1[1]); w.w = cvt_pk_bf16(v1[2], v1[3]);
                    *(u32x4*)dst = w;
                }
            }
    }
};
template <bool FIRST> struct EpiMerge {
    static constexpr bool PERM = true, AFTER_DRAIN = false;
    const bf16_t* G; bf16_t* MG; bf16_t* MGA;
    __device__ __forceinline__ void operator()(const f32x4 (&acc)[2][2][4][2], const Unit& u, int wr, int wc, int fr, int fq) const {
#pragma unroll
        for (int ai = 0; ai < 2; ++ai)
#pragma unroll
            for (int m = 0; m < 4; ++m) {
                const size_t off = (size_t)(u.pm * BM + ai * HALF + wr * 64 + m * 16 + fr) * 2048 + u.pn * BM + wc * 32 + 8 * fq;
#pragma unroll
                for (int bj = 0; bj < 2; ++bj) {
                    const u32x4 g = *(const u32x4*)(G + off + bj * HALF);
                    float gv[8] = {__uint_as_float(g.x << 16), __uint_as_float(g.x & 0xffff0000u), __uint_as_float(g.y << 16), __uint_as_float(g.y & 0xffff0000u),
                                   __uint_as_float(g.z << 16), __uint_as_float(g.z & 0xffff0000u), __uint_as_float(g.w << 16), __uint_as_float(g.w & 0xffff0000u)};
                    float o[8];
#pragma unroll
                    for (int e = 0; e < 8; ++e) o[e] = sigm(gv[e]) * acc[ai][bj][m][e >> 2][e & 3];
                    if (!FIRST) { const u32x4 p = *(const u32x4*)(MG + off + bj * HALF);
                        o[0] += __uint_as_float(p.x << 16); o[1] += __uint_as_float(p.x & 0xffff0000u); o[2] += __uint_as_float(p.y << 16); o[3] += __uint_as_float(p.y & 0xffff0000u);
                        o[4] += __uint_as_float(p.z << 16); o[5] += __uint_as_float(p.z & 0xffff0000u); o[6] += __uint_as_float(p.w << 16); o[7] += __uint_as_float(p.w & 0xffff0000u); }
                    u32x4 w; w.x = cvt_pk_bf16(o[0], o[1]); w.y = cvt_pk_bf16(o[2], o[3]); w.z = cvt_pk_bf16(o[4], o[5]); w.w = cvt_pk_bf16(o[6], o[7]);
                    *(u32x4*)(MG + off + bj * HALF) = w;
                    if (FIRST && MGA) *(u32x4*)(MGA + off + bj * HALF) = w;
                }
            }
    }
};
struct EpiOut {
    static constexpr bool PERM = false, AFTER_DRAIN = false;
    const float* X; const float* G1  ; float* X1;
    __device__ __forceinline__ void operator()(const f32x4 (&acc)[2][2][4][2], const Unit& u, int wr, int wc, int fr, int fq) const {
        const int b = u.pm >> 5;
        const int col0 = u.pn * BM + wc * 32 + 4 * fq;
#pragma unroll
        for (int bj = 0; bj < 2; ++bj)
#pragma unroll
            for (int n = 0; n < 2; ++n) { const int c = col0 + bj * HALF + n * 16; const f32x4 g = *(const f32x4*)(G1 + b * 12288 + c);
#pragma unroll
                for (int ai = 0; ai < 2; ++ai)
#pragma unroll
                    for (int m = 0; m < 4; ++m) { const size_t off = (size_t)(u.pm * BM + ai * HALF + wr * 64 + m * 16 + fr) * 2048 + c;
                        *(f32x4*)(X1 + off) = *(const f32x4*)(X + off) + g * acc[ai][bj][m][n]; } }
    }
};
struct EpiDelta {
    static constexpr bool PERM = true, AFTER_DRAIN = false;
    const float* G1; bf16_t* DA;
    __device__ __forceinline__ void operator()(const f32x4 (&acc)[2][2][4][2], const Unit& u, int wr, int wc, int fr, int fq) const {
        const int b = u.pm >> 5;
#pragma unroll
        for (int ai = 0; ai < 2; ++ai)
#pragma unroll
            for (int m = 0; m < 4; ++m) {
                const size_t off = (size_t)(u.pm * BM + ai * HALF + wr * 64 + m * 16 + fr) * 2048 + u.pn * BM + wc * 32 + 8 * fq;
#pragma unroll
                for (int bj = 0; bj < 2; ++bj) { const int c = u.pn * BM + wc * 32 + 8 * fq + bj * HALF;
                    const f32x4 g0 = *(const f32x4*)(G1 + b * 12288 + c), g1v = *(const f32x4*)(G1 + b * 12288 + c + 4);
                    const f32x4 v0 = acc[ai][bj][m][0] * g0, v1 = acc[ai][bj][m][1] * g1v;
                    u32x4 w; w.x = cvt_pk_bf16(v0[0], v0[1]); w.y = cvt_pk_bf16(v0[2], v0[3]); w.z = cvt_pk_bf16(v1[0], v1[1]); w.w = cvt_pk_bf16(v1[2], v1[3]);
                    *(u32x4*)(DA + off + bj * HALF) = w; }
            }
    }
};
struct EpiScore {
    static constexpr bool PERM = false, AFTER_DRAIN = false;
    float* SC;
    __device__ __forceinline__ void operator()(const f32x4 (&acc)[2][2][4][2], const Unit& u, int wr, int wc, int fr, int fq) const {
        const int col0 = u.pn * BM + wc * 32 + 4 * fq;
#pragma unroll
        for (int ai = 0; ai < 2; ++ai)
#pragma unroll
            for (int m = 0; m < 4; ++m) { const size_t off = (size_t)(u.pm * BM + ai * HALF + wr * 64 + m * 16 + fr) * 2048 + col0;
#pragma unroll
                for (int bj = 0; bj < 2; ++bj)
#pragma unroll
                    for (int n = 0; n < 2; ++n) *(f32x4*)(SC + off + bj * HALF + n * 16) = acc[ai][bj][m][n]; }
    }
};
}
namespace attn {
using bf16x8 = __attribute__((ext_vector_type(8))) short;
using s16x4  = __attribute__((ext_vector_type(4))) short;
using f32x16 = __attribute__((ext_vector_type(16))) float;
using u32x4  = __attribute__((ext_vector_type(4))) unsigned;
typedef unsigned short bf16_t;
constexpr int DQK = 192, DV = 128, NW = 8, QBLK = 32, KVBLK = 64;
constexpr int SHM_V = KVBLK * DV * 2  , SHM_K = KVBLK * DQK * 2  , SHM_QR = 2 * SHM_V + 2 * SHM_K + NW * 64 * 4, SHM_ATTN = SHM_QR + NW * 4096;
constexpr float THR = 8.0f;
#define KSWZ(row, colB) ((row) * 384 + ((colB) ^ (((row) & 7) << 4)))
#define SBAR() __builtin_amdgcn_sched_barrier(0)
__device__ __forceinline__ int crow(int r, int hi) { return (r & 3) + 8 * (r >> 2) + 4 * hi; }
__device__ __forceinline__ unsigned cvtpk(float lo, float hi) { unsigned r; asm volatile("v_cvt_pk_bf16_f32 %0, %1, %2" : "=v"(r) : "v"(lo), "v"(hi)); return r; }
__device__ __forceinline__ void partialSM(f32x16& p0, f32x16& p1, float& m_reg, float& mn, float& alpha) {
  float pmax = p0[0];
#pragma unroll
  for (int r = 1; r < 16; ++r) pmax = fmaxf(pmax, p0[r]);
#pragma unroll
  for (int r = 0; r < 16; ++r) pmax = fmaxf(pmax, p1[r]);
  { auto rr = __builtin_amdgcn_permlane32_swap(__float_as_uint(pmax), __float_as_uint(pmax), false, false);
    pmax = fmaxf(__uint_as_float(rr[0]), __uint_as_float(rr[1])); }
  if (__builtin_expect(__all(pmax - m_reg <= THR), 1)) { mn = m_reg; alpha = 1.f; }
  else { mn = fmaxf(m_reg, pmax); alpha = __builtin_amdgcn_exp2f(m_reg - mn); m_reg = mn; }
#pragma unroll
  for (int r = 0; r < 16; ++r) p0[r] = p0[r] - mn;
#pragma unroll
  for (int r = 0; r < 16; ++r) p1[r] = p1[r] - mn;
#pragma unroll
  for (int r = 0; r < 16; ++r) p0[r] = __builtin_amdgcn_exp2f(p0[r]);
}
__device__ __forceinline__ void finishSM(f32x16& p0, f32x16& p1, float alpha, float& l_reg, bf16x8& pa0, bf16x8& pa1, bf16x8& pa2, bf16x8& pa3) {
#pragma unroll
  for (int r = 0; r < 16; ++r) p1[r] = __builtin_amdgcn_exp2f(p1[r]);
  float ps = 0;
#pragma unroll
  for (int r = 0; r < 16; ++r) ps += p0[r];
#pragma unroll
  for (int r = 0; r < 16; ++r) ps += p1[r];
  { auto rr = __builtin_amdgcn_permlane32_swap(__float_as_uint(ps), __float_as_uint(ps), false, false);
    ps = __uint_as_float(rr[0]) + __uint_as_float(rr[1]); }
  l_reg = l_reg * alpha + ps;
#define PK4(P, BASE, OUT) do { unsigned a0 = cvtpk(P[BASE + 0], P[BASE + 1]), a1 = cvtpk(P[BASE + 2], P[BASE + 3]);   \
    unsigned b0 = cvtpk(P[BASE + 4], P[BASE + 5]), b1 = cvtpk(P[BASE + 6], P[BASE + 7]);                              \
    auto r0 = __builtin_amdgcn_permlane32_swap(a0, b0, false, false); auto r1 = __builtin_amdgcn_permlane32_swap(a1, b1, false, false); \
    u32x4 w = {r0[0], r1[0], r0[1], r1[1]}; OUT = *reinterpret_cast<bf16x8*>(&w); } while (0)
  PK4(p0, 0, pa0); PK4(p0, 8, pa1); PK4(p1, 0, pa2); PK4(p1, 8, pa3);
#undef PK4
}
__device__ __forceinline__ void qkt(f32x16& p0, f32x16& p1, const char* Ks, const bf16x8* qr, const char* qrow, int qx, int r32, int hi) {
  p0 = f32x16{}; p1 = f32x16{};
#pragma unroll
  for (int d0 = 0; d0 < 12; ++d0) { const int cb = (d0 * 16 + hi * 8) * 2;
    bf16x8 b0 = *reinterpret_cast<const bf16x8*>(Ks + KSWZ(r32, cb));
    bf16x8 b1 = *reinterpret_cast<const bf16x8*>(Ks + KSWZ(32 + r32, cb));
    const bf16x8 q = (d0 < 8) ? qr[d0 < 8 ? d0 : 0] : *reinterpret_cast<const bf16x8*>(qrow + (qx ^ ((d0 - 8) << 5)));
    p0 = __builtin_amdgcn_mfma_f32_32x32x16_bf16(b0, q, p0, 0, 0, 0);
    p1 = __builtin_amdgcn_mfma_f32_32x32x16_bf16(b1, q, p1, 0, 0, 0); }
}
__device__ __forceinline__ int v_st(int k, int c) { const int kk = (k & ~0xC) | ((k & 4) << 1) | ((k & 8) >> 1); return ((kk >> 3) * 4 + (c >> 5)) * 512 + ((kk & 7) * 32 + (c & 31)) * 2; }
__device__ __forceinline__ int v_rd_base(int lane) { return ((lane & 3) << 3) | (((lane >> 2) & 3) << 6) | (((lane >> 4) & 1) << 5) | (((lane >> 5) & 1) << 8); }
constexpr int v_rd_off(int d0, int ks, int half) { return d0 * 512 + ks * 4096 + half * 2048; }
template <int OFF> __device__ __forceinline__ s16x4 tr_read(int vb) {
  s16x4 r; asm volatile("ds_read_b64_tr_b16 %0, %1 offset:%2" : "=&v"(r) : "v"(vb), "i"(OFF) : "memory"); return r;
}
template <int D0> __device__ __forceinline__ void pv_one(f32x16& od, int vb, bf16x8 pa0, bf16x8 pa1, bf16x8 pa2, bf16x8 pa3) {
  const s16x4 l0 = tr_read<v_rd_off(D0, 0, 0)>(vb), h0 = tr_read<v_rd_off(D0, 0, 1)>(vb), l1 = tr_read<v_rd_off(D0, 1, 0)>(vb), h1 = tr_read<v_rd_off(D0, 1, 1)>(vb);
  const s16x4 l2 = tr_read<v_rd_off(D0, 2, 0)>(vb), h2 = tr_read<v_rd_off(D0, 2, 1)>(vb), l3 = tr_read<v_rd_off(D0, 3, 0)>(vb), h3 = tr_read<v_rd_off(D0, 3, 1)>(vb);
  asm volatile("s_waitcnt lgkmcnt(0)" ::: "memory"); SBAR();
#define PK(L, H) (bf16x8){L[0], L[1], L[2], L[3], H[0], H[1], H[2], H[3]}
  od = __builtin_amdgcn_mfma_f32_32x32x16_bf16(pa0, PK(l0, h0), od, 0, 0, 0);
  od = __builtin_amdgcn_mfma_f32_32x32x16_bf16(pa1, PK(l1, h1), od, 0, 0, 0);
  od = __builtin_amdgcn_mfma_f32_32x32x16_bf16(pa2, PK(l2, h2), od, 0, 0, 0);
  od = __builtin_amdgcn_mfma_f32_32x32x16_bf16(pa3, PK(l3, h3), od, 0, 0, 0);
#undef PK
}
__device__ __forceinline__ void pv_d0(f32x16* o, int vb, bf16x8 pa0, bf16x8 pa1, bf16x8 pa2, bf16x8 pa3) {
  pv_one<0>(o[0], vb, pa0, pa1, pa2, pa3); pv_one<1>(o[1], vb, pa0, pa1, pa2, pa3); pv_one<2>(o[2], vb, pa0, pa1, pa2, pa3); pv_one<3>(o[3], vb, pa0, pa1, pa2, pa3);
}
__device__ __forceinline__ void attn_unit(const bf16_t* __restrict__ Qb, const bf16_t* __restrict__ Kh, const bf16_t* __restrict__ Vh, bf16_t* __restrict__ Ob, int ldo, int seq, char* lds, int tid_in) {
  int tid_ = tid_in; asm volatile("" : "+v"(tid_));
  const int tid = tid_, wid = tid >> 6, lane = tid & 63, r32 = lane & 31, hi = lane >> 5;
  char* V_lds = lds; char* K_lds = lds + 2 * SHM_V;
  float* ws = (float*)(lds + 2 * SHM_V + 2 * SHM_K) + wid * 64; float* li_l = ws; float* al_l = ws + 32;
  float m_reg = -1e30f, l_reg = 0; f32x16 o[4] = {}; bf16x8 qr[8];
  const bf16_t* Qw = Qb + (long)(wid * QBLK + r32) * DQK + hi * 8;
#pragma unroll
  for (int d0 = 0; d0 < 8; ++d0) qr[d0] = *reinterpret_cast<const bf16x8*>(Qw + d0 * 16);
  char* qrow = lds + SHM_QR + wid * 4096 + r32 * 128; const int qx = (hi ^ (r32 & 7)) << 4;
#pragma unroll
  for (int d0 = 8; d0 < 12; ++d0) *reinterpret_cast<bf16x8*>(qrow + (qx ^ ((d0 - 8) << 5))) = *reinterpret_cast<const bf16x8*>(Qw + d0 * 16);
  const int sr = tid >> 4, sc = (tid & 15) * 8, vst0 = v_st(sr, sc), vst1 = v_st(32 + sr, sc);
  unsigned kgo[3], klo[3];
#pragma unroll
  for (int i = 0; i < 3; ++i) { const int id = tid + 512 * i, kr_ = id / 24, kc_ = (id % 24) * 16; kgo[i] = (unsigned)(kr_ * 384 + kc_); klo[i] = (unsigned)KSWZ(kr_, kc_); }
  const unsigned vgo0 = (unsigned)((sr * DV + sc) * 2), vgo1 = (unsigned)(((32 + sr) * DV + sc) * 2);
  const int vb0 = (int)(uintptr_t)V_lds + v_rd_base(lane);
  bf16x8 vs0, vs1, ks0, ks1, ks2;
#define SLOAD(k0) do { const char* Kt_ = (const char*)Kh + (size_t)(k0) * (DQK * 2); const char* Vt_ = (const char*)Vh + (size_t)(k0) * (DV * 2); \
    vs0 = *reinterpret_cast<const bf16x8*>(Vt_ + vgo0); vs1 = *reinterpret_cast<const bf16x8*>(Vt_ + vgo1); \
    ks0 = *reinterpret_cast<const bf16x8*>(Kt_ + kgo[0]); ks1 = *reinterpret_cast<const bf16x8*>(Kt_ + kgo[1]); ks2 = *reinterpret_cast<const bf16x8*>(Kt_ + kgo[2]); } while (0)
#define SWRITE(b) do { *(bf16x8*)(V_lds + (b) * SHM_V + vst0) = vs0; *(bf16x8*)(V_lds + (b) * SHM_V + vst1) = vs1; \
    *(bf16x8*)(K_lds + (b) * SHM_K + klo[0]) = ks0; *(bf16x8*)(K_lds + (b) * SHM_K + klo[1]) = ks1; *(bf16x8*)(K_lds + (b) * SHM_K + klo[2]) = ks2; } while (0)
#define RESC(a) do { if (__any((a) < 1.f)) { if (hi == 0) al_l[r32] = (a); asm volatile("s_waitcnt lgkmcnt(0)" ::: "memory"); \
    _Pragma("unroll") for (int d = 0; d < 4; ++d) _Pragma("unroll") for (int r = 0; r < 16; ++r) o[d][r] *= al_l[crow(r, hi)]; } } while (0)
  f32x16 pA0, pA1, pB0, pB1; float mnA, mnB, alA, alB; bf16x8 pa0, pa1, pa2, pa3; const int NT = seq / KVBLK;
  SLOAD(0); SWRITE(0); __syncthreads();
  qkt(pA0, pA1, K_lds, qr, qrow, qx, r32, hi); partialSM(pA0, pA1, m_reg, mnA, alA);
  SLOAD(KVBLK);
  SWRITE(1); __syncthreads();
  for (int j = 1; j + 1 < NT; j += 2) {
    SBAR(); qkt(pB0, pB1, K_lds + SHM_K, qr, qrow, qx, r32, hi);
    finishSM(pA0, pA1, alA, l_reg, pa0, pa1, pa2, pa3); SBAR();
    SLOAD((j + 1) * KVBLK); SBAR();
    pv_d0(o, vb0, pa0, pa1, pa2, pa3); partialSM(pB0, pB1, m_reg, mnB, alB);
    __syncthreads(); SWRITE(0);
    RESC(alB); __syncthreads();
    SBAR(); qkt(pA0, pA1, K_lds, qr, qrow, qx, r32, hi);
    finishSM(pB0, pB1, alB, l_reg, pa0, pa1, pa2, pa3); SBAR();
    SLOAD((j + 2) * KVBLK); SBAR();
    pv_d0(o, vb0 + SHM_V, pa0, pa1, pa2, pa3); partialSM(pA0, pA1, m_reg, mnA, alA);
    __syncthreads(); SWRITE(1);
    RESC(alA); __syncthreads();
  }
  SBAR(); qkt(pB0, pB1, K_lds + SHM_K, qr, qrow, qx, r32, hi);
  finishSM(pA0, pA1, alA, l_reg, pa0, pa1, pa2, pa3); SBAR();
  pv_d0(o, vb0, pa0, pa1, pa2, pa3); partialSM(pB0, pB1, m_reg, mnB, alB);
  __syncthreads(); RESC(alB);
  finishSM(pB0, pB1, alB, l_reg, pa0, pa1, pa2, pa3); SBAR();
  pv_d0(o, vb0 + SHM_V, pa0, pa1, pa2, pa3);
  if (hi == 0) li_l[r32] = l_reg; asm volatile("s_waitcnt lgkmcnt(0)" ::: "memory");
  float rli[16];
#pragma unroll
  for (int r = 0; r < 16; ++r) rli[r] = __builtin_amdgcn_rcpf(li_l[crow(r, hi)]);
  { int t2 = tid_in; asm volatile("" : "+v"(t2));
    const int w2 = t2 >> 6, l2 = t2 & 63, c2 = l2 & 31, h2 = l2 >> 5;
    bf16_t* Ow = Ob + (unsigned)((w2 * QBLK + 4 * h2) * ldo + c2);
#pragma unroll
    for (int r = 0; r < 16; ++r) { const unsigned ro = (unsigned)(((r & 3) + 8 * (r >> 2)) * ldo);
#pragma unroll
      for (int d0 = 0; d0 < 4; ++d0) { const float v = o[d0][r] * rli[r]; Ow[ro + d0 * 32] = (bf16_t)(cvtpk(v, v) & 0xffffu); } } }
  __syncthreads();
#undef SLOAD
#undef SWRITE
#undef RESC
}
#undef KSWZ
#undef SBAR
}
#define GAS __attribute__((address_space(1)))
#define LAS __attribute__((address_space(3)))
typedef unsigned short bf16_t;
typedef unsigned v4u __attribute__((ext_vector_type(4)));
typedef unsigned v2u __attribute__((ext_vector_type(2)));
typedef float f32x4 __attribute__((ext_vector_type(4)));
typedef short bf16x8 __attribute__((ext_vector_type(8)));
constexpr int NT_ = 512;
constexpr int BATCH = 2, SEQ = 8192, DM = 2048, CTXL = 256;
constexpr int ML = BATCH * SEQ  , MC = BATCH * CTXL  , M1 = ML + MC  ;
constexpr int NIN_PAD = 9216;
constexpr int LKV = CTXL + SEQ;
constexpr int NCH = 132;
constexpr float EPS = 1e-6f;
constexpr float QSCALE = 0.07216878364870322f * 1.4426950408889634f;
constexpr size_t MiB = 1u << 20;
constexpr size_t WS_CTL = 0, CTL_BYTES = 1 * MiB;
constexpr size_t CTL_BAR = 4096;
static_assert(CTL_BAR + 3456 * 4 <= CTL_BYTES, "ctl");
constexpr size_t WS_WUQ = 1 * MiB, WS_WUKV = WS_WUQ + 1536 * 512 * 2, WS_WBA = WS_WUKV + 2048 * 256 * 2, WS_WBB = WS_WBA + 4 * MiB, WS_WOUT = WS_WBB + 4 * MiB, WS_WPQ = WS_WOUT + 8 * MiB;
static_assert(WS_WPQ + 8 * MiB <= 28 * MiB, "small weights");
constexpr size_t WS_C = 28 * MiB;
constexpr size_t WS_D = 66 * MiB;
constexpr size_t WS_E1 = 132 * MiB;
constexpr size_t WS_CQ = WS_E1, WS_CKV = WS_CQ + 16 * MiB, WS_KR = WS_CKV + (size_t)M1 * 256 * 2, WS_AB = WS_KR + (size_t)M1 * 64 * 4;
static_assert(WS_AB + (size_t)M1 * 32 * 4 <= 164 * MiB, "E1");
constexpr size_t WS_Z = 164 * MiB, WS_GA = 196 * MiB, WS_GB = 260 * MiB;
constexpr size_t WS_QKV = 324 * MiB;
constexpr size_t WS_K = 423 * MiB;
constexpr size_t WS_DNQ = 473 * MiB;
constexpr size_t WS_GBETA = 572 * MiB;
constexpr size_t WS_EG = 575 * MiB;
constexpr size_t CTL_MOD = 27 * MiB + 512 * 1024;
constexpr size_t CTL_SSQQ = 575 * MiB, CTL_SSQKV = CTL_SSQQ + (size_t)16384 * 8 * 4;
static_assert(CTL_SSQKV + (size_t)16896 * 4 * 4 <= 577 * MiB && CTL_MOD + 3 * 12288 * 4 <= 28 * MiB && WS_WPQ + 8 * MiB <= CTL_MOD, "mod/ssq");
constexpr size_t WS_W = WS_QKV, WS_U = WS_QKV + 66 * MiB, WS_ATT = WS_C, WS_OF = WS_D, WS_OB = WS_D + 32 * MiB, WS_YA = WS_E1, WS_YB = WS_C;
constexpr size_t WS_MG = 324 * MiB, WS_H2 = 388 * MiB, WS_UB = 452 * MiB, WS_VB = 484 * MiB, WS_USC = 516 * MiB, WS_VSC = 517 * MiB, WS_SC = 196 * MiB, WS_END = 580 * MiB;
static_assert(WS_EG + (size_t)4224 * 132 * 4 <= WS_END && WS_K + (size_t)16 * LKV * 192 * 2 <= WS_DNQ && WS_DNQ + (size_t)M1 * 3072 * 2 <= WS_GBETA, "ws map");

__device__ __forceinline__ unsigned f2bf(float f) { unsigned u = __builtin_bit_cast(unsigned, f); return (u + 0x7fffu + ((u >> 16) & 1u)) >> 16; }
typedef float f32x2_c __attribute__((ext_vector_type(2))); typedef __bf16 bf16x2_c __attribute__((ext_vector_type(2)));
__device__ __forceinline__ unsigned pk2(float lo, float hi) { f32x2_c v = {lo, hi}; bf16x2_c b = __builtin_convertvector(v, bf16x2_c); return __builtin_bit_cast(unsigned, b); }
__device__ __forceinline__ float bflo(unsigned w) { return __uint_as_float(w << 16); }
__device__ __forceinline__ float bfhi(unsigned w) { return __uint_as_float(w & 0xffff0000u); }
__device__ __forceinline__ float wave_sum(float v) {
#pragma unroll
    for (int o = 1; o < 64; o <<= 1) v += __shfl_xor(v, o);
    return v;
}
__device__ __forceinline__ float siluf(float v) { return v / (1.0f + __expf(-v)); }

struct Params {
    const float *x, *c, *ctx, *c_ctx, *w_mod, *b_mod, *norm1_w, *w_in, *qn_w, *kvn_w, *w_uq, *w_ukv, *conv_w, *a_log, *dt_bias, *dn_norm_w,
                *w_ba, *w_bb, *w_out, *norm2_w, *peer_wq, *sub_keys, *peer_u, *peer_v, *final_w;
    float* out; unsigned char* ws;
    int ph_lo, ph_hi;
};
#define XB_TMO      128
#define XB_XCNT(j)  (256  + 64 * (j))
#define XB_XSUB(j)  (1280 + 64 * (j))
#define XB_XGEN(j)  (2304 + 64 * (j))
#define XB_TOP      3328
#define XB_TOPGEN   3392
#define XCD_BAR_WORDS 3456
#define XB_SPIN_CAP (1u << 18)

__device__ __forceinline__ unsigned xb_ld(unsigned* p)              { return __hip_atomic_load(p, __ATOMIC_RELAXED, __HIP_MEMORY_SCOPE_AGENT); }
__device__ __forceinline__ unsigned xb_add(unsigned* p, unsigned v) { return __hip_atomic_fetch_add(p, v, __ATOMIC_RELAXED, __HIP_MEMORY_SCOPE_AGENT); }
__device__ __forceinline__ unsigned xb_xcc_id() { return (unsigned)__builtin_amdgcn_s_getreg((3 << 11) | 20) & 0xFu; }
#define XB_SPIN(cond, bar) do { unsigned _sp = 0; while (cond) { __builtin_amdgcn_s_sleep(1); \
    if ((++_sp & 255u) == 0u) { if (xb_ld(&(bar)[XB_TMO])) break; if (_sp > XB_SPIN_CAP) { atomicAdd(&(bar)[XB_TMO], 1u); break; } } } } while (0)

struct XcdBarrier {
    unsigned* bar; unsigned x;
    volatile LAS unsigned* st;
};

__device__ __forceinline__ XcdBarrier xcd_barrier_post(unsigned* bar, volatile LAS unsigned* st, int tid) {
    XcdBarrier b; b.bar = bar; b.x = xb_xcc_id(); b.st = st;
    if (tid == 0) (void)xb_add(&bar[XB_XCNT(b.x)], 1u);
    return b;
}
__device__ __forceinline__ void xcd_barrier_complete(unsigned* bar, unsigned x, unsigned& nloc, unsigned& nx) {
    const unsigned G = gridDim.x * gridDim.y * gridDim.z;
    unsigned sum, cnt, mine, sp = 0u;
    for (;;) {
        sum = 0u; cnt = 0u; mine = 0u;
#pragma unroll
        for (unsigned j = 0; j < 16; ++j) { const unsigned c = xb_ld(&bar[XB_XCNT(j)]); sum += c; cnt += (c > 0u) ? 1u : 0u; mine = (j == x) ? c : mine; }
        if (sum == G) break;
        __builtin_amdgcn_s_sleep(1);
        if ((++sp & 255u) == 0u) { if (xb_ld(&bar[XB_TMO])) break; if (sp > XB_SPIN_CAP) { atomicAdd(&bar[XB_TMO], 1u); break; } }
    }
    nloc = mine > 0u ? mine : 1u; nx = cnt > 0u ? cnt : 1u;
}

__device__ __forceinline__ void xcd_barrier(const XcdBarrier& b, int tid) {
    asm volatile("s_waitcnt vmcnt(0)" ::: "memory");
    __syncthreads();
    if (tid == 0) {
        unsigned* bar = b.bar;
        __builtin_amdgcn_s_waitcnt(0);
        unsigned nloc = b.st[0], nx = b.st[1];
        if (nloc == 0u) { xcd_barrier_complete(bar, b.x, nloc, nx); b.st[0] = nloc; b.st[1] = nx; }
        const unsigned old = xb_add(&bar[XB_XSUB(b.x)], 1u);
        const unsigned gen = old / nloc;
        if (old + 1u == (gen + 1u) * nloc) {
            __builtin_amdgcn_fence(__ATOMIC_RELEASE, "agent");
            asm volatile("s_waitcnt vmcnt(0)" ::: "memory");
            const unsigned og = xb_add(&bar[XB_TOP], 1u);
            const unsigned tg = og / nx;
            if (og + 1u == (tg + 1u) * nx) xb_add(&bar[XB_TOPGEN], 1u);
            else XB_SPIN(xb_ld(&bar[XB_TOPGEN]) == tg, bar);
            __builtin_amdgcn_fence(__ATOMIC_ACQUIRE, "agent");
            xb_add(&bar[XB_XGEN(b.x)], 1u);
            asm volatile("s_waitcnt vmcnt(0)" ::: "memory");
        } else {
            XB_SPIN(xb_ld(&bar[XB_XGEN(b.x)]) == gen, bar);
            __builtin_amdgcn_fence(__ATOMIC_ACQUIRE, "agent");
            asm volatile("s_waitcnt vmcnt(0)" ::: "memory");
        }
    }
    __syncthreads();
}
struct Ctx { LAS unsigned char* lds; int tid, lane, wave, vcu, G; };

__device__ __forceinline__ void p0_mod_item(const Params& p, const Ctx& C, int it) {
    LAS float* sl = (LAS float*)C.lds;
    LAS float* red = sl + 3 * 2048;
    for (int e = C.tid; e < 3 * 2048; e += NT_) { const int i = e >> 11, k = e & 2047; const float v = (i < 2) ? p.c[i * DM + k] : p.c_ctx[k]; sl[e] = siluf(v); }
    __syncthreads();
    typedef float f32x2_ __attribute__((ext_vector_type(2)));
    f32x2_ a0 = {0, 0}, a1 = {0, 0}, a2 = {0, 0};
    const int col = it * 128 + C.lane * 2, k0 = C.wave * 256;
    const float* wp = p.w_mod + (size_t)k0 * 12288 + col;
#pragma unroll 8
    for (int k = 0; k < 256; ++k) { const f32x2_ w = *(const f32x2_*)(wp + (size_t)k * 12288); a0 += w * sl[k0 + k]; a1 += w * sl[2048 + k0 + k]; a2 += w * sl[4096 + k0 + k]; }
    LAS float* rw = red + C.wave * 384 + C.lane * 2;
    rw[0] = a0[0]; rw[1] = a0[1]; rw[128] = a1[0]; rw[129] = a1[1]; rw[256] = a2[0]; rw[257] = a2[1];
    __syncthreads();
    if (C.tid < 384) { float s = p.b_mod[it * 128 + (C.tid & 127)];
#pragma unroll
        for (int w = 0; w < 8; ++w) s += red[w * 384 + C.tid];
        ((float*)(p.ws + CTL_MOD))[(C.tid >> 7) * 12288 + it * 128 + (C.tid & 127)] = s; }
    __syncthreads();
}
__device__ __forceinline__ void p0_wprime_item(const Params& p, const Ctx& C, int it) {
    LAS float* As = (LAS float*)C.lds;
    LAS float* Ss = As + 64 * 129;
    const int hp = it >> 5, i0 = (it & 31) * 64, pp = hp & 1;
    for (int e = C.tid; e < 64 * 128; e += NT_) { const int i = e >> 7, d = e & 127; As[i * 129 + d] = p.peer_wq[(size_t)(i0 + i) * 2048 + hp * 128 + d]; }
    for (int e = C.tid; e < 128 * 128; e += NT_) { const int k = e >> 7, d = e & 127; Ss[k * 129 + d] = p.sub_keys[(size_t)(pp * 128 + k) * 128 + d]; }
    __syncthreads();
    const int k = C.tid & 127, ig = C.tid >> 7;
    float acc[16];
#pragma unroll
    for (int ii = 0; ii < 16; ++ii) acc[ii] = 0.f;
    for (int d = 0; d < 128; ++d) { const float s = Ss[k * 129 + d];
#pragma unroll
        for (int ii = 0; ii < 16; ++ii) acc[ii] += As[(ig * 16 + ii) * 129 + d] * s; }
    bf16_t* dst = (bf16_t*)(p.ws + WS_WPQ) + (size_t)(hp * 128 + k) * 2048 + i0 + ig * 16;
    v4u w0, w1; w0.x = pk2(acc[0], acc[1]); w0.y = pk2(acc[2], acc[3]); w0.z = pk2(acc[4], acc[5]); w0.w = pk2(acc[6], acc[7]);
    w1.x = pk2(acc[8], acc[9]); w1.y = pk2(acc[10], acc[11]); w1.z = pk2(acc[12], acc[13]); w1.w = pk2(acc[14], acc[15]);
    *(v4u*)dst = w0; *(v4u*)(dst + 8) = w1;
    __syncthreads();
}
__device__ __forceinline__ void p0_transpose_item(const float* W, int K, int N, int k0, int n0, bf16_t* WT, int drow0, const float* kscale, LAS float* scr, int lane) {
#pragma unroll 8
    for (int i = 0; i < 32; ++i) { const int kk = 2 * i + (lane >> 5); float v = W[(size_t)(k0 + kk) * N + n0 + (lane & 31)]; if (kscale) v *= kscale[k0 + kk]; scr[kk * 33 + (lane & 31)] = v; }
    asm volatile("s_waitcnt lgkmcnt(0)" ::: "memory");
    const int c = lane & 7;
#pragma unroll
    for (int j = 0; j < 4; ++j) { const int n = (lane >> 3) + 8 * j; const LAS float* s = scr + (8 * c) * 33 + n;
        v4u o; o.x = pk2(s[0 * 33], s[1 * 33]); o.y = pk2(s[2 * 33], s[3 * 33]); o.z = pk2(s[4 * 33], s[5 * 33]); o.w = pk2(s[6 * 33], s[7 * 33]);
        *(v4u*)(WT + (size_t)(drow0 + n) * K + k0 + 8 * c) = o; }
    asm volatile("s_waitcnt lgkmcnt(0)" ::: "memory");
}
__device__ __forceinline__ int win_dest_row(int n0) {
    if (n0 < 768) return n0;
    if (n0 < 832) return 8960 + (n0 - 768);
    if (n0 < 3904) return 768 + (n0 - 832);
    if (n0 < 4928) return 3840 + (n0 - 3904);
    if (n0 < 4960) return 9024 + (n0 - 4928);
    if (n0 < 7008) return 4864 + (n0 - 4960);
    return 6912 + (n0 - 7008);
}
__device__ __forceinline__ void p0_prologue(const Params& p, const Ctx& C) {
    for (int it = C.vcu; it < 96; it += C.G) p0_mod_item(p, C, it);
    for (int it = C.vcu; it < 512; it += C.G) p0_wprime_item(p, C, it);
    LAS float* scr = (LAS float*)(C.lds + C.wave * 16384);
    const int gw = C.vcu * 8 + C.wave, NGW = C.G * 8;
    constexpr int I_IN = 32 * 283, I_UQ = 8 * 48, I_UKV = 4 * 64, I_BA = 16 * 64, I_BB = 16 * 64, I_OUT = 32 * 64;
    constexpr int NITEMS = I_IN + I_UQ + I_UKV + I_BA + I_BB + I_OUT;
    unsigned char* ws = p.ws;
    for (int it = gw; it < NITEMS; it += NGW) {
        int r = it;
        if (r < I_IN) { const int kb = r / 283, nb = r % 283; p0_transpose_item(p.w_in, 2048, 9056, kb * 64, nb * 32, (bf16_t*)(ws + WS_C), win_dest_row(nb * 32), nullptr, scr, C.lane); continue; } r -= I_IN;
        if (r < I_UQ) { const int kb = r / 48, nb = r % 48, n0 = nb * 32, h = n0 / 192, j0 = n0 % 192; const int dr = (j0 < 128) ? (h * 128 + j0) : (1024 + h * 64 + (j0 - 128));
            p0_transpose_item(p.w_uq, 512, 1536, kb * 64, n0, (bf16_t*)(ws + WS_WUQ), dr, p.qn_w, scr, C.lane); continue; } r -= I_UQ;
        if (r < I_UKV) { const int kb = r / 64, nb = r % 64; p0_transpose_item(p.w_ukv, 256, 2048, kb * 64, nb * 32, (bf16_t*)(ws + WS_WUKV), nb * 32, p.kvn_w, scr, C.lane); continue; } r -= I_UKV;
        if (r < I_BA) { const int kb = r / 64, nb = r % 64; p0_transpose_item(p.w_ba, 1024, 2048, kb * 64, nb * 32, (bf16_t*)(ws + WS_WBA), nb * 32, nullptr, scr, C.lane); continue; } r -= I_BA;
        if (r < I_BB) { const int kb = r / 64, nb = r % 64; p0_transpose_item(p.w_bb, 1024, 2048, kb * 64, nb * 32, (bf16_t*)(ws + WS_WBB), nb * 32, nullptr, scr, C.lane); continue; } r -= I_BB;
        { const int kb = r / 64, nb = r % 64; p0_transpose_item(p.w_out, 2048, 2048, kb * 64, nb * 32, (bf16_t*)(ws + WS_WOUT), nb * 32, nullptr, scr, C.lane); }
    }
    { v4u* z = (v4u*)((bf16_t*)(ws + WS_C) + (size_t)9056 * 2048); const int n16 = 160 * 2048 * 2 / 16;
      for (int i = C.vcu * NT_ + C.tid; i < n16; i += C.G * NT_) z[i] = (v4u){0u, 0u, 0u, 0u}; }
}

__device__ __forceinline__ void mod_norm_rows(const Ctx& C, const float* X, int nrows, const float* nw, const float* sh, const float* sc, bf16_t* O) {
    f32x4 a[8], s[8];
#pragma unroll
    for (int j = 0; j < 8; ++j) { const int c = 4 * C.lane + 256 * j; const f32x4 w = *(const f32x4*)(nw + c), q = *(const f32x4*)(sc + c); a[j] = w * (q + 1.0f); s[j] = *(const f32x4*)(sh + c); }
    const int gw = C.vcu * 8 + C.wave, NGW = C.G * 8;
    for (int r = gw; r < nrows; r += NGW) {
        const f32x4* xr = (const f32x4*)(X + (size_t)r * DM) + C.lane; f32x4 v[8]; float ss = 0.f;
#pragma unroll
        for (int j = 0; j < 8; ++j) { v[j] = xr[64 * j]; ss += (v[j].x * v[j].x + v[j].y * v[j].y) + (v[j].z * v[j].z + v[j].w * v[j].w); }
        const float rstd = rsqrtf(wave_sum(ss) * (1.0f / DM) + EPS);
        v2u* o8 = (v2u*)(O + (size_t)r * DM) + C.lane;
#pragma unroll
        for (int j = 0; j < 8; ++j) { const f32x4 y = v[j] * rstd * a[j] + s[j]; v2u w; w.x = pk2(y.x, y.y); w.y = pk2(y.z, y.w); o8[64 * j] = w; }
    }
}
__device__ __forceinline__ void p3_conv(const Params& p, const Ctx& C) {
    const bf16_t* QKV = (const bf16_t*)(p.ws + WS_QKV); bf16_t* DNQ = (bf16_t*)(p.ws + WS_DNQ);
    const int total = (M1 / 16) * 384;
    for (int it = C.vcu * NT_ + C.tid; it < total; it += C.G * NT_) {
        const int rb = it / 384, c8 = it % 384, ch = c8 * 8, r0 = rb * 16;
        int seg0, segn, t0;
        if (r0 < ML) { seg0 = r0 & ~8191; segn = SEQ; t0 = r0 & 8191; } else { seg0 = ML + ((r0 - ML) & ~255); segn = CTXL; t0 = (r0 - ML) & 255; }
        f32x4 wlo[5], whi[5];
#pragma unroll
        for (int j = 0; j < 5; ++j) { wlo[j] = *(const f32x4*)(p.conv_w + j * 3072 + ch); whi[j] = *(const f32x4*)(p.conv_w + j * 3072 + ch + 4); }
        const float qs = (ch < 1024) ? 0.08838834764831845f : 1.0f; const bool nrm = ch < 2048;
        v4u win[5];
#pragma unroll
        for (int j = 0; j < 4; ++j) { const int tt = t0 + j - 2; win[j + 1] = (tt >= 0 && tt < segn) ? *(const v4u*)(QKV + (size_t)(seg0 + tt) * 3072 + ch) : (v4u){0u, 0u, 0u, 0u}; }
#pragma unroll
        for (int i = 0; i < 16; ++i) {
#pragma unroll
            for (int j = 0; j < 4; ++j) win[j] = win[j + 1];
            { const int tt = t0 + i + 2; win[4] = (tt < segn) ? *(const v4u*)(QKV + (size_t)(seg0 + tt) * 3072 + ch) : (v4u){0u, 0u, 0u, 0u}; }
            float acc[8];
#pragma unroll
            for (int e = 0; e < 8; ++e) acc[e] = 0.f;
#pragma unroll
            for (int j = 0; j < 5; ++j) { const v4u xv = win[j];
                acc[0] += bflo(xv.x) * wlo[j].x; acc[1] += bfhi(xv.x) * wlo[j].y; acc[2] += bflo(xv.y) * wlo[j].z; acc[3] += bfhi(xv.y) * wlo[j].w;
                acc[4] += bflo(xv.z) * whi[j].x; acc[5] += bfhi(xv.z) * whi[j].y; acc[6] += bflo(xv.w) * whi[j].z; acc[7] += bfhi(xv.w) * whi[j].w; }
            float ss = 0.f;
#pragma unroll
            for (int e = 0; e < 8; ++e) { acc[e] = siluf(acc[e]); ss += acc[e] * acc[e]; }
            ss += __shfl_xor(ss, 1); ss += __shfl_xor(ss, 2); ss += __shfl_xor(ss, 4); ss += __shfl_xor(ss, 8);
            const float sc = nrm ? rsqrtf(ss + EPS) * qs : 1.0f;
            v4u w; w.x = pk2(acc[0] * sc, acc[1] * sc); w.y = pk2(acc[2] * sc, acc[3] * sc); w.z = pk2(acc[4] * sc, acc[5] * sc); w.w = pk2(acc[6] * sc, acc[7] * sc);
            *(v4u*)(DNQ + (size_t)(r0 + i) * 3072 + ch) = w;
        }
    }
}
__device__ __forceinline__ void p3_krope_gbeta(const Params& p, const Ctx& C) {
    const float* KR = (const float*)(p.ws + WS_KR); bf16_t* K = (bf16_t*)(p.ws + WS_K);
    for (int it = C.vcu * NT_ + C.tid; it < M1 * 4; it += C.G * NT_) {
        const int r = it >> 2, q = it & 3, half = q >> 1, part = q & 1;
        int b, l, t; bool lat = r < ML;
        if (lat) { b = r >> 13; t = r & 8191; l = CTXL + t; } else { b = (r - ML) >> 8; t = 0; l = (r - ML) & 255; }
        const float* x1p = KR + (size_t)r * 64 + half * 32; const float* x2p = x1p + 16;
        float o[16];
        if (lat) { const float pos = (float)(half == 0 ? (t >> 6) : (t & 63));
#pragma unroll
            for (int i = 0; i < 16; ++i) { const float invf = exp2f(-(float)i * (13.287712379549449f / 16.0f)); float sn, cs; pg8::fast_sincos(pos * invf, sn, cs);
                const float x1 = x1p[i], x2 = x2p[i]; o[i] = part == 0 ? (x1 * cs - x2 * sn) : (x1 * sn + x2 * cs); } }
        else {
#pragma unroll
            for (int i = 0; i < 16; ++i) o[i] = part == 0 ? x1p[i] : x2p[i]; }
        v4u w0, w1; w0.x = pk2(o[0], o[1]); w0.y = pk2(o[2], o[3]); w0.z = pk2(o[4], o[5]); w0.w = pk2(o[6], o[7]);
        w1.x = pk2(o[8], o[9]); w1.y = pk2(o[10], o[11]); w1.z = pk2(o[12], o[13]); w1.w = pk2(o[14], o[15]);
#pragma unroll
        for (int h = 0; h < 8; ++h) { bf16_t* dst = K + ((size_t)(b * 8 + h) * LKV + l) * 192 + 128 + half * 32 + part * 16; *(v4u*)dst = w0; *(v4u*)(dst + 8) = w1; }
    }
    const float* AB = (const float*)(p.ws + WS_AB); float* Gd = (float*)(p.ws + WS_GBETA); float* Bd = Gd + (size_t)2 * M1 * 8;
    for (int it = C.vcu * NT_ + C.tid; it < M1 * 16; it += C.G * NT_) {
        const int r = it >> 4, dh = it & 15, dir = dh >> 3, h = dh & 7;
        const float a = AB[(size_t)r * 32 + dir * 8 + h] + p.dt_bias[dir * 8 + h], bl = AB[(size_t)r * 32 + 16 + dir * 8 + h];
        const float sp = (a > 20.f) ? a : log1pf(__expf(a));
        Gd[((size_t)dir * M1 + r) * 8 + h] = -__expf(p.a_log[dir * 8 + h]) * sp;
        Bd[((size_t)dir * M1 + r) * 8 + h] = 1.0f / (1.0f + __expf(-bl));
    }
}
typedef short s16x4c __attribute__((ext_vector_type(4)));
constexpr int CP_LD = 136;
constexpr int CP_K = 0, CP_Q = CP_K + 64 * CP_LD * 2, CP_V = CP_Q + 64 * CP_LD * 2, CP_VEC = CP_V + 64 * CP_LD * 2  , CP_MLO = CP_VEC + 640 * 4  ,
              CP_DG = CP_MLO + 2 * 64 * 72 * 2  , CP_DB = CP_DG + 2 * 4 * 16 * 17 * 4  , CP_ATS = CP_DB + 2 * 4 * 16 * 24 * 2  ,
              CP_XW = CP_ATS + 2 * 64 * 72 * 2  , CP_END = CP_XW + 8 * 16 * 72 * 2;
static_assert(CP_END <= 147456 - 64 && CP_MLO % 16 == 0 && CP_DB % 16 == 0 && CP_ATS % 16 == 0 && CP_XW % 16 == 0 && CP_DG % 16 == 0, "chunk-prep LDS");
__device__ __forceinline__ unsigned short bf1(float f) { return (unsigned short)(pk2(f, f) & 0xffffu); }
__device__ __forceinline__ void p5_chunk_prep(const Params& p, const Ctx& C) {
    const bf16_t* DNQ = (const bf16_t*)(p.ws + WS_DNQ); const float* Gd = (const float*)(p.ws + WS_GBETA); const float* Bd = Gd + (size_t)2 * M1 * 8;
    bf16_t* Wd = (bf16_t*)(p.ws + WS_W); bf16_t* Ud = (bf16_t*)(p.ws + WS_U); bf16_t* ATd = (bf16_t*)(p.ws + WS_ATT);
    float* EG = (float*)(p.ws + WS_EG); float* EKD = EG + (size_t)4224 * 64; float* EGL = EKD + (size_t)4224 * 64;
    LAS unsigned char* L = C.lds;
    LAS bf16_t* Ks = (LAS bf16_t*)(L + CP_K); LAS bf16_t* Qs = (LAS bf16_t*)(L + CP_Q); LAS bf16_t* Vs = (LAS bf16_t*)(L + CP_V);
    LAS float* Vec = (LAS float*)(L + CP_VEC); LAS bf16_t* MLO = (LAS bf16_t*)(L + CP_MLO); LAS float* DG = (LAS float*)(L + CP_DG); LAS bf16_t* DB = (LAS bf16_t*)(L + CP_DB);
    LAS bf16_t* ATS = (LAS bf16_t*)(L + CP_ATS); LAS bf16_t* XW = (LAS bf16_t*)(L + CP_XW) + C.wave * (16 * 72);
    const int tid = C.tid, lane = C.lane, wave = C.wave, l15 = lane & 15, lq = lane >> 4;
    for (int task = C.vcu; task < 16 * NCH; task += C.G) {
        const int bh = task / NCH, tc = task % NCH, b = bh >> 3, h = bh & 7;
        const int row0 = (tc < 4) ? (ML + b * CTXL + tc * 64) : (b * SEQ + (tc - 4) * 64);
        const size_t cidx0 = (size_t)(bh * 2 + 0) * NCH + tc, cidx1 = (size_t)(bh * 2 + 1) * NCH + (tc < 4 ? 3 - tc : 135 - tc);
        for (int e = tid; e < 3 * 1024; e += NT_) { const int which = e >> 10, id = e & 1023, i = id >> 4, chn = id & 15;
            const v4u v = *(const v4u*)(DNQ + (size_t)(row0 + i) * 3072 + which * 1024 + h * 128 + chn * 8);
            LAS bf16_t* dst = (which == 0 ? Qs : (which == 1 ? Ks : Vs)) + i * CP_LD + chn * 8; *(LAS v4u*)dst = v; }
        if (wave < 2) { const int dir = wave, pi = dir ? 63 - lane : lane;
            const float g = Gd[((size_t)dir * M1 + row0 + pi) * 8 + h], be = Bd[((size_t)dir * M1 + row0 + pi) * 8 + h];
            float v = g;
#pragma unroll
            for (int o = 1; o < 64; o <<= 1) { const float u = __shfl_up(v, o); if (lane >= o) v += u; }
            const float gl = __shfl(v, 63), eg = __expf(v);
            Vec[256 + dir * 64 + lane] = v; Vec[384 + dir * 128 + lane] = be; Vec[384 + dir * 128 + 64 + lane] = eg;
            const size_t cidx = dir ? cidx1 : cidx0;
            EG[cidx * 64 + lane] = eg; EKD[cidx * 64 + lane] = __expf(gl - v); if (lane == 0) EGL[cidx] = __expf(gl); }
        __syncthreads();
        {
#pragma unroll
            for (int q = 0; q < 4; ++q) { const int t16 = wave * 2 + (q & 1), tm = t16 >> 2, tn = t16 & 3; const bool isq = q >= 2;
                const LAS bf16_t* Ab = (isq ? Qs : Ks) + (tm * 16 + l15) * CP_LD + 8 * lq; const LAS bf16_t* Bb = Ks + (tn * 16 + l15) * CP_LD + 8 * lq;
                f32x4 acc = {0.f, 0.f, 0.f, 0.f};
#pragma unroll
                for (int kk = 0; kk < 4; ++kk) acc = __builtin_amdgcn_mfma_f32_16x16x32_bf16(*(const LAS bf16x8*)(Ab + kk * 32), *(const LAS bf16x8*)(Bb + kk * 32), acc, 0, 0, 0);
                const int j = tn * 16 + l15, jb = 63 - j; const float gfj = Vec[256 + j], gbj = Vec[320 + jb];
#pragma unroll
                for (int rg = 0; rg < 4; ++rg) { const int i = tm * 16 + 4 * lq + rg, ib = 63 - i; const float a = acc[rg];
                    const float df = __expf(Vec[256 + i] - gfj), db = __expf(Vec[320 + ib] - gbj);
                    if (isq) { ATS[i * 72 + j] = bf1(i >= j ? a * df : 0.f); ATS[64 * 72 + ib * 72 + jb] = bf1(i <= j ? a * db : 0.f); }
                    else if (i > j) { const float m = Vec[384 + i] * a * df;
                        if (tm == tn) DG[(tm * 16 + (i & 15)) * 17 + (j & 15)] = m; else MLO[i * 72 + j] = bf1(-m); }
                    else if (i < j) { const float m = Vec[384 + 128 + ib] * a * db;
                        if (tm == tn) DG[((4 + (3 - tm)) * 16 + (ib & 15)) * 17 + (jb & 15)] = m; else MLO[64 * 72 + ib * 72 + jb] = bf1(-m); }
                }
            }
        }
        __syncthreads();
        if (tid < 128) { const int blk = tid >> 4, cc = tid & 15; const LAS float* Mb = DG + blk * 16 * 17;
            float d[16];
#pragma unroll
            for (int r = 0; r < 16; ++r) { float v = (r == cc) ? 1.f : 0.f;
#pragma unroll
                for (int k = 0; k < r; ++k) v -= Mb[r * 17 + k] * d[k];
                d[r] = v; DB[(blk * 16 + r) * 24 + cc] = bf1(v); }
        } else { for (int e = tid - 128; e < 2 * 64 * 8; e += NT_ - 128) { const int dir = e >> 9, i = (e >> 3) & 63, chn = e & 7;
                *(v4u*)(ATd + (dir ? cidx1 : cidx0) * 4096 + i * 64 + chn * 8) = *(const LAS v4u*)(ATS + dir * (64 * 72) + i * 72 + chn * 8); } }
        __syncthreads();
        {
            const int dir = wave >> 2, wq = wave & 3; const bool isw = wq >= 2; const int cb0 = (wq & 1) * 64;
            const LAS bf16_t* src = (isw ? Ks : Vs) + cb0 + l15; const LAS float* bsc = Vec + 384 + dir * 128;
            const LAS bf16_t* Mo = MLO + dir * (64 * 72); const LAS bf16_t* Dd = DB + dir * (4 * 16 * 24);
            s16x4c aoff[6], adg[4];
            { int q = 0;
#pragma unroll
              for (int bb = 1; bb < 4; ++bb)
#pragma unroll
                  for (int j = 0; j < bb; ++j) { aoff[q] = *(const LAS s16x4c*)(Mo + (bb * 16 + l15) * 72 + j * 16 + 4 * lq); ++q; }
#pragma unroll
              for (int bb = 0; bb < 4; ++bb) adg[bb] = *(const LAS s16x4c*)(Dd + (bb * 16 + l15) * 24 + 4 * lq); }
            s16x4c xp[4][4];
            bf16_t* gdst = (isw ? Wd : Ud) + (dir ? cidx1 : cidx0) * 8192 + cb0;
#pragma unroll
            for (int bb = 0; bb < 4; ++bb) {
#pragma unroll
                for (int ct = 0; ct < 4; ++ct) {
                    f32x4 acc;
#pragma unroll
                    for (int rg = 0; rg < 4; ++rg) { const int i = bb * 16 + 4 * lq + rg, pi = dir ? 63 - i : i;
                        float v = __uint_as_float(((unsigned)src[pi * CP_LD + ct * 16]) << 16) * bsc[i]; if (isw) v *= bsc[64 + i]; acc[rg] = v; }
#pragma unroll
                    for (int j = 0; j < bb; ++j) acc = __builtin_amdgcn_mfma_f32_16x16x16bf16_1k(aoff[bb * (bb - 1) / 2 + j], xp[ct][j], acc, 0, 0, 0);
                    const unsigned a01 = pk2(acc[0], acc[1]), a23 = pk2(acc[2], acc[3]);
                    const s16x4c accb = {(short)(a01 & 0xffff), (short)(a01 >> 16), (short)(a23 & 0xffff), (short)(a23 >> 16)};
                    const f32x4 x = __builtin_amdgcn_mfma_f32_16x16x16bf16_1k(adg[bb], accb, (f32x4){0.f, 0.f, 0.f, 0.f}, 0, 0, 0);
                    const unsigned x01 = pk2(x[0], x[1]), x23 = pk2(x[2], x[3]);
                    xp[ct][bb] = (s16x4c){(short)(x01 & 0xffff), (short)(x01 >> 16), (short)(x23 & 0xffff), (short)(x23 >> 16)};
                    LAS bf16_t* xw = XW + (4 * lq) * 72 + ct * 16 + l15;
                    xw[0] = (bf16_t)(x01 & 0xffff); xw[72] = (bf16_t)(x01 >> 16); xw[144] = (bf16_t)(x23 & 0xffff); xw[216] = (bf16_t)(x23 >> 16);
                }
                asm volatile("s_waitcnt lgkmcnt(0)" ::: "memory");
#pragma unroll
                for (int e2 = 0; e2 < 2; ++e2) { const int pc = lane + 64 * e2, r = pc >> 3, chn = pc & 7;
                    *(v4u*)(gdst + (size_t)(bb * 16 + r) * 128 + chn * 8) = *(const LAS v4u*)(XW + r * 72 + chn * 8); }
                asm volatile("s_waitcnt lgkmcnt(0)" ::: "memory");
            }
        }
        __syncthreads();
    }
}
typedef short s16x4_ __attribute__((ext_vector_type(4))); typedef short v4i16_ __attribute__((ext_vector_type(4)));
constexpr int SC_WLD = 136, SC_TLD = 72;
constexpr int SB_W = 0, SB_Q = SB_W + 64 * SC_WLD * 2, SB_K = SB_Q + 64 * SC_WLD * 2, SB_ATT = SB_K + 64 * SC_WLD * 2, SB_U = SB_ATT + 64 * SC_TLD * 2, SB_EV = SB_U + 64 * 16 * 4  , SB_SIZE = SB_EV + 128 * 4;
constexpr int SC_SBT = 2 * SB_SIZE, SC_VNT = SC_SBT + 16 * SC_WLD * 2, SC_VNK = SC_VNT + 16 * SC_TLD * 2, SC_END = SC_VNK + 16 * SC_TLD * 2;
static_assert(SC_END <= 147456 - 64 && SB_SIZE % 16 == 0 && SB_Q % 16 == 0 && SB_ATT % 16 == 0 && SB_U % 16 == 0 && SB_EV % 16 == 0 && SC_SBT % 16 == 0 && SC_VNT % 16 == 0 && SC_VNK % 16 == 0, "scan LDS");
struct ScanRegs { v4u w0, w1, q0, q1, k0, k1, at, u; float ev, egl; };
struct ScanPtrs { const bf16_t *DNQ, *Wd, *Ud, *ATd; const float *EG, *EKD, *EGL; };
__device__ __forceinline__ int scan_base(int s, int b, int dir) { return dir == 0 ? ((s < 4) ? (ML + b * CTXL + s * 64) : (b * SEQ + (s - 4) * 64)) : ((s < 4) ? (ML + b * CTXL + (3 - s) * 64) : (b * SEQ + (131 - s) * 64)); }
__device__ __forceinline__ void scan_load(ScanRegs& R, const ScanPtrs& P, int s, int bhd, int b, int h, int dir, int n0, int tid) {
    const size_t cidx = (size_t)bhd * NCH + s; const int base = scan_base(s, b, dir);
    { const int i = tid >> 4, chn = tid & 15, row = base + (dir ? 63 - i : i);
      R.w0 = *(const v4u*)(P.Wd + cidx * 8192 + i * 128 + chn * 8); R.q0 = *(const v4u*)(P.DNQ + (size_t)row * 3072 + h * 128 + chn * 8); R.k0 = *(const v4u*)(P.DNQ + (size_t)row * 3072 + 1024 + h * 128 + chn * 8); }
    { const int i = 32 + (tid >> 4), chn = tid & 15, row = base + (dir ? 63 - i : i);
      R.w1 = *(const v4u*)(P.Wd + cidx * 8192 + i * 128 + chn * 8); R.q1 = *(const v4u*)(P.DNQ + (size_t)row * 3072 + h * 128 + chn * 8); R.k1 = *(const v4u*)(P.DNQ + (size_t)row * 3072 + 1024 + h * 128 + chn * 8); }
    R.at = *(const v4u*)(P.ATd + cidx * 4096 + (tid >> 3) * 64 + (tid & 7) * 8);
    if (tid < 128) { R.u = *(const v4u*)(P.Ud + cidx * 8192 + (tid >> 1) * 128 + n0 + (tid & 1) * 8); R.ev = (tid < 64) ? P.EG[cidx * 64 + tid] : P.EKD[cidx * 64 + tid - 64]; }
    R.egl = P.EGL[cidx];
}
__device__ __forceinline__ void scan_store(const ScanRegs& R, LAS unsigned char* B, int tid) {
    LAS bf16_t* Ws = (LAS bf16_t*)(B + SB_W); LAS bf16_t* Qs = (LAS bf16_t*)(B + SB_Q); LAS bf16_t* Ks = (LAS bf16_t*)(B + SB_K); LAS bf16_t* ATs = (LAS bf16_t*)(B + SB_ATT);
    const int chn = tid & 15;
    { const int i = tid >> 4; *(LAS v4u*)(Ws + i * SC_WLD + chn * 8) = R.w0; *(LAS v4u*)(Qs + i * SC_WLD + chn * 8) = R.q0; *(LAS v4u*)(Ks + i * SC_WLD + chn * 8) = R.k0; }
    { const int i = 32 + (tid >> 4); *(LAS v4u*)(Ws + i * SC_WLD + chn * 8) = R.w1; *(LAS v4u*)(Qs + i * SC_WLD + chn * 8) = R.q1; *(LAS v4u*)(Ks + i * SC_WLD + chn * 8) = R.k1; }
    *(LAS v4u*)(ATs + (tid >> 3) * SC_TLD + (tid & 7) * 8) = R.at;
    if (tid < 128) { LAS float* ud = (LAS float*)(B + SB_U) + (tid >> 1) * 16 + (tid & 1) * 8; *(LAS f32x4*)ud = (f32x4){bflo(R.u.x), bfhi(R.u.x), bflo(R.u.y), bfhi(R.u.y)}; *(LAS f32x4*)(ud + 4) = (f32x4){bflo(R.u.z), bfhi(R.u.z), bflo(R.u.w), bfhi(R.u.w)};
        ((LAS float*)(B + SB_EV))[tid] = R.ev; }
}
__device__ __forceinline__ void p6_scan(const Params& p, const Ctx& C) {
    ScanPtrs P; P.DNQ = (const bf16_t*)(p.ws + WS_DNQ); P.Wd = (const bf16_t*)(p.ws + WS_W); P.Ud = (const bf16_t*)(p.ws + WS_U); P.ATd = (const bf16_t*)(p.ws + WS_ATT);
    P.EG = (const float*)(p.ws + WS_EG); P.EKD = P.EG + (size_t)4224 * 64; P.EGL = P.EKD + (size_t)4224 * 64;
    LAS unsigned char* L = C.lds;
    LAS bf16_t* SBT = (LAS bf16_t*)(L + SC_SBT); LAS bf16_t* VNT = (LAS bf16_t*)(L + SC_VNT); LAS bf16_t* VNK = (LAS bf16_t*)(L + SC_VNK);
    const int tid = C.tid, lane = C.lane, wave = C.wave, l15 = lane & 15, lq = lane >> 4;
    for (int task = C.vcu; task < 256; task += C.G) {
        const int bhd = task >> 3, cb = task & 7, bh = bhd >> 1, dir = bhd & 1, b = bh >> 3, h = bh & 7, n0 = cb * 16;
        bf16_t* Od = (bf16_t*)(p.ws + (dir ? WS_OB : WS_OF));
        f32x4 S = {0.f, 0.f, 0.f, 0.f};
        for (int e = tid; e < 16 * SC_WLD / 2; e += NT_) ((LAS unsigned*)SBT)[e] = 0u;
        ScanRegs RA, RB;
        scan_load(RA, P, 0, bhd, b, h, dir, n0, tid); scan_load(RB, P, 1, bhd, b, h, dir, n0, tid);
        scan_store(RA, L, tid); float egl_cur = RA.egl;
        scan_load(RA, P, 2, bhd, b, h, dir, n0, tid);
#define SCAN_STEP(RN, s_) do { const int s = (s_); const int base = scan_base(s, b, dir); LAS unsigned char* Bc = L + (s & 1) * SB_SIZE; LAS unsigned char* Bn = L + ((s + 1) & 1) * SB_SIZE; \
            __syncthreads();                                                          \
            const float egl = egl_cur; \
            const int mt = wave & 3; f32x4 acc = {0.f, 0.f, 0.f, 0.f}; \
            { const LAS bf16_t* Ab = (LAS bf16_t*)(Bc + ((wave < 4) ? SB_W : SB_Q)) + (mt * 16 + l15) * SC_WLD + 8 * lq; const LAS bf16_t* Bb = SBT + l15 * SC_WLD + 8 * lq; \
              _Pragma("unroll") for (int kk = 0; kk < 4; ++kk) acc = __builtin_amdgcn_mfma_f32_16x16x32_bf16(*(const LAS bf16x8*)(Ab + kk * 32), *(const LAS bf16x8*)(Bb + kk * 32), acc, 0, 0, 0); } \
            if (wave < 4) { const int i0 = mt * 16 + 4 * lq; const LAS float* Us = (const LAS float*)(Bc + SB_U); const f32x4 ek = *(const LAS f32x4*)((const LAS float*)(Bc + SB_EV) + 64 + i0); \
                const float v0 = Us[(i0 + 0) * 16 + l15] - acc[0], v1 = Us[(i0 + 1) * 16 + l15] - acc[1], v2 = Us[(i0 + 2) * 16 + l15] - acc[2], v3 = Us[(i0 + 3) * 16 + l15] - acc[3]; \
                v2u w; w.x = pk2(v0, v1); w.y = pk2(v2, v3); *(LAS v2u*)(VNT + l15 * SC_TLD + i0) = w; \
                v2u wk; wk.x = pk2(v0 * ek[0], v1 * ek[1]); wk.y = pk2(v2 * ek[2], v3 * ek[3]); *(LAS v2u*)(VNK + l15 * SC_TLD + i0) = wk; } \
            else { const f32x4 eg = *(const LAS f32x4*)((const LAS float*)(Bc + SB_EV) + mt * 16 + 4 * lq); acc = acc * eg; } \
            if (s + 1 < NCH) { scan_store(RN, Bn, tid); egl_cur = RN.egl; if (s + 3 < NCH) scan_load(RN, P, s + 3, bhd, b, h, dir, n0, tid); } \
            __syncthreads();                                                          \
            if (wave >= 4) { const LAS bf16_t* Ab = (LAS bf16_t*)(Bc + SB_ATT) + (mt * 16 + l15) * SC_TLD + 8 * lq; const LAS bf16_t* Bb = VNT + l15 * SC_TLD + 8 * lq; \
                _Pragma("unroll") for (int kk = 0; kk < 2; ++kk) acc = __builtin_amdgcn_mfma_f32_16x16x32_bf16(*(const LAS bf16x8*)(Ab + kk * 32), *(const LAS bf16x8*)(Bb + kk * 32), acc, 0, 0, 0); \
                if (s >= 4) { _Pragma("unroll") for (int rg = 0; rg < 4; ++rg) { const int i = mt * 16 + 4 * lq + rg; const int row = base + (dir ? 63 - i : i); \
                        Od[(size_t)row * 1024 + h * 128 + n0 + l15] = (bf16_t)f2bf(acc[rg]); } } } \
            { f32x4 sn = S * egl; const LAS bf16_t* Bb = VNK + l15 * SC_TLD + 8 * lq; \
              const LAS bf16_t* Ta = (LAS bf16_t*)(Bc + SB_K) + (8 * lq + (l15 >> 2)) * SC_WLD + wave * 16 + 4 * (l15 & 3); \
              _Pragma("unroll") for (int kk = 0; kk < 2; ++kk) { \
                  const s16x4_ t0 = __builtin_bit_cast(s16x4_, __builtin_amdgcn_ds_read_tr16_b64_v4i16((LAS v4i16_*)(Ta + (kk * 32) * SC_WLD))); \
                  const s16x4_ t1 = __builtin_bit_cast(s16x4_, __builtin_amdgcn_ds_read_tr16_b64_v4i16((LAS v4i16_*)(Ta + (kk * 32 + 4) * SC_WLD))); \
                  const bf16x8 af = (bf16x8){t0[0], t0[1], t0[2], t0[3], t1[0], t1[1], t1[2], t1[3]}; \
                  sn = __builtin_amdgcn_mfma_f32_16x16x32_bf16(af, *(const LAS bf16x8*)(Bb + kk * 32), sn, 0, 0, 0); } \
              S = sn; } \
            { v2u w; w.x = pk2(S[0], S[1]); w.y = pk2(S[2], S[3]); *(LAS v2u*)(SBT + l15 * SC_WLD + wave * 16 + 4 * lq) = w; } \
        } while (0)
        for (int s2 = 0; s2 < NCH; s2 += 2) { SCAN_STEP(RB, s2); SCAN_STEP(RA, s2 + 1); }
#undef SCAN_STEP
        __syncthreads();
    }
}
__device__ __forceinline__ void p7_yb(const Params& p, const Ctx& C) {
    const bf16_t* OF = (const bf16_t*)(p.ws + WS_OF); const bf16_t* OB = (const bf16_t*)(p.ws + WS_OB); const bf16_t* Z = (const bf16_t*)(p.ws + WS_Z); bf16_t* YB = (bf16_t*)(p.ws + WS_YB);
    const long total = (long)ML * 128;
    for (long it = (long)C.vcu * NT_ + C.tid; it < total; it += (long)C.G * NT_) {
        const size_t off = (size_t)it * 8; const int d0 = (int)(off & 127);
        const v4u a = *(const v4u*)(OF + off), bq = *(const v4u*)(OB + off), zz = *(const v4u*)(Z + off);
        float o[8] = {bflo(a.x) + bflo(bq.x), bfhi(a.x) + bfhi(bq.x), bflo(a.y) + bflo(bq.y), bfhi(a.y) + bfhi(bq.y), bflo(a.z) + bflo(bq.z), bfhi(a.z) + bfhi(bq.z), bflo(a.w) + bflo(bq.w), bfhi(a.w) + bfhi(bq.w)};
        float zf[8] = {bflo(zz.x), bfhi(zz.x), bflo(zz.y), bfhi(zz.y), bflo(zz.z), bfhi(zz.z), bflo(zz.w), bfhi(zz.w)};
        float ss = 0.f;
#pragma unroll
        for (int e = 0; e < 8; ++e) ss += o[e] * o[e];
        ss += __shfl_xor(ss, 1); ss += __shfl_xor(ss, 2); ss += __shfl_xor(ss, 4); ss += __shfl_xor(ss, 8);
        const float rstd = rsqrtf(ss * (1.0f / 128.0f) + EPS);
        const f32x4 w0 = *(const f32x4*)(p.dn_norm_w + d0), w1 = *(const f32x4*)(p.dn_norm_w + d0 + 4);
        float y[8];
#pragma unroll
        for (int e = 0; e < 8; ++e) y[e] = o[e] * rstd * (e < 4 ? w0[e] : w1[e - 4]) * siluf(zf[e]);
        v4u w; w.x = pk2(y[0], y[1]); w.y = pk2(y[2], y[3]); w.z = pk2(y[4], y[5]); w.w = pk2(y[6], y[7]);
        *(v4u*)(YB + off) = w;
    }
}
typedef float f32x2_t __attribute__((ext_vector_type(2)));
__device__ __forceinline__ float gelu_erf(float v) { return 0.5f * v * (1.0f + erff(v * 0.7071067811865476f)); }
__device__ __forceinline__ float dot8(v4u a, v4u b, float acc) {
    acc += bflo(a.x) * bflo(b.x); acc += bfhi(a.x) * bfhi(b.x); acc += bflo(a.y) * bflo(b.y); acc += bfhi(a.y) * bfhi(b.y);
    acc += bflo(a.z) * bflo(b.z); acc += bfhi(a.z) * bfhi(b.z); acc += bflo(a.w) * bflo(b.w); acc += bfhi(a.w) * bfhi(b.w); return acc;
}
__device__ __forceinline__ unsigned ord_u32(float f) { const unsigned u = __float_as_uint(f); return u ^ ((u >> 31) ? 0xffffffffu : 0x80000000u); }
#define INS16(k, x) do { unsigned x_ = (x); _Pragma("unroll") for (int i_ = 0; i_ < 16; ++i_) { const unsigned lo_ = min(k[i_], x_); k[i_] = max(k[i_], x_); x_ = lo_; } } while (0)
constexpr int P12_SC = 0, P12_TOPS = 128 * 129 * 4, P12_TOPI = P12_TOPS + 128 * 16 * 4, P12_IDX = P12_TOPI + 128 * 16 * 4  , P12_PW = P12_IDX + 64 * 128 * 2  , P12_END = P12_PW + 64 * 128 * 4;
static_assert(P12_END <= 147456 - 64 && P12_IDX % 16 == 0 && P12_PW % 16 == 0, "p12 lds");
__device__ __forceinline__ float octet_sum(float d) {
    d += __builtin_bit_cast(float, __builtin_amdgcn_update_dpp(0, __builtin_bit_cast(int, d), 0xB1, 0xF, 0xF, true));
    d += __builtin_bit_cast(float, __builtin_amdgcn_update_dpp(0, __builtin_bit_cast(int, d), 0x4E, 0xF, 0xF, true));
    d += __builtin_bit_cast(float, __builtin_amdgcn_update_dpp(0, __builtin_bit_cast(int, d), 0x141, 0xF, 0xF, true));
    return d;
}
__device__ __forceinline__ void p12_peer(const Params& p, const Ctx& C, const bool do_final) {
    const float* SCp = (const float*)(p.ws + WS_SC); const bf16_t* H2 = (const bf16_t*)(p.ws + WS_H2);
    const unsigned char* UB = (const unsigned char*)(p.ws + WS_UB); const unsigned char* VB = (const unsigned char*)(p.ws + WS_VB); const float* USC = (const float*)(p.ws + WS_USC); const float* VSC = (const float*)(p.ws + WS_VSC);
    const float* MOD = (const float*)(p.ws + CTL_MOD);
    LAS float* SCs = (LAS float*)(C.lds + P12_SC); LAS float* TOPS = (LAS float*)(C.lds + P12_TOPS); LAS int* TOPI = (LAS int*)(C.lds + P12_TOPI);
    LAS unsigned short* IDXs = (LAS unsigned short*)(C.lds + P12_IDX); LAS float* PWs = (LAS float*)(C.lds + P12_PW);
    const int lane = C.lane, tid = C.tid;
    for (int blk = C.vcu; blk < ML / 64; blk += C.G) {
        for (int sub = 0; sub < 8; ++sub) {
            { const float* src = SCp + ((size_t)blk * 64 + sub * 8) * 2048;
#pragma unroll 4
              for (int e4 = tid; e4 < 8 * 2048 / 4; e4 += NT_) { const f32x4 v = *(const f32x4*)(src + e4 * 4); const int L = e4 >> 5, k = (e4 & 31) * 4; LAS float* d = SCs + L * 129 + k; d[0] = v.x; d[1] = v.y; d[2] = v.z; d[3] = v.w; } }
            __syncthreads();
            if (tid < 256) {
                const int L = tid >> 1, hf = tid & 1; const LAS float* s = SCs + L * 129 + hf * 64;
                unsigned k[16];
#pragma unroll
                for (int i = 0; i < 16; ++i) k[i] = 0u;
#pragma unroll 8
                for (int j = 0; j < 64; ++j) { const unsigned key = (ord_u32(s[j]) & ~127u) | (unsigned)(127 - (hf * 64 + j)); INS16(k, key); }
#pragma unroll
                for (int i = 0; i < 16; ++i) { const unsigned o = __shfl_xor(k[i], 1); if (hf == 0) INS16(k, o); }
                if (hf == 0) {
#pragma unroll
                    for (int i = 0; i < 16; ++i) { const int ki = 127 - (int)(k[i] & 127u); TOPI[L * 16 + i] = ki; TOPS[L * 16 + i] = SCs[L * 129 + ki]; } }
            }
            __syncthreads();
            if (tid < 64) {
                const int tt = tid >> 3, h = tid & 7, L0 = tt * 16 + h * 2, L1 = L0 + 1;
                float s0[16], s1[16];
#pragma unroll
                for (int i = 0; i < 16; ++i) { s0[i] = TOPS[L0 * 16 + i]; s1[i] = TOPS[L1 * 16 + i]; }
                unsigned k[16];
#pragma unroll
                for (int i = 0; i < 16; ++i) k[i] = 0u;
#pragma unroll
                for (int a = 0; a < 16; ++a)
#pragma unroll
                    for (int b2 = 0; b2 < 16; ++b2) if ((a + 1) * (b2 + 1) <= 16) { const unsigned key = (ord_u32(s0[a] + s1[b2]) & ~255u) | (unsigned)(255 - (a * 16 + b2)); INS16(k, key); }
                float bs[16]; float mx = -3.0e38f; const int orow = (sub * 8 + tt) * 128 + h * 16;
#pragma unroll
                for (int i = 0; i < 16; ++i) { const int pos = 255 - (int)(k[i] & 255u), a = pos >> 4, b2 = pos & 15;
                    bs[i] = TOPS[L0 * 16 + a] + TOPS[L1 * 16 + b2]; mx = fmaxf(mx, bs[i]);
                    IDXs[orow + i] = (unsigned short)(TOPI[L0 * 16 + a] * 128 + TOPI[L1 * 16 + b2]); }
                float sm = 0.f;
#pragma unroll
                for (int i = 0; i < 16; ++i) { bs[i] = __expf(bs[i] - mx); sm += bs[i]; }
                const float inv = 1.0f / sm;
#pragma unroll
                for (int i = 0; i < 16; ++i) PWs[orow + i] = bs[i] * inv;
            }
            __syncthreads();
        }
        const int tl = C.wave * 8 + (lane >> 3), piece = lane & 7; const size_t t = (size_t)blk * 64 + tl;
        const LAS unsigned short* idxrow = IDXs + tl * 128; LAS float* pwrow = PWs + tl * 128;
        LAS float* actrow = (LAS float*)(C.lds + P12_SC) + tl * 128;
#pragma unroll
        for (int i = 0; i < 16; ++i) actrow[i * 8 + piece] = 0.f;
#define P12_LOAD(R, TAB, it_) do { const int itx = (it_); const v4u i8 = *(const LAS v4u*)(idxrow + (itx & 15) * 8); const unsigned off_ = (unsigned)((itx >> 4) * 128 + piece * 16); \
            _Pragma("unroll") for (int j = 0; j < 8; ++j) { const unsigned ex = (i8[j >> 1] >> (16 * (j & 1))) & 0xffffu; R[j] = *(const v4u*)(TAB + (ex * 2048u + off_)); } } while (0)
#define P12_HXLOAD(cb_) do { const bf16_t* hp = H2 + t * 2048 + (cb_) * 128 + piece * 16; hra = *(const v4u*)hp; hrb = *(const v4u*)(hp + 8); } while (0)
#define P12_BCOMP(R, it_) do { const int s8x = (it_) & 15; float mine = 0.f; \
            _Pragma("unroll") for (int j = 0; j < 8; ++j) { f32x2_t d2 = {0.f, 0.f}; \
                _Pragma("unroll") for (int w4 = 0; w4 < 4; ++w4) { const int wd = (int)R[j][w4]; const f32x2_t lo = __builtin_amdgcn_cvt_pk_f32_fp8(wd, false), hi2 = __builtin_amdgcn_cvt_pk_f32_fp8(wd, true); \
                    d2 += lo * hx2[2 * w4]; d2 += hi2 * hx2[2 * w4 + 1]; } \
                const float d = octet_sum(d2.x + d2.y); mine = (piece == j) ? d : mine; } \
            actrow[s8x * 8 + piece] += mine; } while (0)
        {
            v4u rA[8], rB[8], rC[8], rD[8], hra, hrb; f32x2_t hx2[8];
            P12_HXLOAD(0);
            P12_LOAD(rA, UB, 0); P12_LOAD(rB, UB, 1); P12_LOAD(rC, UB, 2); P12_LOAD(rD, UB, 3);
            for (int it = 0; it < 256; it += 4) {
                if ((it & 15) == 0) {
                    hx2[0] = (f32x2_t){bflo(hra.x), bfhi(hra.x)}; hx2[1] = (f32x2_t){bflo(hra.y), bfhi(hra.y)}; hx2[2] = (f32x2_t){bflo(hra.z), bfhi(hra.z)}; hx2[3] = (f32x2_t){bflo(hra.w), bfhi(hra.w)};
                    hx2[4] = (f32x2_t){bflo(hrb.x), bfhi(hrb.x)}; hx2[5] = (f32x2_t){bflo(hrb.y), bfhi(hrb.y)}; hx2[6] = (f32x2_t){bflo(hrb.z), bfhi(hrb.z)}; hx2[7] = (f32x2_t){bflo(hrb.w), bfhi(hrb.w)};
                    P12_HXLOAD(min((it >> 4) + 1, 15));
                }
                P12_BCOMP(rA, it);     P12_LOAD(rA, UB, min(it + 4, 255));
                P12_BCOMP(rB, it + 1); P12_LOAD(rB, UB, min(it + 5, 255));
                P12_BCOMP(rC, it + 2); P12_LOAD(rC, UB, min(it + 6, 255));
                P12_BCOMP(rD, it + 3); P12_LOAD(rD, UB, min(it + 7, 255));
            }
        }
#pragma unroll
        for (int s8 = 0; s8 < 16; ++s8) { const int sel = s8 * 8 + piece; const unsigned ex = idxrow[sel];
            pwrow[sel] = pwrow[sel] * gelu_erf(actrow[sel] * USC[ex]) * VSC[ex]; }
        asm volatile("s_waitcnt lgkmcnt(0)" ::: "memory");
        const int bsel = (int)(t >> 13); const float* g2 = MOD + bsel * 12288 + 10240;
        float* orow = p.out + t * 2048; float ssq = 0.f;
#define P12_CCOMP(R, it_) do { const int s8x = (it_) & 15; const f32x4 c0 = *(const LAS f32x4*)(pwrow + s8x * 8), c1 = *(const LAS f32x4*)(pwrow + s8x * 8 + 4); \
            _Pragma("unroll") for (int j = 0; j < 8; ++j) { const float c = (j < 4) ? c0[j & 3] : c1[j & 3]; const f32x2_t cc = {c, c}; \
                _Pragma("unroll") for (int w4 = 0; w4 < 4; ++w4) { const int wd = (int)R[j][w4]; const f32x2_t lo = __builtin_amdgcn_cvt_pk_f32_fp8(wd, false), hi2 = __builtin_amdgcn_cvt_pk_f32_fp8(wd, true); \
                    a2[2 * w4] += cc * lo; a2[2 * w4 + 1] += cc * hi2; } } } while (0)
        {
            v4u rA[8], rB[8], rC[8], rD[8]; f32x2_t a2[8];
            P12_LOAD(rA, VB, 0); P12_LOAD(rB, VB, 1); P12_LOAD(rC, VB, 2); P12_LOAD(rD, VB, 3);
            for (int it = 0; it < 256; it += 4) {
                if ((it & 15) == 0) {
#pragma unroll
                    for (int i = 0; i < 8; ++i) a2[i] = (f32x2_t){0.f, 0.f}; }
                P12_CCOMP(rA, it);     P12_LOAD(rA, VB, min(it + 4, 255));
                P12_CCOMP(rB, it + 1); P12_LOAD(rB, VB, min(it + 5, 255));
                P12_CCOMP(rC, it + 2); P12_LOAD(rC, VB, min(it + 6, 255));
                P12_CCOMP(rD, it + 3); P12_LOAD(rD, VB, min(it + 7, 255));
                if ((it & 15) == 12) {
                    if (do_final) {
                        const int c0i = (it >> 4) * 128 + piece * 16;
#pragma unroll
                        for (int q4 = 0; q4 < 4; ++q4) { const f32x4 xv = *(const f32x4*)(orow + c0i + 4 * q4), gv = *(const f32x4*)(g2 + c0i + 4 * q4);
                            f32x4 y; y[0] = xv[0] + gv[0] * a2[2 * q4].x; y[1] = xv[1] + gv[1] * a2[2 * q4].y; y[2] = xv[2] + gv[2] * a2[2 * q4 + 1].x; y[3] = xv[3] + gv[3] * a2[2 * q4 + 1].y;
                            ssq += (y[0] * y[0] + y[1] * y[1]) + (y[2] * y[2] + y[3] * y[3]);
                            *(f32x4*)(orow + c0i + 4 * q4) = y; }
                    } else { asm volatile("" :: "v"(a2[0]), "v"(a2[3]), "v"(a2[5]), "v"(a2[7])); }
                }
            }
        }
        if (do_final) {
            const float rstd = rsqrtf(octet_sum(ssq) * (1.0f / DM) + EPS);
            for (int cb = 0; cb < 16; ++cb) { const int c0i = cb * 128 + piece * 16;
#pragma unroll
                for (int q4 = 0; q4 < 4; ++q4) { const f32x4 y = *(const f32x4*)(orow + c0i + 4 * q4), fw = *(const f32x4*)(p.final_w + c0i + 4 * q4); *(f32x4*)(orow + c0i + 4 * q4) = y * rstd * fw; } }
        }
        __syncthreads();
    }
}
__device__ __forceinline__ void cvt_fp8_rows(const Ctx& C, const float* src, unsigned char* dst, float* scl, int nrows) {
    const int gw = C.vcu * 8 + C.wave, NGW = C.G * 8, lane = C.lane;
    for (int r = gw; r < nrows; r += NGW) {
        const float* sp = src + (size_t)r * 2048 + 16 * lane; f32x4 v[8]; float mx = 0.f;
#pragma unroll
        for (int j = 0; j < 2; ++j)
#pragma unroll
            for (int q = 0; q < 4; ++q) { v[j * 4 + q] = *(const f32x4*)(sp + 1024 * j + 4 * q); const f32x4 a = v[j * 4 + q]; mx = fmaxf(mx, fmaxf(fmaxf(fabsf(a.x), fabsf(a.y)), fmaxf(fabsf(a.z), fabsf(a.w)))); }
#pragma unroll
        for (int o = 1; o < 64; o <<= 1) mx = fmaxf(mx, __shfl_xor(mx, o));
        mx = fmaxf(mx, 1e-30f); const float inv = 440.0f / mx;
        if (lane == 0) scl[r] = mx * (1.0f / 440.0f);
#pragma unroll
        for (int j = 0; j < 2; ++j) { v4u w;
#pragma unroll
            for (int q = 0; q < 4; ++q) { const f32x4 a = v[j * 4 + q] * inv; int wd = 0; wd = __builtin_amdgcn_cvt_pk_fp8_f32(a.x, a.y, wd, false); wd = __builtin_amdgcn_cvt_pk_fp8_f32(a.z, a.w, wd, true); w[q] = (unsigned)wd; }
            *(v4u*)(dst + (size_t)r * 2048 + 1024 * j + 16 * lane) = w; }
    }
}
__device__ __forceinline__ void cvt_rows(const Ctx& C, const float* src, bf16_t* dst, long n8) {
    for (long i = (long)C.vcu * NT_ + C.tid; i < n8; i += (long)C.G * NT_) { const f32x4 a = *(const f32x4*)(src + i * 8), b = *(const f32x4*)(src + i * 8 + 4);
        v4u w; w.x = pk2(a.x, a.y); w.y = pk2(a.z, a.w); w.z = pk2(b.x, b.y); w.w = pk2(b.z, b.w); *(v4u*)(dst + i * 8) = w; }
}
#ifdef PROBE_ATTN_ALPHA
#define PROBE_MGA(ws) ((bf16_t*)((ws) + 60 * MiB))
#else
#define PROBE_MGA(ws) ((bf16_t*)nullptr)
#endif
constexpr int LDS_BYTES = 147456;
constexpr int N_PHASES = 13;
constexpr int LDS_MISC = LDS_BYTES - 64;
__global__ void __launch_bounds__(NT_, 2) mega_fwd(Params p_arg) {
    extern __shared__ __attribute__((aligned(16))) unsigned char lds_raw[];
    const int wave_s = __builtin_amdgcn_readfirstlane((int)threadIdx.x >> 6);
    const int G_s = gridDim.x, bx_s = blockIdx.x, vcu_s = (G_s % 8 == 0) ? (bx_s % 8) * (G_s / 8) + bx_s / 8 : bx_s;
#define MKCTX() Ctx C; { unsigned m_ = ~0u; asm volatile("" : "+s"(m_)); C.lane = (int)__builtin_amdgcn_mbcnt_hi(m_, __builtin_amdgcn_mbcnt_lo(m_, 0u)); } \
    C.lds = (LAS unsigned char*)lds_raw; C.wave = wave_s; C.tid = wave_s * 64 + C.lane; C.G = G_s; C.vcu = vcu_s
    const int lo = p_arg.ph_lo, hi = p_arg.ph_hi;
#if defined(__HIP_DEVICE_COMPILE__)
#define LOADP() MKCTX(); typedef const __attribute__((address_space(4))) Params* CPP_; CPP_ kp_ = (CPP_)__builtin_amdgcn_kernarg_segment_ptr(); asm volatile("" : "+s"(kp_)); const Params p = *kp_; \
    unsigned char* ws = p.ws; const float* MOD = (const float*)(ws + CTL_MOD); (void)MOD
#else
#define LOADP() MKCTX(); const Params p = p_arg; unsigned char* ws = p.ws; const float* MOD = (const float*)(ws + CTL_MOD); (void)MOD
#endif
#ifndef PH_MASK
#define PH_MASK 0xffff
#endif
#define IN(k) (((PH_MASK >> (k)) & 1) && lo <= (k) && (k) < hi)
#ifndef P3DUP
#define P3DUP 0
#endif
#ifndef PROBE_REP
#define PROBE_REP -1
#endif
#define NREP(k) ((PROBE_REP == (k)) ? 2 : 1)
#define BAR_() do { LOADP(); XcdBarrier b_; b_.bar = (unsigned*)(ws + CTL_BAR); b_.x = xb_xcc_id(); b_.st = (volatile LAS unsigned*)(C.lds + LDS_MISC); xcd_barrier(b_, C.tid); } while (0)
#define SEAM(k) do { if (IN(k) && IN((k) + 1)) { LOADP(); XcdBarrier b_; b_.bar = (unsigned*)(ws + CTL_BAR); b_.x = xb_xcc_id(); b_.st = (volatile LAS unsigned*)(C.lds + LDS_MISC); xcd_barrier(b_, C.tid); } } while (0)
    if (hi - lo > 1) { LOADP(); if (C.tid < 2) ((volatile LAS unsigned*)(C.lds + LDS_MISC))[C.tid] = 0u; __syncthreads();
        (void)xcd_barrier_post((unsigned*)(ws + CTL_BAR), (volatile LAS unsigned*)(C.lds + LDS_MISC), C.tid); }
    for (int rep_ = 0; rep_ < NREP(0); ++rep_) if (IN(0)) { if (rep_) BAR_(); LOADP(); p0_prologue(p, C); } SEAM(0);
    for (int rep_ = 0; rep_ < NREP(1); ++rep_) if (IN(1)) { if (rep_) BAR_(); LOADP();
        bf16_t* H = (bf16_t*)(ws + WS_D);
        mod_norm_rows(C, p.x, SEQ, p.norm1_w, MOD, MOD + 2048, H);
        mod_norm_rows(C, p.x + (size_t)SEQ * DM, SEQ, p.norm1_w, MOD + 12288, MOD + 12288 + 2048, H + (size_t)SEQ * DM);
        mod_norm_rows(C, p.ctx, MC, p.norm1_w, MOD + 2 * 12288, MOD + 2 * 12288 + 2048, H + (size_t)ML * DM);
    } SEAM(1);
    for (int rep_ = 0; rep_ < NREP(2); ++rep_) if (IN(2)) { if (rep_) BAR_(); LOADP();
        pg8::Gemm g{(const bf16_t*)(ws + WS_D), (const bf16_t*)(ws + WS_C), M1, NIN_PAD, DM}; pg8::StaticOrder S; S.init(M1, NIN_PAD, C.G, (int)blockIdx.x);
        pg8::EpiIn E{(bf16_t*)(ws + WS_CQ), (bf16_t*)(ws + WS_CKV), (bf16_t*)(ws + WS_QKV), (bf16_t*)(ws + WS_Z), (bf16_t*)(ws + WS_GA), (bf16_t*)(ws + WS_GB),
                     (float*)(ws + WS_KR), (float*)(ws + WS_AB), (float*)(ws + CTL_SSQQ), (float*)(ws + CTL_SSQKV)};
        pg8::gemm_phase<pg8::EpiIn, pg8::StaticOrder, true, true>(C.lds, g, S, E, C.tid);
    } SEAM(2);
    for (int rep_ = 0; rep_ < NREP(3); ++rep_) if (IN(3)) { if (rep_) BAR_();
        for (int d_ = 0; d_ < (P3DUP == 1 ? 2 : 1); ++d_) { LOADP(); pg8::Gemm g{(const bf16_t*)(ws + WS_CQ), (const bf16_t*)(ws + WS_WUQ), ML, 1536, 512}; pg8::StaticOrder S; S.init(ML, 1536, C.G, (int)blockIdx.x);
          pg8::EpiQ E{(bf16_t*)(ws + WS_D), (const float*)(ws + CTL_SSQQ), QSCALE};
          pg8::gemm_phase<pg8::EpiQ, pg8::StaticOrder, true, true>(C.lds, g, S, E, C.tid); }
        for (int d_ = 0; d_ < (P3DUP == 2 ? 2 : 1); ++d_) { LOADP(); pg8::Gemm g{(const bf16_t*)(ws + WS_CKV), (const bf16_t*)(ws + WS_WUKV), M1, 2048, 256}; pg8::StaticOrder S; S.init(M1, 2048, C.G, (int)blockIdx.x);
          pg8::EpiKV E{(bf16_t*)(ws + WS_K), (bf16_t*)(ws + WS_C), (const float*)(ws + CTL_SSQKV)};
          pg8::gemm_phase<pg8::EpiKV, pg8::StaticOrder, true, true>(C.lds, g, S, E, C.tid); }
        for (int d_ = 0; d_ < (P3DUP == 3 ? 2 : 1); ++d_) { LOADP(); p3_conv(p, C); }
        for (int d_ = 0; d_ < (P3DUP == 4 ? 2 : 1); ++d_) { LOADP(); p3_krope_gbeta(p, C); }
    } SEAM(3);
    for (int rep_ = 0; rep_ < NREP(4); ++rep_) if (IN(4)) { if (rep_) BAR_(); LOADP();
        const bf16_t* Q = (const bf16_t*)(ws + WS_D); const bf16_t* K = (const bf16_t*)(ws + WS_K); const bf16_t* V = (const bf16_t*)(ws + WS_C); bf16_t* YA = (bf16_t*)(ws + WS_YA);
        for (int u = C.vcu; u < 512; u += C.G) { const int bh = u >> 5, qb = u & 31, b = bh >> 3, h = bh & 7;
            attn::attn_unit(Q + ((size_t)bh * SEQ + qb * 256) * 192, K + (size_t)bh * LKV * 192, V + (size_t)bh * LKV * 128,
                            YA + ((size_t)b * SEQ + qb * 256) * 1024 + h * 128, 1024, LKV, (char*)lds_raw, C.tid); }
    } SEAM(4);
    for (int rep_ = 0; rep_ < NREP(5); ++rep_) if (IN(5)) { if (rep_) BAR_(); LOADP(); p5_chunk_prep(p, C); } SEAM(5);
    for (int rep_ = 0; rep_ < NREP(6); ++rep_) if (IN(6)) { if (rep_) BAR_(); LOADP(); p6_scan(p, C); } SEAM(6);
    for (int rep_ = 0; rep_ < NREP(7); ++rep_) if (IN(7)) { if (rep_) BAR_(); LOADP(); p7_yb(p, C); } SEAM(7);
    for (int rep_ = 0; rep_ < NREP(8); ++rep_) if (IN(8)) { if (rep_) BAR_();
        { LOADP(); pg8::Gemm g{(const bf16_t*)(ws + WS_YA), (const bf16_t*)(ws + WS_WBA), ML, 2048, 1024}; pg8::StaticOrder S; S.init(ML, 2048, C.G, (int)blockIdx.x);
          pg8::EpiMerge<true> E{(const bf16_t*)(ws + WS_GA), (bf16_t*)(ws + WS_MG), PROBE_MGA(ws)};
          pg8::gemm_phase<pg8::EpiMerge<true>, pg8::StaticOrder, true, true>(C.lds, g, S, E, C.tid); }
        { LOADP(); pg8::Gemm g{(const bf16_t*)(ws + WS_YB), (const bf16_t*)(ws + WS_WBB), ML, 2048, 1024}; pg8::StaticOrder S; S.init(ML, 2048, C.G, (int)blockIdx.x);
          pg8::EpiMerge<false> E{(const bf16_t*)(ws + WS_GB), (bf16_t*)(ws + WS_MG), nullptr};
          pg8::gemm_phase<pg8::EpiMerge<false>, pg8::StaticOrder, true, true>(C.lds, g, S, E, C.tid); }
    } SEAM(8);
    for (int rep_ = 0; rep_ < NREP(9); ++rep_) if (IN(9)) { if (rep_) BAR_(); LOADP();
        pg8::Gemm g{(const bf16_t*)(ws + WS_MG), (const bf16_t*)(ws + WS_WOUT), ML, 2048, 2048}; pg8::StaticOrder S; S.init(ML, 2048, C.G, (int)blockIdx.x);
        pg8::EpiOut E{p.x, MOD + 4096, p.out};
        pg8::gemm_phase<pg8::EpiOut, pg8::StaticOrder, true, true>(C.lds, g, S, E, C.tid);
    } SEAM(9);
#ifdef PROBE_ATTN_ALPHA
    if (IN(9)) { BAR_(); LOADP();
        pg8::Gemm g{(const bf16_t*)(ws + 60 * MiB), (const bf16_t*)(ws + WS_WOUT), ML, 2048, 2048}; pg8::StaticOrder S; S.init(ML, 2048, C.G, (int)blockIdx.x);
        pg8::EpiDelta E{MOD + 4096, (bf16_t*)(ws + 124 * MiB)};
        pg8::gemm_phase<pg8::EpiDelta, pg8::StaticOrder, true, true>(C.lds, g, S, E, C.tid);
    }
#endif
    for (int rep_ = 0; rep_ < NREP(10); ++rep_) if (IN(10)) { if (rep_) BAR_(); LOADP();
        bf16_t* H2 = (bf16_t*)(ws + WS_H2);
        mod_norm_rows(C, p.out, SEQ, p.norm2_w, MOD + 6144, MOD + 8192, H2);
        mod_norm_rows(C, p.out + (size_t)SEQ * DM, SEQ, p.norm2_w, MOD + 12288 + 6144, MOD + 12288 + 8192, H2 + (size_t)SEQ * DM);
        cvt_fp8_rows(C, p.peer_u, ws + WS_UB, (float*)(ws + WS_USC), 16384);
        cvt_fp8_rows(C, p.peer_v, ws + WS_VB, (float*)(ws + WS_VSC), 16384);
    } SEAM(10);
    for (int rep_ = 0; rep_ < NREP(11); ++rep_) if (IN(11)) { if (rep_) BAR_(); LOADP();
        pg8::Gemm g{(const bf16_t*)(ws + WS_H2), (const bf16_t*)(ws + WS_WPQ), ML, 2048, 2048}; pg8::StaticOrder S; S.init(ML, 2048, C.G, (int)blockIdx.x);
        pg8::EpiScore E{(float*)(ws + WS_SC)};
        pg8::gemm_phase<pg8::EpiScore, pg8::StaticOrder, true, true>(C.lds, g, S, E, C.tid);
    } SEAM(11);
    for (int rep_ = 0; rep_ < NREP(12); ++rep_) if (IN(12)) { if (rep_) BAR_(); LOADP(); p12_peer(p, C, rep_ == NREP(12) - 1); }
#undef IN
#undef SEAM
}

#ifndef MK_SINGLE
#define MK_SINGLE 1
#endif
extern "C" void kernel_launch(void* const* d_in, const int* in_sizes, int n_in, void* d_out, int out_size, void* d_ws, size_t ws_size, hipStream_t stream) {
    static int grid = 0;
    if (grid == 0) {
        if (n_in != 25 || out_size != ML * DM || ws_size < WS_END) { fprintf(stderr, "kernel_launch: unexpected shapes: n_in %d out %d ws %zu (need %zu)\n", n_in, out_size, ws_size, (size_t)WS_END); grid = -1; return; }
        int dev = 0, cus = 0, per_cu = 0;
        if (hipGetDevice(&dev) != hipSuccess || hipDeviceGetAttribute(&cus, hipDeviceAttributeMultiprocessorCount, dev) != hipSuccess) { grid = -1; return; }
        if (hipFuncSetAttribute((const void*)mega_fwd, hipFuncAttributeMaxDynamicSharedMemorySize, LDS_BYTES) != hipSuccess) { fprintf(stderr, "kernel_launch: hipFuncSetAttribute failed\n"); grid = -1; return; }
        if (hipOccupancyMaxActiveBlocksPerMultiprocessor(&per_cu, (const void*)mega_fwd, NT_, LDS_BYTES) != hipSuccess || per_cu < 1) { fprintf(stderr, "kernel_launch: occupancy query says %d\n", per_cu); per_cu = 1; }
        (void)hipGetLastError();
        grid = cus;
    }
    if (grid < 0) return;
    (void)hipMemsetAsync((char*)d_ws + WS_CTL, 0, CTL_BYTES, stream);
    Params p{};
    const float** pp = (const float**)&p;
    for (int i = 0; i < 25; ++i) pp[i] = (const float*)d_in[i];
    p.out = (float*)d_out; p.ws = (unsigned char*)d_ws;
#if MK_SINGLE
    p.ph_lo = 0; p.ph_hi = N_PHASES;
    hipLaunchKernelGGL(mega_fwd, dim3(grid), dim3(NT_), LDS_BYTES, stream, p);
#else
    for (int ph = 0; ph < N_PHASES; ++ph) { p.ph_lo = ph; p.ph_hi = ph + 1; hipLaunchKernelGGL(mega_fwd, dim3(grid), dim3(NT_), LDS_BYTES, stream, p); }
#endif
}
```

```cpp
#include <hip/hip_runtime.h>
#include <hip/hip_bf16.h>
#include <cstdio>
#include <cstdint>
#include <cmath>
namespace pg8 {
#define PG8_LAS __attribute__((address_space(3)))
typedef unsigned short bf16_t;
typedef short bf16x8 __attribute__((ext_vector_type(8)));
typedef float f32x4 __attribute__((ext_vector_type(4)));
typedef unsigned u32x4 __attribute__((ext_vector_type(4)));
typedef unsigned u32x2 __attribute__((ext_vector_type(2)));
constexpr int BM = 256, BK = 64, HALF = 128, HTB = HALF * BK * 2  , STAGE_BYTES = 8 * HTB, NXCD = 8, WGM = 8;

__host__ __device__ __forceinline__ int lds_byte(int r, int c) { const int st = (r >> 4) * 2 + (c >> 5), rr = r & 15, cc = c & 31, ob = rr * 64 + cc * 2; return st * 1024 + (ob ^ (((ob >> 9) & 1) << 5)); }
__host__ __device__ __forceinline__ void stage_rc(int b, int& R, int& C) { const int st = b / 1024, sb = b % 1024, swz = sb ^ (((sb >> 9) & 1) << 5); R = (st >> 1) * 16 + swz / 64; C = (st & 1) * 32 + (swz % 64) / 2; }
__host__ __device__ __forceinline__ int perm32(int rho) { const int n = rho >> 4, i = rho & 15; return 8 * (i >> 2) + 4 * n + (i & 3); }

struct Unit { int pm, pn, half; };
struct Gemm { const bf16_t* A; const bf16_t* Bt; int M, N, K; const bf16_t* A2 = nullptr; const bf16_t* Bt2 = nullptr; };

struct StaticOrder {
    int nM, nN, nwg, G, c;
    __host__ __device__ void init(int M, int N, int G_, int c_) { nM = M / BM; nN = N / BM; nwg = nM * nN; G = G_; c = c_; }
    __host__ __device__ bool next(int i, Unit& u) const { return at((long)i * G + c, u); }
    __host__ __device__ bool at(const long L, Unit& u) const {
        if (L >= nwg) return false;
        int wgid = (int)L; { const int q = nwg / NXCD, r = nwg % NXCD, xcd = wgid % NXCD, off = wgid / NXCD; wgid = (xcd < r ? xcd * (q + 1) : r * (q + 1) + (xcd - r) * q) + off; }
        const int nig = WGM * nN, gid = wgid / nig, fm = gid * WGM, gsz = (nM - fm) < WGM ? (nM - fm) : WGM;
        u.pm = fm + ((wgid % nig) % gsz); u.pn = (wgid % nig) / gsz; return true;
    }
    __device__ __forceinline__ void a_ready(const Unit&) const {}
    __device__ __forceinline__ void done(const Unit&) const {}
};
struct KvOrder {
    StaticOrder base; int c;
    __host__ __device__ void init(int M, int N, int G_, int c_) { base.init(M, N, G_, c_); c = c_; }
    __host__ __device__ bool next(int i, Unit& u) const {
        if (base.G != 256 || base.nwg != 528) return base.next(i, u);
        if (c >= 128) return i < 3 ? base.at((long)(c - 128) + 128 * i, u) : false;
        if (i == 0) return base.at(384 + c, u);
        return (i == 1 && c < 16) ? base.at(512 + c, u) : false;
    }
    __device__ __forceinline__ void a_ready(const Unit&) const {}
    __device__ __forceinline__ void done(const Unit&) const {}
};
struct ChainOrder {
    StaticOrder base;
    __host__ __device__ void init(int M, int N, int G_, int c_) { base.init(M, N, G_, c_); }
    __host__ __device__ bool next(int i, Unit& u) const { if (!base.next(i >> 1, u)) return false; u.half = i & 1; return true; }
    __device__ __forceinline__ void a_ready(const Unit&) const {}
    __device__ __forceinline__ void done(const Unit&) const {}
};
typedef float f32x2 __attribute__((ext_vector_type(2)));
typedef __bf16 bf16x2_g __attribute__((ext_vector_type(2)));
__device__ __forceinline__ unsigned cvt_pk_bf16(float lo, float hi) { f32x2 v = {lo, hi}; bf16x2_g b = __builtin_convertvector(v, bf16x2_g); return __builtin_bit_cast(unsigned, b); }
template <class Epi, class Sched, bool ALIGN_EPI = false, bool SP2 = false>
__device__ __forceinline__ void gemm_phase(PG8_LAS unsigned char* lds, const Gemm g, const Sched& S, const Epi& E, const int tid) {
    const int wid = __builtin_amdgcn_readfirstlane(tid >> 6), lane = tid & 63, wr = wid >> 2, wc = wid & 3, fr = lane & 15, fq = lane >> 4;
    const int K = g.K, nt = K / BK;
    unsigned voffA[2], voffB[2];
#pragma unroll
    for (int i = 0; i < 2; ++i) { int R, C; stage_rc(tid * 16 + i * 8192, R, C); const int Rb = Epi::PERM ? ((R & ~31) + perm32(R & 31)) : R;
        voffA[i] = (unsigned)(R * K + C) * 2u; voffB[i] = (unsigned)(Rb * K + C) * 2u; }
    const size_t kstep = (size_t)(BK * 2);
    const size_t hstep = (size_t)HALF * K * 2;
    const size_t tstep = 2 * hstep;
    const unsigned ldsw = (unsigned)wid * 1024u;
    const int aoff = lds_byte(wr * 64 + fr, fq * 8), boff = lds_byte(wc * 32 + fr, fq * 8);
#define PG8_SA(b, h) (((b) * 2 + (h)) * HTB)
#define PG8_SB(b, h) ((4 + (b) * 2 + (h)) * HTB)
#define PG8_STAGE(bufoff, gbase, voff) do { _Pragma("unroll") for (int _i = 0; _i < 2; ++_i) \
        __builtin_amdgcn_global_load_lds((const unsigned*)((const char*)(gbase) + (voff)[_i]), (PG8_LAS unsigned*)(lds + (bufoff) + ldsw + _i * 8192), 16, 0, 0); } while (0)
#define PG8_LDA(dst, b, h) do { _Pragma("unroll") for (int m = 0; m < 4; ++m) _Pragma("unroll") for (int k = 0; k < 2; ++k) dst[m][k] = *(const PG8_LAS bf16x8*)(lds + PG8_SA(b, h) + aoff + m * 2048 + k * 1024); } while (0)
#define PG8_LDB(dst, b, h) do { _Pragma("unroll") for (int n = 0; n < 2; ++n) _Pragma("unroll") for (int k = 0; k < 2; ++k) dst[n][k] = *(const PG8_LAS bf16x8*)(lds + PG8_SB(b, h) + boff + n * 2048 + k * 1024); } while (0)
#define PG8_MMA(ai, bj, At, Bt) do { __builtin_amdgcn_s_setprio(1); _Pragma("unroll") for (int m = 0; m < 4; ++m) _Pragma("unroll") for (int n = 0; n < 2; ++n) _Pragma("unroll") for (int k = 0; k < 2; ++k) \
        acc[ai][bj][m][n] = __builtin_amdgcn_mfma_f32_16x16x32_bf16(Bt[n][k], At[m][k], acc[ai][bj][m][n], 0, 0, 0); __builtin_amdgcn_s_setprio(0); } while (0)
#define PG8_WAIT_V(n) asm volatile("s_waitcnt vmcnt(" #n ")" ::: "memory")
#define PG8_WAIT_L(n) asm volatile("s_waitcnt lgkmcnt(" #n ")" ::: "memory")
#define PG8_BAR __builtin_amdgcn_s_barrier()
#define PG8_SCHED __builtin_amdgcn_sched_barrier(0)
    Unit cur, nxt; int ui = 0;
    if (!S.next(0, cur)) return;
    f32x4 acc[2][2][4][2];
#pragma unroll
    for (int a = 0; a < 2; ++a)
#pragma unroll
        for (int b = 0; b < 2; ++b)
#pragma unroll
            for (int m = 0; m < 4; ++m)
#pragma unroll
                for (int n = 0; n < 2; ++n) acc[a][b][m][n] = (f32x4){0.f, 0.f, 0.f, 0.f};
    bf16x8 At[4][2], B0[2][2], B1[2][2];
    const char* cA; const char* cB;
    if constexpr (Epi::CHAIN) { cA = (const char*)(cur.half ? g.A2 : g.A) + (size_t)cur.pm * tstep; cB = (const char*)(cur.half ? g.Bt2 : g.Bt) + (size_t)cur.pn * tstep; }
    else { cA = (const char*)g.A + (size_t)cur.pm * tstep; cB = (const char*)g.Bt + (size_t)cur.pn * tstep; }
    S.a_ready(cur);
    if constexpr (SP2) {
        PG8_STAGE(PG8_SB(0, 0), cB, voffB); PG8_STAGE(PG8_SB(0, 1), cB + hstep, voffB); PG8_STAGE(PG8_SA(0, 0), cA, voffA); PG8_STAGE(PG8_SA(0, 1), cA + hstep, voffA);
        if (wr == 1) PG8_BAR;
        PG8_WAIT_V(2); PG8_BAR;
        PG8_STAGE(PG8_SB(1, 0), cB + kstep, voffB); PG8_STAGE(PG8_SA(1, 0), cA + kstep, voffA); PG8_STAGE(PG8_SB(1, 1), cB + hstep + kstep, voffB);
        PG8_WAIT_V(6); PG8_BAR;
    } else {
        PG8_STAGE(PG8_SB(0, 0), cB, voffB); PG8_STAGE(PG8_SA(0, 0), cA, voffA); PG8_STAGE(PG8_SB(0, 1), cB + hstep, voffB); PG8_STAGE(PG8_SA(0, 1), cA + hstep, voffA);
        if (wr == 1) PG8_BAR;
        PG8_WAIT_V(4); PG8_BAR;
        PG8_STAGE(PG8_SB(1, 0), cB + kstep, voffB); PG8_STAGE(PG8_SA(1, 0), cA + kstep, voffA); PG8_STAGE(PG8_SB(1, 1), cB + hstep + kstep, voffB);
        PG8_WAIT_V(6); PG8_BAR;
    }
    for (;;) {
        const bool has_next = S.next(ui + 1, nxt);
        const char* nA; const char* nB;
        if constexpr (Epi::CHAIN) { nA = has_next ? (const char*)(nxt.half ? g.A2 : g.A) + (size_t)nxt.pm * tstep : cA; nB = has_next ? (const char*)(nxt.half ? g.Bt2 : g.Bt) + (size_t)nxt.pn * tstep : cB; }
        else { nA = has_next ? (const char*)g.A + (size_t)nxt.pm * tstep : cA; nB = has_next ? (const char*)g.Bt + (size_t)nxt.pn * tstep : cB; }
        for (int t = 0; t < nt; t += 2) {
            const bool last = (t == nt - 2);
            const char* a1 = cA + (size_t)(t + 1) * kstep;
            const char* a2 = last ? nA : cA + (size_t)(t + 2) * kstep; const char* b2 = last ? nB : cB + (size_t)(t + 2) * kstep;
            const char* a3 = a2 + kstep; const char* b3 = b2 + kstep;
            if (last && has_next) S.a_ready(nxt);
            if constexpr (Epi::PREFETCH) E.prefetch(cur, t, tid, (PG8_LAS unsigned*)(lds + 131072 + wid * 256));
            if constexpr (SP2) {
            PG8_LDB(B0, 0, 0); PG8_LDB(B1, 0, 1); PG8_SCHED; PG8_LDA(At, 0, 0); PG8_STAGE(PG8_SA(1, 1), a1 + hstep, voffA);
            PG8_WAIT_V(8); PG8_WAIT_L(0); PG8_BAR; PG8_MMA(0, 0, At, B0); PG8_MMA(0, 1, At, B1); PG8_BAR; PG8_SCHED;
            PG8_LDA(At, 0, 1); PG8_STAGE(PG8_SB(0, 0), b2, voffB); PG8_STAGE(PG8_SB(0, 1), b2 + hstep, voffB); PG8_STAGE(PG8_SA(0, 0), a2, voffA);
            PG8_WAIT_V(8); PG8_WAIT_L(0); PG8_BAR; PG8_MMA(1, 0, At, B0); PG8_MMA(1, 1, At, B1); PG8_BAR; PG8_SCHED;
            PG8_LDB(B0, 1, 0); PG8_LDB(B1, 1, 1); PG8_SCHED; PG8_LDA(At, 1, 0); PG8_STAGE(PG8_SA(0, 1), a2 + hstep, voffA);
            PG8_WAIT_V(8); PG8_WAIT_L(0); PG8_BAR; PG8_MMA(0, 0, At, B0); PG8_MMA(0, 1, At, B1); PG8_BAR; PG8_SCHED;
            PG8_LDA(At, 1, 1); PG8_STAGE(PG8_SB(1, 0), b3, voffB); PG8_STAGE(PG8_SB(1, 1), b3 + hstep, voffB); PG8_STAGE(PG8_SA(1, 0), a3, voffA);
            PG8_WAIT_V(8); PG8_WAIT_L(0); PG8_BAR; PG8_MMA(1, 0, At, B0); PG8_MMA(1, 1, At, B1); PG8_BAR; PG8_SCHED;
            } else {
            PG8_LDB(B0, 0, 0); PG8_SCHED; PG8_LDA(At, 0, 0); PG8_STAGE(PG8_SA(1, 1), a1 + hstep, voffA);
            PG8_WAIT_L(8); PG8_BAR; PG8_WAIT_L(0); PG8_MMA(0, 0, At, B0); PG8_BAR; PG8_SCHED;
            PG8_LDB(B1, 0, 1); PG8_STAGE(PG8_SB(0, 0), b2, voffB);
            PG8_BAR; PG8_WAIT_L(0); PG8_MMA(0, 1, At, B1); PG8_BAR;
            PG8_LDA(At, 0, 1); PG8_STAGE(PG8_SA(0, 0), a2, voffA);
            PG8_BAR; PG8_WAIT_L(0); PG8_MMA(1, 0, At, B0); PG8_BAR; PG8_SCHED;
            PG8_STAGE(PG8_SB(0, 1), b2 + hstep, voffB);
            PG8_WAIT_V(6); PG8_BAR; PG8_MMA(1, 1, At, B1); PG8_BAR;
            PG8_LDB(B0, 1, 0); PG8_SCHED; PG8_LDA(At, 1, 0); PG8_STAGE(PG8_SA(0, 1), a2 + hstep, voffA);
            PG8_WAIT_L(8); PG8_BAR; PG8_WAIT_L(0); PG8_MMA(0, 0, At, B0); PG8_BAR; PG8_SCHED;
            PG8_LDB(B1, 1, 1); PG8_STAGE(PG8_SB(1, 0), b3, voffB);
            PG8_BAR; PG8_WAIT_L(0); PG8_MMA(0, 1, At, B1); PG8_BAR;
            PG8_LDA(At, 1, 1); PG8_STAGE(PG8_SA(1, 0), a3, voffA);
            PG8_BAR; PG8_WAIT_L(0); PG8_MMA(1, 0, At, B0); PG8_BAR; PG8_SCHED;
            PG8_STAGE(PG8_SB(1, 1), b3 + hstep, voffB);
            PG8_WAIT_V(6); PG8_BAR; PG8_MMA(1, 1, At, B1); PG8_BAR;
            }
        }
        if constexpr (ALIGN_EPI) { if (wr == 0) PG8_BAR; }
        if constexpr (!Epi::AFTER_DRAIN) { E(acc, cur, wr, wc, fr, fq); S.done(cur); }
        if (!has_next) break;
        if (!(Epi::CHAIN && cur.half == 0))
#pragma unroll
        for (int a = 0; a < 2; ++a)
#pragma unroll
            for (int b = 0; b < 2; ++b)
#pragma unroll
                for (int m = 0; m < 4; ++m)
#pragma unroll
                    for (int n = 0; n < 2; ++n) acc[a][b][m][n] = (f32x4){0.f, 0.f, 0.f, 0.f};
        cur = nxt; cA = nA; cB = nB; ++ui;
        if constexpr (ALIGN_EPI) { if (wr == 1) PG8_BAR; }
    }
    PG8_WAIT_V(0);
    if constexpr (!ALIGN_EPI) { if (wr == 0) PG8_BAR; }
    PG8_BAR;
    if constexpr (Epi::AFTER_DRAIN) { E.fused(acc, cur, wr, wc, fr, fq, lds, wid, lane); S.done(cur); }
#undef PG8_SA
#undef PG8_SB
#undef PG8_STAGE
#undef PG8_LDA
#undef PG8_LDB
#undef PG8_MMA
#undef PG8_WAIT_V
#undef PG8_WAIT_L
#undef PG8_BAR
#undef PG8_SCHED
}
__device__ __forceinline__ float bfu(unsigned short v) { return __uint_as_float(((unsigned)v) << 16); }
__device__ __forceinline__ void fast_sincos(float x, float& sn, float& cs) {
    float rev = x * 0.15915494309189535f; rev -= rintf(rev); sn = __builtin_amdgcn_sinf(rev); cs = __builtin_amdgcn_cosf(rev); }
__device__ __forceinline__ float sigm(float v) { return 1.0f / (1.0f + __expf(-v)); }
__device__ __forceinline__ void store_tile_bf16(const f32x4 (&acc)[2][2][4][2], bf16_t* tile  , int ld, int wr, int wc, int fr, int fq) {
#pragma unroll
    for (int ai = 0; ai < 2; ++ai)
#pragma unroll
        for (int m = 0; m < 4; ++m) { bf16_t* rowp = tile + (size_t)(ai * HALF + wr * 64 + m * 16 + fr) * ld + wc * 32 + 8 * fq;
#pragma unroll
            for (int bj = 0; bj < 2; ++bj) { const f32x4 v0 = acc[ai][bj][m][0], v1 = acc[ai][bj][m][1];
                u32x4 w; w.x = cvt_pk_bf16(v0[0], v0[1]); w.y = cvt_pk_bf16(v0[2], v0[3]); w.z = cvt_pk_bf16(v1[0], v1[1]); w.w = cvt_pk_bf16(v1[2], v1[3]);
                *(u32x4*)(rowp + bj * HALF) = w; } }
}
__device__ __forceinline__ void tile_ssq(const f32x4 (&acc)[2][2][4][2], float* ssq  , int nslot, int slot, int wr, int fr, int fq) {
#pragma unroll
    for (int ai = 0; ai < 2; ++ai)
#pragma unroll
        for (int m = 0; m < 4; ++m) { float s = 0.f;
#pragma unroll
            for (int bj = 0; bj < 2; ++bj)
#pragma unroll
                for (int n = 0; n < 2; ++n) { const f32x4 x = acc[ai][bj][m][n]; s += (x[0] * x[0] + x[1] * x[1]) + (x[2] * x[2] + x[3] * x[3]); }
            s += __shfl_xor(s, 16); s += __shfl_xor(s, 32);
            if (fq == 0) ssq[(size_t)(ai * HALF + wr * 64 + m * 16 + fr) * nslot + slot] = s; }
}
struct EpiIn {
    static constexpr bool PERM = true, AFTER_DRAIN = false, CHAIN = false, PREFETCH = false;
    bf16_t *CQ, *CKV, *QKV, *Z, *GA, *GB; float *KR, *AB, *ssq_q, *ssq_kv;
    __device__ __forceinline__ void operator()(const f32x4 (&acc)[2][2][4][2], const Unit& u, int wr, int wc, int fr, int fq) const {
        const int pn = u.pn, pm = u.pm; const size_t r0 = (size_t)pm * BM;
        const bool lat = pm < 64;
        if (pn == 35) {
            const int cl = wc * 32 + 8 * fq;
            if (cl < 96) {
#pragma unroll
                for (int ai = 0; ai < 2; ++ai)
#pragma unroll
                    for (int m = 0; m < 4; ++m) { const size_t r = r0 + ai * HALF + wr * 64 + m * 16 + fr;
                        float* dst = (cl < 64) ? (KR + r * 64 + cl) : (AB + r * 32 + (cl - 64));
                        *(f32x4*)dst = acc[ai][0][m][0]; *(f32x4*)(dst + 4) = acc[ai][0][m][1]; }
            }
            return;
        }
        bf16_t* base; int ld; bool latonly = true; float* ssq = nullptr; int nslot = 4, slot = wc;
        if (pn < 2) { base = CQ + pn * 256; ld = 512; ssq = ssq_q; nslot = 8; slot = pn * 4 + wc; }
        else if (pn == 2) { base = CKV; ld = 256; ssq = ssq_kv; latonly = false; }
        else if (pn < 15) { base = QKV + (pn - 3) * 256; ld = 3072; latonly = false; }
        else if (pn < 19) { base = Z + (pn - 15) * 256; ld = 1024; }
        else if (pn < 27) { base = GA + (pn - 19) * 256; ld = 2048; }
        else { base = GB + (pn - 27) * 256; ld = 2048; }
        if (latonly && !lat) return;
        store_tile_bf16(acc, base + r0 * ld, ld, wr, wc, fr, fq);
        if (ssq) tile_ssq(acc, ssq + r0 * nslot, nslot, slot, wr, fr, fq);
    }
};
struct EpiQ {
    static constexpr bool PERM = true, AFTER_DRAIN = false, CHAIN = false, PREFETCH = false;
    bf16_t* Q; const float* ssq_q; float qscale;
    __device__ __forceinline__ void operator()(const f32x4 (&acc)[2][2][4][2], const Unit& u, int wr, int wc, int fr, int fq) const {
        const int pn = u.pn;
#pragma unroll
        for (int ai = 0; ai < 2; ++ai)
#pragma unroll
            for (int m = 0; m < 4; ++m) {
                const int r = u.pm * BM + ai * HALF + wr * 64 + m * 16 + fr; const int b = r >> 13, t = r & 8191;
                const f32x4 sa = *(const f32x4*)(ssq_q + (size_t)r * 8), sb = *(const f32x4*)(ssq_q + (size_t)r * 8 + 4);
                const float rs = rsqrtf((((sa[0] + sa[1]) + (sa[2] + sa[3])) + ((sb[0] + sb[1]) + (sb[2] + sb[3]))) * (1.0f / 512.0f) + 1e-6f) * qscale;
#pragma unroll
                for (int bj = 0; bj < 2; ++bj) {
                    f32x4 v0 = acc[ai][bj][m][0] * rs, v1 = acc[ai][bj][m][1] * rs;
                    bf16_t* dst;
                    if (pn < 4) { const int head = pn * 2 + bj; dst = Q + ((size_t)(b * 8 + head) * 8192 + t) * 192 + wc * 32 + 8 * fq; }
                    else {
                        const int head = (pn - 4) * 4 + bj * 2 + (wc >> 1), half = wc & 1;
                        const float pos = (float)(half == 0 ? (t >> 6) : (t & 63));
                        const int i0 = (8 * fq) & 15;
                        float xs[8] = {v0[0], v0[1], v0[2], v0[3], v1[0], v1[1], v1[2], v1[3]};
#pragma unroll
                        for (int e = 0; e < 8; ++e) {
                            const float other = __shfl_xor(xs[e], 32);
                            const float invf = exp2f(-(float)(i0 + e) * (13.287712379549449f / 16.0f));
                            float sn, cs; fast_sincos(pos * invf, sn, cs);
                            xs[e] = (fq < 2) ? (xs[e] * cs - other * sn) : (other * sn + xs[e] * cs);
                        }
                        v0 = (f32x4){xs[0], xs[1], xs[2], xs[3]}; v1 = (f32x4){xs[4], xs[5], xs[6], xs[7]};
                        dst = Q + ((size_t)(b * 8 + head) * 8192 + t) * 192 + 128 + half * 32 + 8 * fq;
                    }
                    u32x4 w; w.x = cvt_pk_bf16(v0[0], v0[1]); w.y = cvt_pk_bf16(v0[2], v0[3]); w.z = cvt_pk_bf16(v1[0], v1[1]); w.w = cvt_pk_bf16(v1[2], v1[3]);
                    *(u32x4*)dst = w;
                }
            }
    }
};
struct EpiKV {
    static constexpr bool PERM = true, AFTER_DRAIN = false, CHAIN = false, PREFETCH = false;
    bf16_t *K, *V; const float* ssq_kv;
    __device__ __forceinline__ void operator()(const f32x4 (&acc)[2][2][4][2], const Unit& u, int wr, int wc, int fr, int fq) const {
        const int head = u.pn;
#pragma unroll
        for (int ai = 0; ai < 2; ++ai)
#pragma unroll
            for (int m = 0; m < 4; ++m) {
                const int r = u.pm * BM + ai * HALF + wr * 64 + m * 16 + fr;
                int b, l; if (r < 16384) { b = r >> 13; l = 256 + (r & 8191); } else { b = (r - 16384) >> 8; l = (r - 16384) & 255; }
                const f32x4 sa = *(const f32x4*)(ssq_kv + (size_t)r * 4);
                const float rs = rsqrtf(((sa[0] + sa[1]) + (sa[2] + sa[3])) * (1.0f / 256.0f) + 1e-6f);
                const size_t rowi = (size_t)(b * 8 + head) * 8448 + l;
#pragma unroll
                for (int bj = 0; bj < 2; ++bj) {
                    const f32x4 v0 = acc[ai][bj][m][0] * rs, v1 = acc[ai][bj][m][1] * rs;
                    bf16_t* dst = (bj == 0) ? (K + rowi * 192 + wc * 32 + 8 * fq) : (V + rowi * 128 + wc * 32 + 8 * fq);
                    u32x4 w; w.x = cvt_pk_bf16(v0[0], v0[1]); w.y = cvt_pk_bf16(v0[2], v0[3]); w.z = cvt_pk_bf16(v1[0], v1[1]); w.w = cvt_pk_bf16(v1[2], v1[3]);
                    *(u32x4*)dst = w;
                }
            }
    }
};
template <bool FIRST> struct EpiMerge {
    static constexpr bool PERM = true, AFTER_DRAIN = false, CHAIN = false, PREFETCH = false;
    const bf16_t* G; bf16_t* MG; bf16_t* MGA;
    __device__ __forceinline__ void operator()(const f32x4 (&acc)[2][2][4][2], const Unit& u, int wr, int wc, int fr, int fq) const {
#pragma unroll
        for (int ai = 0; ai < 2; ++ai) {
            u32x4 gq[4][2], pq[4][2];
#pragma unroll
            for (int m = 0; m < 4; ++m)
#pragma unroll
                for (int bj = 0; bj < 2; ++bj) { const size_t off = (size_t)(u.pm * BM + ai * HALF + wr * 64 + m * 16 + fr) * 2048 + u.pn * BM + wc * 32 + 8 * fq + bj * HALF;
                    gq[m][bj] = *(const u32x4*)(G + off); if (!FIRST) pq[m][bj] = *(const u32x4*)(MG + off); }
            asm volatile("" ::: "memory");
#pragma unroll
            for (int m = 0; m < 4; ++m)
#pragma unroll
                for (int bj = 0; bj < 2; ++bj) { const size_t off = (size_t)(u.pm * BM + ai * HALF + wr * 64 + m * 16 + fr) * 2048 + u.pn * BM + wc * 32 + 8 * fq + bj * HALF;
                    const u32x4 g = gq[m][bj];
                    float gv[8] = {__uint_as_float(g.x << 16), __uint_as_float(g.x & 0xffff0000u), __uint_as_float(g.y << 16), __uint_as_float(g.y & 0xffff0000u),
                                   __uint_as_float(g.z << 16), __uint_as_float(g.z & 0xffff0000u), __uint_as_float(g.w << 16), __uint_as_float(g.w & 0xffff0000u)};
                    float o[8];
#pragma unroll
                    for (int e2 = 0; e2 < 8; ++e2) o[e2] = sigm(gv[e2]) * acc[ai][bj][m][e2 >> 2][e2 & 3];
                    if (!FIRST) { const u32x4 p = pq[m][bj];
                        o[0] += __uint_as_float(p.x << 16); o[1] += __uint_as_float(p.x & 0xffff0000u); o[2] += __uint_as_float(p.y << 16); o[3] += __uint_as_float(p.y & 0xffff0000u);
                        o[4] += __uint_as_float(p.z << 16); o[5] += __uint_as_float(p.z & 0xffff0000u); o[6] += __uint_as_float(p.w << 16); o[7] += __uint_as_float(p.w & 0xffff0000u); }
                    u32x4 w; w.x = cvt_pk_bf16(o[0], o[1]); w.y = cvt_pk_bf16(o[2], o[3]); w.z = cvt_pk_bf16(o[4], o[5]); w.w = cvt_pk_bf16(o[6], o[7]);
                    *(u32x4*)(MG + off) = w;
                    if (FIRST && MGA) *(u32x4*)(MGA + off) = w;
                }
            asm volatile("" ::: "memory");
        }
    }
};
struct EpiMerge2 {
    static constexpr bool PERM = true, AFTER_DRAIN = false, CHAIN = true, PREFETCH = false;
    const bf16_t* GA; const bf16_t* GB; bf16_t* MG;
    __device__ __forceinline__ void prefetch(const Unit& u, int t, int tid, PG8_LAS unsigned* dump) const {
        if (u.half == 0 && t < 8) { const int it = t >> 1, line = (it & 1) * 512 + tid, row = line >> 2, seg = line & 3; const bf16_t* G = (it < 2) ? GA : GB;
            __builtin_amdgcn_global_load_lds((const unsigned*)(G + (size_t)(u.pm * BM + row) * 2048 + u.pn * BM + seg * 64), dump, 4, 0, 0); } }
    __device__ __forceinline__ void operator()(f32x4 (&acc)[2][2][4][2], const Unit& u, int wr, int wc, int fr, int fq) const {
#pragma unroll
        for (int ai = 0; ai < 2; ++ai) {
            u32x4 gq[4][2], hq[4][2];
#pragma unroll
            for (int m = 0; m < 4; ++m)
#pragma unroll
                for (int bj = 0; bj < 2; ++bj) { const size_t off = (size_t)(u.pm * BM + ai * HALF + wr * 64 + m * 16 + fr) * 2048 + u.pn * BM + wc * 32 + 8 * fq + bj * HALF;
                    hq[m][bj] = *(const u32x4*)(GB + off); if (u.half == 0) gq[m][bj] = *(const u32x4*)(GA + off); }
            asm volatile("" ::: "memory");
#pragma unroll
            for (int m = 0; m < 4; ++m)
#pragma unroll
                for (int bj = 0; bj < 2; ++bj) { const size_t off = (size_t)(u.pm * BM + ai * HALF + wr * 64 + m * 16 + fr) * 2048 + u.pn * BM + wc * 32 + 8 * fq + bj * HALF;
                    const u32x4 h = hq[m][bj];
                    float hv[8] = {__uint_as_float(h.x << 16), __uint_as_float(h.x & 0xffff0000u), __uint_as_float(h.y << 16), __uint_as_float(h.y & 0xffff0000u),
                                   __uint_as_float(h.z << 16), __uint_as_float(h.z & 0xffff0000u), __uint_as_float(h.w << 16), __uint_as_float(h.w & 0xffff0000u)};
                    float eb[8];
#pragma unroll
                    for (int e2 = 0; e2 < 8; ++e2) eb[e2] = 1.0f + __expf(-fmaxf(hv[e2], -30.0f));
                    if (u.half == 0) { const u32x4 g = gq[m][bj];
                        float gv[8] = {__uint_as_float(g.x << 16), __uint_as_float(g.x & 0xffff0000u), __uint_as_float(g.y << 16), __uint_as_float(g.y & 0xffff0000u),
                                       __uint_as_float(g.z << 16), __uint_as_float(g.z & 0xffff0000u), __uint_as_float(g.w << 16), __uint_as_float(g.w & 0xffff0000u)};
#pragma unroll
                        for (int e2 = 0; e2 < 8; ++e2) acc[ai][bj][m][e2 >> 2][e2 & 3] *= eb[e2] * __builtin_amdgcn_rcpf(1.0f + __expf(-gv[e2]));
                    } else { float o[8];
#pragma unroll
                        for (int e2 = 0; e2 < 8; ++e2) o[e2] = acc[ai][bj][m][e2 >> 2][e2 & 3] * __builtin_amdgcn_rcpf(eb[e2]);
                        u32x4 w; w.x = cvt_pk_bf16(o[0], o[1]); w.y = cvt_pk_bf16(o[2], o[3]); w.z = cvt_pk_bf16(o[4], o[5]); w.w = cvt_pk_bf16(o[6], o[7]);
                        *(u32x4*)(MG + off) = w; }
                }
            asm volatile("" ::: "memory");
        }
    }
};
struct EpiOut {
    static constexpr bool PERM = false, AFTER_DRAIN = false, CHAIN = false, PREFETCH = false;
    const float* X; const float* G1  ; float* X1;
    __device__ __forceinline__ void prefetch(const Unit& u, int t, int tid, PG8_LAS unsigned* dump) const {
        if (t < 8) { const int line = (t >> 1) * 512 + tid, row = line >> 3, seg = line & 7;
            __builtin_amdgcn_global_load_lds((const unsigned*)(X + (size_t)(u.pm * BM + row) * 2048 + u.pn * BM + seg * 32), dump, 4, 0, 0); } }
    __device__ __forceinline__ void operator()(const f32x4 (&acc)[2][2][4][2], const Unit& u, int wr, int wc, int fr, int fq) const {
        const int b = u.pm >> 5;
        const int col0 = u.pn * BM + wc * 32 + 4 * fq;
#pragma unroll
        for (int bj = 0; bj < 2; ++bj)
#pragma unroll
            for (int n = 0; n < 2; ++n) { const int c = col0 + bj * HALF + n * 16; const f32x4 g = *(const f32x4*)(G1 + b * 12288 + c);
                f32x4 xv[2][4];
#pragma unroll
                for (int ai = 0; ai < 2; ++ai)
#pragma unroll
                    for (int m = 0; m < 4; ++m) xv[ai][m] = *(const f32x4*)(X + (size_t)(u.pm * BM + ai * HALF + wr * 64 + m * 16 + fr) * 2048 + c);
                asm volatile("" ::: "memory");
#pragma unroll
                for (int ai = 0; ai < 2; ++ai)
#pragma unroll
                    for (int m = 0; m < 4; ++m) *(f32x4*)(X1 + (size_t)(u.pm * BM + ai * HALF + wr * 64 + m * 16 + fr) * 2048 + c) = xv[ai][m] + g * acc[ai][bj][m][n];
                asm volatile("" ::: "memory"); }
    }
};
struct EpiDelta {
    static constexpr bool PERM = true, AFTER_DRAIN = false, CHAIN = false, PREFETCH = false;
    const float* G1; bf16_t* DA;
    __device__ __forceinline__ void operator()(const f32x4 (&acc)[2][2][4][2], const Unit& u, int wr, int wc, int fr, int fq) const {
        const int b = u.pm >> 5;
#pragma unroll
        for (int ai = 0; ai < 2; ++ai)
#pragma unroll
            for (int m = 0; m < 4; ++m) {
                const size_t off = (size_t)(u.pm * BM + ai * HALF + wr * 64 + m * 16 + fr) * 2048 + u.pn * BM + wc * 32 + 8 * fq;
#pragma unroll
                for (int bj = 0; bj < 2; ++bj) { const int c = u.pn * BM + wc * 32 + 8 * fq + bj * HALF;
                    const f32x4 g0 = *(const f32x4*)(G1 + b * 12288 + c), g1v = *(const f32x4*)(G1 + b * 12288 + c + 4);
                    const f32x4 v0 = acc[ai][bj][m][0] * g0, v1 = acc[ai][bj][m][1] * g1v;
                    u32x4 w; w.x = cvt_pk_bf16(v0[0], v0[1]); w.y = cvt_pk_bf16(v0[2], v0[3]); w.z = cvt_pk_bf16(v1[0], v1[1]); w.w = cvt_pk_bf16(v1[2], v1[3]);
                    *(u32x4*)(DA + off + bj * HALF) = w; }
            }
    }
};
struct EpiScore {
    static constexpr bool PERM = false, AFTER_DRAIN = false, CHAIN = false, PREFETCH = false;
    float* SC;
    __device__ __forceinline__ void operator()(const f32x4 (&acc)[2][2][4][2], const Unit& u, int wr, int wc, int fr, int fq) const {
        const int col0 = u.pn * BM + wc * 32 + 4 * fq;
#pragma unroll
        for (int ai = 0; ai < 2; ++ai)
#pragma unroll
            for (int m = 0; m < 4; ++m) { const size_t off = (size_t)(u.pm * BM + ai * HALF + wr * 64 + m * 16 + fr) * 2048 + col0;
#pragma unroll
                for (int bj = 0; bj < 2; ++bj)
#pragma unroll
                    for (int n = 0; n < 2; ++n) *(f32x4*)(SC + off + bj * HALF + n * 16) = acc[ai][bj][m][n]; }
    }
};
}
namespace attn {
using bf16x8 = __attribute__((ext_vector_type(8))) short;
using s16x4  = __attribute__((ext_vector_type(4))) short;
using f32x16 = __attribute__((ext_vector_type(16))) float;
using u32x4  = __attribute__((ext_vector_type(4))) unsigned;
typedef unsigned short bf16_t;
constexpr int DQK = 192, DV = 128, NW = 8, QBLK = 32, KVBLK = 64;
constexpr int SHM_V = KVBLK * DV * 2  , SHM_K = KVBLK * DQK * 2  , SHM_QR = 2 * SHM_V + 2 * SHM_K + NW * 64 * 4, SHM_ATTN = SHM_QR + NW * 4096;
constexpr float THR = 8.0f;
#define KSWZ(row, colB) ((row) * 384 + ((colB) ^ (((row) & 7) << 4)))
#define SBAR() __builtin_amdgcn_sched_barrier(0)
__device__ __forceinline__ int crow(int r, int hi) { return (r & 3) + 8 * (r >> 2) + 4 * hi; }
__device__ __forceinline__ unsigned cvtpk(float lo, float hi) { unsigned r; asm volatile("v_cvt_pk_bf16_f32 %0, %1, %2" : "=v"(r) : "v"(lo), "v"(hi)); return r; }
__device__ __forceinline__ void partialSM(f32x16& p0, f32x16& p1, float& m_reg, float& mn, float& alpha) {
  float pmax = p0[0];
#pragma unroll
  for (int r = 1; r < 16; ++r) pmax = fmaxf(pmax, p0[r]);
#pragma unroll
  for (int r = 0; r < 16; ++r) pmax = fmaxf(pmax, p1[r]);
  { auto rr = __builtin_amdgcn_permlane32_swap(__float_as_uint(pmax), __float_as_uint(pmax), false, false);
    pmax = fmaxf(__uint_as_float(rr[0]), __uint_as_float(rr[1])); }
  if (__builtin_expect(__all(pmax - m_reg <= THR), 1)) { mn = m_reg; alpha = 1.f; }
  else { mn = fmaxf(m_reg, pmax); alpha = __builtin_amdgcn_exp2f(m_reg - mn); m_reg = mn; }
#pragma unroll
  for (int r = 0; r < 16; ++r) p0[r] = p0[r] - mn;
#pragma unroll
  for (int r = 0; r < 16; ++r) p1[r] = p1[r] - mn;
#pragma unroll
  for (int r = 0; r < 16; ++r) p0[r] = __builtin_amdgcn_exp2f(p0[r]);
}
__device__ __forceinline__ void finishSM(f32x16& p0, f32x16& p1, float alpha, float& l_reg, bf16x8& pa0, bf16x8& pa1, bf16x8& pa2, bf16x8& pa3) {
#pragma unroll
  for (int r = 0; r < 16; ++r) p1[r] = __builtin_amdgcn_exp2f(p1[r]);
  float ps = 0;
#pragma unroll
  for (int r = 0; r < 16; ++r) ps += p0[r];
#pragma unroll
  for (int r = 0; r < 16; ++r) ps += p1[r];
  { auto rr = __builtin_amdgcn_permlane32_swap(__float_as_uint(ps), __float_as_uint(ps), false, false);
    ps = __uint_as_float(rr[0]) + __uint_as_float(rr[1]); }
  l_reg = l_reg * alpha + ps;
#define PK4(P, BASE, OUT) do { unsigned a0 = cvtpk(P[BASE + 0], P[BASE + 1]), a1 = cvtpk(P[BASE + 2], P[BASE + 3]);   \
    unsigned b0 = cvtpk(P[BASE + 4], P[BASE + 5]), b1 = cvtpk(P[BASE + 6], P[BASE + 7]);                              \
    auto r0 = __builtin_amdgcn_permlane32_swap(a0, b0, false, false); auto r1 = __builtin_amdgcn_permlane32_swap(a1, b1, false, false); \
    u32x4 w = {r0[0], r1[0], r0[1], r1[1]}; OUT = *reinterpret_cast<bf16x8*>(&w); } while (0)
  PK4(p0, 0, pa0); PK4(p0, 8, pa1); PK4(p1, 0, pa2); PK4(p1, 8, pa3);
#undef PK4
}
__device__ __forceinline__ void qkt(f32x16& p0, f32x16& p1, const char* Ks, const bf16x8* qr, const char* qrow, int qx, int r32, int hi) {
  p0 = f32x16{}; p1 = f32x16{};
#pragma unroll
  for (int d0 = 0; d0 < 12; ++d0) { const int cb = (d0 * 16 + hi * 8) * 2;
    bf16x8 b0 = *reinterpret_cast<const bf16x8*>(Ks + KSWZ(r32, cb));
    bf16x8 b1 = *reinterpret_cast<const bf16x8*>(Ks + KSWZ(32 + r32, cb));
    const bf16x8 q = (d0 < 8) ? qr[d0 < 8 ? d0 : 0] : *reinterpret_cast<const bf16x8*>(qrow + (qx ^ ((d0 - 8) << 5)));
    p0 = __builtin_amdgcn_mfma_f32_32x32x16_bf16(b0, q, p0, 0, 0, 0);
    p1 = __builtin_amdgcn_mfma_f32_32x32x16_bf16(b1, q, p1, 0, 0, 0); }
}
__device__ __forceinline__ int v_st(int k, int c) { const int kk = (k & ~0xC) | ((k & 4) << 1) | ((k & 8) >> 1); return ((kk >> 3) * 4 + (c >> 5)) * 512 + ((kk & 7) * 32 + (c & 31)) * 2; }
__device__ __forceinline__ int v_rd_base(int lane) { return ((lane & 3) << 3) | (((lane >> 2) & 3) << 6) | (((lane >> 4) & 1) << 5) | (((lane >> 5) & 1) << 8); }
constexpr int v_rd_off(int d0, int ks, int half) { return d0 * 512 + ks * 4096 + half * 2048; }
template <int OFF> __device__ __forceinline__ s16x4 tr_read(int vb) {
  s16x4 r; asm volatile("ds_read_b64_tr_b16 %0, %1 offset:%2" : "=&v"(r) : "v"(vb), "i"(OFF) : "memory"); return r;
}
template <int D0> __device__ __forceinline__ void pv_one(f32x16& od, int vb, bf16x8 pa0, bf16x8 pa1, bf16x8 pa2, bf16x8 pa3) {
  const s16x4 l0 = tr_read<v_rd_off(D0, 0, 0)>(vb), h0 = tr_read<v_rd_off(D0, 0, 1)>(vb), l1 = tr_read<v_rd_off(D0, 1, 0)>(vb), h1 = tr_read<v_rd_off(D0, 1, 1)>(vb);
  const s16x4 l2 = tr_read<v_rd_off(D0, 2, 0)>(vb), h2 = tr_read<v_rd_off(D0, 2, 1)>(vb), l3 = tr_read<v_rd_off(D0, 3, 0)>(vb), h3 = tr_read<v_rd_off(D0, 3, 1)>(vb);
  asm volatile("s_waitcnt lgkmcnt(0)" ::: "memory"); SBAR();
#define PK(L, H) (bf16x8){L[0], L[1], L[2], L[3], H[0], H[1], H[2], H[3]}
  od = __builtin_amdgcn_mfma_f32_32x32x16_bf16(pa0, PK(l0, h0), od, 0, 0, 0);
  od = __builtin_amdgcn_mfma_f32_32x32x16_bf16(pa1, PK(l1, h1), od, 0, 0, 0);
  od = __builtin_amdgcn_mfma_f32_32x32x16_bf16(pa2, PK(l2, h2), od, 0, 0, 0);
  od = __builtin_amdgcn_mfma_f32_32x32x16_bf16(pa3, PK(l3, h3), od, 0, 0, 0);
#undef PK
}
__device__ __forceinline__ void pv_d0(f32x16* o, int vb, bf16x8 pa0, bf16x8 pa1, bf16x8 pa2, bf16x8 pa3) {
  pv_one<0>(o[0], vb, pa0, pa1, pa2, pa3); pv_one<1>(o[1], vb, pa0, pa1, pa2, pa3); pv_one<2>(o[2], vb, pa0, pa1, pa2, pa3); pv_one<3>(o[3], vb, pa0, pa1, pa2, pa3);
}
__device__ __forceinline__ void attn_unit(const bf16_t* __restrict__ Qb, const bf16_t* __restrict__ Kh, const bf16_t* __restrict__ Vh, bf16_t* __restrict__ Ob, int ldo, int seq, char* lds, int tid_in) {
  int tid_ = tid_in; asm volatile("" : "+v"(tid_));
  const int tid = tid_, wid = tid >> 6, lane = tid & 63, r32 = lane & 31, hi = lane >> 5;
  char* V_lds = lds; char* K_lds = lds + 2 * SHM_V;
  float* ws = (float*)(lds + 2 * SHM_V + 2 * SHM_K) + wid * 64; float* li_l = ws; float* al_l = ws + 32;
  float m_reg = -1e30f, l_reg = 0; f32x16 o[4] = {}; bf16x8 qr[8];
  const bf16_t* Qw = Qb + (long)(wid * QBLK + r32) * DQK + hi * 8;
#pragma unroll
  for (int d0 = 0; d0 < 8; ++d0) qr[d0] = *reinterpret_cast<const bf16x8*>(Qw + d0 * 16);
  char* qrow = lds + SHM_QR + wid * 4096 + r32 * 128; const int qx = (hi ^ (r32 & 7)) << 4;
#pragma unroll
  for (int d0 = 8; d0 < 12; ++d0) *reinterpret_cast<bf16x8*>(qrow + (qx ^ ((d0 - 8) << 5))) = *reinterpret_cast<const bf16x8*>(Qw + d0 * 16);
  const int sr = tid >> 4, sc = (tid & 15) * 8, vst0 = v_st(sr, sc); constexpr int vst1d = 8192;
  unsigned kgo[3], klo[3];
#pragma unroll
  for (int i = 0; i < 3; ++i) { const int id = tid + 512 * i, kr_ = id / 24, kc_ = (id % 24) * 16; kgo[i] = (unsigned)(kr_ * 384 + kc_); klo[i] = (unsigned)KSWZ(kr_, kc_); }
  const unsigned vgo0 = (unsigned)((sr * DV + sc) * 2); constexpr unsigned vgo1d = 32 * DV * 2;
  const int vb0 = (int)(uintptr_t)V_lds + v_rd_base(lane);
  bf16x8 vs0, vs1, ks0, ks1, ks2;
#define SLOAD(k0) do { const char* Kt_ = (const char*)Kh + (size_t)(k0) * (DQK * 2); const char* Vt_ = (const char*)Vh + (size_t)(k0) * (DV * 2); \
    vs0 = *reinterpret_cast<const bf16x8*>(Vt_ + vgo0); vs1 = *reinterpret_cast<const bf16x8*>(Vt_ + vgo0 + vgo1d); \
    ks0 = *reinterpret_cast<const bf16x8*>(Kt_ + kgo[0]); ks1 = *reinterpret_cast<const bf16x8*>(Kt_ + kgo[1]); ks2 = *reinterpret_cast<const bf16x8*>(Kt_ + kgo[2]); } while (0)
#define SWRITE(b) do { *(bf16x8*)(V_lds + (b) * SHM_V + vst0) = vs0; *(bf16x8*)(V_lds + (b) * SHM_V + vst0 + vst1d) = vs1; \
    *(bf16x8*)(K_lds + (b) * SHM_K + klo[0]) = ks0; *(bf16x8*)(K_lds + (b) * SHM_K + klo[1]) = ks1; *(bf16x8*)(K_lds + (b) * SHM_K + klo[2]) = ks2; } while (0)
#define RESC(a) do { if (__any((a) < 1.f)) { if (hi == 0) al_l[r32] = (a); asm volatile("s_waitcnt lgkmcnt(0)" ::: "memory"); \
    _Pragma("unroll") for (int d = 0; d < 4; ++d) _Pragma("unroll") for (int r = 0; r < 16; ++r) o[d][r] *= al_l[crow(r, hi)]; } } while (0)
  f32x16 pA0, pA1, pB0, pB1; float mnA, mnB, alA, alB; bf16x8 pa0, pa1, pa2, pa3; const int NT = seq / KVBLK;
  SLOAD(0); SWRITE(0); __syncthreads();
  qkt(pA0, pA1, K_lds, qr, qrow, qx, r32, hi); partialSM(pA0, pA1, m_reg, mnA, alA);
  SLOAD(KVBLK);
  SWRITE(1); __syncthreads();
  for (int j = 1; j + 1 < NT; j += 2) {
    SBAR(); qkt(pB0, pB1, K_lds + SHM_K, qr, qrow, qx, r32, hi);
    finishSM(pA0, pA1, alA, l_reg, pa0, pa1, pa2, pa3); SBAR();
    SLOAD((j + 1) * KVBLK); SBAR();
    pv_d0(o, vb0, pa0, pa1, pa2, pa3); partialSM(pB0, pB1, m_reg, mnB, alB);
    __syncthreads(); SWRITE(0);
    RESC(alB); __syncthreads();
    SBAR(); qkt(pA0, pA1, K_lds, qr, qrow, qx, r32, hi);
    finishSM(pB0, pB1, alB, l_reg, pa0, pa1, pa2, pa3); SBAR();
    SLOAD((j + 2) * KVBLK); SBAR();
    pv_d0(o, vb0 + SHM_V, pa0, pa1, pa2, pa3); partialSM(pA0, pA1, m_reg, mnA, alA);
    __syncthreads(); SWRITE(1);
    RESC(alA); __syncthreads();
  }
  SBAR(); qkt(pB0, pB1, K_lds + SHM_K, qr, qrow, qx, r32, hi);
  finishSM(pA0, pA1, alA, l_reg, pa0, pa1, pa2, pa3); SBAR();
  pv_d0(o, vb0, pa0, pa1, pa2, pa3); partialSM(pB0, pB1, m_reg, mnB, alB);
  __syncthreads(); RESC(alB);
  finishSM(pB0, pB1, alB, l_reg, pa0, pa1, pa2, pa3); SBAR();
  pv_d0(o, vb0 + SHM_V, pa0, pa1, pa2, pa3);
  if (hi == 0) li_l[r32] = l_reg; asm volatile("s_waitcnt lgkmcnt(0)" ::: "memory");
  float rli[16];
#pragma unroll
  for (int r = 0; r < 16; ++r) rli[r] = __builtin_amdgcn_rcpf(li_l[crow(r, hi)]);
  { int t2 = tid_in; asm volatile("" : "+v"(t2));
    const int w2 = t2 >> 6, l2 = t2 & 63, c2 = l2 & 31, h2 = l2 >> 5;
    bf16_t* Ow = Ob + (unsigned)((w2 * QBLK + 4 * h2) * ldo + c2);
#pragma unroll
    for (int r = 0; r < 16; ++r) { const unsigned ro = (unsigned)(((r & 3) + 8 * (r >> 2)) * ldo);
#pragma unroll
      for (int d0 = 0; d0 < 4; ++d0) { const float v = o[d0][r] * rli[r]; Ow[ro + d0 * 32] = (bf16_t)(cvtpk(v, v) & 0xffffu); } } }
  __syncthreads();
#undef SLOAD
#undef SWRITE
#undef RESC
}
#undef KSWZ
#undef SBAR
}
#define GAS __attribute__((address_space(1)))
#define LAS __attribute__((address_space(3)))
typedef unsigned short bf16_t;
typedef unsigned v4u __attribute__((ext_vector_type(4)));
typedef unsigned v2u __attribute__((ext_vector_type(2)));
typedef float f32x4 __attribute__((ext_vector_type(4)));
typedef short bf16x8 __attribute__((ext_vector_type(8)));
constexpr int NT_ = 512;
constexpr int BATCH = 2, SEQ = 8192, DM = 2048, CTXL = 256;
constexpr int ML = BATCH * SEQ  , MC = BATCH * CTXL  , M1 = ML + MC  ;
constexpr int NIN_PAD = 9216;
constexpr int LKV = CTXL + SEQ;
constexpr int NCH = 132;
constexpr float EPS = 1e-6f;
constexpr float QSCALE = 0.07216878364870322f * 1.4426950408889634f;
constexpr size_t MiB = 1u << 20;
constexpr size_t WS_CTL = 0, CTL_BYTES = 128 * 1024;
#ifndef PROBE_TS
#define PROBE_TS -1
#endif
#ifndef PROBE_SCALE
#define PROBE_SCALE 1e-4f
#endif
constexpr size_t CTL_TS = 65536;
constexpr size_t CTL_XQ = 32768;
constexpr size_t CTL_BAR = 4096;
static_assert(CTL_BAR + 3456 * 4 <= CTL_XQ && CTL_XQ + 8 * 256 <= CTL_TS && CTL_TS + 1024 + 1024 <= CTL_BYTES, "ctl");
constexpr size_t WS_WUQ = 1 * MiB, WS_WUKV = WS_WUQ + 1536 * 512 * 2, WS_WBA = WS_WUKV + 2048 * 256 * 2, WS_WBB = WS_WBA + 4 * MiB, WS_WOUT = WS_WBB + 4 * MiB, WS_WPQ = WS_WOUT + 8 * MiB;
static_assert(WS_WPQ + 8 * MiB <= 28 * MiB, "small weights");
constexpr size_t WS_C = 28 * MiB;
constexpr size_t WS_D = 66 * MiB;
constexpr size_t WS_E1 = 132 * MiB;
constexpr size_t WS_CQ = WS_E1, WS_CKV = WS_CQ + 16 * MiB, WS_KR = WS_CKV + (size_t)M1 * 256 * 2, WS_AB = WS_KR + (size_t)M1 * 64 * 4;
static_assert(WS_AB + (size_t)M1 * 32 * 4 <= 164 * MiB, "E1");
constexpr size_t WS_Z = 164 * MiB, WS_GA = 196 * MiB, WS_GB = 260 * MiB;
constexpr size_t WS_QKV = 324 * MiB;
constexpr size_t WS_K = 423 * MiB;
constexpr size_t WS_DNQ = 473 * MiB;
constexpr size_t WS_GBETA = 572 * MiB;
constexpr size_t WS_EG = 61 * MiB;
constexpr size_t CTL_MOD = 27 * MiB + 512 * 1024;
constexpr size_t CTL_SSQQ = 64 * MiB, CTL_SSQKV = CTL_SSQQ + (size_t)16384 * 8 * 4;
static_assert(CTL_SSQKV + (size_t)16896 * 4 * 4 <= 66 * MiB && CTL_MOD + 3 * 12288 * 4 <= 28 * MiB && WS_WPQ + 8 * MiB <= CTL_MOD, "mod/ssq");
constexpr size_t WS_XB = WS_D;
constexpr size_t WS_W = WS_QKV, WS_U = WS_QKV + 66 * MiB, WS_ATT = WS_C, WS_OF = WS_D, WS_OB = WS_D + 32 * MiB, WS_YA = WS_E1, WS_YB = WS_C;
constexpr size_t WS_MG = 324 * MiB, WS_H2 = 388 * MiB, WS_UB = 574 * MiB + 512 * 1024  , WS_VB = 484 * MiB, WS_USC = WS_UB + 32 * MiB, WS_VSC = 517 * MiB, WS_SC = 196 * MiB, WS_END = 607 * MiB;
static_assert(WS_EG + (size_t)4224 * 132 * 4 <= 64 * MiB && WS_USC + 16384 * 4 <= WS_END && WS_GBETA + (size_t)4 * M1 * 8 * 4 <= WS_UB && WS_K + (size_t)16 * LKV * 192 * 2 <= WS_DNQ && WS_DNQ + (size_t)M1 * 3072 * 2 <= WS_GBETA, "ws map");

__device__ __forceinline__ unsigned f2bf(float f) { unsigned u = __builtin_bit_cast(unsigned, f); return (u + 0x7fffu + ((u >> 16) & 1u)) >> 16; }
typedef float f32x2_c __attribute__((ext_vector_type(2))); typedef __bf16 bf16x2_c __attribute__((ext_vector_type(2)));
__device__ __forceinline__ unsigned pk2(float lo, float hi) { f32x2_c v = {lo, hi}; bf16x2_c b = __builtin_convertvector(v, bf16x2_c); return __builtin_bit_cast(unsigned, b); }
__device__ __forceinline__ float bflo(unsigned w) { return __uint_as_float(w << 16); }
__device__ __forceinline__ float bfhi(unsigned w) { return __uint_as_float(w & 0xffff0000u); }
__device__ __forceinline__ float wave_sum(float v) {
#pragma unroll
    for (int o = 1; o < 64; o <<= 1) v += __shfl_xor(v, o);
    return v;
}
__device__ __forceinline__ float siluf(float v) { return v / (1.0f + __expf(-v)); }

struct Params {
    const float *x, *c, *ctx, *c_ctx, *w_mod, *b_mod, *norm1_w, *w_in, *qn_w, *kvn_w, *w_uq, *w_ukv, *conv_w, *a_log, *dt_bias, *dn_norm_w,
                *w_ba, *w_bb, *w_out, *norm2_w, *peer_wq, *sub_keys, *peer_u, *peer_v, *final_w;
    float* out; unsigned char* ws;
    int ph_lo, ph_hi;
};
#define XB_TMO      128
#define XB_XCNT(j)  (256  + 64 * (j))
#define XB_XSUB(j)  (1280 + 64 * (j))
#define XB_XGEN(j)  (2304 + 64 * (j))
#define XB_TOP      3328
#define XB_TOPGEN   3392
#define XCD_BAR_WORDS 3456
#define XB_SPIN_CAP (1u << 18)

__device__ __forceinline__ unsigned xb_ld(unsigned* p)              { return __hip_atomic_load(p, __ATOMIC_RELAXED, __HIP_MEMORY_SCOPE_AGENT); }
__device__ __forceinline__ unsigned xb_add(unsigned* p, unsigned v) { return __hip_atomic_fetch_add(p, v, __ATOMIC_RELAXED, __HIP_MEMORY_SCOPE_AGENT); }
__device__ __forceinline__ unsigned xb_xcc_id() { return (unsigned)__builtin_amdgcn_s_getreg((3 << 11) | 20) & 0xFu; }
#define XB_SPIN(cond, bar) do { unsigned _sp = 0; while (cond) { __builtin_amdgcn_s_sleep(1); \
    if ((++_sp & 255u) == 0u) { if (xb_ld(&(bar)[XB_TMO])) break; if (_sp > XB_SPIN_CAP) { atomicAdd(&(bar)[XB_TMO], 1u); break; } } } } while (0)

struct XcdBarrier {
    unsigned* bar; unsigned x;
    volatile LAS unsigned* st;
};

__device__ __forceinline__ XcdBarrier xcd_barrier_post(unsigned* bar, volatile LAS unsigned* st, int tid) {
    XcdBarrier b; b.bar = bar; b.x = xb_xcc_id(); b.st = st;
    if (tid == 0) (void)xb_add(&bar[XB_XCNT(b.x)], 1u);
    return b;
}
__device__ __forceinline__ void xcd_barrier_complete(unsigned* bar, unsigned x, unsigned& nloc, unsigned& nx) {
    const unsigned G = gridDim.x * gridDim.y * gridDim.z;
    unsigned sum, cnt, mine, sp = 0u;
    for (;;) {
        sum = 0u; cnt = 0u; mine = 0u;
#pragma unroll
        for (unsigned j = 0; j < 16; ++j) { const unsigned c = xb_ld(&bar[XB_XCNT(j)]); sum += c; cnt += (c > 0u) ? 1u : 0u; mine = (j == x) ? c : mine; }
        if (sum == G) break;
        __builtin_amdgcn_s_sleep(1);
        if ((++sp & 255u) == 0u) { if (xb_ld(&bar[XB_TMO])) break; if (sp > XB_SPIN_CAP) { atomicAdd(&bar[XB_TMO], 1u); break; } }
    }
    nloc = mine > 0u ? mine : 1u; nx = cnt > 0u ? cnt : 1u;
}

__device__ __forceinline__ void xcd_barrier(const XcdBarrier& b, int tid) {
    asm volatile("s_waitcnt vmcnt(0)" ::: "memory");
    __syncthreads();
    if (tid == 0) {
        unsigned* bar = b.bar;
        __builtin_amdgcn_s_waitcnt(0);
        unsigned nloc = b.st[0], nx = b.st[1];
        if (nloc == 0u) { xcd_barrier_complete(bar, b.x, nloc, nx); b.st[0] = nloc; b.st[1] = nx; }
        const unsigned old = xb_add(&bar[XB_XSUB(b.x)], 1u);
        const unsigned gen = old / nloc;
        if (old + 1u == (gen + 1u) * nloc) {
            __builtin_amdgcn_fence(__ATOMIC_RELEASE, "agent");
            asm volatile("s_waitcnt vmcnt(0)" ::: "memory");
            const unsigned og = xb_add(&bar[XB_TOP], 1u);
            const unsigned tg = og / nx;
            if (og + 1u == (tg + 1u) * nx) xb_add(&bar[XB_TOPGEN], 1u);
            else XB_SPIN(xb_ld(&bar[XB_TOPGEN]) == tg, bar);
            __builtin_amdgcn_fence(__ATOMIC_ACQUIRE, "agent");
            xb_add(&bar[XB_XGEN(b.x)], 1u);
            asm volatile("s_waitcnt vmcnt(0)" ::: "memory");
        } else {
            XB_SPIN(xb_ld(&bar[XB_XGEN(b.x)]) == gen, bar);
            __builtin_amdgcn_fence(__ATOMIC_ACQUIRE, "agent");
            asm volatile("s_waitcnt vmcnt(0)" ::: "memory");
        }
    }
    __syncthreads();
}
struct Ctx { LAS unsigned char* lds; int tid, lane, wave, vcu, G; };

__device__ __forceinline__ void p0_mod_item(const Params& p, const Ctx& C, int it) {
    LAS float* sl = (LAS float*)C.lds;
    LAS float* red = sl + 3 * 2048;
    for (int e = C.tid; e < 3 * 2048; e += NT_) { const int i = e >> 11, k = e & 2047; const float v = (i < 2) ? p.c[i * DM + k] : p.c_ctx[k]; sl[e] = siluf(v); }
    __syncthreads();
    typedef float f32x2_ __attribute__((ext_vector_type(2)));
    f32x2_ a0 = {0, 0}, a1 = {0, 0}, a2 = {0, 0};
    const int col = it * 128 + C.lane * 2, k0 = C.wave * 256;
    const float* wp = p.w_mod + (size_t)k0 * 12288 + col;
    for (int kb = 0; kb < 256; kb += 32) {
        f32x2_ wv[32];
#pragma unroll
        for (int k = 0; k < 32; ++k) wv[k] = *(const f32x2_*)(wp + (size_t)(kb + k) * 12288);
#pragma unroll
        for (int k = 0; k < 32; ++k) { a0 += wv[k] * sl[k0 + kb + k]; a1 += wv[k] * sl[2048 + k0 + kb + k]; a2 += wv[k] * sl[4096 + k0 + kb + k]; } }
    LAS float* rw = red + C.wave * 384 + C.lane * 2;
    rw[0] = a0[0]; rw[1] = a0[1]; rw[128] = a1[0]; rw[129] = a1[1]; rw[256] = a2[0]; rw[257] = a2[1];
    __syncthreads();
    if (C.tid < 384) { float s = p.b_mod[it * 128 + (C.tid & 127)];
#pragma unroll
        for (int w = 0; w < 8; ++w) s += red[w * 384 + C.tid];
        ((float*)(p.ws + CTL_MOD))[(C.tid >> 7) * 12288 + it * 128 + (C.tid & 127)] = s; }
    __syncthreads();
}
__device__ __forceinline__ void p0_wprime_item(const Params& p, const Ctx& C, int it) {
    LAS float* As = (LAS float*)C.lds;
    LAS float* Ss = As + 64 * 129;
    LAS unsigned short* Os = (LAS unsigned short*)(Ss + 128 * 129);
    const int hp = it >> 5, i0 = (it & 31) * 64, pp = hp & 1;
    for (int e = C.tid; e < 64 * 128; e += NT_) { const int i = e >> 7, d = e & 127; As[i * 129 + d] = p.peer_wq[(size_t)(i0 + i) * 2048 + hp * 128 + d]; }
    for (int e = C.tid; e < 128 * 128; e += NT_) { const int k = e >> 7, d = e & 127; Ss[k * 129 + d] = p.sub_keys[(size_t)(pp * 128 + k) * 128 + d]; }
    __syncthreads();
    const int l15 = C.lane & 15, lq = C.lane >> 4, tm = C.wave & 3;
#pragma unroll
    for (int q = 0; q < 4; ++q) { const int tn = (C.wave >> 2) * 4 + q;
        f32x4 acc = {0.f, 0.f, 0.f, 0.f};
        const LAS float* ap = As + (tm * 16 + l15) * 129 + lq; const LAS float* bp = Ss + (tn * 16 + l15) * 129 + lq;
#pragma unroll 8
        for (int kk = 0; kk < 32; ++kk) acc = __builtin_amdgcn_mfma_f32_16x16x4f32(ap[4 * kk], bp[4 * kk], acc, 0, 0, 0);
        LAS unsigned short* o = Os + (tn * 16 + l15) * 72 + tm * 16 + 4 * lq; const unsigned w0 = pk2(acc[0], acc[1]), w1 = pk2(acc[2], acc[3]);
        *(LAS v2u*)o = (v2u){w0, w1}; }
    __syncthreads();
    for (int e = C.tid; e < 128 * 8; e += NT_) { const int k = e >> 3, chn = e & 7;
        *(v4u*)((bf16_t*)(p.ws + WS_WPQ) + (size_t)(hp * 128 + k) * 2048 + i0 + chn * 8) = *(const LAS v4u*)(Os + k * 72 + chn * 8); }
    __syncthreads();
}
__device__ __forceinline__ void p0_transpose_item(const float* W, int K, int N, int k0, int n0, bf16_t* WT, int drow0, const float* kscale, LAS float* scr, int lane) {
#pragma unroll 8
    for (int i = 0; i < 32; ++i) { const int kk = 2 * i + (lane >> 5); float v = W[(size_t)(k0 + kk) * N + n0 + (lane & 31)]; if (kscale) v *= kscale[k0 + kk]; scr[kk * 33 + (lane & 31)] = v; }
    asm volatile("s_waitcnt lgkmcnt(0)" ::: "memory");
    const int c = lane & 7;
#pragma unroll
    for (int j = 0; j < 4; ++j) { const int n = (lane >> 3) + 8 * j; const LAS float* s = scr + (8 * c) * 33 + n;
        v4u o; o.x = pk2(s[0 * 33], s[1 * 33]); o.y = pk2(s[2 * 33], s[3 * 33]); o.z = pk2(s[4 * 33], s[5 * 33]); o.w = pk2(s[6 * 33], s[7 * 33]);
        *(v4u*)(WT + (size_t)(drow0 + n) * K + k0 + 8 * c) = o; }
    asm volatile("s_waitcnt lgkmcnt(0)" ::: "memory");
}
__device__ __forceinline__ int win_dest_row(int n0) {
    if (n0 < 768) return n0;
    if (n0 < 832) return 8960 + (n0 - 768);
    if (n0 < 3904) return 768 + (n0 - 832);
    if (n0 < 4928) return 3840 + (n0 - 3904);
    if (n0 < 4960) return 9024 + (n0 - 4928);
    if (n0 < 7008) return 4864 + (n0 - 4960);
    return 6912 + (n0 - 7008);
}
constexpr int P0_I_IN = 32 * 283, P0_I_UQ = 8 * 48, P0_I_UKV = 4 * 64, P0_I_BA = 16 * 64, P0_I_BB = 16 * 64, P0_I_OUT = 32 * 64;
constexpr int P0_NITEMS = P0_I_IN + P0_I_UQ + P0_I_UKV + P0_I_BA + P0_I_BB + P0_I_OUT;
constexpr int P0_SPLIT = 5800;
__device__ __forceinline__ void p0_copy_items(const Params& p, const Ctx& C, int it_lo, int it_hi, int it_lo2, int it_hi2, int part, int nparts) {
    LAS float* scr = (LAS float*)(C.lds + C.wave * 16384);
    const int gw = part * 8 + C.wave, NGW = nparts * 8;
    unsigned char* ws = p.ws;
    const int n1 = it_hi - it_lo, n2 = it_hi2 - it_lo2;
    for (int q = gw; q < n1 + n2; q += NGW) {
        const int it = (q < n1) ? it_lo + q : it_lo2 + (q - n1);
        int r = it;
        if (r < P0_I_IN) { const int kb = r / 283, nb = r % 283; p0_transpose_item(p.w_in, 2048, 9056, kb * 64, nb * 32, (bf16_t*)(ws + WS_C), win_dest_row(nb * 32), nullptr, scr, C.lane); continue; } r -= P0_I_IN;
        if (r < P0_I_UQ) { const int kb = r / 48, nb = r % 48, n0 = nb * 32, h = n0 / 192, j0 = n0 % 192; const int dr = (j0 < 128) ? (h * 128 + j0) : (1024 + h * 64 + (j0 - 128));
            p0_transpose_item(p.w_uq, 512, 1536, kb * 64, n0, (bf16_t*)(ws + WS_WUQ), dr, p.qn_w, scr, C.lane); continue; } r -= P0_I_UQ;
        if (r < P0_I_UKV) { const int kb = r / 64, nb = r % 64; p0_transpose_item(p.w_ukv, 256, 2048, kb * 64, nb * 32, (bf16_t*)(ws + WS_WUKV), nb * 32, p.kvn_w, scr, C.lane); continue; } r -= P0_I_UKV;
        if (r < P0_I_BA) { const int kb = r / 64, nb = r % 64; p0_transpose_item(p.w_ba, 1024, 2048, kb * 64, nb * 32, (bf16_t*)(ws + WS_WBA), nb * 32, nullptr, scr, C.lane); continue; } r -= P0_I_BA;
        if (r < P0_I_BB) { const int kb = r / 64, nb = r % 64; p0_transpose_item(p.w_bb, 1024, 2048, kb * 64, nb * 32, (bf16_t*)(ws + WS_WBB), nb * 32, nullptr, scr, C.lane); continue; } r -= P0_I_BB;
        { const int kb = r / 64, nb = r % 64; p0_transpose_item(p.w_out, 2048, 2048, kb * 64, nb * 32, (bf16_t*)(ws + WS_WOUT), nb * 32, nullptr, scr, C.lane); }
    }
}
__device__ __forceinline__ void p0_prologue(const Params& p, const Ctx& C) {
    for (int it = C.vcu; it < 96; it += C.G) p0_mod_item(p, C, it);
    if (C.G != 256) for (int it = C.vcu; it < 512; it += C.G) p0_wprime_item(p, C, it);
    p0_copy_items(p, C, 0, P0_NITEMS, 0, 0, C.vcu, C.G);
    { v4u* z = (v4u*)((bf16_t*)(p.ws + WS_C) + (size_t)9056 * 2048); const int n16 = 160 * 2048 * 2 / 16;
      for (int i = C.vcu * NT_ + C.tid; i < n16; i += C.G * NT_) z[i] = (v4u){0u, 0u, 0u, 0u}; }
}
__device__ __forceinline__ void mod_norm_rows_bf(const Ctx& C, const bf16_t* X, int nrows, const float* nw, const float* sh, const float* sc, bf16_t* O) {
    f32x4 a[8], s[8];
#pragma unroll
    for (int j = 0; j < 8; ++j) { const int c = 8 * C.lane + 512 * (j >> 1) + 4 * (j & 1); const f32x4 w = *(const f32x4*)(nw + c), q = *(const f32x4*)(sc + c); a[j] = w * (q + 1.0f); s[j] = *(const f32x4*)(sh + c); }
    const int gw = C.vcu * 8 + C.wave, NGW = C.G * 8;
    for (int r = gw; r < nrows; r += NGW) {
        const v4u* xr = (const v4u*)(X + (size_t)r * DM) + C.lane; v4u v[4]; float ss = 0.f;
#pragma unroll
        for (int j = 0; j < 4; ++j) v[j] = xr[64 * j];
        f32x4 f[8];
#pragma unroll
        for (int j = 0; j < 4; ++j) { f[2 * j] = (f32x4){bflo(v[j].x), bfhi(v[j].x), bflo(v[j].y), bfhi(v[j].y)}; f[2 * j + 1] = (f32x4){bflo(v[j].z), bfhi(v[j].z), bflo(v[j].w), bfhi(v[j].w)}; }
#pragma unroll
        for (int j = 0; j < 8; ++j) ss += (f[j].x * f[j].x + f[j].y * f[j].y) + (f[j].z * f[j].z + f[j].w * f[j].w);
        const float rstd = rsqrtf(wave_sum(ss) * (1.0f / DM) + EPS);
        v4u* o8 = (v4u*)(O + (size_t)r * DM) + C.lane;
#pragma unroll
        for (int j = 0; j < 4; ++j) { const f32x4 y0 = f[2 * j] * rstd * a[2 * j] + s[2 * j], y1 = f[2 * j + 1] * rstd * a[2 * j + 1] + s[2 * j + 1];
            v4u w; w.x = pk2(y0.x, y0.y); w.y = pk2(y0.z, y0.w); w.z = pk2(y1.x, y1.y); w.w = pk2(y1.z, y1.w); o8[64 * j] = w; }
    }
}
__device__ __forceinline__ void mod_norm_rows(const Ctx& C, const float* X, int nrows, const float* nw, const float* sh, const float* sc, bf16_t* O) {
    f32x4 a[8], s[8];
#pragma unroll
    for (int j = 0; j < 8; ++j) { const int c = 4 * C.lane + 256 * j; const f32x4 w = *(const f32x4*)(nw + c), q = *(const f32x4*)(sc + c); a[j] = w * (q + 1.0f); s[j] = *(const f32x4*)(sh + c); }
    const int gw = C.vcu * 8 + C.wave, NGW = C.G * 8;
    for (int r = gw; r < nrows; r += NGW) {
        const f32x4* xr = (const f32x4*)(X + (size_t)r * DM) + C.lane; f32x4 v[8]; float ss = 0.f;
#pragma unroll
        for (int j = 0; j < 8; ++j) { v[j] = xr[64 * j]; ss += (v[j].x * v[j].x + v[j].y * v[j].y) + (v[j].z * v[j].z + v[j].w * v[j].w); }
        const float rstd = rsqrtf(wave_sum(ss) * (1.0f / DM) + EPS);
        v2u* o8 = (v2u*)(O + (size_t)r * DM) + C.lane;
#pragma unroll
        for (int j = 0; j < 8; ++j) { const f32x4 y = v[j] * rstd * a[j] + s[j]; v2u w; w.x = pk2(y.x, y.y); w.y = pk2(y.z, y.w); o8[64 * j] = w; }
    }
}
__device__ __forceinline__ void p3_conv(const Params& p, const Ctx& C) {
    const bf16_t* QKV = (const bf16_t*)(p.ws + WS_QKV); bf16_t* DNQ = (bf16_t*)(p.ws + WS_DNQ);
    const int total = (M1 / 16) * 384;
    for (int it = C.vcu * NT_ + C.tid; it < total; it += C.G * NT_) {
        const int rb = it / 384, c8 = it % 384, ch = c8 * 8, r0 = rb * 16;
        int seg0, segn, t0;
        if (r0 < ML) { seg0 = r0 & ~8191; segn = SEQ; t0 = r0 & 8191; } else { seg0 = ML + ((r0 - ML) & ~255); segn = CTXL; t0 = (r0 - ML) & 255; }
        f32x4 wlo[5], whi[5];
#pragma unroll
        for (int j = 0; j < 5; ++j) { wlo[j] = *(const f32x4*)(p.conv_w + j * 3072 + ch); whi[j] = *(const f32x4*)(p.conv_w + j * 3072 + ch + 4); }
        const float qs = (ch < 1024) ? 0.08838834764831845f : 1.0f; const bool nrm = ch < 2048;
        v4u rowsv[20];
#pragma unroll
        for (int j = 0; j < 20; ++j) { const int tt = t0 + j - 2; rowsv[j] = (tt >= 0 && tt < segn) ? *(const v4u*)(QKV + (size_t)(seg0 + tt) * 3072 + ch) : (v4u){0u, 0u, 0u, 0u}; }
        asm volatile("" ::: "memory");
#pragma unroll
        for (int i = 0; i < 16; ++i) {
            v4u win[5];
#pragma unroll
            for (int j = 0; j < 5; ++j) win[j] = rowsv[i + j];
            float acc[8];
#pragma unroll
            for (int e = 0; e < 8; ++e) acc[e] = 0.f;
#pragma unroll
            for (int j = 0; j < 5; ++j) { const v4u xv = win[j];
                acc[0] += bflo(xv.x) * wlo[j].x; acc[1] += bfhi(xv.x) * wlo[j].y; acc[2] += bflo(xv.y) * wlo[j].z; acc[3] += bfhi(xv.y) * wlo[j].w;
                acc[4] += bflo(xv.z) * whi[j].x; acc[5] += bfhi(xv.z) * whi[j].y; acc[6] += bflo(xv.w) * whi[j].z; acc[7] += bfhi(xv.w) * whi[j].w; }
            float ss = 0.f;
#pragma unroll
            for (int e = 0; e < 8; ++e) { acc[e] = siluf(acc[e]); ss += acc[e] * acc[e]; }
            ss += __shfl_xor(ss, 1); ss += __shfl_xor(ss, 2); ss += __shfl_xor(ss, 4); ss += __shfl_xor(ss, 8);
            const float sc = nrm ? rsqrtf(ss + EPS) * qs : 1.0f;
            v4u w; w.x = pk2(acc[0] * sc, acc[1] * sc); w.y = pk2(acc[2] * sc, acc[3] * sc); w.z = pk2(acc[4] * sc, acc[5] * sc); w.w = pk2(acc[6] * sc, acc[7] * sc);
            *(v4u*)(DNQ + (size_t)(r0 + i) * 3072 + ch) = w;
        }
    }
}
__device__ __forceinline__ void p3_krope_gbeta(const Params& p, const Ctx& C) {
    const float* KR = (const float*)(p.ws + WS_KR); bf16_t* K = (bf16_t*)(p.ws + WS_K);
    for (int it = C.vcu * NT_ + C.tid; it < M1 * 4; it += C.G * NT_) {
        const int r = it >> 2, q = it & 3, half = q >> 1, part = q & 1;
        int b, l, t; bool lat = r < ML;
        if (lat) { b = r >> 13; t = r & 8191; l = CTXL + t; } else { b = (r - ML) >> 8; t = 0; l = (r - ML) & 255; }
        const float* x1p = KR + (size_t)r * 64 + half * 32; const float* x2p = x1p + 16;
        float o[16];
        if (lat) { const float pos = (float)(half == 0 ? (t >> 6) : (t & 63));
#pragma unroll
            for (int i = 0; i < 16; ++i) { const float invf = exp2f(-(float)i * (13.287712379549449f / 16.0f)); float sn, cs; pg8::fast_sincos(pos * invf, sn, cs);
                const float x1 = x1p[i], x2 = x2p[i]; o[i] = part == 0 ? (x1 * cs - x2 * sn) : (x1 * sn + x2 * cs); } }
        else {
#pragma unroll
            for (int i = 0; i < 16; ++i) o[i] = part == 0 ? x1p[i] : x2p[i]; }
        v4u w0, w1; w0.x = pk2(o[0], o[1]); w0.y = pk2(o[2], o[3]); w0.z = pk2(o[4], o[5]); w0.w = pk2(o[6], o[7]);
        w1.x = pk2(o[8], o[9]); w1.y = pk2(o[10], o[11]); w1.z = pk2(o[12], o[13]); w1.w = pk2(o[14], o[15]);
#pragma unroll
        for (int h = 0; h < 8; ++h) { bf16_t* dst = K + ((size_t)(b * 8 + h) * LKV + l) * 192 + 128 + half * 32 + part * 16; *(v4u*)dst = w0; *(v4u*)(dst + 8) = w1; }
    }
    const float* AB = (const float*)(p.ws + WS_AB); float* Gd = (float*)(p.ws + WS_GBETA); float* Bd = Gd + (size_t)2 * M1 * 8;
    for (int it = C.vcu * NT_ + C.tid; it < M1 * 16; it += C.G * NT_) {
        const int r = it >> 4, dh = it & 15, dir = dh >> 3, h = dh & 7;
        const float a = AB[(size_t)r * 32 + dir * 8 + h] + p.dt_bias[dir * 8 + h], bl = AB[(size_t)r * 32 + 16 + dir * 8 + h];
        const float sp = (a > 20.f) ? a : log1pf(__expf(a));
        Gd[((size_t)dir * M1 + r) * 8 + h] = -__expf(p.a_log[dir * 8 + h]) * sp;
        Bd[((size_t)dir * M1 + r) * 8 + h] = 1.0f / (1.0f + __expf(-bl));
    }
}
typedef short s16x4c __attribute__((ext_vector_type(4)));
constexpr int CP_LD = 136;
constexpr int CP_K = 0, CP_Q = CP_K + 64 * CP_LD * 2, CP_V = CP_Q + 64 * CP_LD * 2, CP_VEC = CP_V + 64 * CP_LD * 2  , CP_MLO = CP_VEC + 640 * 4  ,
              CP_DG = CP_MLO + 2 * 64 * 72 * 2  , CP_DB = CP_DG + 2 * 4 * 16 * 17 * 4  , CP_ATS = CP_DB + 2 * 4 * 16 * 24 * 2  ,
              CP_XW = CP_ATS + 2 * 64 * 72 * 2  , CP_END = CP_XW + 8 * 16 * 72 * 2;
static_assert(CP_END <= 147456 - 64 && CP_MLO % 16 == 0 && CP_DB % 16 == 0 && CP_ATS % 16 == 0 && CP_XW % 16 == 0 && CP_DG % 16 == 0, "chunk-prep LDS");
__device__ __forceinline__ unsigned short bf1(float f) { return (unsigned short)(pk2(f, f) & 0xffffu); }
__device__ __forceinline__ void p5_chunk_prep(const Params& p, const Ctx& C) {
    const bf16_t* DNQ = (const bf16_t*)(p.ws + WS_DNQ); const float* Gd = (const float*)(p.ws + WS_GBETA); const float* Bd = Gd + (size_t)2 * M1 * 8;
    bf16_t* Wd = (bf16_t*)(p.ws + WS_W); bf16_t* Ud = (bf16_t*)(p.ws + WS_U); bf16_t* ATd = (bf16_t*)(p.ws + WS_ATT);
    float* EG = (float*)(p.ws + WS_EG); float* EKD = EG + (size_t)4224 * 64; float* EGL = EKD + (size_t)4224 * 64;
    LAS unsigned char* L = C.lds;
    LAS bf16_t* Ks = (LAS bf16_t*)(L + CP_K); LAS bf16_t* Qs = (LAS bf16_t*)(L + CP_Q); LAS bf16_t* Vs = (LAS bf16_t*)(L + CP_V);
    LAS float* Vec = (LAS float*)(L + CP_VEC); LAS bf16_t* MLO = (LAS bf16_t*)(L + CP_MLO); LAS float* DG = (LAS float*)(L + CP_DG); LAS bf16_t* DB = (LAS bf16_t*)(L + CP_DB);
    LAS bf16_t* ATS = (LAS bf16_t*)(L + CP_ATS); LAS bf16_t* XW = (LAS bf16_t*)(L + CP_XW) + C.wave * (16 * 72);
    const int tid = C.tid, lane = C.lane, wave = C.wave, l15 = lane & 15, lq = lane >> 4;
    unsigned long long p5acc = 0ull;
    v4u pre[6]; float pre_g = 0.f, pre_b = 0.f;
#define CP_ROW0(task_) ((((task_) % NCH) < 4) ? (ML + (((task_) / NCH) >> 3) * CTXL + ((task_) % NCH) * 64) : ((((task_) / NCH) >> 3) * SEQ + (((task_) % NCH) - 4) * 64))
#define CP_PREFETCH(task_) do { const int t_ = (task_); const int r0_ = CP_ROW0(t_), h_ = (t_ / NCH) & 7; \
        _Pragma("unroll") for (int q_ = 0; q_ < 6; ++q_) { const int e = tid + q_ * NT_, which = e >> 10, id = e & 1023, i = id >> 4, chn = id & 15; \
            pre[q_] = *(const v4u*)(DNQ + (size_t)(r0_ + i) * 3072 + which * 1024 + h_ * 128 + chn * 8); } \
        if (wave < 2) { const int pi_ = wave ? 63 - lane : lane; pre_g = Gd[((size_t)wave * M1 + r0_ + pi_) * 8 + h_]; pre_b = Bd[((size_t)wave * M1 + r0_ + pi_) * 8 + h_]; } } while (0)
    if (C.vcu < 16 * NCH) CP_PREFETCH(C.vcu);
    for (int task = C.vcu; task < 16 * NCH; task += C.G) {
        const int bh = task / NCH, tc = task % NCH, b = bh >> 3, h = bh & 7;
        const int row0 = (tc < 4) ? (ML + b * CTXL + tc * 64) : (b * SEQ + (tc - 4) * 64);
        const size_t cidx0 = (size_t)(bh * 2 + 0) * NCH + tc, cidx1 = (size_t)(bh * 2 + 1) * NCH + (tc < 4 ? 3 - tc : 135 - tc);
        unsigned long long q5_[5]; if (PROBE_TS >= 30 && PROBE_TS <= 33) q5_[0] = __builtin_amdgcn_s_memrealtime();
#pragma unroll
        for (int q_ = 0; q_ < 6; ++q_) { const int e = tid + q_ * NT_, which = e >> 10, id = e & 1023, i = id >> 4, chn = id & 15;
            LAS bf16_t* dst = (which == 0 ? Qs : (which == 1 ? Ks : Vs)) + i * CP_LD + chn * 8; *(LAS v4u*)dst = pre[q_]; }
        if (wave < 2) { const int dir = wave;
            const float g = pre_g, be = pre_b;
            float v = g;
#pragma unroll
            for (int o = 1; o < 64; o <<= 1) { const float u = __shfl_up(v, o); if (lane >= o) v += u; }
            const float gl = __shfl(v, 63), eg = __expf(v);
            Vec[256 + dir * 64 + lane] = v; Vec[384 + dir * 128 + lane] = be; Vec[384 + dir * 128 + 64 + lane] = eg;
            const size_t cidx = dir ? cidx1 : cidx0;
            EG[cidx * 64 + lane] = eg; EKD[cidx * 64 + lane] = __expf(gl - v); if (lane == 0) EGL[cidx] = __expf(gl); }
        __syncthreads();
        if (PROBE_TS >= 30 && PROBE_TS <= 33) q5_[1] = __builtin_amdgcn_s_memrealtime();
        if (task + C.G < 16 * NCH) CP_PREFETCH(task + C.G);
        {
            float df[2][4], db[2][4], bef[2][4], beb[2][4];
#pragma unroll
            for (int t = 0; t < 2; ++t) { const int t16 = wave * 2 + t, tm = t16 >> 2, tn = t16 & 3;
                const int j = tn * 16 + l15, jb = 63 - j; const float gfj = Vec[256 + j], gbj = Vec[320 + jb];
#pragma unroll
                for (int rg = 0; rg < 4; ++rg) { const int i = tm * 16 + 4 * lq + rg, ib = 63 - i;
                    df[t][rg] = __expf(Vec[256 + i] - gfj); db[t][rg] = __expf(Vec[320 + ib] - gbj);
                    bef[t][rg] = Vec[384 + i]; beb[t][rg] = Vec[384 + 128 + ib]; } }
#pragma unroll
            for (int q = 0; q < 4; ++q) { const int t = q & 1, t16 = wave * 2 + t, tm = t16 >> 2, tn = t16 & 3; const bool isq = q >= 2;
                const LAS bf16_t* Ab = (isq ? Qs : Ks) + (tm * 16 + l15) * CP_LD + 8 * lq; const LAS bf16_t* Bb = Ks + (tn * 16 + l15) * CP_LD + 8 * lq;
                f32x4 acc = {0.f, 0.f, 0.f, 0.f};
#pragma unroll
                for (int kk = 0; kk < 4; ++kk) acc = __builtin_amdgcn_mfma_f32_16x16x32_bf16(*(const LAS bf16x8*)(Ab + kk * 32), *(const LAS bf16x8*)(Bb + kk * 32), acc, 0, 0, 0);
                const int j = tn * 16 + l15, jb = 63 - j;
#pragma unroll
                for (int rg = 0; rg < 4; ++rg) { const int i = tm * 16 + 4 * lq + rg, ib = 63 - i; const float a = acc[rg];
                    if (isq) { ATS[i * 72 + j] = bf1(i >= j ? a * df[t][rg] : 0.f); ATS[64 * 72 + ib * 72 + jb] = bf1(i <= j ? a * db[t][rg] : 0.f); }
                    else if (i > j) { const float m = bef[t][rg] * a * df[t][rg];
                        if (tm == tn) DG[(tm * 16 + (i & 15)) * 17 + (j & 15)] = m; else MLO[i * 72 + j] = bf1(-m); }
                    else if (i < j) { const float m = beb[t][rg] * a * db[t][rg];
                        if (tm == tn) DG[((4 + (3 - tm)) * 16 + (ib & 15)) * 17 + (jb & 15)] = m; else MLO[64 * 72 + ib * 72 + jb] = bf1(-m); }
                }
            }
        }
        __syncthreads();
        if (PROBE_TS >= 30 && PROBE_TS <= 33) q5_[2] = __builtin_amdgcn_s_memrealtime();
        if (tid < 128) { const int blk = tid >> 4, cc = tid & 15; const LAS float* Mb = DG + blk * 16 * 17;
            float d[16];
#pragma unroll
            for (int r = 0; r < 16; ++r) { float v = (r == cc) ? 1.f : 0.f;
#pragma unroll
                for (int k = 0; k < r; ++k) v -= Mb[r * 17 + k] * d[k];
                d[r] = v; }
#pragma unroll
            for (int r = 0; r < 16; ++r) DB[(blk * 16 + r) * 24 + cc] = bf1(d[r]);
        } else { for (int e = tid - 128; e < 2 * 64 * 8; e += NT_ - 128) { const int dir = e >> 9, i = (e >> 3) & 63, chn = e & 7;
                *(v4u*)(ATd + (dir ? cidx1 : cidx0) * 4096 + i * 64 + chn * 8) = *(const LAS v4u*)(ATS + dir * (64 * 72) + i * 72 + chn * 8); } }
        __syncthreads();
        if (PROBE_TS >= 30 && PROBE_TS <= 33) q5_[3] = __builtin_amdgcn_s_memrealtime();
        {
            const int dir = wave >> 2, wq = wave & 3; const bool isw = wq >= 2; const int cb0 = (wq & 1) * 64;
            const LAS bf16_t* src = (isw ? Ks : Vs) + cb0 + l15; const LAS float* bsc = Vec + 384 + dir * 128;
            const LAS bf16_t* Mo = MLO + dir * (64 * 72); const LAS bf16_t* Dd = DB + dir * (4 * 16 * 24);
            s16x4c aoff[6], adg[4];
            { int q = 0;
#pragma unroll
              for (int bb = 1; bb < 4; ++bb)
#pragma unroll
                  for (int j = 0; j < bb; ++j) { aoff[q] = *(const LAS s16x4c*)(Mo + (bb * 16 + l15) * 72 + j * 16 + 4 * lq); ++q; }
#pragma unroll
              for (int bb = 0; bb < 4; ++bb) adg[bb] = *(const LAS s16x4c*)(Dd + (bb * 16 + l15) * 24 + 4 * lq); }
            s16x4c xp[4][4];
            bf16_t* gdst = (isw ? Wd : Ud) + (dir ? cidx1 : cidx0) * 8192 + cb0;
            s16x4c rv[4][4]; f32x4 sc[4];
            { const LAS bf16_t* tb = src - l15 + 4 * (l15 & 3);
#pragma unroll
              for (int bb = 0; bb < 4; ++bb) { const int i0 = bb * 16 + 4 * lq, ir = i0 + (l15 >> 2), pr = dir ? 63 - ir : ir;
                const f32x4 s1 = *(const LAS f32x4*)(bsc + i0), s2 = *(const LAS f32x4*)(bsc + 64 + i0);
#pragma unroll
                for (int rg = 0; rg < 4; ++rg) sc[bb][rg] = isw ? s1[rg] * s2[rg] : s1[rg];
#pragma unroll
                for (int ct = 0; ct < 4; ++ct) rv[bb][ct] = __builtin_amdgcn_ds_read_tr16_b64_v4i16((LAS s16x4c*)(tb + pr * CP_LD + ct * 16)); } }
            asm volatile("s_waitcnt lgkmcnt(0)" ::: "memory");
#pragma unroll
            for (int bb = 0; bb < 4; ++bb) {
#pragma unroll
                for (int ct = 0; ct < 4; ++ct) {
                    f32x4 acc;
#pragma unroll
                    for (int rg = 0; rg < 4; ++rg) acc[rg] = __uint_as_float(((unsigned)(unsigned short)rv[bb][ct][rg]) << 16) * sc[bb][rg];
#pragma unroll
                    for (int j = 0; j < bb; ++j) acc = __builtin_amdgcn_mfma_f32_16x16x16bf16_1k(aoff[bb * (bb - 1) / 2 + j], xp[ct][j], acc, 0, 0, 0);
                    const unsigned a01 = pk2(acc[0], acc[1]), a23 = pk2(acc[2], acc[3]);
                    const s16x4c accb = {(short)(a01 & 0xffff), (short)(a01 >> 16), (short)(a23 & 0xffff), (short)(a23 >> 16)};
                    const f32x4 x = __builtin_amdgcn_mfma_f32_16x16x16bf16_1k(adg[bb], accb, (f32x4){0.f, 0.f, 0.f, 0.f}, 0, 0, 0);
                    const unsigned x01 = pk2(x[0], x[1]), x23 = pk2(x[2], x[3]);
                    xp[ct][bb] = (s16x4c){(short)(x01 & 0xffff), (short)(x01 >> 16), (short)(x23 & 0xffff), (short)(x23 >> 16)};
                    LAS bf16_t* xw = XW + (4 * lq) * 72 + ct * 16 + l15;
                    xw[0] = (bf16_t)(x01 & 0xffff); xw[72] = (bf16_t)(x01 >> 16); xw[144] = (bf16_t)(x23 & 0xffff); xw[216] = (bf16_t)(x23 >> 16);
                }
                asm volatile("s_waitcnt lgkmcnt(0)" ::: "memory");
#pragma unroll
                for (int e2 = 0; e2 < 2; ++e2) { const int pc = lane + 64 * e2, r = pc >> 3, chn = pc & 7;
                    *(v4u*)(gdst + (size_t)(bb * 16 + r) * 128 + chn * 8) = *(const LAS v4u*)(XW + r * 72 + chn * 8); }
                asm volatile("s_waitcnt lgkmcnt(0)" ::: "memory");
            }
        }
        __syncthreads();
        if (PROBE_TS >= 30 && PROBE_TS <= 33) { q5_[4] = __builtin_amdgcn_s_memrealtime(); p5acc += q5_[PROBE_TS - 30 + 1] - q5_[PROBE_TS - 30]; }
    }
    if (PROBE_TS >= 30 && PROBE_TS <= 33 && tid == 0) ((float*)(p.ws + CTL_TS + 1024))[C.vcu] = (float)p5acc * 0.01f;
}
typedef short s16x4_ __attribute__((ext_vector_type(4))); typedef short v4i16_ __attribute__((ext_vector_type(4)));
constexpr int SC_WLD = 136, SC_TLD = 72;
constexpr int SB_W = 0, SB_Q = SB_W + 64 * SC_WLD * 2, SB_K = SB_Q + 64 * SC_WLD * 2, SB_ATT = SB_K + 64 * SC_WLD * 2, SB_U = SB_ATT + 64 * SC_TLD * 2, SB_EV = SB_U + 64 * 16 * 4  , SB_SIZE = SB_EV + 128 * 4;
constexpr int SC_SBT = 2 * SB_SIZE, SC_VNT = SC_SBT + 16 * SC_WLD * 2, SC_VNK = SC_VNT + 16 * SC_TLD * 2, SC_END = SC_VNK + 16 * SC_TLD * 2;
static_assert(SC_END <= 147456 - 64 && SB_SIZE % 16 == 0 && SB_Q % 16 == 0 && SB_ATT % 16 == 0 && SB_U % 16 == 0 && SB_EV % 16 == 0 && SC_SBT % 16 == 0 && SC_VNT % 16 == 0 && SC_VNK % 16 == 0, "scan LDS");
struct ScanRegs { v4u w0, w1, q0, q1, k0, k1, at, u; float ev, egl; };
struct ScanPtrs { const bf16_t *DNQ, *Wd, *Ud, *ATd; const float *EG, *EKD, *EGL; };
__device__ __forceinline__ int scan_base(int s, int b, int dir) { return dir == 0 ? ((s < 4) ? (ML + b * CTXL + s * 64) : (b * SEQ + (s - 4) * 64)) : ((s < 4) ? (ML + b * CTXL + (3 - s) * 64) : (b * SEQ + (131 - s) * 64)); }
__device__ __forceinline__ void scan_load(ScanRegs& R, const ScanPtrs& P, int s, int bhd, int b, int h, int dir, int n0, int tid) {
    const size_t cidx = (size_t)bhd * NCH + s; const int base = scan_base(s, b, dir);
    { const int i = tid >> 4, chn = tid & 15, row = base + (dir ? 63 - i : i);
      R.w0 = *(const v4u*)(P.Wd + cidx * 8192 + i * 128 + chn * 8); R.q0 = *(const v4u*)(P.DNQ + (size_t)row * 3072 + h * 128 + chn * 8); R.k0 = *(const v4u*)(P.DNQ + (size_t)row * 3072 + 1024 + h * 128 + chn * 8); }
    { const int i = 32 + (tid >> 4), chn = tid & 15, row = base + (dir ? 63 - i : i);
      R.w1 = *(const v4u*)(P.Wd + cidx * 8192 + i * 128 + chn * 8); R.q1 = *(const v4u*)(P.DNQ + (size_t)row * 3072 + h * 128 + chn * 8); R.k1 = *(const v4u*)(P.DNQ + (size_t)row * 3072 + 1024 + h * 128 + chn * 8); }
    R.at = *(const v4u*)(P.ATd + cidx * 4096 + (tid >> 3) * 64 + (tid & 7) * 8);
    if (tid < 128) { R.u = *(const v4u*)(P.Ud + cidx * 8192 + (tid >> 1) * 128 + n0 + (tid & 1) * 8); R.ev = (tid < 64) ? P.EG[cidx * 64 + tid] : P.EKD[cidx * 64 + tid - 64]; }
    R.egl = P.EGL[cidx];
}
__device__ __forceinline__ void scan_store(const ScanRegs& R, LAS unsigned char* B, int tid) {
    LAS bf16_t* Ws = (LAS bf16_t*)(B + SB_W); LAS bf16_t* Qs = (LAS bf16_t*)(B + SB_Q); LAS bf16_t* Ks = (LAS bf16_t*)(B + SB_K); LAS bf16_t* ATs = (LAS bf16_t*)(B + SB_ATT);
    const int chn = tid & 15;
    { const int i = tid >> 4; *(LAS v4u*)(Ws + i * SC_WLD + chn * 8) = R.w0; *(LAS v4u*)(Qs + i * SC_WLD + chn * 8) = R.q0; *(LAS v4u*)(Ks + i * SC_WLD + chn * 8) = R.k0; }
    { const int i = 32 + (tid >> 4); *(LAS v4u*)(Ws + i * SC_WLD + chn * 8) = R.w1; *(LAS v4u*)(Qs + i * SC_WLD + chn * 8) = R.q1; *(LAS v4u*)(Ks + i * SC_WLD + chn * 8) = R.k1; }
    *(LAS v4u*)(ATs + (tid >> 3) * SC_TLD + (tid & 7) * 8) = R.at;
    if (tid < 128) { LAS float* ud = (LAS float*)(B + SB_U) + (tid >> 1) * 16 + (tid & 1) * 8; *(LAS f32x4*)ud = (f32x4){bflo(R.u.x), bfhi(R.u.x), bflo(R.u.y), bfhi(R.u.y)}; *(LAS f32x4*)(ud + 4) = (f32x4){bflo(R.u.z), bfhi(R.u.z), bflo(R.u.w), bfhi(R.u.w)};
        ((LAS float*)(B + SB_EV))[tid] = R.ev; }
}
__device__ __forceinline__ void p6_scan(const Params& p, const Ctx& C) {
    ScanPtrs P; P.DNQ = (const bf16_t*)(p.ws + WS_DNQ); P.Wd = (const bf16_t*)(p.ws + WS_W); P.Ud = (const bf16_t*)(p.ws + WS_U); P.ATd = (const bf16_t*)(p.ws + WS_ATT);
    P.EG = (const float*)(p.ws + WS_EG); P.EKD = P.EG + (size_t)4224 * 64; P.EGL = P.EKD + (size_t)4224 * 64;
    LAS unsigned char* L = C.lds;
    LAS bf16_t* SBT = (LAS bf16_t*)(L + SC_SBT); LAS bf16_t* VNT = (LAS bf16_t*)(L + SC_VNT); LAS bf16_t* VNK = (LAS bf16_t*)(L + SC_VNK);
    const int tid = C.tid, lane = C.lane, wave = C.wave, l15 = lane & 15, lq = lane >> 4;
    for (int task = C.vcu; task < 256; task += C.G) {
        const int bhd = task >> 3, cb = task & 7, bh = bhd >> 1, dir = bhd & 1, b = bh >> 3, h = bh & 7, n0 = cb * 16;
        bf16_t* Od = (bf16_t*)(p.ws + (dir ? WS_OB : WS_OF));
        f32x4 S = {0.f, 0.f, 0.f, 0.f};
        for (int e = tid; e < 16 * SC_WLD / 2; e += NT_) ((LAS unsigned*)SBT)[e] = 0u;
        ScanRegs RA, RB; unsigned long long pt0 = 0ull, pacc = 0ull;
#ifdef SCAN_STAGGER
        { const unsigned long long ts0 = __builtin_amdgcn_s_memrealtime(); const unsigned long long lag = (unsigned long long)(cb * SCAN_STAGGER);
          while (__builtin_amdgcn_s_memrealtime() - ts0 < lag) __builtin_amdgcn_s_sleep(8); }
#endif
        scan_load(RA, P, 0, bhd, b, h, dir, n0, tid); scan_load(RB, P, 1, bhd, b, h, dir, n0, tid);
        scan_store(RA, L, tid); float egl_cur = RA.egl;
        scan_load(RA, P, 2, bhd, b, h, dir, n0, tid);
#define SCAN_STEP(RN, s_) do { const int s = (s_); const int base = scan_base(s, b, dir); LAS unsigned char* Bc = L + (s & 1) * SB_SIZE; LAS unsigned char* Bn = L + ((s + 1) & 1) * SB_SIZE; \
            __syncthreads();                                                          \
            if (PROBE_TS == 20 || PROBE_TS == 22) pt0 = __builtin_amdgcn_s_memrealtime(); if (PROBE_TS == 21 && pt0 != 0ull) pacc += __builtin_amdgcn_s_memrealtime() - pt0; \
            const float egl = egl_cur; \
            const int mt = wave & 3; f32x4 acc = {0.f, 0.f, 0.f, 0.f}; \
            { const LAS bf16_t* Ab = (LAS bf16_t*)(Bc + ((wave < 4) ? SB_W : SB_Q)) + (mt * 16 + l15) * SC_WLD + 8 * lq; const LAS bf16_t* Bb = SBT + l15 * SC_WLD + 8 * lq; \
              _Pragma("unroll") for (int kk = 0; kk < 4; ++kk) acc = __builtin_amdgcn_mfma_f32_16x16x32_bf16(*(const LAS bf16x8*)(Ab + kk * 32), *(const LAS bf16x8*)(Bb + kk * 32), acc, 0, 0, 0); } \
            if (wave < 4) { const int i0 = mt * 16 + 4 * lq; const LAS float* Us = (const LAS float*)(Bc + SB_U); const f32x4 ek = *(const LAS f32x4*)((const LAS float*)(Bc + SB_EV) + 64 + i0); \
                const float v0 = Us[(i0 + 0) * 16 + l15] - acc[0], v1 = Us[(i0 + 1) * 16 + l15] - acc[1], v2 = Us[(i0 + 2) * 16 + l15] - acc[2], v3 = Us[(i0 + 3) * 16 + l15] - acc[3]; \
                v2u w; w.x = pk2(v0, v1); w.y = pk2(v2, v3); *(LAS v2u*)(VNT + l15 * SC_TLD + i0) = w; \
                v2u wk; wk.x = pk2(v0 * ek[0], v1 * ek[1]); wk.y = pk2(v2 * ek[2], v3 * ek[3]); *(LAS v2u*)(VNK + l15 * SC_TLD + i0) = wk; } \
            else { const f32x4 eg = *(const LAS f32x4*)((const LAS float*)(Bc + SB_EV) + mt * 16 + 4 * lq); acc = acc * eg; } \
            if (PROBE_TS == 22) pacc += __builtin_amdgcn_s_memrealtime() - pt0; if (PROBE_TS == 23) pt0 = __builtin_amdgcn_s_memrealtime(); \
            if (s + 1 < NCH) { scan_store(RN, Bn, tid); egl_cur = RN.egl; asm volatile("s_waitcnt lgkmcnt(0)" ::: "memory"); if (PROBE_TS == 23) pacc += __builtin_amdgcn_s_memrealtime() - pt0; if (PROBE_TS == 24) pt0 = __builtin_amdgcn_s_memrealtime(); \
                if (s + 3 < NCH) scan_load(RN, P, s + 3, bhd, b, h, dir, n0, tid); if (PROBE_TS == 24) pacc += __builtin_amdgcn_s_memrealtime() - pt0; } \
            __syncthreads();                                                          \
            if (PROBE_TS == 20) pacc += __builtin_amdgcn_s_memrealtime() - pt0; if (PROBE_TS == 21) pt0 = __builtin_amdgcn_s_memrealtime(); \
            if (wave >= 4) { const LAS bf16_t* Ab = (LAS bf16_t*)(Bc + SB_ATT) + (mt * 16 + l15) * SC_TLD + 8 * lq; const LAS bf16_t* Bb = VNT + l15 * SC_TLD + 8 * lq; \
                _Pragma("unroll") for (int kk = 0; kk < 2; ++kk) acc = __builtin_amdgcn_mfma_f32_16x16x32_bf16(*(const LAS bf16x8*)(Ab + kk * 32), *(const LAS bf16x8*)(Bb + kk * 32), acc, 0, 0, 0); \
                if (s >= 4) { _Pragma("unroll") for (int rg = 0; rg < 4; ++rg) { const int i = mt * 16 + 4 * lq + rg; const int row = base + (dir ? 63 - i : i); \
                        Od[(size_t)row * 1024 + h * 128 + n0 + l15] = (bf16_t)f2bf(acc[rg]); } } } \
            { f32x4 sn = S * egl; const LAS bf16_t* Bb = VNK + l15 * SC_TLD + 8 * lq; \
              const LAS bf16_t* Ta = (LAS bf16_t*)(Bc + SB_K) + (8 * lq + (l15 >> 2)) * SC_WLD + wave * 16 + 4 * (l15 & 3); \
              _Pragma("unroll") for (int kk = 0; kk < 2; ++kk) { \
                  const s16x4_ t0 = __builtin_bit_cast(s16x4_, __builtin_amdgcn_ds_read_tr16_b64_v4i16((LAS v4i16_*)(Ta + (kk * 32) * SC_WLD))); \
                  const s16x4_ t1 = __builtin_bit_cast(s16x4_, __builtin_amdgcn_ds_read_tr16_b64_v4i16((LAS v4i16_*)(Ta + (kk * 32 + 4) * SC_WLD))); \
                  const bf16x8 af = (bf16x8){t0[0], t0[1], t0[2], t0[3], t1[0], t1[1], t1[2], t1[3]}; \
                  sn = __builtin_amdgcn_mfma_f32_16x16x32_bf16(af, *(const LAS bf16x8*)(Bb + kk * 32), sn, 0, 0, 0); } \
              S = sn; } \
            { v2u w; w.x = pk2(S[0], S[1]); w.y = pk2(S[2], S[3]); *(LAS v2u*)(SBT + l15 * SC_WLD + wave * 16 + 4 * lq) = w; } \
        } while (0)
        for (int s2 = 0; s2 < NCH; s2 += 2) { SCAN_STEP(RB, s2); SCAN_STEP(RA, s2 + 1); }
#undef SCAN_STEP
        if ((PROBE_TS >= 20 && PROBE_TS <= 24) && tid == 0) ((float*)(p.ws + CTL_TS + 1024))[C.vcu] = (float)pacc * 0.01f;
        __syncthreads();
    }
}
__device__ __forceinline__ void p7_yb(const Params& p, const Ctx& C) {
    const bf16_t* OF = (const bf16_t*)(p.ws + WS_OF); const bf16_t* OB = (const bf16_t*)(p.ws + WS_OB); const bf16_t* Z = (const bf16_t*)(p.ws + WS_Z); bf16_t* YB = (bf16_t*)(p.ws + WS_YB);
    const long total = (long)ML * 128;
    for (long it0 = (long)C.vcu * NT_ + C.tid; it0 < total; it0 += (long)C.G * NT_ * 4) {
        v4u a[4], bq[4], zz[4];
#pragma unroll
        for (int u = 0; u < 4; ++u) { const long itu = it0 + (long)u * C.G * NT_; const size_t off = (size_t)(itu < total ? itu : it0) * 8; a[u] = *(const v4u*)(OF + off); bq[u] = *(const v4u*)(OB + off); zz[u] = *(const v4u*)(Z + off); }
        asm volatile("" ::: "memory");
#pragma unroll
        for (int u = 0; u < 4; ++u) { const long itu = it0 + (long)u * C.G * NT_; const size_t off = (size_t)(itu < total ? itu : it0) * 8; const int d0 = (int)(off & 127);
            float o[8] = {bflo(a[u].x) + bflo(bq[u].x), bfhi(a[u].x) + bfhi(bq[u].x), bflo(a[u].y) + bflo(bq[u].y), bfhi(a[u].y) + bfhi(bq[u].y), bflo(a[u].z) + bflo(bq[u].z), bfhi(a[u].z) + bfhi(bq[u].z), bflo(a[u].w) + bflo(bq[u].w), bfhi(a[u].w) + bfhi(bq[u].w)};
            float zf[8] = {bflo(zz[u].x), bfhi(zz[u].x), bflo(zz[u].y), bfhi(zz[u].y), bflo(zz[u].z), bfhi(zz[u].z), bflo(zz[u].w), bfhi(zz[u].w)};
            float ss = 0.f;
#pragma unroll
            for (int e = 0; e < 8; ++e) ss += o[e] * o[e];
            ss += __shfl_xor(ss, 1); ss += __shfl_xor(ss, 2); ss += __shfl_xor(ss, 4); ss += __shfl_xor(ss, 8);
            const float rstd = rsqrtf(ss * (1.0f / 128.0f) + EPS);
            const f32x4 w0 = *(const f32x4*)(p.dn_norm_w + d0), w1 = *(const f32x4*)(p.dn_norm_w + d0 + 4);
            float y[8];
#pragma unroll
            for (int e = 0; e < 8; ++e) y[e] = o[e] * rstd * (e < 4 ? w0[e] : w1[e - 4]) * siluf(zf[e]);
            v4u w; w.x = pk2(y[0], y[1]); w.y = pk2(y[2], y[3]); w.z = pk2(y[4], y[5]); w.w = pk2(y[6], y[7]);
            *(v4u*)(YB + off) = w; }
    }
}
typedef float f32x2_t __attribute__((ext_vector_type(2)));
__device__ __forceinline__ float gelu_erf(float v) { return 0.5f * v * (1.0f + erff(v * 0.7071067811865476f)); }
__device__ __forceinline__ float dot8(v4u a, v4u b, float acc) {
    acc += bflo(a.x) * bflo(b.x); acc += bfhi(a.x) * bfhi(b.x); acc += bflo(a.y) * bflo(b.y); acc += bfhi(a.y) * bfhi(b.y);
    acc += bflo(a.z) * bflo(b.z); acc += bfhi(a.z) * bfhi(b.z); acc += bflo(a.w) * bflo(b.w); acc += bfhi(a.w) * bfhi(b.w); return acc;
}
__device__ __forceinline__ unsigned ord_u32(float f) { const unsigned u = __float_as_uint(f); return u ^ ((u >> 31) ? 0xffffffffu : 0x80000000u); }
#define INS16(k, x) do { unsigned x_ = (x); _Pragma("unroll") for (int i_ = 0; i_ < 16; ++i_) { const unsigned lo_ = min(k[i_], x_); k[i_] = max(k[i_], x_); x_ = lo_; } } while (0)
#define CE_DESC(k, a, b) do { const unsigned hi_ = max(k[a], k[b]), lo_ = min(k[a], k[b]); k[a] = hi_; k[b] = lo_; } while (0)
#define CE_ASC(k, a, b)  do { const unsigned hi_ = max(k[a], k[b]), lo_ = min(k[a], k[b]); k[a] = lo_; k[b] = hi_; } while (0)
__device__ __forceinline__ void sort16_desc(unsigned (&k)[16]) {
#pragma unroll
    for (int kk = 2; kk <= 16; kk <<= 1)
#pragma unroll
        for (int j = kk >> 1; j >= 1; j >>= 1)
#pragma unroll
            for (int i = 0; i < 16; ++i) { const int l = i ^ j; if (l > i) { if ((i & kk) == 0) CE_DESC(k, i, l); else CE_ASC(k, i, l); } }
}
__device__ __forceinline__ void merge_top16(unsigned (&a)[16], const unsigned (&b)[16]) {
#pragma unroll
    for (int i = 0; i < 16; ++i) a[i] = max(a[i], b[15 - i]);
#pragma unroll
    for (int j = 8; j >= 1; j >>= 1)
#pragma unroll
        for (int i = 0; i < 16; ++i) { const int l = i ^ j; if (l > i) CE_DESC(a, i, l); }
}
constexpr int P12_SC = 0, P12_TOPS = 128 * 129 * 4, P12_TOPI = P12_TOPS + 128 * 16 * 4, P12_IDX = P12_TOPI + 128 * 16 * 4  , P12_PW = P12_IDX + 64 * 128 * 2  , P12_END = P12_PW + 64 * 128 * 4;
static_assert(P12_END + 64 <= 147456 - 64 && P12_IDX % 16 == 0 && P12_PW % 16 == 0, "p12 lds");
__device__ __forceinline__ float octet_sum(float d) {
    d += __builtin_bit_cast(float, __builtin_amdgcn_update_dpp(0, __builtin_bit_cast(int, d), 0xB1, 0xF, 0xF, true));
    d += __builtin_bit_cast(float, __builtin_amdgcn_update_dpp(0, __builtin_bit_cast(int, d), 0x4E, 0xF, 0xF, true));
    d += __builtin_bit_cast(float, __builtin_amdgcn_update_dpp(0, __builtin_bit_cast(int, d), 0x141, 0xF, 0xF, true));
    return d;
}
__device__ __forceinline__ void p12_peer(const Params& p, const Ctx& C, const bool do_final) {
    const float* SCp = (const float*)(p.ws + WS_SC); const bf16_t* H2 = (const bf16_t*)(p.ws + WS_H2);
    const unsigned char* UB = (const unsigned char*)(p.ws + WS_UB); const unsigned char* VB = (const unsigned char*)(p.ws + WS_VB); const float* USC = (const float*)(p.ws + WS_USC); const float* VSC = (const float*)(p.ws + WS_VSC);
    const float* MOD = (const float*)(p.ws + CTL_MOD);
    LAS float* SCs = (LAS float*)(C.lds + P12_SC); LAS float* TOPS = (LAS float*)(C.lds + P12_TOPS); LAS int* TOPI = (LAS int*)(C.lds + P12_TOPI);
    LAS unsigned short* IDXs = (LAS unsigned short*)(C.lds + P12_IDX); LAS float* PWs = (LAS float*)(C.lds + P12_PW);
    const int lane = C.lane, tid = C.tid;
    const unsigned long long p12_t0 = (PROBE_TS == 12 || PROBE_TS == 13) ? __builtin_amdgcn_s_memrealtime() : 0ull; unsigned long long p12_tA = 0ull;
    LAS unsigned char* CTAB = (LAS unsigned char*)(C.lds + P12_END);
    if (tid < 64) { unsigned v = 0xffu;
        if (tid < 16) v = tid;
        else if (tid < 24) v = 16 + (tid - 16);
        else if (tid < 29) v = 32 + (tid - 24);
        else if (tid < 33) v = 48 + (tid - 29);
        else if (tid < 36) v = 64 + (tid - 33);
        else if (tid < 38) v = 80 + (tid - 36);
        else if (tid < 40) v = 96 + (tid - 38);
        else if (tid < 42) v = 112 + (tid - 40);
        else if (tid < 50) v = (8 + (tid - 42)) * 16;
        CTAB[tid] = (unsigned char)v; }
    __syncthreads();
    for (int blk = C.vcu; blk < ML / 64; blk += C.G) {
        for (int sub = 0; sub < 8; ++sub) {
            { const float* src = SCp + ((size_t)blk * 64 + sub * 8) * 2048;
#pragma unroll 4
              for (int e4 = tid; e4 < 8 * 2048 / 4; e4 += NT_) { const f32x4 v = *(const f32x4*)(src + e4 * 4); const int L = e4 >> 5, k = (e4 & 31) * 4; LAS float* d = SCs + L * 129 + k; d[0] = v.x; d[1] = v.y; d[2] = v.z; d[3] = v.w; } }
            __syncthreads();
            {
                const int L = tid >> 2, qd = tid & 3; const LAS float* s = SCs + L * 129 + qd * 32;
                unsigned k[16], t2[16];
#pragma unroll
                for (int i = 0; i < 16; ++i) k[i] = (ord_u32(s[i]) & ~127u) | (unsigned)(127 - (qd * 32 + i));
                sort16_desc(k);
#pragma unroll
                for (int i = 0; i < 16; ++i) t2[i] = (ord_u32(s[16 + i]) & ~127u) | (unsigned)(127 - (qd * 32 + 16 + i));
                sort16_desc(t2); merge_top16(k, t2);
#pragma unroll
                for (int i = 0; i < 16; ++i) t2[i] = __shfl_xor(k[i], 1);
                merge_top16(k, t2);
#pragma unroll
                for (int i = 0; i < 16; ++i) t2[i] = __shfl_xor(k[i], 2);
                merge_top16(k, t2);
                if (qd == 0) {
#pragma unroll
                    for (int i = 0; i < 16; ++i) { const int ki = 127 - (int)(k[i] & 127u); TOPI[L * 16 + i] = ki; TOPS[L * 16 + i] = SCs[L * 129 + ki]; } }
            }
            __syncthreads();
            if (tid < 256) {
                const int pr = tid >> 2, g4 = tid & 3, tt = pr >> 3, h = pr & 7, L0 = tt * 16 + h * 2, L1 = L0 + 1;
                unsigned k[16], t2[16];
#pragma unroll
                for (int i = 0; i < 16; ++i) { const unsigned ab = CTAB[g4 * 16 + i];
                    const float sv = TOPS[L0 * 16 + ((ab >> 4) & 15)] + TOPS[L1 * 16 + (ab & 15)];
                    k[i] = (ab == 0xffu) ? 0u : ((ord_u32(sv) & ~255u) | (255u - ab)); }
                sort16_desc(k);
#pragma unroll
                for (int i = 0; i < 16; ++i) t2[i] = __shfl_xor(k[i], 1);
                merge_top16(k, t2);
#pragma unroll
                for (int i = 0; i < 16; ++i) t2[i] = __shfl_xor(k[i], 2);
                merge_top16(k, t2);
                float bs[4]; const int orow = (sub * 8 + tt) * 128 + h * 16 + g4 * 4; float mx;
                { const int pos0 = 255 - (int)(k[0] & 255u); mx = TOPS[L0 * 16 + (pos0 >> 4)] + TOPS[L1 * 16 + (pos0 & 15)]; }
                float sm = 0.f;
#pragma unroll
                for (int i = 0; i < 4; ++i) { unsigned kv = k[0];
#pragma unroll
                    for (int j = 1; j < 16; ++j) kv = (g4 * 4 + i == j) ? k[j] : kv;
                    const int pos = 255 - (int)(kv & 255u), a = pos >> 4, b2 = pos & 15;
                    bs[i] = __expf(TOPS[L0 * 16 + a] + TOPS[L1 * 16 + b2] - mx); sm += bs[i];
                    IDXs[orow + i] = (unsigned short)(TOPI[L0 * 16 + a] * 128 + TOPI[L1 * 16 + b2]); }
                sm += __shfl_xor(sm, 1); sm += __shfl_xor(sm, 2);
                const float inv = 1.0f / sm;
#pragma unroll
                for (int i = 0; i < 4; ++i) PWs[orow + i] = bs[i] * inv;
            }
            __syncthreads();
        }
        int lane_b = lane; asm volatile("" : "+v"(lane_b));
        const int tl = C.wave * 8 + (lane_b >> 3), piece = lane_b & 7; const size_t t = (size_t)blk * 64 + tl;
        const LAS unsigned short* idxrow = IDXs + tl * 128; LAS float* pwrow = PWs + tl * 128;
        LAS float* actrow = (LAS float*)(C.lds + P12_SC) + tl * 128;
#pragma unroll
        for (int i = 0; i < 16; ++i) actrow[i * 8 + piece] = 0.f;
#define P12_LOAD(R, TAB, it_) do { const int itx = (it_); const v4u i8 = *(const LAS v4u*)(idxrow + (itx & 15) * 8); const unsigned off_ = (unsigned)((itx >> 4) * 128 + piece * 16); \
            _Pragma("unroll") for (int j = 0; j < 8; ++j) { const unsigned ex = (i8[j >> 1] >> (16 * (j & 1))) & 0xffffu; R[j] = *(const v4u*)(TAB + (ex * 2048u + off_)); } } while (0)
#define P12_HXLOAD(cb_) do { const bf16_t* hp = H2 + t * 2048 + (cb_) * 128 + piece * 16; hra = *(const v4u*)hp; hrb = *(const v4u*)(hp + 8); } while (0)
#define P12_BCOMP(R, it_) do { const int s8x = (it_) & 15; float mine = 0.f; \
            _Pragma("unroll") for (int j = 0; j < 8; ++j) { f32x2_t d2 = {0.f, 0.f}; \
                _Pragma("unroll") for (int w4 = 0; w4 < 4; ++w4) { const int wd = (int)R[j][w4]; const f32x2_t lo = __builtin_amdgcn_cvt_pk_f32_fp8(wd, false), hi2 = __builtin_amdgcn_cvt_pk_f32_fp8(wd, true); \
                    d2 += lo * hx2[2 * w4]; d2 += hi2 * hx2[2 * w4 + 1]; } \
                const float d = octet_sum(d2.x + d2.y); mine = (piece == j) ? d : mine; } \
            actrow[s8x * 8 + piece] += mine; } while (0)
        {
            v4u rA[8], rB[8], rC[8], rD[8], hra, hrb; f32x2_t hx2[8];
            P12_HXLOAD(0);
            P12_LOAD(rA, UB, 0); P12_LOAD(rB, UB, 1); P12_LOAD(rC, UB, 2); P12_LOAD(rD, UB, 3);
            for (int it = 0; it < 256; it += 4) {
                if ((it & 15) == 0) {
                    hx2[0] = (f32x2_t){bflo(hra.x), bfhi(hra.x)}; hx2[1] = (f32x2_t){bflo(hra.y), bfhi(hra.y)}; hx2[2] = (f32x2_t){bflo(hra.z), bfhi(hra.z)}; hx2[3] = (f32x2_t){bflo(hra.w), bfhi(hra.w)};
                    hx2[4] = (f32x2_t){bflo(hrb.x), bfhi(hrb.x)}; hx2[5] = (f32x2_t){bflo(hrb.y), bfhi(hrb.y)}; hx2[6] = (f32x2_t){bflo(hrb.z), bfhi(hrb.z)}; hx2[7] = (f32x2_t){bflo(hrb.w), bfhi(hrb.w)};
                    P12_HXLOAD(min((it >> 4) + 1, 15));
                }
                P12_BCOMP(rA, it);     P12_LOAD(rA, UB, min(it + 4, 255));
                P12_BCOMP(rB, it + 1); P12_LOAD(rB, UB, min(it + 5, 255));
                P12_BCOMP(rC, it + 2); P12_LOAD(rC, UB, min(it + 6, 255));
                P12_BCOMP(rD, it + 3); P12_LOAD(rD, UB, min(it + 7, 255));
            }
        }
#pragma unroll
        for (int s8 = 0; s8 < 16; ++s8) { const int sel = s8 * 8 + piece; const unsigned ex = idxrow[sel];
            pwrow[sel] = pwrow[sel] * gelu_erf(actrow[sel] * USC[ex]) * VSC[ex]; }
        asm volatile("s_waitcnt lgkmcnt(0)" ::: "memory");
        const int bsel = (int)(t >> 13); const float* g2 = MOD + bsel * 12288 + 10240;
        float* orow = p.out + t * 2048; float ssq = 0.f;
#define P12_CCOMP(R, it_) do { const int s8x = (it_) & 15; const f32x4 c0 = *(const LAS f32x4*)(pwrow + s8x * 8), c1 = *(const LAS f32x4*)(pwrow + s8x * 8 + 4); \
            _Pragma("unroll") for (int j = 0; j < 8; ++j) { const float c = (j < 4) ? c0[j & 3] : c1[j & 3]; const f32x2_t cc = {c, c}; \
                _Pragma("unroll") for (int w4 = 0; w4 < 4; ++w4) { const int wd = (int)R[j][w4]; const f32x2_t lo = __builtin_amdgcn_cvt_pk_f32_fp8(wd, false), hi2 = __builtin_amdgcn_cvt_pk_f32_fp8(wd, true); \
                    a2[2 * w4] += cc * lo; a2[2 * w4 + 1] += cc * hi2; } } } while (0)
        {
            v4u rA[8], rB[8], rC[8], rD[8]; f32x2_t a2[8];
            P12_LOAD(rA, VB, 0); P12_LOAD(rB, VB, 1); P12_LOAD(rC, VB, 2); P12_LOAD(rD, VB, 3);
            for (int it = 0; it < 256; it += 4) {
                if ((it & 15) == 0) {
#pragma unroll
                    for (int i = 0; i < 8; ++i) a2[i] = (f32x2_t){0.f, 0.f}; }
                P12_CCOMP(rA, it);     P12_LOAD(rA, VB, min(it + 4, 255));
                P12_CCOMP(rB, it + 1); P12_LOAD(rB, VB, min(it + 5, 255));
                P12_CCOMP(rC, it + 2); P12_LOAD(rC, VB, min(it + 6, 255));
                P12_CCOMP(rD, it + 3); P12_LOAD(rD, VB, min(it + 7, 255));
                if ((it & 15) == 12) {
                    if (do_final) {
                        const int c0i = (it >> 4) * 128 + piece * 16;
                        f32x4 xv4[4], gv4[4];
#pragma unroll
                        for (int q4 = 0; q4 < 4; ++q4) { xv4[q4] = *(const f32x4*)(orow + c0i + 4 * q4); gv4[q4] = *(const f32x4*)(g2 + c0i + 4 * q4); }
                        asm volatile("" ::: "memory");
#pragma unroll
                        for (int q4 = 0; q4 < 4; ++q4) { const f32x4 xv = xv4[q4], gv = gv4[q4];
                            f32x4 y; y[0] = xv[0] + gv[0] * a2[2 * q4].x; y[1] = xv[1] + gv[1] * a2[2 * q4].y; y[2] = xv[2] + gv[2] * a2[2 * q4 + 1].x; y[3] = xv[3] + gv[3] * a2[2 * q4 + 1].y;
                            ssq += (y[0] * y[0] + y[1] * y[1]) + (y[2] * y[2] + y[3] * y[3]);
                            *(f32x4*)(orow + c0i + 4 * q4) = y; }
                    } else { asm volatile("" :: "v"(a2[0]), "v"(a2[3]), "v"(a2[5]), "v"(a2[7])); }
                }
            }
        }
        if (PROBE_TS == 40) {
            if (tid == 0) { const unsigned long long t0 = __hip_atomic_load((unsigned long long*)(p.ws + CTL_TS), __ATOMIC_RELAXED, __HIP_MEMORY_SCOPE_AGENT);
                const unsigned dt = (unsigned)(__builtin_amdgcn_s_memrealtime() - t0); __hip_atomic_fetch_max((unsigned*)(p.ws + CTL_TS + 512), dt, __ATOMIC_RELAXED, __HIP_MEMORY_SCOPE_AGENT); }
            XcdBarrier b_; b_.bar = (unsigned*)(p.ws + CTL_BAR); b_.x = xb_xcc_id(); b_.st = (volatile LAS unsigned*)(C.lds + 147456 - 64); xcd_barrier(b_, tid);
        }
        if (do_final) {
            const float rstd = rsqrtf(octet_sum(ssq) * (1.0f / DM) + EPS);
            float probe_delta = 0.f;
            if (PROBE_TS == 40) probe_delta = (float)__hip_atomic_load((unsigned*)(p.ws + CTL_TS + 512), __ATOMIC_RELAXED, __HIP_MEMORY_SCOPE_AGENT) * 0.01f * PROBE_SCALE;
            else if ((PROBE_TS >= 20 && PROBE_TS <= 24) || (PROBE_TS >= 30 && PROBE_TS <= 33)) probe_delta = ((const float*)(p.ws + CTL_TS + 1024))[C.vcu] * PROBE_SCALE;
            else if (PROBE_TS == 14) { const unsigned long long t0 = __hip_atomic_load((unsigned long long*)(p.ws + CTL_TS), __ATOMIC_RELAXED, __HIP_MEMORY_SCOPE_AGENT); probe_delta = (float)(__builtin_amdgcn_s_memrealtime() - t0) * 0.01f * PROBE_SCALE; }
            else if (PROBE_TS == 12) probe_delta = (float)(__builtin_amdgcn_s_memrealtime() - p12_t0) * 0.01f * PROBE_SCALE;
            else if (PROBE_TS == 13) probe_delta = (float)(p12_tA - p12_t0) * 0.01f * PROBE_SCALE;
            else if (PROBE_TS >= 0) { unsigned long long* ts = (unsigned long long*)(p.ws + CTL_TS); const unsigned long long t1 = __hip_atomic_load(ts + PROBE_TS + 1, __ATOMIC_RELAXED, __HIP_MEMORY_SCOPE_AGENT), t0 = __hip_atomic_load(ts + PROBE_TS, __ATOMIC_RELAXED, __HIP_MEMORY_SCOPE_AGENT); probe_delta = (float)(t1 - t0) * 0.01f * PROBE_SCALE; }
#pragma unroll 2
            for (int cb = 0; cb < 16; cb += 2) {
                f32x4 yv[8], fv[8];
#pragma unroll
                for (int q8 = 0; q8 < 8; ++q8) { const int c0i = (cb + (q8 >> 2)) * 128 + piece * 16 + 4 * (q8 & 3); yv[q8] = *(const f32x4*)(orow + c0i); fv[q8] = *(const f32x4*)(p.final_w + c0i); }
                asm volatile("" ::: "memory");
#pragma unroll
                for (int q8 = 0; q8 < 8; ++q8) { const int c0i = (cb + (q8 >> 2)) * 128 + piece * 16 + 4 * (q8 & 3); *(f32x4*)(orow + c0i) = yv[q8] * rstd * fv[q8] + probe_delta; } }
        }
        __syncthreads();
    }
}
__device__ __forceinline__ void cvt_fp8_rows(const Ctx& C, const float* src, unsigned char* dst, float* scl, int nrows, int part, int nparts) {
    const int gw = part * 8 + C.wave, NGW = nparts * 8, lane = C.lane;
    f32x4 nx[8];
    if (gw < nrows) { const float* sp = src + (size_t)gw * 2048 + 16 * lane;
#pragma unroll
        for (int j = 0; j < 2; ++j)
#pragma unroll
            for (int q = 0; q < 4; ++q) nx[j * 4 + q] = *(const f32x4*)(sp + 1024 * j + 4 * q); }
    for (int r = gw; r < nrows; r += NGW) {
        f32x4 v[8]; float mx = 0.f;
#pragma unroll
        for (int i = 0; i < 8; ++i) { v[i] = nx[i]; const f32x4 a = v[i]; mx = fmaxf(mx, fmaxf(fmaxf(fabsf(a.x), fabsf(a.y)), fmaxf(fabsf(a.z), fabsf(a.w)))); }
        { const int rn = (r + NGW < nrows) ? r + NGW : r; const float* sp = src + (size_t)rn * 2048 + 16 * lane;
#pragma unroll
          for (int j = 0; j < 2; ++j)
#pragma unroll
              for (int q = 0; q < 4; ++q) nx[j * 4 + q] = *(const f32x4*)(sp + 1024 * j + 4 * q); }
        asm volatile("" ::: "memory");
#pragma unroll
        for (int o = 1; o < 64; o <<= 1) mx = fmaxf(mx, __shfl_xor(mx, o));
        mx = fmaxf(mx, 1e-30f); const float inv = 440.0f / mx;
        if (lane == 0) scl[r] = mx * (1.0f / 440.0f);
#pragma unroll
        for (int j = 0; j < 2; ++j) { v4u w;
#pragma unroll
            for (int q = 0; q < 4; ++q) { const f32x4 a = v[j * 4 + q] * inv; int wd = 0; wd = __builtin_amdgcn_cvt_pk_fp8_f32(a.x, a.y, wd, false); wd = __builtin_amdgcn_cvt_pk_fp8_f32(a.z, a.w, wd, true); w[q] = (unsigned)wd; }
            *(v4u*)(dst + (size_t)r * 2048 + 1024 * j + 16 * lane) = w; }
    }
}
__device__ __forceinline__ void cvt_rows(const Ctx& C, const float* src, bf16_t* dst, long n8) {
    for (long i = (long)C.vcu * NT_ + C.tid; i < n8; i += (long)C.G * NT_) { const f32x4 a = *(const f32x4*)(src + i * 8), b = *(const f32x4*)(src + i * 8 + 4);
        v4u w; w.x = pk2(a.x, a.y); w.y = pk2(a.z, a.w); w.z = pk2(b.x, b.y); w.w = pk2(b.z, b.w); *(v4u*)(dst + i * 8) = w; }
}
#ifdef PROBE_ATTN_ALPHA
#define PROBE_MGA(ws) ((bf16_t*)((ws) + 60 * MiB))
#else
#define PROBE_MGA(ws) ((bf16_t*)nullptr)
#endif
constexpr int LDS_BYTES = 147456;
constexpr int N_PHASES = 13;
constexpr int LDS_MISC = LDS_BYTES - 64;
__global__ void __launch_bounds__(NT_, 2) mega_fwd(Params p_arg) {
    extern __shared__ __attribute__((aligned(16))) unsigned char lds_raw[];
    const int wave_s = __builtin_amdgcn_readfirstlane((int)threadIdx.x >> 6);
    const int G_s = gridDim.x, bx_s = blockIdx.x;
    int vcu_s = (G_s % 8 == 0) ? (bx_s % 8) * (G_s / 8) + bx_s / 8 : bx_s;
    if (p_arg.ph_hi - p_arg.ph_lo > 1 && G_s == 256) {
        if (threadIdx.x == 0) { unsigned* xq = (unsigned*)(p_arg.ws + CTL_XQ); const unsigned x0 = xb_xcc_id() & 7u; int v = -1;
            for (unsigned q = 0; q < 8 && v < 0; ++q) { const unsigned xx = (x0 + q) & 7u; const unsigned t = __hip_atomic_fetch_add(xq + 64 * xx, 1u, __ATOMIC_RELAXED, __HIP_MEMORY_SCOPE_AGENT); if (t < 32u) v = (int)(xx * 32u + t); }
            ((volatile LAS int*)(lds_raw + LDS_MISC))[4] = v < 0 ? vcu_s : v; }
        __syncthreads();
        vcu_s = __builtin_amdgcn_readfirstlane(((volatile LAS int*)(lds_raw + LDS_MISC))[4]);
        __syncthreads();
    }
#define MKCTX() Ctx C; { unsigned m_ = ~0u; asm volatile("" : "+s"(m_)); C.lane = (int)__builtin_amdgcn_mbcnt_hi(m_, __builtin_amdgcn_mbcnt_lo(m_, 0u)); } \
    C.lds = (LAS unsigned char*)lds_raw; C.wave = wave_s; C.tid = wave_s * 64 + C.lane; C.G = G_s; C.vcu = vcu_s
    const int lo = p_arg.ph_lo, hi = p_arg.ph_hi;
#if defined(__HIP_DEVICE_COMPILE__)
#define LOADP() MKCTX(); typedef const __attribute__((address_space(4))) Params* CPP_; CPP_ kp_ = (CPP_)__builtin_amdgcn_kernarg_segment_ptr(); asm volatile("" : "+s"(kp_)); const Params p = *kp_; \
    unsigned char* ws = p.ws; const float* MOD = (const float*)(ws + CTL_MOD); (void)MOD
#else
#define LOADP() MKCTX(); const Params p = p_arg; unsigned char* ws = p.ws; const float* MOD = (const float*)(ws + CTL_MOD); (void)MOD
#endif
#ifndef PH_MASK
#define PH_MASK 0xffff
#endif
#define IN(k) (((PH_MASK >> (k)) & 1) && lo <= (k) && (k) < hi)
#ifndef P3DUP
#define P3DUP 0
#endif
#ifndef PROBE_REP
#define PROBE_REP -1
#endif
#define NREP(k) ((PROBE_REP == (k)) ? 2 : 1)
#define BAR_() do { LOADP(); XcdBarrier b_; b_.bar = (unsigned*)(ws + CTL_BAR); b_.x = xb_xcc_id(); b_.st = (volatile LAS unsigned*)(C.lds + LDS_MISC); xcd_barrier(b_, C.tid); } while (0)
#if defined(__HIP_DEVICE_COMPILE__)
#define TSTAMP(idx) do { if (PROBE_TS >= 0 && vcu_s == 0 && wave_s == 0) { if (__builtin_amdgcn_mbcnt_hi(~0u, __builtin_amdgcn_mbcnt_lo(~0u, 0u)) == 0u) { \
        typedef const __attribute__((address_space(4))) Params* CPT_; unsigned char* w_ = ((CPT_)__builtin_amdgcn_kernarg_segment_ptr())->ws; __hip_atomic_store((unsigned long long*)(w_ + CTL_TS) + (idx), (unsigned long long)__builtin_amdgcn_s_memrealtime(), __ATOMIC_RELAXED, __HIP_MEMORY_SCOPE_AGENT); } } } while (0)
#else
#define TSTAMP(idx) do { } while (0)
#endif
#define SEAM(k) do { if (IN(k) && IN((k) + 1)) { LOADP(); XcdBarrier b_; b_.bar = (unsigned*)(ws + CTL_BAR); b_.x = xb_xcc_id(); b_.st = (volatile LAS unsigned*)(C.lds + LDS_MISC); xcd_barrier(b_, C.tid); } TSTAMP((k) + 1); } while (0)
    if (hi - lo > 1) { LOADP(); if (C.tid < 2) ((volatile LAS unsigned*)(C.lds + LDS_MISC))[C.tid] = 0u; __syncthreads();
        (void)xcd_barrier_post((unsigned*)(ws + CTL_BAR), (volatile LAS unsigned*)(C.lds + LDS_MISC), C.tid); }
    TSTAMP(0);
    for (int rep_ = 0; rep_ < NREP(0); ++rep_) if (IN(0)) { if (rep_) BAR_(); LOADP(); p0_prologue(p, C); } SEAM(0);
    for (int rep_ = 0; rep_ < NREP(1); ++rep_) if (IN(1)) { if (rep_) BAR_(); LOADP();
        bf16_t* H = (bf16_t*)(ws + WS_D);
        mod_norm_rows(C, p.x, SEQ, p.norm1_w, MOD, MOD + 2048, H);
        mod_norm_rows(C, p.x + (size_t)SEQ * DM, SEQ, p.norm1_w, MOD + 12288, MOD + 12288 + 2048, H + (size_t)SEQ * DM);
        mod_norm_rows(C, p.ctx, MC, p.norm1_w, MOD + 2 * 12288, MOD + 2 * 12288 + 2048, H + (size_t)ML * DM);
    } SEAM(1);
    for (int rep_ = 0; rep_ < NREP(2); ++rep_) if (IN(2)) { if (rep_) BAR_(); LOADP();
        pg8::Gemm g{(const bf16_t*)(ws + WS_D), (const bf16_t*)(ws + WS_C), M1, NIN_PAD, DM}; pg8::StaticOrder S; S.init(M1, NIN_PAD, C.G, (C.G == 256) ? ((C.vcu & 31) * 8 + (C.vcu >> 5)) : (int)blockIdx.x);
        pg8::EpiIn E{(bf16_t*)(ws + WS_CQ), (bf16_t*)(ws + WS_CKV), (bf16_t*)(ws + WS_QKV), (bf16_t*)(ws + WS_Z), (bf16_t*)(ws + WS_GA), (bf16_t*)(ws + WS_GB),
                     (float*)(ws + WS_KR), (float*)(ws + WS_AB), (float*)(ws + CTL_SSQQ), (float*)(ws + CTL_SSQKV)};
        pg8::gemm_phase<pg8::EpiIn, pg8::StaticOrder, true, true>(C.lds, g, S, E, C.tid);
        if (C.G == 256) { const int cv = (C.vcu & 31) * 8 + (C.vcu >> 5); if (cv >= 72) { cvt_fp8_rows(C, p.peer_u, ws + WS_UB, (float*)(ws + WS_USC), 16384, cv - 72, 184); __syncthreads(); for (int it = cv - 72; it < 512; it += 184) p0_wprime_item(p, C, it); } }
    } SEAM(2);
    for (int rep_ = 0; rep_ < NREP(3); ++rep_) if (IN(3)) { if (rep_) BAR_();
        for (int d_ = 0; d_ < (P3DUP == 1 ? 2 : 1); ++d_) { LOADP(); pg8::Gemm g{(const bf16_t*)(ws + WS_CQ), (const bf16_t*)(ws + WS_WUQ), ML, 1536, 512}; pg8::StaticOrder S; S.init(ML, 1536, C.G, (C.G == 256) ? ((C.vcu & 31) * 8 + (C.vcu >> 5)) : (int)blockIdx.x);
          pg8::EpiQ E{(bf16_t*)(ws + WS_D), (const float*)(ws + CTL_SSQQ), QSCALE};
          pg8::gemm_phase<pg8::EpiQ, pg8::StaticOrder, true, true>(C.lds, g, S, E, C.tid); }
        for (int d_ = 0; d_ < (P3DUP == 2 ? 2 : 1); ++d_) { LOADP(); pg8::Gemm g{(const bf16_t*)(ws + WS_CKV), (const bf16_t*)(ws + WS_WUKV), M1, 2048, 256}; pg8::KvOrder S; S.init(M1, 2048, C.G, (C.G == 256) ? ((C.vcu & 31) * 8 + (C.vcu >> 5)) : (int)blockIdx.x);
          pg8::EpiKV E{(bf16_t*)(ws + WS_K), (bf16_t*)(ws + WS_C), (const float*)(ws + CTL_SSQKV)};
          pg8::gemm_phase<pg8::EpiKV, pg8::KvOrder, true, true>(C.lds, g, S, E, C.tid); }
        for (int d_ = 0; d_ < (P3DUP == 3 ? 2 : 1); ++d_) { LOADP(); p3_conv(p, C); }
        for (int d_ = 0; d_ < (P3DUP == 4 ? 2 : 1); ++d_) { LOADP(); p3_krope_gbeta(p, C); }
    } SEAM(3);
    for (int rep_ = 0; rep_ < NREP(4); ++rep_) if (IN(4)) { if (rep_) BAR_(); LOADP();
        const bf16_t* Q = (const bf16_t*)(ws + WS_D); const bf16_t* K = (const bf16_t*)(ws + WS_K); const bf16_t* V = (const bf16_t*)(ws + WS_C); bf16_t* YA = (bf16_t*)(ws + WS_YA);
        for (int u = C.vcu; u < 512; u += C.G) { const int bh = u >> 5, qb = u & 31, b = bh >> 3, h = bh & 7;
            attn::attn_unit(Q + ((size_t)bh * SEQ + qb * 256) * 192, K + (size_t)bh * LKV * 192, V + (size_t)bh * LKV * 128,
                            YA + ((size_t)b * SEQ + qb * 256) * 1024 + h * 128, 1024, LKV, (char*)lds_raw, C.tid); }
    } SEAM(4);
    for (int rep_ = 0; rep_ < NREP(5); ++rep_) if (IN(5)) { if (rep_) BAR_(); LOADP(); p5_chunk_prep(p, C); } SEAM(5);
    for (int rep_ = 0; rep_ < NREP(6); ++rep_) if (IN(6)) { if (rep_) BAR_(); LOADP(); p6_scan(p, C); } SEAM(6);
    for (int rep_ = 0; rep_ < NREP(7); ++rep_) if (IN(7)) { if (rep_) BAR_(); LOADP(); p7_yb(p, C); } SEAM(7);
    for (int rep_ = 0; rep_ < NREP(8); ++rep_) if (IN(8)) { if (rep_) BAR_();
        { LOADP(); pg8::Gemm g{(const bf16_t*)(ws + WS_YA), (const bf16_t*)(ws + WS_WBA), ML, 2048, 1024, (const bf16_t*)(ws + WS_YB), (const bf16_t*)(ws + WS_WBB)};
          pg8::ChainOrder S; S.init(ML, 2048, C.G, (C.G == 256) ? ((C.vcu & 31) * 8 + (C.vcu >> 5)) : (int)blockIdx.x);
          pg8::EpiMerge2 E{(const bf16_t*)(ws + WS_GA), (const bf16_t*)(ws + WS_GB), (bf16_t*)(ws + WS_MG)};
          pg8::gemm_phase<pg8::EpiMerge2, pg8::ChainOrder, true, true>(C.lds, g, S, E, C.tid); }
    } SEAM(8);
    for (int rep_ = 0; rep_ < NREP(9); ++rep_) if (IN(9)) { if (rep_) BAR_(); LOADP();
        pg8::Gemm g{(const bf16_t*)(ws + WS_MG), (const bf16_t*)(ws + WS_WOUT), ML, 2048, 2048}; pg8::StaticOrder S; S.init(ML, 2048, C.G, (C.G == 256) ? ((C.vcu & 31) * 8 + (C.vcu >> 5)) : (int)blockIdx.x);
        pg8::EpiOut E{p.x, MOD + 4096, p.out};
        pg8::gemm_phase<pg8::EpiOut, pg8::StaticOrder, true, true>(C.lds, g, S, E, C.tid);
    } SEAM(9);
#ifdef PROBE_ATTN_ALPHA
    if (IN(9)) { BAR_(); LOADP();
        pg8::Gemm g{(const bf16_t*)(ws + 60 * MiB), (const bf16_t*)(ws + WS_WOUT), ML, 2048, 2048}; pg8::StaticOrder S; S.init(ML, 2048, C.G, (C.G == 256) ? ((C.vcu & 31) * 8 + (C.vcu >> 5)) : (int)blockIdx.x);
        pg8::EpiDelta E{MOD + 4096, (bf16_t*)(ws + 124 * MiB)};
        pg8::gemm_phase<pg8::EpiDelta, pg8::StaticOrder, true, true>(C.lds, g, S, E, C.tid);
    }
#endif
    for (int rep_ = 0; rep_ < NREP(10); ++rep_) if (IN(10)) { if (rep_) BAR_(); LOADP();
        bf16_t* H2 = (bf16_t*)(ws + WS_H2);
        mod_norm_rows(C, p.out, SEQ, p.norm2_w, MOD + 6144, MOD + 8192, H2);
        mod_norm_rows(C, p.out + (size_t)SEQ * DM, SEQ, p.norm2_w, MOD + 12288 + 6144, MOD + 12288 + 8192, H2 + (size_t)SEQ * DM);
        if (C.G != 256) cvt_fp8_rows(C, p.peer_u, ws + WS_UB, (float*)(ws + WS_USC), 16384, C.vcu, C.G);
        cvt_fp8_rows(C, p.peer_v, ws + WS_VB, (float*)(ws + WS_VSC), 16384, C.vcu, C.G);
    } SEAM(10);
    for (int rep_ = 0; rep_ < NREP(11); ++rep_) if (IN(11)) { if (rep_) BAR_(); LOADP();
        pg8::Gemm g{(const bf16_t*)(ws + WS_H2), (const bf16_t*)(ws + WS_WPQ), ML, 2048, 2048}; pg8::StaticOrder S; S.init(ML, 2048, C.G, (C.G == 256) ? ((C.vcu & 31) * 8 + (C.vcu >> 5)) : (int)blockIdx.x);
        pg8::EpiScore E{(float*)(ws + WS_SC)};
        pg8::gemm_phase<pg8::EpiScore, pg8::StaticOrder, true, true>(C.lds, g, S, E, C.tid);
    } SEAM(11);
    for (int rep_ = 0; rep_ < NREP(12); ++rep_) if (IN(12)) { if (rep_) BAR_(); LOADP(); p12_peer(p, C, rep_ == NREP(12) - 1); }
#undef IN
#undef SEAM
}

#ifndef MK_SINGLE
#define MK_SINGLE 1
#endif
extern "C" void kernel_launch(void* const* d_in, const int* in_sizes, int n_in, void* d_out, int out_size, void* d_ws, size_t ws_size, hipStream_t stream) {
    static int grid = 0;
    if (grid == 0) {
        if (n_in != 25 || out_size != ML * DM || ws_size < WS_END) { fprintf(stderr, "kernel_launch: unexpected shapes: n_in %d out %d ws %zu (need %zu)\n", n_in, out_size, ws_size, (size_t)WS_END); grid = -1; return; }
        int dev = 0, cus = 0, per_cu = 0;
        if (hipGetDevice(&dev) != hipSuccess || hipDeviceGetAttribute(&cus, hipDeviceAttributeMultiprocessorCount, dev) != hipSuccess) { grid = -1; return; }
        if (hipFuncSetAttribute((const void*)mega_fwd, hipFuncAttributeMaxDynamicSharedMemorySize, LDS_BYTES) != hipSuccess) { fprintf(stderr, "kernel_launch: hipFuncSetAttribute failed\n"); grid = -1; return; }
        if (hipOccupancyMaxActiveBlocksPerMultiprocessor(&per_cu, (const void*)mega_fwd, NT_, LDS_BYTES) != hipSuccess || per_cu < 1) { fprintf(stderr, "kernel_launch: occupancy query says %d\n", per_cu); per_cu = 1; }
        (void)hipGetLastError();
        grid = cus;
    }
    if (grid < 0) return;
    (void)hipMemsetAsync((char*)d_ws + WS_CTL, 0, CTL_BYTES, stream);
    Params p{};
    const float** pp = (const float**)&p;
    for (int i = 0; i < 25; ++i) pp[i] = (const float*)d_in[i];
    p.out = (float*)d_out; p.ws = (unsigned char*)d_ws;
#if MK_SINGLE
    p.ph_lo = 0; p.ph_hi = N_PHASES;
    hipLaunchKernelGGL(mega_fwd, dim3(grid), dim3(NT_), LDS_BYTES, stream, p);
#else
    for (int ph = 0; ph < N_PHASES; ++ph) { p.ph_lo = ph; p.ph_hi = ph + 1; hipLaunchKernelGGL(mega_fwd, dim3(grid), dim3(NT_), LDS_BYTES, stream, p); }
#endif
}
```

```cpp
#include <hip/hip_runtime.h>
#include <hip/hip_bf16.h>
#include <cstdio>
#include <cstdint>
#include <cmath>
namespace pg8 {
#define PG8_LAS __attribute__((address_space(3)))
typedef unsigned short bf16_t;
typedef short bf16x8 __attribute__((ext_vector_type(8)));
typedef float f32x4 __attribute__((ext_vector_type(4)));
typedef unsigned u32x4 __attribute__((ext_vector_type(4)));
typedef unsigned u32x2 __attribute__((ext_vector_type(2)));
constexpr int BM = 256, BK = 64, HALF = 128, HTB = HALF * BK * 2  , STAGE_BYTES = 8 * HTB, NXCD = 8, WGM = 8;

__host__ __device__ __forceinline__ int lds_byte(int r, int c) { const int st = (r >> 4) * 2 + (c >> 5), rr = r & 15, cc = c & 31, ob = rr * 64 + cc * 2; return st * 1024 + (ob ^ (((ob >> 9) & 1) << 5)); }
__host__ __device__ __forceinline__ void stage_rc(int b, int& R, int& C) { const int st = b / 1024, sb = b % 1024, swz = sb ^ (((sb >> 9) & 1) << 5); R = (st >> 1) * 16 + swz / 64; C = (st & 1) * 32 + (swz % 64) / 2; }
__host__ __device__ __forceinline__ int perm32(int rho) { const int n = rho >> 4, i = rho & 15; return 8 * (i >> 2) + 4 * n + (i & 3); }

struct Unit { int pm, pn, half; };
struct Gemm { const bf16_t* A; const bf16_t* Bt; int M, N, K; const bf16_t* A2 = nullptr; const bf16_t* Bt2 = nullptr; };

struct StaticOrder {
    int nM, nN, nwg, G, c;
    __host__ __device__ void init(int M, int N, int G_, int c_) { nM = M / BM; nN = N / BM; nwg = nM * nN; G = G_; c = c_; }
    __host__ __device__ bool next(int i, Unit& u) const { return at((long)i * G + c, u); }
    __host__ __device__ bool at(const long L, Unit& u) const {
        if (L >= nwg) return false;
        int wgid = (int)L; { const int q = nwg / NXCD, r = nwg % NXCD, xcd = wgid % NXCD, off = wgid / NXCD; wgid = (xcd < r ? xcd * (q + 1) : r * (q + 1) + (xcd - r) * q) + off; }
        const int nig = WGM * nN, gid = wgid / nig, fm = gid * WGM, gsz = (nM - fm) < WGM ? (nM - fm) : WGM;
        u.pm = fm + ((wgid % nig) % gsz); u.pn = (wgid % nig) / gsz; return true;
    }
    __device__ __forceinline__ void a_ready(const Unit&) const {}
    __device__ __forceinline__ void done(const Unit&) const {}
};
struct KvOrder {
    StaticOrder base; int c;
    __host__ __device__ void init(int M, int N, int G_, int c_) { base.init(M, N, G_, c_); c = c_; }
    __host__ __device__ bool next(int i, Unit& u) const {
        if (base.G != 256 || base.nwg != 528) return base.next(i, u);
        if (c >= 128) return i < 3 ? base.at((long)(c - 128) + 128 * i, u) : false;
        if (i == 0) return base.at(384 + c, u);
        return (i == 1 && c < 16) ? base.at(512 + c, u) : false;
    }
    __device__ __forceinline__ void a_ready(const Unit&) const {}
    __device__ __forceinline__ void done(const Unit&) const {}
};
struct ChainOrder {
    StaticOrder base;
    __host__ __device__ void init(int M, int N, int G_, int c_) { base.init(M, N, G_, c_); }
    __host__ __device__ bool next(int i, Unit& u) const { if (!base.next(i >> 1, u)) return false; u.half = i & 1; return true; }
    __device__ __forceinline__ void a_ready(const Unit&) const {}
    __device__ __forceinline__ void done(const Unit&) const {}
};
typedef float f32x2 __attribute__((ext_vector_type(2)));
typedef __bf16 bf16x2_g __attribute__((ext_vector_type(2)));
__device__ __forceinline__ unsigned cvt_pk_bf16(float lo, float hi) { f32x2 v = {lo, hi}; bf16x2_g b = __builtin_convertvector(v, bf16x2_g); return __builtin_bit_cast(unsigned, b); }
template <class Epi, class Sched, bool ALIGN_EPI = false, bool SP2 = false>
__device__ __forceinline__ void gemm_phase(PG8_LAS unsigned char* lds, const Gemm g, const Sched& S, const Epi& E, const int tid) {
    const int wid = __builtin_amdgcn_readfirstlane(tid >> 6), lane = tid & 63, wr = wid >> 2, wc = wid & 3, fr = lane & 15, fq = lane >> 4;
    const int K = g.K, nt = K / BK;
    unsigned voffA[2], voffB[2];
#pragma unroll
    for (int i = 0; i < 2; ++i) { int R, C; stage_rc(tid * 16 + i * 8192, R, C); const int Rb = Epi::PERM ? ((R & ~31) + perm32(R & 31)) : R;
        voffA[i] = (unsigned)(R * K + C) * 2u; voffB[i] = (unsigned)(Rb * K + C) * 2u; }
    const size_t kstep = (size_t)(BK * 2);
    const size_t hstep = (size_t)HALF * K * 2;
    const size_t tstep = 2 * hstep;
    const unsigned ldsw = (unsigned)wid * 1024u;
    const int aoff = lds_byte(wr * 64 + fr, fq * 8), boff = lds_byte(wc * 32 + fr, fq * 8);
#define PG8_SA(b, h) (((b) * 2 + (h)) * HTB)
#define PG8_SB(b, h) ((4 + (b) * 2 + (h)) * HTB)
#define PG8_STAGE(bufoff, gbase, voff) do { _Pragma("unroll") for (int _i = 0; _i < 2; ++_i) \
        __builtin_amdgcn_global_load_lds((const unsigned*)((const char*)(gbase) + (voff)[_i]), (PG8_LAS unsigned*)(lds + (bufoff) + ldsw + _i * 8192), 16, 0, 0); } while (0)
#define PG8_LDA(dst, b, h) do { _Pragma("unroll") for (int m = 0; m < 4; ++m) _Pragma("unroll") for (int k = 0; k < 2; ++k) dst[m][k] = *(const PG8_LAS bf16x8*)(lds + PG8_SA(b, h) + aoff + m * 2048 + k * 1024); } while (0)
#define PG8_LDB(dst, b, h) do { _Pragma("unroll") for (int n = 0; n < 2; ++n) _Pragma("unroll") for (int k = 0; k < 2; ++k) dst[n][k] = *(const PG8_LAS bf16x8*)(lds + PG8_SB(b, h) + boff + n * 2048 + k * 1024); } while (0)
#define PG8_MMA(ai, bj, At, Bt) do { __builtin_amdgcn_s_setprio(1); _Pragma("unroll") for (int m = 0; m < 4; ++m) _Pragma("unroll") for (int n = 0; n < 2; ++n) _Pragma("unroll") for (int k = 0; k < 2; ++k) \
        acc[ai][bj][m][n] = __builtin_amdgcn_mfma_f32_16x16x32_bf16(Bt[n][k], At[m][k], acc[ai][bj][m][n], 0, 0, 0); __builtin_amdgcn_s_setprio(0); } while (0)
#define PG8_WAIT_V(n) asm volatile("s_waitcnt vmcnt(" #n ")" ::: "memory")
#define PG8_WAIT_L(n) asm volatile("s_waitcnt lgkmcnt(" #n ")" ::: "memory")
#define PG8_BAR __builtin_amdgcn_s_barrier()
#define PG8_SCHED __builtin_amdgcn_sched_barrier(0)
    Unit cur, nxt; int ui = 0;
    if (!S.next(0, cur)) return;
    f32x4 acc[2][2][4][2];
#pragma unroll
    for (int a = 0; a < 2; ++a)
#pragma unroll
        for (int b = 0; b < 2; ++b)
#pragma unroll
            for (int m = 0; m < 4; ++m)
#pragma unroll
                for (int n = 0; n < 2; ++n) acc[a][b][m][n] = (f32x4){0.f, 0.f, 0.f, 0.f};
    bf16x8 At[4][2], B0[2][2], B1[2][2];
    const char* cA; const char* cB;
    if constexpr (Epi::CHAIN) { cA = (const char*)(cur.half ? g.A2 : g.A) + (size_t)cur.pm * tstep; cB = (const char*)(cur.half ? g.Bt2 : g.Bt) + (size_t)cur.pn * tstep; }
    else { cA = (const char*)g.A + (size_t)cur.pm * tstep; cB = (const char*)g.Bt + (size_t)cur.pn * tstep; }
    S.a_ready(cur);
    if constexpr (SP2) {
        PG8_STAGE(PG8_SB(0, 0), cB, voffB); PG8_STAGE(PG8_SB(0, 1), cB + hstep, voffB); PG8_STAGE(PG8_SA(0, 0), cA, voffA); PG8_STAGE(PG8_SA(0, 1), cA + hstep, voffA);
        if (wr == 1) PG8_BAR;
        PG8_WAIT_V(2); PG8_BAR;
        PG8_STAGE(PG8_SB(1, 0), cB + kstep, voffB); PG8_STAGE(PG8_SA(1, 0), cA + kstep, voffA); PG8_STAGE(PG8_SB(1, 1), cB + hstep + kstep, voffB);
        PG8_WAIT_V(6); PG8_BAR;
    } else {
        PG8_STAGE(PG8_SB(0, 0), cB, voffB); PG8_STAGE(PG8_SA(0, 0), cA, voffA); PG8_STAGE(PG8_SB(0, 1), cB + hstep, voffB); PG8_STAGE(PG8_SA(0, 1), cA + hstep, voffA);
        if (wr == 1) PG8_BAR;
        PG8_WAIT_V(4); PG8_BAR;
        PG8_STAGE(PG8_SB(1, 0), cB + kstep, voffB); PG8_STAGE(PG8_SA(1, 0), cA + kstep, voffA); PG8_STAGE(PG8_SB(1, 1), cB + hstep + kstep, voffB);
        PG8_WAIT_V(6); PG8_BAR;
    }
    for (;;) {
        const bool has_next = S.next(ui + 1, nxt);
        const char* nA; const char* nB;
        if constexpr (Epi::CHAIN) { nA = has_next ? (const char*)(nxt.half ? g.A2 : g.A) + (size_t)nxt.pm * tstep : cA; nB = has_next ? (const char*)(nxt.half ? g.Bt2 : g.Bt) + (size_t)nxt.pn * tstep : cB; }
        else { nA = has_next ? (const char*)g.A + (size_t)nxt.pm * tstep : cA; nB = has_next ? (const char*)g.Bt + (size_t)nxt.pn * tstep : cB; }
        for (int t = 0; t < nt; t += 2) {
            const bool last = (t == nt - 2);
            const char* a1 = cA + (size_t)(t + 1) * kstep;
            const char* a2 = last ? nA : cA + (size_t)(t + 2) * kstep; const char* b2 = last ? nB : cB + (size_t)(t + 2) * kstep;
            const char* a3 = a2 + kstep; const char* b3 = b2 + kstep;
            if (last && has_next) S.a_ready(nxt);
            if constexpr (Epi::PREFETCH) E.prefetch(cur, t, tid, (PG8_LAS unsigned*)(lds + 131072 + wid * 256));
            if constexpr (SP2) {
            PG8_LDB(B0, 0, 0); PG8_LDB(B1, 0, 1); PG8_SCHED; PG8_LDA(At, 0, 0); PG8_STAGE(PG8_SA(1, 1), a1 + hstep, voffA);
            PG8_WAIT_V(8); PG8_WAIT_L(0); PG8_BAR; PG8_MMA(0, 0, At, B0); PG8_MMA(0, 1, At, B1); PG8_BAR; PG8_SCHED;
            PG8_LDA(At, 0, 1); PG8_STAGE(PG8_SB(0, 0), b2, voffB); PG8_STAGE(PG8_SB(0, 1), b2 + hstep, voffB); PG8_STAGE(PG8_SA(0, 0), a2, voffA);
            PG8_WAIT_V(8); PG8_WAIT_L(0); PG8_BAR; PG8_MMA(1, 0, At, B0); PG8_MMA(1, 1, At, B1); PG8_BAR; PG8_SCHED;
            PG8_LDB(B0, 1, 0); PG8_LDB(B1, 1, 1); PG8_SCHED; PG8_LDA(At, 1, 0); PG8_STAGE(PG8_SA(0, 1), a2 + hstep, voffA);
            PG8_WAIT_V(8); PG8_WAIT_L(0); PG8_BAR; PG8_MMA(0, 0, At, B0); PG8_MMA(0, 1, At, B1); PG8_BAR; PG8_SCHED;
            PG8_LDA(At, 1, 1); PG8_STAGE(PG8_SB(1, 0), b3, voffB); PG8_STAGE(PG8_SB(1, 1), b3 + hstep, voffB); PG8_STAGE(PG8_SA(1, 0), a3, voffA);
            PG8_WAIT_V(8); PG8_WAIT_L(0); PG8_BAR; PG8_MMA(1, 0, At, B0); PG8_MMA(1, 1, At, B1); PG8_BAR; PG8_SCHED;
            } else {
            PG8_LDB(B0, 0, 0); PG8_SCHED; PG8_LDA(At, 0, 0); PG8_STAGE(PG8_SA(1, 1), a1 + hstep, voffA);
            PG8_WAIT_L(8); PG8_BAR; PG8_WAIT_L(0); PG8_MMA(0, 0, At, B0); PG8_BAR; PG8_SCHED;
            PG8_LDB(B1, 0, 1); PG8_STAGE(PG8_SB(0, 0), b2, voffB);
            PG8_BAR; PG8_WAIT_L(0); PG8_MMA(0, 1, At, B1); PG8_BAR;
            PG8_LDA(At, 0, 1); PG8_STAGE(PG8_SA(0, 0), a2, voffA);
            PG8_BAR; PG8_WAIT_L(0); PG8_MMA(1, 0, At, B0); PG8_BAR; PG8_SCHED;
            PG8_STAGE(PG8_SB(0, 1), b2 + hstep, voffB);
            PG8_WAIT_V(6); PG8_BAR; PG8_MMA(1, 1, At, B1); PG8_BAR;
            PG8_LDB(B0, 1, 0); PG8_SCHED; PG8_LDA(At, 1, 0); PG8_STAGE(PG8_SA(0, 1), a2 + hstep, voffA);
            PG8_WAIT_L(8); PG8_BAR; PG8_WAIT_L(0); PG8_MMA(0, 0, At, B0); PG8_BAR; PG8_SCHED;
            PG8_LDB(B1, 1, 1); PG8_STAGE(PG8_SB(1, 0), b3, voffB);
            PG8_BAR; PG8_WAIT_L(0); PG8_MMA(0, 1, At, B1); PG8_BAR;
            PG8_LDA(At, 1, 1); PG8_STAGE(PG8_SA(1, 0), a3, voffA);
            PG8_BAR; PG8_WAIT_L(0); PG8_MMA(1, 0, At, B0); PG8_BAR; PG8_SCHED;
            PG8_STAGE(PG8_SB(1, 1), b3 + hstep, voffB);
            PG8_WAIT_V(6); PG8_BAR; PG8_MMA(1, 1, At, B1); PG8_BAR;
            }
        }
        if constexpr (ALIGN_EPI) { if (wr == 0) PG8_BAR; }
        if constexpr (!Epi::AFTER_DRAIN) { E(acc, cur, wr, wc, fr, fq); S.done(cur); }
        if (!has_next) break;
        if (!(Epi::CHAIN && cur.half == 0))
#pragma unroll
        for (int a = 0; a < 2; ++a)
#pragma unroll
            for (int b = 0; b < 2; ++b)
#pragma unroll
                for (int m = 0; m < 4; ++m)
#pragma unroll
                    for (int n = 0; n < 2; ++n) acc[a][b][m][n] = (f32x4){0.f, 0.f, 0.f, 0.f};
        cur = nxt; cA = nA; cB = nB; ++ui;
        if constexpr (ALIGN_EPI) { if (wr == 1) PG8_BAR; }
    }
    PG8_WAIT_V(0);
    if constexpr (!ALIGN_EPI) { if (wr == 0) PG8_BAR; }
    PG8_BAR;
    if constexpr (Epi::AFTER_DRAIN) { E.fused(acc, cur, wr, wc, fr, fq, lds, wid, lane); S.done(cur); }
#undef PG8_SA
#undef PG8_SB
#undef PG8_STAGE
#undef PG8_LDA
#undef PG8_LDB
#undef PG8_MMA
#undef PG8_WAIT_V
#undef PG8_WAIT_L
#undef PG8_BAR
#undef PG8_SCHED
}
__device__ __forceinline__ float bfu(unsigned short v) { return __uint_as_float(((unsigned)v) << 16); }
__device__ __forceinline__ void fast_sincos(float x, float& sn, float& cs) {
    float rev = x * 0.15915494309189535f; rev -= rintf(rev); sn = __builtin_amdgcn_sinf(rev); cs = __builtin_amdgcn_cosf(rev); }
__device__ __forceinline__ float sigm(float v) { return 1.0f / (1.0f + __expf(-v)); }
__device__ __forceinline__ void store_tile_bf16(const f32x4 (&acc)[2][2][4][2], bf16_t* tile  , int ld, int wr, int wc, int fr, int fq) {
#pragma unroll
    for (int ai = 0; ai < 2; ++ai)
#pragma unroll
        for (int m = 0; m < 4; ++m) { bf16_t* rowp = tile + (size_t)(ai * HALF + wr * 64 + m * 16 + fr) * ld + wc * 32 + 8 * fq;
#pragma unroll
            for (int bj = 0; bj < 2; ++bj) { const f32x4 v0 = acc[ai][bj][m][0], v1 = acc[ai][bj][m][1];
                u32x4 w; w.x = cvt_pk_bf16(v0[0], v0[1]); w.y = cvt_pk_bf16(v0[2], v0[3]); w.z = cvt_pk_bf16(v1[0], v1[1]); w.w = cvt_pk_bf16(v1[2], v1[3]);
                *(u32x4*)(rowp + bj * HALF) = w; } }
}
__device__ __forceinline__ void tile_ssq(const f32x4 (&acc)[2][2][4][2], float* ssq  , int nslot, int slot, int wr, int fr, int fq) {
#pragma unroll
    for (int ai = 0; ai < 2; ++ai)
#pragma unroll
        for (int m = 0; m < 4; ++m) { float s = 0.f;
#pragma unroll
            for (int bj = 0; bj < 2; ++bj)
#pragma unroll
                for (int n = 0; n < 2; ++n) { const f32x4 x = acc[ai][bj][m][n]; s += (x[0] * x[0] + x[1] * x[1]) + (x[2] * x[2] + x[3] * x[3]); }
            s += __shfl_xor(s, 16); s += __shfl_xor(s, 32);
            if (fq == 0) ssq[(size_t)(ai * HALF + wr * 64 + m * 16 + fr) * nslot + slot] = s; }
}
struct EpiIn {
    static constexpr bool PERM = true, AFTER_DRAIN = false, CHAIN = false, PREFETCH = false;
    bf16_t *CQ, *CKV, *QKV, *Z, *GA, *GB; float *KR, *AB, *ssq_q, *ssq_kv;
    __device__ __forceinline__ void operator()(const f32x4 (&acc)[2][2][4][2], const Unit& u, int wr, int wc, int fr, int fq) const {
        const int pn = u.pn, pm = u.pm; const size_t r0 = (size_t)pm * BM;
        const bool lat = pm < 64;
        if (pn == 35) {
            const int cl = wc * 32 + 8 * fq;
            if (cl < 96) {
#pragma unroll
                for (int ai = 0; ai < 2; ++ai)
#pragma unroll
                    for (int m = 0; m < 4; ++m) { const size_t r = r0 + ai * HALF + wr * 64 + m * 16 + fr;
                        float* dst = (cl < 64) ? (KR + r * 64 + cl) : (AB + r * 32 + (cl - 64));
                        *(f32x4*)dst = acc[ai][0][m][0]; *(f32x4*)(dst + 4) = acc[ai][0][m][1]; }
            }
            return;
        }
        bf16_t* base; int ld; bool latonly = true; float* ssq = nullptr; int nslot = 4, slot = wc;
        if (pn < 2) { base = CQ + pn * 256; ld = 512; ssq = ssq_q; nslot = 8; slot = pn * 4 + wc; }
        else if (pn == 2) { base = CKV; ld = 256; ssq = ssq_kv; latonly = false; }
        else if (pn < 15) { base = QKV + (pn - 3) * 256; ld = 3072; latonly = false; }
        else if (pn < 19) { base = Z + (pn - 15) * 256; ld = 1024; }
        else if (pn < 27) { base = GA + (pn - 19) * 256; ld = 2048; }
        else { base = GB + (pn - 27) * 256; ld = 2048; }
        if (latonly && !lat) return;
        store_tile_bf16(acc, base + r0 * ld, ld, wr, wc, fr, fq);
        if (ssq) tile_ssq(acc, ssq + r0 * nslot, nslot, slot, wr, fr, fq);
    }
};
struct EpiQ {
    static constexpr bool PERM = true, AFTER_DRAIN = false, CHAIN = false, PREFETCH = false;
    bf16_t* Q; const float* ssq_q; float qscale;
    __device__ __forceinline__ void operator()(const f32x4 (&acc)[2][2][4][2], const Unit& u, int wr, int wc, int fr, int fq) const {
        const int pn = u.pn;
#pragma unroll
        for (int ai = 0; ai < 2; ++ai)
#pragma unroll
            for (int m = 0; m < 4; ++m) {
                const int r = u.pm * BM + ai * HALF + wr * 64 + m * 16 + fr; const int b = r >> 13, t = r & 8191;
                const f32x4 sa = *(const f32x4*)(ssq_q + (size_t)r * 8), sb = *(const f32x4*)(ssq_q + (size_t)r * 8 + 4);
                const float rs = rsqrtf((((sa[0] + sa[1]) + (sa[2] + sa[3])) + ((sb[0] + sb[1]) + (sb[2] + sb[3]))) * (1.0f / 512.0f) + 1e-6f) * qscale;
#pragma unroll
                for (int bj = 0; bj < 2; ++bj) {
                    f32x4 v0 = acc[ai][bj][m][0] * rs, v1 = acc[ai][bj][m][1] * rs;
                    bf16_t* dst;
                    if (pn < 4) { const int head = pn * 2 + bj; dst = Q + ((size_t)(b * 8 + head) * 8192 + t) * 192 + wc * 32 + 8 * fq; }
                    else {
                        const int head = (pn - 4) * 4 + bj * 2 + (wc >> 1), half = wc & 1;
                        const float pos = (float)(half == 0 ? (t >> 6) : (t & 63));
                        const int i0 = (8 * fq) & 15;
                        float xs[8] = {v0[0], v0[1], v0[2], v0[3], v1[0], v1[1], v1[2], v1[3]};
#pragma unroll
                        for (int e = 0; e < 8; ++e) {
                            const float other = __shfl_xor(xs[e], 32);
                            const float invf = exp2f(-(float)(i0 + e) * (13.287712379549449f / 16.0f));
                            float sn, cs; fast_sincos(pos * invf, sn, cs);
                            xs[e] = (fq < 2) ? (xs[e] * cs - other * sn) : (other * sn + xs[e] * cs);
                        }
                        v0 = (f32x4){xs[0], xs[1], xs[2], xs[3]}; v1 = (f32x4){xs[4], xs[5], xs[6], xs[7]};
                        dst = Q + ((size_t)(b * 8 + head) * 8192 + t) * 192 + 128 + half * 32 + 8 * fq;
                    }
                    u32x4 w; w.x = cvt_pk_bf16(v0[0], v0[1]); w.y = cvt_pk_bf16(v0[2], v0[3]); w.z = cvt_pk_bf16(v1[0], v1[1]); w.w = cvt_pk_bf16(v1[2], v1[3]);
                    *(u32x4*)dst = w;
                }
            }
    }
};
struct EpiKV {
    static constexpr bool PERM = true, AFTER_DRAIN = false, CHAIN = false, PREFETCH = false;
    bf16_t *K, *V; const float* ssq_kv;
    __device__ __forceinline__ void operator()(const f32x4 (&acc)[2][2][4][2], const Unit& u, int wr, int wc, int fr, int fq) const {
        const int head = u.pn;
#pragma unroll
        for (int ai = 0; ai < 2; ++ai)
#pragma unroll
            for (int m = 0; m < 4; ++m) {
                const int r = u.pm * BM + ai * HALF + wr * 64 + m * 16 + fr;
                int b, l; if (r < 16384) { b = r >> 13; l = 256 + (r & 8191); } else { b = (r - 16384) >> 8; l = (r - 16384) & 255; }
                const f32x4 sa = *(const f32x4*)(ssq_kv + (size_t)r * 4);
                const float rs = rsqrtf(((sa[0] + sa[1]) + (sa[2] + sa[3])) * (1.0f / 256.0f) + 1e-6f);
                const size_t rowi = (size_t)(b * 8 + head) * 8448 + l;
#pragma unroll
                for (int bj = 0; bj < 2; ++bj) {
                    const f32x4 v0 = acc[ai][bj][m][0] * rs, v1 = acc[ai][bj][m][1] * rs;
                    bf16_t* dst = (bj == 0) ? (K + rowi * 192 + wc * 32 + 8 * fq) : (V + rowi * 128 + wc * 32 + 8 * fq);
                    u32x4 w; w.x = cvt_pk_bf16(v0[0], v0[1]); w.y = cvt_pk_bf16(v0[2], v0[3]); w.z = cvt_pk_bf16(v1[0], v1[1]); w.w = cvt_pk_bf16(v1[2], v1[3]);
                    *(u32x4*)dst = w;
                }
            }
    }
};
template <bool FIRST> struct EpiMerge {
    static constexpr bool PERM = true, AFTER_DRAIN = false, CHAIN = false, PREFETCH = false;
    const bf16_t* G; bf16_t* MG; bf16_t* MGA;
    __device__ __forceinline__ void operator()(const f32x4 (&acc)[2][2][4][2], const Unit& u, int wr, int wc, int fr, int fq) const {
#pragma unroll
        for (int ai = 0; ai < 2; ++ai) {
            u32x4 gq[4][2], pq[4][2];
#pragma unroll
            for (int m = 0; m < 4; ++m)
#pragma unroll
                for (int bj = 0; bj < 2; ++bj) { const size_t off = (size_t)(u.pm * BM + ai * HALF + wr * 64 + m * 16 + fr) * 2048 + u.pn * BM + wc * 32 + 8 * fq + bj * HALF;
                    gq[m][bj] = *(const u32x4*)(G + off); if (!FIRST) pq[m][bj] = *(const u32x4*)(MG + off); }
            asm volatile("" ::: "memory");
#pragma unroll
            for (int m = 0; m < 4; ++m)
#pragma unroll
                for (int bj = 0; bj < 2; ++bj) { const size_t off = (size_t)(u.pm * BM + ai * HALF + wr * 64 + m * 16 + fr) * 2048 + u.pn * BM + wc * 32 + 8 * fq + bj * HALF;
                    const u32x4 g = gq[m][bj];
                    float gv[8] = {__uint_as_float(g.x << 16), __uint_as_float(g.x & 0xffff0000u), __uint_as_float(g.y << 16), __uint_as_float(g.y & 0xffff0000u),
                                   __uint_as_float(g.z << 16), __uint_as_float(g.z & 0xffff0000u), __uint_as_float(g.w << 16), __uint_as_float(g.w & 0xffff0000u)};
                    float o[8];
#pragma unroll
                    for (int e2 = 0; e2 < 8; ++e2) o[e2] = sigm(gv[e2]) * acc[ai][bj][m][e2 >> 2][e2 & 3];
                    if (!FIRST) { const u32x4 p = pq[m][bj];
                        o[0] += __uint_as_float(p.x << 16); o[1] += __uint_as_float(p.x & 0xffff0000u); o[2] += __uint_as_float(p.y << 16); o[3] += __uint_as_float(p.y & 0xffff0000u);
                        o[4] += __uint_as_float(p.z << 16); o[5] += __uint_as_float(p.z & 0xffff0000u); o[6] += __uint_as_float(p.w << 16); o[7] += __uint_as_float(p.w & 0xffff0000u); }
                    u32x4 w; w.x = cvt_pk_bf16(o[0], o[1]); w.y = cvt_pk_bf16(o[2], o[3]); w.z = cvt_pk_bf16(o[4], o[5]); w.w = cvt_pk_bf16(o[6], o[7]);
                    *(u32x4*)(MG + off) = w;
                    if (FIRST && MGA) *(u32x4*)(MGA + off) = w;
                }
            asm volatile("" ::: "memory");
        }
    }
};
struct EpiMerge2 {
    static constexpr bool PERM = true, AFTER_DRAIN = false, CHAIN = true, PREFETCH = false;
    const bf16_t* GA; const bf16_t* GB; bf16_t* MG;
    __device__ __forceinline__ void prefetch(const Unit& u, int t, int tid, PG8_LAS unsigned* dump) const {
        if (u.half == 0 && t < 8) { const int it = t >> 1, line = (it & 1) * 512 + tid, row = line >> 2, seg = line & 3; const bf16_t* G = (it < 2) ? GA : GB;
            __builtin_amdgcn_global_load_lds((const unsigned*)(G + (size_t)(u.pm * BM + row) * 2048 + u.pn * BM + seg * 64), dump, 4, 0, 0); } }
    __device__ __forceinline__ void operator()(f32x4 (&acc)[2][2][4][2], const Unit& u, int wr, int wc, int fr, int fq) const {
#pragma unroll
        for (int ai = 0; ai < 2; ++ai) {
            u32x4 gq[4][2], hq[4][2];
#pragma unroll
            for (int m = 0; m < 4; ++m)
#pragma unroll
                for (int bj = 0; bj < 2; ++bj) { const size_t off = (size_t)(u.pm * BM + ai * HALF + wr * 64 + m * 16 + fr) * 2048 + u.pn * BM + wc * 32 + 8 * fq + bj * HALF;
                    hq[m][bj] = *(const u32x4*)(GB + off); if (u.half == 0) gq[m][bj] = *(const u32x4*)(GA + off); }
            asm volatile("" ::: "memory");
#pragma unroll
            for (int m = 0; m < 4; ++m)
#pragma unroll
                for (int bj = 0; bj < 2; ++bj) { const size_t off = (size_t)(u.pm * BM + ai * HALF + wr * 64 + m * 16 + fr) * 2048 + u.pn * BM + wc * 32 + 8 * fq + bj * HALF;
                    const u32x4 h = hq[m][bj];
                    float hv[8] = {__uint_as_float(h.x << 16), __uint_as_float(h.x & 0xffff0000u), __uint_as_float(h.y << 16), __uint_as_float(h.y & 0xffff0000u),
                                   __uint_as_float(h.z << 16), __uint_as_float(h.z & 0xffff0000u), __uint_as_float(h.w << 16), __uint_as_float(h.w & 0xffff0000u)};
                    float eb[8];
#pragma unroll
                    for (int e2 = 0; e2 < 8; ++e2) eb[e2] = 1.0f + __expf(-fmaxf(hv[e2], -30.0f));
                    if (u.half == 0) { const u32x4 g = gq[m][bj];
                        float gv[8] = {__uint_as_float(g.x << 16), __uint_as_float(g.x & 0xffff0000u), __uint_as_float(g.y << 16), __uint_as_float(g.y & 0xffff0000u),
                                       __uint_as_float(g.z << 16), __uint_as_float(g.z & 0xffff0000u), __uint_as_float(g.w << 16), __uint_as_float(g.w & 0xffff0000u)};
#pragma unroll
                        for (int e2 = 0; e2 < 8; ++e2) acc[ai][bj][m][e2 >> 2][e2 & 3] *= eb[e2] * __builtin_amdgcn_rcpf(1.0f + __expf(-gv[e2]));
                    } else { float o[8];
#pragma unroll
                        for (int e2 = 0; e2 < 8; ++e2) o[e2] = acc[ai][bj][m][e2 >> 2][e2 & 3] * __builtin_amdgcn_rcpf(eb[e2]);
                        u32x4 w; w.x = cvt_pk_bf16(o[0], o[1]); w.y = cvt_pk_bf16(o[2], o[3]); w.z = cvt_pk_bf16(o[4], o[5]); w.w = cvt_pk_bf16(o[6], o[7]);
                        *(u32x4*)(MG + off) = w; }
                }
            asm volatile("" ::: "memory");
        }
    }
};
struct EpiOut {
    static constexpr bool PERM = false, AFTER_DRAIN = false, CHAIN = false, PREFETCH = false;
    const float* X; const float* G1  ; float* X1;
    __device__ __forceinline__ void prefetch(const Unit& u, int t, int tid, PG8_LAS unsigned* dump) const {
        if (t < 8) { const int line = (t >> 1) * 512 + tid, row = line >> 3, seg = line & 7;
            __builtin_amdgcn_global_load_lds((const unsigned*)(X + (size_t)(u.pm * BM + row) * 2048 + u.pn * BM + seg * 32), dump, 4, 0, 0); } }
    __device__ __forceinline__ void operator()(const f32x4 (&acc)[2][2][4][2], const Unit& u, int wr, int wc, int fr, int fq) const {
        const int b = u.pm >> 5;
        const int col0 = u.pn * BM + wc * 32 + 4 * fq;
#pragma unroll
        for (int bj = 0; bj < 2; ++bj)
#pragma unroll
            for (int n = 0; n < 2; ++n) { const int c = col0 + bj * HALF + n * 16; const f32x4 g = *(const f32x4*)(G1 + b * 12288 + c);
                f32x4 xv[2][4];
#pragma unroll
                for (int ai = 0; ai < 2; ++ai)
#pragma unroll
                    for (int m = 0; m < 4; ++m) xv[ai][m] = *(const f32x4*)(X + (size_t)(u.pm * BM + ai * HALF + wr * 64 + m * 16 + fr) * 2048 + c);
                asm volatile("" ::: "memory");
#pragma unroll
                for (int ai = 0; ai < 2; ++ai)
#pragma unroll
                    for (int m = 0; m < 4; ++m) *(f32x4*)(X1 + (size_t)(u.pm * BM + ai * HALF + wr * 64 + m * 16 + fr) * 2048 + c) = xv[ai][m] + g * acc[ai][bj][m][n];
                asm volatile("" ::: "memory"); }
    }
};
struct EpiDelta {
    static constexpr bool PERM = true, AFTER_DRAIN = false, CHAIN = false, PREFETCH = false;
    const float* G1; bf16_t* DA;
    __device__ __forceinline__ void operator()(const f32x4 (&acc)[2][2][4][2], const Unit& u, int wr, int wc, int fr, int fq) const {
        const int b = u.pm >> 5;
#pragma unroll
        for (int ai = 0; ai < 2; ++ai)
#pragma unroll
            for (int m = 0; m < 4; ++m) {
                const size_t off = (size_t)(u.pm * BM + ai * HALF + wr * 64 + m * 16 + fr) * 2048 + u.pn * BM + wc * 32 + 8 * fq;
#pragma unroll
                for (int bj = 0; bj < 2; ++bj) { const int c = u.pn * BM + wc * 32 + 8 * fq + bj * HALF;
                    const f32x4 g0 = *(const f32x4*)(G1 + b * 12288 + c), g1v = *(const f32x4*)(G1 + b * 12288 + c + 4);
                    const f32x4 v0 = acc[ai][bj][m][0] * g0, v1 = acc[ai][bj][m][1] * g1v;
                    u32x4 w; w.x = cvt_pk_bf16(v0[0], v0[1]); w.y = cvt_pk_bf16(v0[2], v0[3]); w.z = cvt_pk_bf16(v1[0], v1[1]); w.w = cvt_pk_bf16(v1[2], v1[3]);
                    *(u32x4*)(DA + off + bj * HALF) = w; }
            }
    }
};
struct EpiScore {
    static constexpr bool PERM = false, AFTER_DRAIN = false, CHAIN = false, PREFETCH = false;
    float* SC;
    __device__ __forceinline__ void operator()(const f32x4 (&acc)[2][2][4][2], const Unit& u, int wr, int wc, int fr, int fq) const {
        const int col0 = u.pn * BM + wc * 32 + 4 * fq;
#pragma unroll
        for (int ai = 0; ai < 2; ++ai)
#pragma unroll
            for (int m = 0; m < 4; ++m) { const size_t off = (size_t)(u.pm * BM + ai * HALF + wr * 64 + m * 16 + fr) * 2048 + col0;
#pragma unroll
                for (int bj = 0; bj < 2; ++bj)
#pragma unroll
                    for (int n = 0; n < 2; ++n) *(f32x4*)(SC + off + bj * HALF + n * 16) = acc[ai][bj][m][n]; }
    }
};
}
namespace attn {
using bf16x8 = __attribute__((ext_vector_type(8))) short;
using s16x4  = __attribute__((ext_vector_type(4))) short;
using f32x16 = __attribute__((ext_vector_type(16))) float;
using u32x4  = __attribute__((ext_vector_type(4))) unsigned;
typedef unsigned short bf16_t;
constexpr int DQK = 192, DV = 128, NW = 8, QBLK = 32, KVBLK = 64;
constexpr int SHM_V = KVBLK * DV * 2  , SHM_K = KVBLK * DQK * 2  , SHM_QR = 2 * SHM_V + 2 * SHM_K + NW * 64 * 4, SHM_ATTN = SHM_QR + NW * 4096;
constexpr float THR = 8.0f;
#define KSWZ(row, colB) ((row) * 384 + ((colB) ^ (((row) & 7) << 4)))
#define SBAR() __builtin_amdgcn_sched_barrier(0)
__device__ __forceinline__ int crow(int r, int hi) { return (r & 3) + 8 * (r >> 2) + 4 * hi; }
__device__ __forceinline__ unsigned cvtpk(float lo, float hi) { unsigned r; asm volatile("v_cvt_pk_bf16_f32 %0, %1, %2" : "=v"(r) : "v"(lo), "v"(hi)); return r; }
__device__ __forceinline__ void partialSM(f32x16& p0, f32x16& p1, float& m_reg, float& mn, float& alpha) {
  float pmax = p0[0];
#pragma unroll
  for (int r = 1; r < 16; ++r) pmax = fmaxf(pmax, p0[r]);
#pragma unroll
  for (int r = 0; r < 16; ++r) pmax = fmaxf(pmax, p1[r]);
  { auto rr = __builtin_amdgcn_permlane32_swap(__float_as_uint(pmax), __float_as_uint(pmax), false, false);
    pmax = fmaxf(__uint_as_float(rr[0]), __uint_as_float(rr[1])); }
  if (__builtin_expect(__all(pmax - m_reg <= THR), 1)) { mn = m_reg; alpha = 1.f; }
  else { mn = fmaxf(m_reg, pmax); alpha = __builtin_amdgcn_exp2f(m_reg - mn); m_reg = mn; }
#pragma unroll
  for (int r = 0; r < 16; ++r) p0[r] = p0[r] - mn;
#pragma unroll
  for (int r = 0; r < 16; ++r) p1[r] = p1[r] - mn;
#pragma unroll
  for (int r = 0; r < 16; ++r) p0[r] = __builtin_amdgcn_exp2f(p0[r]);
}
__device__ __forceinline__ void finishSM(f32x16& p0, f32x16& p1, float alpha, float& l_reg, bf16x8& pa0, bf16x8& pa1, bf16x8& pa2, bf16x8& pa3) {
#pragma unroll
  for (int r = 0; r < 16; ++r) p1[r] = __builtin_amdgcn_exp2f(p1[r]);
  float ps = 0;
#pragma unroll
  for (int r = 0; r < 16; ++r) ps += p0[r];
#pragma unroll
  for (int r = 0; r < 16; ++r) ps += p1[r];
  { auto rr = __builtin_amdgcn_permlane32_swap(__float_as_uint(ps), __float_as_uint(ps), false, false);
    ps = __uint_as_float(rr[0]) + __uint_as_float(rr[1]); }
  l_reg = l_reg * alpha + ps;
#define PK4(P, BASE, OUT) do { unsigned a0 = cvtpk(P[BASE + 0], P[BASE + 1]), a1 = cvtpk(P[BASE + 2], P[BASE + 3]);   \
    unsigned b0 = cvtpk(P[BASE + 4], P[BASE + 5]), b1 = cvtpk(P[BASE + 6], P[BASE + 7]);                              \
    auto r0 = __builtin_amdgcn_permlane32_swap(a0, b0, false, false); auto r1 = __builtin_amdgcn_permlane32_swap(a1, b1, false, false); \
    u32x4 w = {r0[0], r1[0], r0[1], r1[1]}; OUT = *reinterpret_cast<bf16x8*>(&w); } while (0)
  PK4(p0, 0, pa0); PK4(p0, 8, pa1); PK4(p1, 0, pa2); PK4(p1, 8, pa3);
#undef PK4
}
__device__ __forceinline__ void qkt(f32x16& p0, f32x16& p1, const char* Ks, const bf16x8* qr, const char* qrow, int qx, int r32, int hi) {
  p0 = f32x16{}; p1 = f32x16{};
#pragma unroll
  for (int d0 = 0; d0 < 12; ++d0) { const int cb = (d0 * 16 + hi * 8) * 2;
    bf16x8 b0 = *reinterpret_cast<const bf16x8*>(Ks + KSWZ(r32, cb));
    bf16x8 b1 = *reinterpret_cast<const bf16x8*>(Ks + KSWZ(32 + r32, cb));
    const bf16x8 q = (d0 < 8) ? qr[d0 < 8 ? d0 : 0] : *reinterpret_cast<const bf16x8*>(qrow + (qx ^ ((d0 - 8) << 5)));
    p0 = __builtin_amdgcn_mfma_f32_32x32x16_bf16(b0, q, p0, 0, 0, 0);
    p1 = __builtin_amdgcn_mfma_f32_32x32x16_bf16(b1, q, p1, 0, 0, 0); }
}
__device__ __forceinline__ int v_st(int k, int c) { const int kk = (k & ~0xC) | ((k & 4) << 1) | ((k & 8) >> 1); return ((kk >> 3) * 4 + (c >> 5)) * 512 + ((kk & 7) * 32 + (c & 31)) * 2; }
__device__ __forceinline__ int v_rd_base(int lane) { return ((lane & 3) << 3) | (((lane >> 2) & 3) << 6) | (((lane >> 4) & 1) << 5) | (((lane >> 5) & 1) << 8); }
constexpr int v_rd_off(int d0, int ks, int half) { return d0 * 512 + ks * 4096 + half * 2048; }
template <int OFF> __device__ __forceinline__ s16x4 tr_read(int vb) {
  s16x4 r; asm volatile("ds_read_b64_tr_b16 %0, %1 offset:%2" : "=&v"(r) : "v"(vb), "i"(OFF) : "memory"); return r;
}
template <int D0> __device__ __forceinline__ void pv_one(f32x16& od, int vb, bf16x8 pa0, bf16x8 pa1, bf16x8 pa2, bf16x8 pa3) {
  const s16x4 l0 = tr_read<v_rd_off(D0, 0, 0)>(vb), h0 = tr_read<v_rd_off(D0, 0, 1)>(vb), l1 = tr_read<v_rd_off(D0, 1, 0)>(vb), h1 = tr_read<v_rd_off(D0, 1, 1)>(vb);
  const s16x4 l2 = tr_read<v_rd_off(D0, 2, 0)>(vb), h2 = tr_read<v_rd_off(D0, 2, 1)>(vb), l3 = tr_read<v_rd_off(D0, 3, 0)>(vb), h3 = tr_read<v_rd_off(D0, 3, 1)>(vb);
  asm volatile("s_waitcnt lgkmcnt(0)" ::: "memory"); SBAR();
#define PK(L, H) (bf16x8){L[0], L[1], L[2], L[3], H[0], H[1], H[2], H[3]}
  od = __builtin_amdgcn_mfma_f32_32x32x16_bf16(pa0, PK(l0, h0), od, 0, 0, 0);
  od = __builtin_amdgcn_mfma_f32_32x32x16_bf16(pa1, PK(l1, h1), od, 0, 0, 0);
  od = __builtin_amdgcn_mfma_f32_32x32x16_bf16(pa2, PK(l2, h2), od, 0, 0, 0);
  od = __builtin_amdgcn_mfma_f32_32x32x16_bf16(pa3, PK(l3, h3), od, 0, 0, 0);
#undef PK
}
__device__ __forceinline__ void pv_d0(f32x16* o, int vb, bf16x8 pa0, bf16x8 pa1, bf16x8 pa2, bf16x8 pa3) {
  pv_one<0>(o[0], vb, pa0, pa1, pa2, pa3); pv_one<1>(o[1], vb, pa0, pa1, pa2, pa3); pv_one<2>(o[2], vb, pa0, pa1, pa2, pa3); pv_one<3>(o[3], vb, pa0, pa1, pa2, pa3);
}
__device__ __forceinline__ void attn_unit(const bf16_t* __restrict__ Qb, const bf16_t* __restrict__ Kh, const bf16_t* __restrict__ Vh, bf16_t* __restrict__ Ob, int ldo, int seq, char* lds, int tid_in) {
  int tid_ = tid_in; asm volatile("" : "+v"(tid_));
  const int tid = tid_, wid = tid >> 6, lane = tid & 63, r32 = lane & 31, hi = lane >> 5;
  char* V_lds = lds; char* K_lds = lds + 2 * SHM_V;
  float* ws = (float*)(lds + 2 * SHM_V + 2 * SHM_K) + wid * 64; float* li_l = ws; float* al_l = ws + 32;
  float m_reg = -1e30f, l_reg = 0; f32x16 o[4] = {}; bf16x8 qr[8];
  const bf16_t* Qw = Qb + (long)(wid * QBLK + r32) * DQK + hi * 8;
#pragma unroll
  for (int d0 = 0; d0 < 8; ++d0) qr[d0] = *reinterpret_cast<const bf16x8*>(Qw + d0 * 16);
  char* qrow = lds + SHM_QR + wid * 4096 + r32 * 128; const int qx = (hi ^ (r32 & 7)) << 4;
#pragma unroll
  for (int d0 = 8; d0 < 12; ++d0) *reinterpret_cast<bf16x8*>(qrow + (qx ^ ((d0 - 8) << 5))) = *reinterpret_cast<const bf16x8*>(Qw + d0 * 16);
  const int sr = tid >> 4, sc = (tid & 15) * 8, vst0 = v_st(sr, sc); constexpr int vst1d = 8192;
  unsigned kgo[3], klo[3];
#pragma unroll
  for (int i = 0; i < 3; ++i) { const int id = tid + 512 * i, kr_ = id / 24, kc_ = (id % 24) * 16; kgo[i] = (unsigned)(kr_ * 384 + kc_); klo[i] = (unsigned)KSWZ(kr_, kc_); }
  const unsigned vgo0 = (unsigned)((sr * DV + sc) * 2); constexpr unsigned vgo1d = 32 * DV * 2;
  const int vb0 = (int)(uintptr_t)V_lds + v_rd_base(lane);
  bf16x8 vs0, vs1, ks0, ks1, ks2;
#define SLOAD(k0) do { const char* Kt_ = (const char*)Kh + (size_t)(k0) * (DQK * 2); const char* Vt_ = (const char*)Vh + (size_t)(k0) * (DV * 2); \
    vs0 = *reinterpret_cast<const bf16x8*>(Vt_ + vgo0); vs1 = *reinterpret_cast<const bf16x8*>(Vt_ + vgo0 + vgo1d); \
    ks0 = *reinterpret_cast<const bf16x8*>(Kt_ + kgo[0]); ks1 = *reinterpret_cast<const bf16x8*>(Kt_ + kgo[1]); ks2 = *reinterpret_cast<const bf16x8*>(Kt_ + kgo[2]); } while (0)
#define SWRITE(b) do { *(bf16x8*)(V_lds + (b) * SHM_V + vst0) = vs0; *(bf16x8*)(V_lds + (b) * SHM_V + vst0 + vst1d) = vs1; \
    *(bf16x8*)(K_lds + (b) * SHM_K + klo[0]) = ks0; *(bf16x8*)(K_lds + (b) * SHM_K + klo[1]) = ks1; *(bf16x8*)(K_lds + (b) * SHM_K + klo[2]) = ks2; } while (0)
#define RESC(a) do { if (__any((a) < 1.f)) { if (hi == 0) al_l[r32] = (a); asm volatile("s_waitcnt lgkmcnt(0)" ::: "memory"); \
    _Pragma("unroll") for (int d = 0; d < 4; ++d) _Pragma("unroll") for (int r = 0; r < 16; ++r) o[d][r] *= al_l[crow(r, hi)]; } } while (0)
  f32x16 pA0, pA1, pB0, pB1; float mnA, mnB, alA, alB; bf16x8 pa0, pa1, pa2, pa3; const int NT = seq / KVBLK;
  SLOAD(0); SWRITE(0); __syncthreads();
  qkt(pA0, pA1, K_lds, qr, qrow, qx, r32, hi); partialSM(pA0, pA1, m_reg, mnA, alA);
  SLOAD(KVBLK);
  SWRITE(1); __syncthreads();
  for (int j = 1; j + 1 < NT; j += 2) {
    SBAR(); qkt(pB0, pB1, K_lds + SHM_K, qr, qrow, qx, r32, hi);
    finishSM(pA0, pA1, alA, l_reg, pa0, pa1, pa2, pa3); SBAR();
    SLOAD((j + 1) * KVBLK); SBAR();
    pv_d0(o, vb0, pa0, pa1, pa2, pa3); partialSM(pB0, pB1, m_reg, mnB, alB);
    __syncthreads(); SWRITE(0);
    RESC(alB); __syncthreads();
    SBAR(); qkt(pA0, pA1, K_lds, qr, qrow, qx, r32, hi);
    finishSM(pB0, pB1, alB, l_reg, pa0, pa1, pa2, pa3); SBAR();
    SLOAD((j + 2) * KVBLK); SBAR();
    pv_d0(o, vb0 + SHM_V, pa0, pa1, pa2, pa3); partialSM(pA0, pA1, m_reg, mnA, alA);
    __syncthreads(); SWRITE(1);
    RESC(alA); __syncthreads();
  }
  SBAR(); qkt(pB0, pB1, K_lds + SHM_K, qr, qrow, qx, r32, hi);
  finishSM(pA0, pA1, alA, l_reg, pa0, pa1, pa2, pa3); SBAR();
  pv_d0(o, vb0, pa0, pa1, pa2, pa3); partialSM(pB0, pB1, m_reg, mnB, alB);
  __syncthreads(); RESC(alB);
  finishSM(pB0, pB1, alB, l_reg, pa0, pa1, pa2, pa3); SBAR();
  pv_d0(o, vb0 + SHM_V, pa0, pa1, pa2, pa3);
  if (hi == 0) li_l[r32] = l_reg; asm volatile("s_waitcnt lgkmcnt(0)" ::: "memory");
  float rli[16];
#pragma unroll
  for (int r = 0; r < 16; ++r) rli[r] = __builtin_amdgcn_rcpf(li_l[crow(r, hi)]);
  { int t2 = tid_in; asm volatile("" : "+v"(t2));
    const int w2 = t2 >> 6, l2 = t2 & 63, c2 = l2 & 31, h2 = l2 >> 5;
    bf16_t* Ow = Ob + (unsigned)((w2 * QBLK + 4 * h2) * ldo + c2);
#pragma unroll
    for (int r = 0; r < 16; ++r) { const unsigned ro = (unsigned)(((r & 3) + 8 * (r >> 2)) * ldo);
#pragma unroll
      for (int d0 = 0; d0 < 4; ++d0) { const float v = o[d0][r] * rli[r]; Ow[ro + d0 * 32] = (bf16_t)(cvtpk(v, v) & 0xffffu); } } }
  __syncthreads();
#undef SLOAD
#undef SWRITE
#undef RESC
}
#undef KSWZ
#undef SBAR
}
#define GAS __attribute__((address_space(1)))
#define LAS __attribute__((address_space(3)))
typedef unsigned short bf16_t;
typedef unsigned v4u __attribute__((ext_vector_type(4)));
typedef unsigned v2u __attribute__((ext_vector_type(2)));
typedef float f32x4 __attribute__((ext_vector_type(4)));
typedef short bf16x8 __attribute__((ext_vector_type(8)));
constexpr int NT_ = 512;
constexpr int BATCH = 2, SEQ = 8192, DM = 2048, CTXL = 256;
constexpr int ML = BATCH * SEQ  , MC = BATCH * CTXL  , M1 = ML + MC  ;
constexpr int NIN_PAD = 9216;
constexpr int LKV = CTXL + SEQ;
constexpr int NCH = 132;
constexpr float EPS = 1e-6f;
constexpr float QSCALE = 0.07216878364870322f * 1.4426950408889634f;
constexpr size_t MiB = 1u << 20;
constexpr size_t WS_CTL = 0, CTL_BYTES = 128 * 1024;
#ifndef PROBE_TS
#define PROBE_TS -1
#endif
#ifndef PROBE_SCALE
#define PROBE_SCALE 1e-4f
#endif
constexpr size_t CTL_TS = 65536;
constexpr size_t CTL_XQ = 32768;
constexpr size_t CTL_BAR = 4096;
static_assert(CTL_BAR + 3456 * 4 <= CTL_XQ && CTL_XQ + 8 * 256 <= CTL_TS && CTL_TS + 1024 + 1024 <= CTL_BYTES, "ctl");
constexpr size_t WS_WUQ = 1 * MiB, WS_WUKV = WS_WUQ + 1536 * 512 * 2, WS_WBA = WS_WUKV + 2048 * 256 * 2, WS_WBB = WS_WBA + 4 * MiB, WS_WOUT = WS_WBB + 4 * MiB, WS_WPQ = WS_WOUT + 8 * MiB;
static_assert(WS_WPQ + 8 * MiB <= 28 * MiB, "small weights");
constexpr size_t WS_C = 28 * MiB;
constexpr size_t WS_D = 66 * MiB;
constexpr size_t WS_E1 = 132 * MiB;
constexpr size_t WS_CQ = WS_E1, WS_CKV = WS_CQ + 16 * MiB, WS_KR = WS_CKV + (size_t)M1 * 256 * 2, WS_AB = WS_KR + (size_t)M1 * 64 * 4;
static_assert(WS_AB + (size_t)M1 * 32 * 4 <= 164 * MiB, "E1");
constexpr size_t WS_Z = 164 * MiB, WS_GA = 196 * MiB, WS_GB = 260 * MiB;
constexpr size_t WS_QKV = 324 * MiB;
constexpr size_t WS_K = 423 * MiB;
constexpr size_t WS_DNQ = 473 * MiB;
constexpr size_t WS_GBETA = 572 * MiB;
constexpr size_t WS_EG = 61 * MiB;
constexpr size_t CTL_MOD = 27 * MiB + 512 * 1024;
constexpr size_t CTL_SSQQ = 64 * MiB, CTL_SSQKV = CTL_SSQQ + (size_t)16384 * 8 * 4;
static_assert(CTL_SSQKV + (size_t)16896 * 4 * 4 <= 66 * MiB && CTL_MOD + 3 * 12288 * 4 <= 28 * MiB && WS_WPQ + 8 * MiB <= CTL_MOD, "mod/ssq");
constexpr size_t WS_XB = WS_D;
constexpr size_t WS_W = WS_QKV, WS_U = WS_QKV + 66 * MiB, WS_ATT = WS_C, WS_OF = WS_D, WS_OB = WS_D + 32 * MiB, WS_YA = WS_E1, WS_YB = WS_C;
constexpr size_t WS_MG = 324 * MiB, WS_H2 = 388 * MiB, WS_UB = 574 * MiB + 512 * 1024  , WS_VB = 484 * MiB, WS_USC = WS_UB + 32 * MiB, WS_VSC = 517 * MiB, WS_SC = 196 * MiB, WS_END = 607 * MiB;
static_assert(WS_EG + (size_t)4224 * 132 * 4 <= 64 * MiB && WS_USC + 16384 * 4 <= WS_END && WS_GBETA + (size_t)4 * M1 * 8 * 4 <= WS_UB && WS_K + (size_t)16 * LKV * 192 * 2 <= WS_DNQ && WS_DNQ + (size_t)M1 * 3072 * 2 <= WS_GBETA, "ws map");

__device__ __forceinline__ unsigned f2bf(float f) { unsigned u = __builtin_bit_cast(unsigned, f); return (u + 0x7fffu + ((u >> 16) & 1u)) >> 16; }
typedef float f32x2_c __attribute__((ext_vector_type(2))); typedef __bf16 bf16x2_c __attribute__((ext_vector_type(2)));
__device__ __forceinline__ unsigned pk2(float lo, float hi) { f32x2_c v = {lo, hi}; bf16x2_c b = __builtin_convertvector(v, bf16x2_c); return __builtin_bit_cast(unsigned, b); }
__device__ __forceinline__ float bflo(unsigned w) { return __uint_as_float(w << 16); }
__device__ __forceinline__ float bfhi(unsigned w) { return __uint_as_float(w & 0xffff0000u); }
__device__ __forceinline__ float wave_sum(float v) {
#pragma unroll
    for (int o = 1; o < 64; o <<= 1) v += __shfl_xor(v, o);
    return v;
}
__device__ __forceinline__ float siluf(float v) { return v / (1.0f + __expf(-v)); }

struct Params {
    const float *x, *c, *ctx, *c_ctx, *w_mod, *b_mod, *norm1_w, *w_in, *qn_w, *kvn_w, *w_uq, *w_ukv, *conv_w, *a_log, *dt_bias, *dn_norm_w,
                *w_ba, *w_bb, *w_out, *norm2_w, *peer_wq, *sub_keys, *peer_u, *peer_v, *final_w;
    float* out; unsigned char* ws;
    int ph_lo, ph_hi;
};
#define XB_TMO      128
#define XB_XCNT(j)  (256  + 64 * (j))
#define XB_XSUB(j)  (1280 + 64 * (j))
#define XB_XGEN(j)  (2304 + 64 * (j))
#define XB_TOP      3328
#define XB_TOPGEN   3392
#define XCD_BAR_WORDS 3456
#define XB_SPIN_CAP (1u << 18)

__device__ __forceinline__ unsigned xb_ld(unsigned* p)              { return __hip_atomic_load(p, __ATOMIC_RELAXED, __HIP_MEMORY_SCOPE_AGENT); }
__device__ __forceinline__ unsigned xb_add(unsigned* p, unsigned v) { return __hip_atomic_fetch_add(p, v, __ATOMIC_RELAXED, __HIP_MEMORY_SCOPE_AGENT); }
__device__ __forceinline__ unsigned xb_xcc_id() { return (unsigned)__builtin_amdgcn_s_getreg((3 << 11) | 20) & 0xFu; }
#define XB_SPIN(cond, bar) do { unsigned _sp = 0; while (cond) { __builtin_amdgcn_s_sleep(1); \
    if ((++_sp & 255u) == 0u) { if (xb_ld(&(bar)[XB_TMO])) break; if (_sp > XB_SPIN_CAP) { atomicAdd(&(bar)[XB_TMO], 1u); break; } } } } while (0)

struct XcdBarrier {
    unsigned* bar; unsigned x;
    volatile LAS unsigned* st;
};

__device__ __forceinline__ XcdBarrier xcd_barrier_post(unsigned* bar, volatile LAS unsigned* st, int tid) {
    XcdBarrier b; b.bar = bar; b.x = xb_xcc_id(); b.st = st;
    if (tid == 0) (void)xb_add(&bar[XB_XCNT(b.x)], 1u);
    return b;
}
__device__ __forceinline__ void xcd_barrier_complete(unsigned* bar, unsigned x, unsigned& nloc, unsigned& nx) {
    const unsigned G = gridDim.x * gridDim.y * gridDim.z;
    unsigned sum, cnt, mine, sp = 0u;
    for (;;) {
        sum = 0u; cnt = 0u; mine = 0u;
#pragma unroll
        for (unsigned j = 0; j < 16; ++j) { const unsigned c = xb_ld(&bar[XB_XCNT(j)]); sum += c; cnt += (c > 0u) ? 1u : 0u; mine = (j == x) ? c : mine; }
        if (sum == G) break;
        __builtin_amdgcn_s_sleep(1);
        if ((++sp & 255u) == 0u) { if (xb_ld(&bar[XB_TMO])) break; if (sp > XB_SPIN_CAP) { atomicAdd(&bar[XB_TMO], 1u); break; } }
    }
    nloc = mine > 0u ? mine : 1u; nx = cnt > 0u ? cnt : 1u;
}

__device__ __forceinline__ void xcd_barrier(const XcdBarrier& b, int tid) {
    asm volatile("s_waitcnt vmcnt(0)" ::: "memory");
    __syncthreads();
    if (tid == 0) {
        unsigned* bar = b.bar;
        __builtin_amdgcn_s_waitcnt(0);
        unsigned nloc = b.st[0], nx = b.st[1];
        if (nloc == 0u) { xcd_barrier_complete(bar, b.x, nloc, nx); b.st[0] = nloc; b.st[1] = nx; }
        const unsigned old = xb_add(&bar[XB_XSUB(b.x)], 1u);
        const unsigned gen = old / nloc;
        if (old + 1u == (gen + 1u) * nloc) {
            __builtin_amdgcn_fence(__ATOMIC_RELEASE, "agent");
            asm volatile("s_waitcnt vmcnt(0)" ::: "memory");
            const unsigned og = xb_add(&bar[XB_TOP], 1u);
            const unsigned tg = og / nx;
            if (og + 1u == (tg + 1u) * nx) xb_add(&bar[XB_TOPGEN], 1u);
            else XB_SPIN(xb_ld(&bar[XB_TOPGEN]) == tg, bar);
            __builtin_amdgcn_fence(__ATOMIC_ACQUIRE, "agent");
            xb_add(&bar[XB_XGEN(b.x)], 1u);
            asm volatile("s_waitcnt vmcnt(0)" ::: "memory");
        } else {
            XB_SPIN(xb_ld(&bar[XB_XGEN(b.x)]) == gen, bar);
            __builtin_amdgcn_fence(__ATOMIC_ACQUIRE, "agent");
            asm volatile("s_waitcnt vmcnt(0)" ::: "memory");
        }
    }
    __syncthreads();
}
struct Ctx { LAS unsigned char* lds; int tid, lane, wave, vcu, G; };

__device__ __forceinline__ void p0_mod_item(const Params& p, const Ctx& C, int it) {
    LAS float* sl = (LAS float*)C.lds;
    LAS float* red = sl + 3 * 2048;
    for (int e = C.tid; e < 3 * 2048; e += NT_) { const int i = e >> 11, k = e & 2047; const float v = (i < 2) ? p.c[i * DM + k] : p.c_ctx[k]; sl[e] = siluf(v); }
    __syncthreads();
    typedef float f32x2_ __attribute__((ext_vector_type(2)));
    f32x2_ a0 = {0, 0}, a1 = {0, 0}, a2 = {0, 0};
    const int col = it * 128 + C.lane * 2, k0 = C.wave * 256;
    const float* wp = p.w_mod + (size_t)k0 * 12288 + col;
    for (int kb = 0; kb < 256; kb += 32) {
        f32x2_ wv[32];
#pragma unroll
        for (int k = 0; k < 32; ++k) wv[k] = *(const f32x2_*)(wp + (size_t)(kb + k) * 12288);
#pragma unroll
        for (int k = 0; k < 32; ++k) { a0 += wv[k] * sl[k0 + kb + k]; a1 += wv[k] * sl[2048 + k0 + kb + k]; a2 += wv[k] * sl[4096 + k0 + kb + k]; } }
    LAS float* rw = red + C.wave * 384 + C.lane * 2;
    rw[0] = a0[0]; rw[1] = a0[1]; rw[128] = a1[0]; rw[129] = a1[1]; rw[256] = a2[0]; rw[257] = a2[1];
    __syncthreads();
    if (C.tid < 384) { float s = p.b_mod[it * 128 + (C.tid & 127)];
#pragma unroll
        for (int w = 0; w < 8; ++w) s += red[w * 384 + C.tid];
        ((float*)(p.ws + CTL_MOD))[(C.tid >> 7) * 12288 + it * 128 + (C.tid & 127)] = s; }
    __syncthreads();
}
__device__ __forceinline__ void p0_wprime_item(const Params& p, const Ctx& C, int it) {
    LAS float* As = (LAS float*)C.lds;
    LAS float* Ss = As + 64 * 129;
    LAS unsigned short* Os = (LAS unsigned short*)(Ss + 128 * 129);
    const int hp = it >> 5, i0 = (it & 31) * 64, pp = hp & 1;
    for (int e = C.tid; e < 64 * 128; e += NT_) { const int i = e >> 7, d = e & 127; As[i * 129 + d] = p.peer_wq[(size_t)(i0 + i) * 2048 + hp * 128 + d]; }
    for (int e = C.tid; e < 128 * 128; e += NT_) { const int k = e >> 7, d = e & 127; Ss[k * 129 + d] = p.sub_keys[(size_t)(pp * 128 + k) * 128 + d]; }
    __syncthreads();
    const int l15 = C.lane & 15, lq = C.lane >> 4, tm = C.wave & 3;
#pragma unroll
    for (int q = 0; q < 4; ++q) { const int tn = (C.wave >> 2) * 4 + q;
        f32x4 acc = {0.f, 0.f, 0.f, 0.f};
        const LAS float* ap = As + (tm * 16 + l15) * 129 + lq; const LAS float* bp = Ss + (tn * 16 + l15) * 129 + lq;
#pragma unroll 8
        for (int kk = 0; kk < 32; ++kk) acc = __builtin_amdgcn_mfma_f32_16x16x4f32(ap[4 * kk], bp[4 * kk], acc, 0, 0, 0);
        LAS unsigned short* o = Os + (tn * 16 + l15) * 72 + tm * 16 + 4 * lq; const unsigned w0 = pk2(acc[0], acc[1]), w1 = pk2(acc[2], acc[3]);
        *(LAS v2u*)o = (v2u){w0, w1}; }
    __syncthreads();
    for (int e = C.tid; e < 128 * 8; e += NT_) { const int k = e >> 3, chn = e & 7;
        *(v4u*)((bf16_t*)(p.ws + WS_WPQ) + (size_t)(hp * 128 + k) * 2048 + i0 + chn * 8) = *(const LAS v4u*)(Os + k * 72 + chn * 8); }
    __syncthreads();
}
__device__ __forceinline__ void p0_transpose_item(const float* W, int K, int N, int k0, int n0, bf16_t* WT, int drow0, const float* kscale, LAS float* scr, int lane) {
#pragma unroll 8
    for (int i = 0; i < 32; ++i) { const int kk = 2 * i + (lane >> 5); float v = W[(size_t)(k0 + kk) * N + n0 + (lane & 31)]; if (kscale) v *= kscale[k0 + kk]; scr[kk * 33 + (lane & 31)] = v; }
    asm volatile("s_waitcnt lgkmcnt(0)" ::: "memory");
    const int c = lane & 7;
#pragma unroll
    for (int j = 0; j < 4; ++j) { const int n = (lane >> 3) + 8 * j; const LAS float* s = scr + (8 * c) * 33 + n;
        v4u o; o.x = pk2(s[0 * 33], s[1 * 33]); o.y = pk2(s[2 * 33], s[3 * 33]); o.z = pk2(s[4 * 33], s[5 * 33]); o.w = pk2(s[6 * 33], s[7 * 33]);
        *(v4u*)(WT + (size_t)(drow0 + n) * K + k0 + 8 * c) = o; }
    asm volatile("s_waitcnt lgkmcnt(0)" ::: "memory");
}
__device__ __forceinline__ int win_dest_row(int n0) {
    if (n0 < 768) return n0;
    if (n0 < 832) return 8960 + (n0 - 768);
    if (n0 < 3904) return 768 + (n0 - 832);
    if (n0 < 4928) return 3840 + (n0 - 3904);
    if (n0 < 4960) return 9024 + (n0 - 4928);
    if (n0 < 7008) return 4864 + (n0 - 4960);
    return 6912 + (n0 - 7008);
}
constexpr int P0_I_IN = 32 * 283, P0_I_UQ = 8 * 48, P0_I_UKV = 4 * 64, P0_I_BA = 16 * 64, P0_I_BB = 16 * 64, P0_I_OUT = 32 * 64;
constexpr int P0_NITEMS = P0_I_IN + P0_I_UQ + P0_I_UKV + P0_I_BA + P0_I_BB + P0_I_OUT;
constexpr int P0_SPLIT = 5800;
__device__ __forceinline__ void p0_copy_items(const Params& p, const Ctx& C, int it_lo, int it_hi, int it_lo2, int it_hi2, int part, int nparts) {
    LAS float* scr = (LAS float*)(C.lds + C.wave * 16384);
    const int gw = part * 8 + C.wave, NGW = nparts * 8;
    unsigned char* ws = p.ws;
    const int n1 = it_hi - it_lo, n2 = it_hi2 - it_lo2;
    for (int q = gw; q < n1 + n2; q += NGW) {
        const int it = (q < n1) ? it_lo + q : it_lo2 + (q - n1);
        int r = it;
        if (r < P0_I_IN) { const int kb = r / 283, nb = r % 283; p0_transpose_item(p.w_in, 2048, 9056, kb * 64, nb * 32, (bf16_t*)(ws + WS_C), win_dest_row(nb * 32), nullptr, scr, C.lane); continue; } r -= P0_I_IN;
        if (r < P0_I_UQ) { const int kb = r / 48, nb = r % 48, n0 = nb * 32, h = n0 / 192, j0 = n0 % 192; const int dr = (j0 < 128) ? (h * 128 + j0) : (1024 + h * 64 + (j0 - 128));
            p0_transpose_item(p.w_uq, 512, 1536, kb * 64, n0, (bf16_t*)(ws + WS_WUQ), dr, p.qn_w, scr, C.lane); continue; } r -= P0_I_UQ;
        if (r < P0_I_UKV) { const int kb = r / 64, nb = r % 64; p0_transpose_item(p.w_ukv, 256, 2048, kb * 64, nb * 32, (bf16_t*)(ws + WS_WUKV), nb * 32, p.kvn_w, scr, C.lane); continue; } r -= P0_I_UKV;
        if (r < P0_I_BA) { const int kb = r / 64, nb = r % 64; p0_transpose_item(p.w_ba, 1024, 2048, kb * 64, nb * 32, (bf16_t*)(ws + WS_WBA), nb * 32, nullptr, scr, C.lane); continue; } r -= P0_I_BA;
        if (r < P0_I_BB) { const int kb = r / 64, nb = r % 64; p0_transpose_item(p.w_bb, 1024, 2048, kb * 64, nb * 32, (bf16_t*)(ws + WS_WBB), nb * 32, nullptr, scr, C.lane); continue; } r -= P0_I_BB;
        { const int kb = r / 64, nb = r % 64; p0_transpose_item(p.w_out, 2048, 2048, kb * 64, nb * 32, (bf16_t*)(ws + WS_WOUT), nb * 32, nullptr, scr, C.lane); }
    }
}
__device__ __forceinline__ void p0_prologue(const Params& p, const Ctx& C) {
    for (int it = C.vcu; it < 96; it += C.G) p0_mod_item(p, C, it);
    if (C.G != 256) for (int it = C.vcu; it < 512; it += C.G) p0_wprime_item(p, C, it);
    p0_copy_items(p, C, 0, P0_NITEMS, 0, 0, C.vcu, C.G);
    { v4u* z = (v4u*)((bf16_t*)(p.ws + WS_C) + (size_t)9056 * 2048); const int n16 = 160 * 2048 * 2 / 16;
      for (int i = C.vcu * NT_ + C.tid; i < n16; i += C.G * NT_) z[i] = (v4u){0u, 0u, 0u, 0u}; }
}
__device__ __forceinline__ void mod_norm_rows_bf(const Ctx& C, const bf16_t* X, int nrows, const float* nw, const float* sh, const float* sc, bf16_t* O) {
    f32x4 a[8], s[8];
#pragma unroll
    for (int j = 0; j < 8; ++j) { const int c = 8 * C.lane + 512 * (j >> 1) + 4 * (j & 1); const f32x4 w = *(const f32x4*)(nw + c), q = *(const f32x4*)(sc + c); a[j] = w * (q + 1.0f); s[j] = *(const f32x4*)(sh + c); }
    const int gw = C.vcu * 8 + C.wave, NGW = C.G * 8;
    for (int r = gw; r < nrows; r += NGW) {
        const v4u* xr = (const v4u*)(X + (size_t)r * DM) + C.lane; v4u v[4]; float ss = 0.f;
#pragma unroll
        for (int j = 0; j < 4; ++j) v[j] = xr[64 * j];
        f32x4 f[8];
#pragma unroll
        for (int j = 0; j < 4; ++j) { f[2 * j] = (f32x4){bflo(v[j].x), bfhi(v[j].x), bflo(v[j].y), bfhi(v[j].y)}; f[2 * j + 1] = (f32x4){bflo(v[j].z), bfhi(v[j].z), bflo(v[j].w), bfhi(v[j].w)}; }
#pragma unroll
        for (int j = 0; j < 8; ++j) ss += (f[j].x * f[j].x + f[j].y * f[j].y) + (f[j].z * f[j].z + f[j].w * f[j].w);
        const float rstd = rsqrtf(wave_sum(ss) * (1.0f / DM) + EPS);
        v4u* o8 = (v4u*)(O + (size_t)r * DM) + C.lane;
#pragma unroll
        for (int j = 0; j < 4; ++j) { const f32x4 y0 = f[2 * j] * rstd * a[2 * j] + s[2 * j], y1 = f[2 * j + 1] * rstd * a[2 * j + 1] + s[2 * j + 1];
            v4u w; w.x = pk2(y0.x, y0.y); w.y = pk2(y0.z, y0.w); w.z = pk2(y1.x, y1.y); w.w = pk2(y1.z, y1.w); o8[64 * j] = w; }
    }
}
__device__ __forceinline__ void mod_norm_rows(const Ctx& C, const float* X, int nrows, const float* nw, const float* sh, const float* sc, bf16_t* O) {
    f32x4 a[8], s[8];
#pragma unroll
    for (int j = 0; j < 8; ++j) { const int c = 4 * C.lane + 256 * j; const f32x4 w = *(const f32x4*)(nw + c), q = *(const f32x4*)(sc + c); a[j] = w * (q + 1.0f); s[j] = *(const f32x4*)(sh + c); }
    const int gw = C.vcu * 8 + C.wave, NGW = C.G * 8;
    for (int r = gw; r < nrows; r += NGW) {
        const f32x4* xr = (const f32x4*)(X + (size_t)r * DM) + C.lane; f32x4 v[8]; float ss = 0.f;
#pragma unroll
        for (int j = 0; j < 8; ++j) { v[j] = xr[64 * j]; ss += (v[j].x * v[j].x + v[j].y * v[j].y) + (v[j].z * v[j].z + v[j].w * v[j].w); }
        const float rstd = rsqrtf(wave_sum(ss) * (1.0f / DM) + EPS);
        v2u* o8 = (v2u*)(O + (size_t)r * DM) + C.lane;
#pragma unroll
        for (int j = 0; j < 8; ++j) { const f32x4 y = v[j] * rstd * a[j] + s[j]; v2u w; w.x = pk2(y.x, y.y); w.y = pk2(y.z, y.w); o8[64 * j] = w; }
    }
}
__device__ __forceinline__ void p3_conv(const Params& p, const Ctx& C) {
    const bf16_t* QKV = (const bf16_t*)(p.ws + WS_QKV); bf16_t* DNQ = (bf16_t*)(p.ws + WS_DNQ);
    const int total = (M1 / 16) * 384;
    const int cvi = (C.G == 256) ? ((((C.vcu & 31) * 8 + (C.vcu >> 5)) + 240) & 255) : C.vcu;
    for (int it = cvi * NT_ + C.tid; it < total; it += C.G * NT_) {
        const int rb = it / 384, c8 = it % 384, ch = c8 * 8, r0 = rb * 16;
        int seg0, segn, t0;
        if (r0 < ML) { seg0 = r0 & ~8191; segn = SEQ; t0 = r0 & 8191; } else { seg0 = ML + ((r0 - ML) & ~255); segn = CTXL; t0 = (r0 - ML) & 255; }
        f32x4 wlo[5], whi[5];
#pragma unroll
        for (int j = 0; j < 5; ++j) { wlo[j] = *(const f32x4*)(p.conv_w + j * 3072 + ch); whi[j] = *(const f32x4*)(p.conv_w + j * 3072 + ch + 4); }
        const float qs = (ch < 1024) ? 0.08838834764831845f : 1.0f; const bool nrm = ch < 2048;
        v4u rowsv[20];
#pragma unroll
        for (int j = 0; j < 20; ++j) { const int tt = t0 + j - 2; rowsv[j] = (tt >= 0 && tt < segn) ? *(const v4u*)(QKV + (size_t)(seg0 + tt) * 3072 + ch) : (v4u){0u, 0u, 0u, 0u}; }
        asm volatile("" ::: "memory");
#pragma unroll
        for (int i = 0; i < 16; ++i) {
            v4u win[5];
#pragma unroll
            for (int j = 0; j < 5; ++j) win[j] = rowsv[i + j];
            float acc[8];
#pragma unroll
            for (int e = 0; e < 8; ++e) acc[e] = 0.f;
#pragma unroll
            for (int j = 0; j < 5; ++j) { const v4u xv = win[j];
                acc[0] += bflo(xv.x) * wlo[j].x; acc[1] += bfhi(xv.x) * wlo[j].y; acc[2] += bflo(xv.y) * wlo[j].z; acc[3] += bfhi(xv.y) * wlo[j].w;
                acc[4] += bflo(xv.z) * whi[j].x; acc[5] += bfhi(xv.z) * whi[j].y; acc[6] += bflo(xv.w) * whi[j].z; acc[7] += bfhi(xv.w) * whi[j].w; }
            float ss = 0.f;
#pragma unroll
            for (int e = 0; e < 8; ++e) { acc[e] = siluf(acc[e]); ss += acc[e] * acc[e]; }
            ss += __shfl_xor(ss, 1); ss += __shfl_xor(ss, 2); ss += __shfl_xor(ss, 4); ss += __shfl_xor(ss, 8);
            const float sc = nrm ? rsqrtf(ss + EPS) * qs : 1.0f;
            v4u w; w.x = pk2(acc[0] * sc, acc[1] * sc); w.y = pk2(acc[2] * sc, acc[3] * sc); w.z = pk2(acc[4] * sc, acc[5] * sc); w.w = pk2(acc[6] * sc, acc[7] * sc);
            *(v4u*)(DNQ + (size_t)(r0 + i) * 3072 + ch) = w;
        }
    }
}
__device__ __forceinline__ void p3_krope_gbeta(const Params& p, const Ctx& C) {
    const float* KR = (const float*)(p.ws + WS_KR); bf16_t* K = (bf16_t*)(p.ws + WS_K);
    for (int it = C.vcu * NT_ + C.tid; it < M1 * 4; it += C.G * NT_) {
        const int r = it >> 2, q = it & 3, half = q >> 1, part = q & 1;
        int b, l, t; bool lat = r < ML;
        if (lat) { b = r >> 13; t = r & 8191; l = CTXL + t; } else { b = (r - ML) >> 8; t = 0; l = (r - ML) & 255; }
        const float* x1p = KR + (size_t)r * 64 + half * 32; const float* x2p = x1p + 16;
        float o[16];
        if (lat) { const float pos = (float)(half == 0 ? (t >> 6) : (t & 63));
#pragma unroll
            for (int i = 0; i < 16; ++i) { const float invf = exp2f(-(float)i * (13.287712379549449f / 16.0f)); float sn, cs; pg8::fast_sincos(pos * invf, sn, cs);
                const float x1 = x1p[i], x2 = x2p[i]; o[i] = part == 0 ? (x1 * cs - x2 * sn) : (x1 * sn + x2 * cs); } }
        else {
#pragma unroll
            for (int i = 0; i < 16; ++i) o[i] = part == 0 ? x1p[i] : x2p[i]; }
        v4u w0, w1; w0.x = pk2(o[0], o[1]); w0.y = pk2(o[2], o[3]); w0.z = pk2(o[4], o[5]); w0.w = pk2(o[6], o[7]);
        w1.x = pk2(o[8], o[9]); w1.y = pk2(o[10], o[11]); w1.z = pk2(o[12], o[13]); w1.w = pk2(o[14], o[15]);
#pragma unroll
        for (int h = 0; h < 8; ++h) { bf16_t* dst = K + ((size_t)(b * 8 + h) * LKV + l) * 192 + 128 + half * 32 + part * 16; *(v4u*)dst = w0; *(v4u*)(dst + 8) = w1; }
    }
    const float* AB = (const float*)(p.ws + WS_AB); float* Gd = (float*)(p.ws + WS_GBETA); float* Bd = Gd + (size_t)2 * M1 * 8;
    for (int it = C.vcu * NT_ + C.tid; it < M1 * 16; it += C.G * NT_) {
        const int r = it >> 4, dh = it & 15, dir = dh >> 3, h = dh & 7;
        const float a = AB[(size_t)r * 32 + dir * 8 + h] + p.dt_bias[dir * 8 + h], bl = AB[(size_t)r * 32 + 16 + dir * 8 + h];
        const float sp = (a > 20.f) ? a : log1pf(__expf(a));
        Gd[((size_t)dir * M1 + r) * 8 + h] = -__expf(p.a_log[dir * 8 + h]) * sp;
        Bd[((size_t)dir * M1 + r) * 8 + h] = 1.0f / (1.0f + __expf(-bl));
    }
}
typedef short s16x4c __attribute__((ext_vector_type(4)));
constexpr int CP_LD = 136;
constexpr int CP_K = 0, CP_Q = CP_K + 64 * CP_LD * 2, CP_V = CP_Q + 64 * CP_LD * 2, CP_VEC = CP_V + 64 * CP_LD * 2  , CP_MLO = CP_VEC + 640 * 4  ,
              CP_DG = CP_MLO + 2 * 64 * 72 * 2  , CP_DB = CP_DG + 2 * 4 * 16 * 17 * 4  , CP_ATS = CP_DB + 2 * 4 * 16 * 24 * 2  ,
              CP_XW = CP_ATS + 2 * 64 * 72 * 2  , CP_END = CP_XW + 8 * 16 * 72 * 2;
static_assert(CP_END <= 147456 - 64 && CP_MLO % 16 == 0 && CP_DB % 16 == 0 && CP_ATS % 16 == 0 && CP_XW % 16 == 0 && CP_DG % 16 == 0, "chunk-prep LDS");
__device__ __forceinline__ unsigned short bf1(float f) { return (unsigned short)(pk2(f, f) & 0xffffu); }
__device__ __forceinline__ void p5_chunk_prep(const Params& p, const Ctx& C) {
    const bf16_t* DNQ = (const bf16_t*)(p.ws + WS_DNQ); const float* Gd = (const float*)(p.ws + WS_GBETA); const float* Bd = Gd + (size_t)2 * M1 * 8;
    bf16_t* Wd = (bf16_t*)(p.ws + WS_W); bf16_t* Ud = (bf16_t*)(p.ws + WS_U); bf16_t* ATd = (bf16_t*)(p.ws + WS_ATT);
    float* EG = (float*)(p.ws + WS_EG); float* EKD = EG + (size_t)4224 * 64; float* EGL = EKD + (size_t)4224 * 64;
    LAS unsigned char* L = C.lds;
    LAS bf16_t* Ks = (LAS bf16_t*)(L + CP_K); LAS bf16_t* Qs = (LAS bf16_t*)(L + CP_Q); LAS bf16_t* Vs = (LAS bf16_t*)(L + CP_V);
    LAS float* Vec = (LAS float*)(L + CP_VEC); LAS bf16_t* MLO = (LAS bf16_t*)(L + CP_MLO); LAS float* DG = (LAS float*)(L + CP_DG); LAS bf16_t* DB = (LAS bf16_t*)(L + CP_DB);
    LAS bf16_t* ATS = (LAS bf16_t*)(L + CP_ATS); LAS bf16_t* XW = (LAS bf16_t*)(L + CP_XW) + C.wave * (16 * 72);
    const int tid = C.tid, lane = C.lane, wave = C.wave, l15 = lane & 15, lq = lane >> 4;
    unsigned long long p5acc = 0ull;
    v4u pre[6]; float pre_g = 0.f, pre_b = 0.f;
#define CP_ROW0(task_) ((((task_) % NCH) < 4) ? (ML + (((task_) / NCH) >> 3) * CTXL + ((task_) % NCH) * 64) : ((((task_) / NCH) >> 3) * SEQ + (((task_) % NCH) - 4) * 64))
#define CP_PREFETCH(task_) do { const int t_ = (task_); const int r0_ = CP_ROW0(t_), h_ = (t_ / NCH) & 7; \
        _Pragma("unroll") for (int q_ = 0; q_ < 6; ++q_) { const int e = tid + q_ * NT_, which = e >> 10, id = e & 1023, i = id >> 4, chn = id & 15; \
            pre[q_] = *(const v4u*)(DNQ + (size_t)(r0_ + i) * 3072 + which * 1024 + h_ * 128 + chn * 8); } \
        if (wave < 2) { const int pi_ = wave ? 63 - lane : lane; pre_g = Gd[((size_t)wave * M1 + r0_ + pi_) * 8 + h_]; pre_b = Bd[((size_t)wave * M1 + r0_ + pi_) * 8 + h_]; } } while (0)
    if (C.vcu < 16 * NCH) CP_PREFETCH(C.vcu);
    for (int task = C.vcu; task < 16 * NCH; task += C.G) {
        const int bh = task / NCH, tc = task % NCH, b = bh >> 3, h = bh & 7;
        const int row0 = (tc < 4) ? (ML + b * CTXL + tc * 64) : (b * SEQ + (tc - 4) * 64);
        const size_t cidx0 = (size_t)(bh * 2 + 0) * NCH + tc, cidx1 = (size_t)(bh * 2 + 1) * NCH + (tc < 4 ? 3 - tc : 135 - tc);
        unsigned long long q5_[5]; if (PROBE_TS >= 30 && PROBE_TS <= 33) q5_[0] = __builtin_amdgcn_s_memrealtime();
#pragma unroll
        for (int q_ = 0; q_ < 6; ++q_) { const int e = tid + q_ * NT_, which = e >> 10, id = e & 1023, i = id >> 4, chn = id & 15;
            LAS bf16_t* dst = (which == 0 ? Qs : (which == 1 ? Ks : Vs)) + i * CP_LD + chn * 8; *(LAS v4u*)dst = pre[q_]; }
        if (wave < 2) { const int dir = wave;
            const float g = pre_g, be = pre_b;
            float v = g;
#pragma unroll
            for (int o = 1; o < 64; o <<= 1) { const float u = __shfl_up(v, o); if (lane >= o) v += u; }
            const float gl = __shfl(v, 63), eg = __expf(v);
            Vec[256 + dir * 64 + lane] = v; Vec[384 + dir * 128 + lane] = be; Vec[384 + dir * 128 + 64 + lane] = eg;
            const size_t cidx = dir ? cidx1 : cidx0;
            EG[cidx * 64 + lane] = eg; EKD[cidx * 64 + lane] = __expf(gl - v); if (lane == 0) EGL[cidx] = __expf(gl); }
        __syncthreads();
        if (PROBE_TS >= 30 && PROBE_TS <= 33) q5_[1] = __builtin_amdgcn_s_memrealtime();
        if (task + C.G < 16 * NCH) CP_PREFETCH(task + C.G);
        {
            float df[2][4], db[2][4], bef[2][4], beb[2][4];
#pragma unroll
            for (int t = 0; t < 2; ++t) { const int t16 = wave * 2 + t, tm = t16 >> 2, tn = t16 & 3;
                const int j = tn * 16 + l15, jb = 63 - j; const float gfj = Vec[256 + j], gbj = Vec[320 + jb];
#pragma unroll
                for (int rg = 0; rg < 4; ++rg) { const int i = tm * 16 + 4 * lq + rg, ib = 63 - i;
                    df[t][rg] = __expf(Vec[256 + i] - gfj); db[t][rg] = __expf(Vec[320 + ib] - gbj);
                    bef[t][rg] = Vec[384 + i]; beb[t][rg] = Vec[384 + 128 + ib]; } }
#pragma unroll
            for (int q = 0; q < 4; ++q) { const int t = q & 1, t16 = wave * 2 + t, tm = t16 >> 2, tn = t16 & 3; const bool isq = q >= 2;
                const LAS bf16_t* Ab = (isq ? Qs : Ks) + (tm * 16 + l15) * CP_LD + 8 * lq; const LAS bf16_t* Bb = Ks + (tn * 16 + l15) * CP_LD + 8 * lq;
                f32x4 acc = {0.f, 0.f, 0.f, 0.f};
#pragma unroll
                for (int kk = 0; kk < 4; ++kk) acc = __builtin_amdgcn_mfma_f32_16x16x32_bf16(*(const LAS bf16x8*)(Ab + kk * 32), *(const LAS bf16x8*)(Bb + kk * 32), acc, 0, 0, 0);
                const int j = tn * 16 + l15, jb = 63 - j;
#pragma unroll
                for (int rg = 0; rg < 4; ++rg) { const int i = tm * 16 + 4 * lq + rg, ib = 63 - i; const float a = acc[rg];
                    if (isq) { ATS[i * 72 + j] = bf1(i >= j ? a * df[t][rg] : 0.f); ATS[64 * 72 + ib * 72 + jb] = bf1(i <= j ? a * db[t][rg] : 0.f); }
                    else if (i > j) { const float m = bef[t][rg] * a * df[t][rg];
                        if (tm == tn) DG[(tm * 16 + (i & 15)) * 17 + (j & 15)] = m; else MLO[i * 72 + j] = bf1(-m); }
                    else if (i < j) { const float m = beb[t][rg] * a * db[t][rg];
                        if (tm == tn) DG[((4 + (3 - tm)) * 16 + (ib & 15)) * 17 + (jb & 15)] = m; else MLO[64 * 72 + ib * 72 + jb] = bf1(-m); }
                }
            }
        }
        __syncthreads();
        if (PROBE_TS >= 30 && PROBE_TS <= 33) q5_[2] = __builtin_amdgcn_s_memrealtime();
        if (tid < 128) { const int blk = tid >> 4, cc = tid & 15; const LAS float* Mb = DG + blk * 16 * 17;
            float d[16];
#pragma unroll
            for (int r = 0; r < 16; ++r) { float v = (r == cc) ? 1.f : 0.f;
#pragma unroll
                for (int k = 0; k < r; ++k) v -= Mb[r * 17 + k] * d[k];
                d[r] = v; }
#pragma unroll
            for (int r = 0; r < 16; ++r) DB[(blk * 16 + r) * 24 + cc] = bf1(d[r]);
        } else { for (int e = tid - 128; e < 2 * 64 * 8; e += NT_ - 128) { const int dir = e >> 9, i = (e >> 3) & 63, chn = e & 7;
                *(v4u*)(ATd + (dir ? cidx1 : cidx0) * 4096 + i * 64 + chn * 8) = *(const LAS v4u*)(ATS + dir * (64 * 72) + i * 72 + chn * 8); } }
        __syncthreads();
        if (PROBE_TS >= 30 && PROBE_TS <= 33) q5_[3] = __builtin_amdgcn_s_memrealtime();
        {
            const int dir = wave >> 2, wq = wave & 3; const bool isw = wq >= 2; const int cb0 = (wq & 1) * 64;
            const LAS bf16_t* src = (isw ? Ks : Vs) + cb0 + l15; const LAS float* bsc = Vec + 384 + dir * 128;
            const LAS bf16_t* Mo = MLO + dir * (64 * 72); const LAS bf16_t* Dd = DB + dir * (4 * 16 * 24);
            s16x4c aoff[6], adg[4];
            { int q = 0;
#pragma unroll
              for (int bb = 1; bb < 4; ++bb)
#pragma unroll
                  for (int j = 0; j < bb; ++j) { aoff[q] = *(const LAS s16x4c*)(Mo + (bb * 16 + l15) * 72 + j * 16 + 4 * lq); ++q; }
#pragma unroll
              for (int bb = 0; bb < 4; ++bb) adg[bb] = *(const LAS s16x4c*)(Dd + (bb * 16 + l15) * 24 + 4 * lq); }
            s16x4c xp[4][4];
            bf16_t* gdst = (isw ? Wd : Ud) + (dir ? cidx1 : cidx0) * 8192 + cb0;
            s16x4c rv[4][4]; f32x4 sc[4];
            { const LAS bf16_t* tb = src - l15 + 4 * (l15 & 3);
#pragma unroll
              for (int bb = 0; bb < 4; ++bb) { const int i0 = bb * 16 + 4 * lq, ir = i0 + (l15 >> 2), pr = dir ? 63 - ir : ir;
                const f32x4 s1 = *(const LAS f32x4*)(bsc + i0), s2 = *(const LAS f32x4*)(bsc + 64 + i0);
#pragma unroll
                for (int rg = 0; rg < 4; ++rg) sc[bb][rg] = isw ? s1[rg] * s2[rg] : s1[rg];
#pragma unroll
                for (int ct = 0; ct < 4; ++ct) rv[bb][ct] = __builtin_amdgcn_ds_read_tr16_b64_v4i16((LAS s16x4c*)(tb + pr * CP_LD + ct * 16)); } }
            asm volatile("s_waitcnt lgkmcnt(0)" ::: "memory");
#pragma unroll
            for (int bb = 0; bb < 4; ++bb) {
#pragma unroll
                for (int ct = 0; ct < 4; ++ct) {
                    f32x4 acc;
#pragma unroll
                    for (int rg = 0; rg < 4; ++rg) acc[rg] = __uint_as_float(((unsigned)(unsigned short)rv[bb][ct][rg]) << 16) * sc[bb][rg];
#pragma unroll
                    for (int j = 0; j < bb; ++j) acc = __builtin_amdgcn_mfma_f32_16x16x16bf16_1k(aoff[bb * (bb - 1) / 2 + j], xp[ct][j], acc, 0, 0, 0);
                    const unsigned a01 = pk2(acc[0], acc[1]), a23 = pk2(acc[2], acc[3]);
                    const s16x4c accb = {(short)(a01 & 0xffff), (short)(a01 >> 16), (short)(a23 & 0xffff), (short)(a23 >> 16)};
                    const f32x4 x = __builtin_amdgcn_mfma_f32_16x16x16bf16_1k(adg[bb], accb, (f32x4){0.f, 0.f, 0.f, 0.f}, 0, 0, 0);
                    const unsigned x01 = pk2(x[0], x[1]), x23 = pk2(x[2], x[3]);
                    xp[ct][bb] = (s16x4c){(short)(x01 & 0xffff), (short)(x01 >> 16), (short)(x23 & 0xffff), (short)(x23 >> 16)};
                    LAS bf16_t* xw = XW + (4 * lq) * 72 + ct * 16 + l15;
                    xw[0] = (bf16_t)(x01 & 0xffff); xw[72] = (bf16_t)(x01 >> 16); xw[144] = (bf16_t)(x23 & 0xffff); xw[216] = (bf16_t)(x23 >> 16);
                }
                asm volatile("s_waitcnt lgkmcnt(0)" ::: "memory");
#pragma unroll
                for (int e2 = 0; e2 < 2; ++e2) { const int pc = lane + 64 * e2, r = pc >> 3, chn = pc & 7;
                    *(v4u*)(gdst + (size_t)(bb * 16 + r) * 128 + chn * 8) = *(const LAS v4u*)(XW + r * 72 + chn * 8); }
                asm volatile("s_waitcnt lgkmcnt(0)" ::: "memory");
            }
        }
        __syncthreads();
        if (PROBE_TS >= 30 && PROBE_TS <= 33) { q5_[4] = __builtin_amdgcn_s_memrealtime(); p5acc += q5_[PROBE_TS - 30 + 1] - q5_[PROBE_TS - 30]; }
    }
    if (PROBE_TS >= 30 && PROBE_TS <= 33 && tid == 0) ((float*)(p.ws + CTL_TS + 1024))[C.vcu] = (float)p5acc * 0.01f;
}
typedef short s16x4_ __attribute__((ext_vector_type(4))); typedef short v4i16_ __attribute__((ext_vector_type(4)));
constexpr int SC_WLD = 136, SC_TLD = 72;
constexpr int SB_W = 0, SB_Q = SB_W + 64 * SC_WLD * 2, SB_K = SB_Q + 64 * SC_WLD * 2, SB_ATT = SB_K + 64 * SC_WLD * 2, SB_U = SB_ATT + 64 * SC_TLD * 2, SB_EV = SB_U + 64 * 16 * 4  , SB_SIZE = SB_EV + 128 * 4;
constexpr int SC_SBT = 2 * SB_SIZE, SC_VNT = SC_SBT + 16 * SC_WLD * 2, SC_VNK = SC_VNT + 16 * SC_TLD * 2, SC_END = SC_VNK + 16 * SC_TLD * 2;
static_assert(SC_END <= 147456 - 64 && SB_SIZE % 16 == 0 && SB_Q % 16 == 0 && SB_ATT % 16 == 0 && SB_U % 16 == 0 && SB_EV % 16 == 0 && SC_SBT % 16 == 0 && SC_VNT % 16 == 0 && SC_VNK % 16 == 0, "scan LDS");
struct ScanRegs { v4u w0, w1, q0, q1, k0, k1, at, u; float ev, egl; };
struct ScanPtrs { const bf16_t *DNQ, *Wd, *Ud, *ATd; const float *EG, *EKD, *EGL; };
__device__ __forceinline__ int scan_base(int s, int b, int dir) { return dir == 0 ? ((s < 4) ? (ML + b * CTXL + s * 64) : (b * SEQ + (s - 4) * 64)) : ((s < 4) ? (ML + b * CTXL + (3 - s) * 64) : (b * SEQ + (131 - s) * 64)); }
__device__ __forceinline__ void scan_load(ScanRegs& R, const ScanPtrs& P, int s, int bhd, int b, int h, int dir, int n0, int tid) {
    const size_t cidx = (size_t)bhd * NCH + s; const int base = scan_base(s, b, dir);
    { const int i = tid >> 4, chn = tid & 15, row = base + (dir ? 63 - i : i);
      R.w0 = *(const v4u*)(P.Wd + cidx * 8192 + i * 128 + chn * 8); R.q0 = *(const v4u*)(P.DNQ + (size_t)row * 3072 + h * 128 + chn * 8); R.k0 = *(const v4u*)(P.DNQ + (size_t)row * 3072 + 1024 + h * 128 + chn * 8); }
    { const int i = 32 + (tid >> 4), chn = tid & 15, row = base + (dir ? 63 - i : i);
      R.w1 = *(const v4u*)(P.Wd + cidx * 8192 + i * 128 + chn * 8); R.q1 = *(const v4u*)(P.DNQ + (size_t)row * 3072 + h * 128 + chn * 8); R.k1 = *(const v4u*)(P.DNQ + (size_t)row * 3072 + 1024 + h * 128 + chn * 8); }
    R.at = *(const v4u*)(P.ATd + cidx * 4096 + (tid >> 3) * 64 + (tid & 7) * 8);
    if (tid < 128) { R.u = *(const v4u*)(P.Ud + cidx * 8192 + (tid >> 1) * 128 + n0 + (tid & 1) * 8); R.ev = (tid < 64) ? P.EG[cidx * 64 + tid] : P.EKD[cidx * 64 + tid - 64]; }
    R.egl = P.EGL[cidx];
}
__device__ __forceinline__ void scan_store(const ScanRegs& R, LAS unsigned char* B, int tid) {
    LAS bf16_t* Ws = (LAS bf16_t*)(B + SB_W); LAS bf16_t* Qs = (LAS bf16_t*)(B + SB_Q); LAS bf16_t* Ks = (LAS bf16_t*)(B + SB_K); LAS bf16_t* ATs = (LAS bf16_t*)(B + SB_ATT);
    const int chn = tid & 15;
    { const int i = tid >> 4; *(LAS v4u*)(Ws + i * SC_WLD + chn * 8) = R.w0; *(LAS v4u*)(Qs + i * SC_WLD + chn * 8) = R.q0; *(LAS v4u*)(Ks + i * SC_WLD + chn * 8) = R.k0; }
    { const int i = 32 + (tid >> 4); *(LAS v4u*)(Ws + i * SC_WLD + chn * 8) = R.w1; *(LAS v4u*)(Qs + i * SC_WLD + chn * 8) = R.q1; *(LAS v4u*)(Ks + i * SC_WLD + chn * 8) = R.k1; }
    *(LAS v4u*)(ATs + (tid >> 3) * SC_TLD + (tid & 7) * 8) = R.at;
    if (tid < 128) { LAS float* ud = (LAS float*)(B + SB_U) + (tid >> 1) * 16 + (tid & 1) * 8; *(LAS f32x4*)ud = (f32x4){bflo(R.u.x), bfhi(R.u.x), bflo(R.u.y), bfhi(R.u.y)}; *(LAS f32x4*)(ud + 4) = (f32x4){bflo(R.u.z), bfhi(R.u.z), bflo(R.u.w), bfhi(R.u.w)};
        ((LAS float*)(B + SB_EV))[tid] = R.ev; }
}
__device__ __forceinline__ void p6_scan(const Params& p, const Ctx& C) {
    ScanPtrs P; P.DNQ = (const bf16_t*)(p.ws + WS_DNQ); P.Wd = (const bf16_t*)(p.ws + WS_W); P.Ud = (const bf16_t*)(p.ws + WS_U); P.ATd = (const bf16_t*)(p.ws + WS_ATT);
    P.EG = (const float*)(p.ws + WS_EG); P.EKD = P.EG + (size_t)4224 * 64; P.EGL = P.EKD + (size_t)4224 * 64;
    LAS unsigned char* L = C.lds;
    LAS bf16_t* SBT = (LAS bf16_t*)(L + SC_SBT); LAS bf16_t* VNT = (LAS bf16_t*)(L + SC_VNT); LAS bf16_t* VNK = (LAS bf16_t*)(L + SC_VNK);
    const int tid = C.tid, lane = C.lane, wave = C.wave, l15 = lane & 15, lq = lane >> 4;
    for (int task = C.vcu; task < 256; task += C.G) {
        const int bhd = task >> 3, cb = task & 7, bh = bhd >> 1, dir = bhd & 1, b = bh >> 3, h = bh & 7, n0 = cb * 16;
        bf16_t* Od = (bf16_t*)(p.ws + (dir ? WS_OB : WS_OF));
        f32x4 S = {0.f, 0.f, 0.f, 0.f};
        for (int e = tid; e < 16 * SC_WLD / 2; e += NT_) ((LAS unsigned*)SBT)[e] = 0u;
        ScanRegs RA, RB; unsigned long long pt0 = 0ull, pacc = 0ull;
#ifdef SCAN_STAGGER
        { const unsigned long long ts0 = __builtin_amdgcn_s_memrealtime(); const unsigned long long lag = (unsigned long long)(cb * SCAN_STAGGER);
          while (__builtin_amdgcn_s_memrealtime() - ts0 < lag) __builtin_amdgcn_s_sleep(8); }
#endif
        scan_load(RA, P, 0, bhd, b, h, dir, n0, tid); scan_load(RB, P, 1, bhd, b, h, dir, n0, tid);
        scan_store(RA, L, tid); float egl_cur = RA.egl;
        scan_load(RA, P, 2, bhd, b, h, dir, n0, tid);
#define SCAN_STEP(RN, s_) do { const int s = (s_); const int base = scan_base(s, b, dir); LAS unsigned char* Bc = L + (s & 1) * SB_SIZE; LAS unsigned char* Bn = L + ((s + 1) & 1) * SB_SIZE; \
            __syncthreads();                                                          \
            if (PROBE_TS == 20 || PROBE_TS == 22) pt0 = __builtin_amdgcn_s_memrealtime(); if (PROBE_TS == 21 && pt0 != 0ull) pacc += __builtin_amdgcn_s_memrealtime() - pt0; \
            const float egl = egl_cur; \
            const int mt = wave & 3; f32x4 acc = {0.f, 0.f, 0.f, 0.f}; \
            { const LAS bf16_t* Ab = (LAS bf16_t*)(Bc + ((wave < 4) ? SB_W : SB_Q)) + (mt * 16 + l15) * SC_WLD + 8 * lq; const LAS bf16_t* Bb = SBT + l15 * SC_WLD + 8 * lq; \
              _Pragma("unroll") for (int kk = 0; kk < 4; ++kk) acc = __builtin_amdgcn_mfma_f32_16x16x32_bf16(*(const LAS bf16x8*)(Ab + kk * 32), *(const LAS bf16x8*)(Bb + kk * 32), acc, 0, 0, 0); } \
            if (wave < 4) { const int i0 = mt * 16 + 4 * lq; const LAS float* Us = (const LAS float*)(Bc + SB_U); const f32x4 ek = *(const LAS f32x4*)((const LAS float*)(Bc + SB_EV) + 64 + i0); \
                const float v0 = Us[(i0 + 0) * 16 + l15] - acc[0], v1 = Us[(i0 + 1) * 16 + l15] - acc[1], v2 = Us[(i0 + 2) * 16 + l15] - acc[2], v3 = Us[(i0 + 3) * 16 + l15] - acc[3]; \
                v2u w; w.x = pk2(v0, v1); w.y = pk2(v2, v3); *(LAS v2u*)(VNT + l15 * SC_TLD + i0) = w; \
                v2u wk; wk.x = pk2(v0 * ek[0], v1 * ek[1]); wk.y = pk2(v2 * ek[2], v3 * ek[3]); *(LAS v2u*)(VNK + l15 * SC_TLD + i0) = wk; } \
            else { const f32x4 eg = *(const LAS f32x4*)((const LAS float*)(Bc + SB_EV) + mt * 16 + 4 * lq); acc = acc * eg; } \
            if (PROBE_TS == 22) pacc += __builtin_amdgcn_s_memrealtime() - pt0; if (PROBE_TS == 23) pt0 = __builtin_amdgcn_s_memrealtime(); \
            if (s + 1 < NCH) { scan_store(RN, Bn, tid); egl_cur = RN.egl; asm volatile("s_waitcnt lgkmcnt(0)" ::: "memory"); if (PROBE_TS == 23) pacc += __builtin_amdgcn_s_memrealtime() - pt0; if (PROBE_TS == 24) pt0 = __builtin_amdgcn_s_memrealtime(); \
                if (s + 3 < NCH) scan_load(RN, P, s + 3, bhd, b, h, dir, n0, tid); if (PROBE_TS == 24) pacc += __builtin_amdgcn_s_memrealtime() - pt0; } \
            __syncthreads();                                                          \
            if (PROBE_TS == 20) pacc += __builtin_amdgcn_s_memrealtime() - pt0; if (PROBE_TS == 21) pt0 = __builtin_amdgcn_s_memrealtime(); \
            if (wave >= 4) { const LAS bf16_t* Ab = (LAS bf16_t*)(Bc + SB_ATT) + (mt * 16 + l15) * SC_TLD + 8 * lq; const LAS bf16_t* Bb = VNT + l15 * SC_TLD + 8 * lq; \
                _Pragma("unroll") for (int kk = 0; kk < 2; ++kk) acc = __builtin_amdgcn_mfma_f32_16x16x32_bf16(*(const LAS bf16x8*)(Ab + kk * 32), *(const LAS bf16x8*)(Bb + kk * 32), acc, 0, 0, 0); \
                if (s >= 4) { _Pragma("unroll") for (int rg = 0; rg < 4; ++rg) { const int i = mt * 16 + 4 * lq + rg; const int row = base + (dir ? 63 - i : i); \
                        Od[(size_t)row * 1024 + h * 128 + n0 + l15] = (bf16_t)f2bf(acc[rg]); } } } \
            { f32x4 sn = S * egl; const LAS bf16_t* Bb = VNK + l15 * SC_TLD + 8 * lq; \
              const LAS bf16_t* Ta = (LAS bf16_t*)(Bc + SB_K) + (8 * lq + (l15 >> 2)) * SC_WLD + wave * 16 + 4 * (l15 & 3); \
              _Pragma("unroll") for (int kk = 0; kk < 2; ++kk) { \
                  const s16x4_ t0 = __builtin_bit_cast(s16x4_, __builtin_amdgcn_ds_read_tr16_b64_v4i16((LAS v4i16_*)(Ta + (kk * 32) * SC_WLD))); \
                  const s16x4_ t1 = __builtin_bit_cast(s16x4_, __builtin_amdgcn_ds_read_tr16_b64_v4i16((LAS v4i16_*)(Ta + (kk * 32 + 4) * SC_WLD))); \
                  const bf16x8 af = (bf16x8){t0[0], t0[1], t0[2], t0[3], t1[0], t1[1], t1[2], t1[3]}; \
                  sn = __builtin_amdgcn_mfma_f32_16x16x32_bf16(af, *(const LAS bf16x8*)(Bb + kk * 32), sn, 0, 0, 0); } \
              S = sn; } \
            { v2u w; w.x = pk2(S[0], S[1]); w.y = pk2(S[2], S[3]); *(LAS v2u*)(SBT + l15 * SC_WLD + wave * 16 + 4 * lq) = w; } \
        } while (0)
        for (int s2 = 0; s2 < NCH; s2 += 2) { SCAN_STEP(RB, s2); SCAN_STEP(RA, s2 + 1); }
#undef SCAN_STEP
        if ((PROBE_TS >= 20 && PROBE_TS <= 24) && tid == 0) ((float*)(p.ws + CTL_TS + 1024))[C.vcu] = (float)pacc * 0.01f;
        __syncthreads();
    }
}
__device__ __forceinline__ void p7_yb(const Params& p, const Ctx& C) {
    const bf16_t* OF = (const bf16_t*)(p.ws + WS_OF); const bf16_t* OB = (const bf16_t*)(p.ws + WS_OB); const bf16_t* Z = (const bf16_t*)(p.ws + WS_Z); bf16_t* YB = (bf16_t*)(p.ws + WS_YB);
    const long total = (long)ML * 128;
    for (long it0 = (long)C.vcu * NT_ + C.tid; it0 < total; it0 += (long)C.G * NT_ * 4) {
        v4u a[4], bq[4], zz[4];
#pragma unroll
        for (int u = 0; u < 4; ++u) { const long itu = it0 + (long)u * C.G * NT_; const size_t off = (size_t)(itu < total ? itu : it0) * 8; a[u] = *(const v4u*)(OF + off); bq[u] = *(const v4u*)(OB + off); zz[u] = *(const v4u*)(Z + off); }
        asm volatile("" ::: "memory");
#pragma unroll
        for (int u = 0; u < 4; ++u) { const long itu = it0 + (long)u * C.G * NT_; const size_t off = (size_t)(itu < total ? itu : it0) * 8; const int d0 = (int)(off & 127);
            float o[8] = {bflo(a[u].x) + bflo(bq[u].x), bfhi(a[u].x) + bfhi(bq[u].x), bflo(a[u].y) + bflo(bq[u].y), bfhi(a[u].y) + bfhi(bq[u].y), bflo(a[u].z) + bflo(bq[u].z), bfhi(a[u].z) + bfhi(bq[u].z), bflo(a[u].w) + bflo(bq[u].w), bfhi(a[u].w) + bfhi(bq[u].w)};
            float zf[8] = {bflo(zz[u].x), bfhi(zz[u].x), bflo(zz[u].y), bfhi(zz[u].y), bflo(zz[u].z), bfhi(zz[u].z), bflo(zz[u].w), bfhi(zz[u].w)};
            float ss = 0.f;
#pragma unroll
            for (int e = 0; e < 8; ++e) ss += o[e] * o[e];
            ss += __shfl_xor(ss, 1); ss += __shfl_xor(ss, 2); ss += __shfl_xor(ss, 4); ss += __shfl_xor(ss, 8);
            const float rstd = rsqrtf(ss * (1.0f / 128.0f) + EPS);
            const f32x4 w0 = *(const f32x4*)(p.dn_norm_w + d0), w1 = *(const f32x4*)(p.dn_norm_w + d0 + 4);
            float y[8];
#pragma unroll
            for (int e = 0; e < 8; ++e) y[e] = o[e] * rstd * (e < 4 ? w0[e] : w1[e - 4]) * siluf(zf[e]);
            v4u w; w.x = pk2(y[0], y[1]); w.y = pk2(y[2], y[3]); w.z = pk2(y[4], y[5]); w.w = pk2(y[6], y[7]);
            *(v4u*)(YB + off) = w; }
    }
}
typedef float f32x2_t __attribute__((ext_vector_type(2)));
__device__ __forceinline__ float gelu_erf(float v) { return 0.5f * v * (1.0f + erff(v * 0.7071067811865476f)); }
__device__ __forceinline__ float dot8(v4u a, v4u b, float acc) {
    acc += bflo(a.x) * bflo(b.x); acc += bfhi(a.x) * bfhi(b.x); acc += bflo(a.y) * bflo(b.y); acc += bfhi(a.y) * bfhi(b.y);
    acc += bflo(a.z) * bflo(b.z); acc += bfhi(a.z) * bfhi(b.z); acc += bflo(a.w) * bflo(b.w); acc += bfhi(a.w) * bfhi(b.w); return acc;
}
__device__ __forceinline__ unsigned ord_u32(float f) { const unsigned u = __float_as_uint(f); return u ^ ((u >> 31) ? 0xffffffffu : 0x80000000u); }
#define INS16(k, x) do { unsigned x_ = (x); _Pragma("unroll") for (int i_ = 0; i_ < 16; ++i_) { const unsigned lo_ = min(k[i_], x_); k[i_] = max(k[i_], x_); x_ = lo_; } } while (0)
#define CE_DESC(k, a, b) do { const unsigned hi_ = max(k[a], k[b]), lo_ = min(k[a], k[b]); k[a] = hi_; k[b] = lo_; } while (0)
#define CE_ASC(k, a, b)  do { const unsigned hi_ = max(k[a], k[b]), lo_ = min(k[a], k[b]); k[a] = lo_; k[b] = hi_; } while (0)
__device__ __forceinline__ void sort16_desc(unsigned (&k)[16]) {
#pragma unroll
    for (int kk = 2; kk <= 16; kk <<= 1)
#pragma unroll
        for (int j = kk >> 1; j >= 1; j >>= 1)
#pragma unroll
            for (int i = 0; i < 16; ++i) { const int l = i ^ j; if (l > i) { if ((i & kk) == 0) CE_DESC(k, i, l); else CE_ASC(k, i, l); } }
}
__device__ __forceinline__ void merge_top16(unsigned (&a)[16], const unsigned (&b)[16]) {
#pragma unroll
    for (int i = 0; i < 16; ++i) a[i] = max(a[i], b[15 - i]);
#pragma unroll
    for (int j = 8; j >= 1; j >>= 1)
#pragma unroll
        for (int i = 0; i < 16; ++i) { const int l = i ^ j; if (l > i) CE_DESC(a, i, l); }
}
constexpr int P12_SC = 0, P12_TOPS = 128 * 129 * 4, P12_TOPI = P12_TOPS + 128 * 16 * 4, P12_IDX = P12_TOPI + 128 * 16 * 4  , P12_PW = P12_IDX + 64 * 128 * 2  , P12_END = P12_PW + 64 * 128 * 4;
static_assert(P12_END + 64 <= 147456 - 64 && P12_IDX % 16 == 0 && P12_PW % 16 == 0, "p12 lds");
__device__ __forceinline__ float octet_sum(float d) {
    d += __builtin_bit_cast(float, __builtin_amdgcn_update_dpp(0, __builtin_bit_cast(int, d), 0xB1, 0xF, 0xF, true));
    d += __builtin_bit_cast(float, __builtin_amdgcn_update_dpp(0, __builtin_bit_cast(int, d), 0x4E, 0xF, 0xF, true));
    d += __builtin_bit_cast(float, __builtin_amdgcn_update_dpp(0, __builtin_bit_cast(int, d), 0x141, 0xF, 0xF, true));
    return d;
}
__device__ __forceinline__ void p12_peer(const Params& p, const Ctx& C, const bool do_final) {
    const float* SCp = (const float*)(p.ws + WS_SC); const bf16_t* H2 = (const bf16_t*)(p.ws + WS_H2);
    const unsigned char* UB = (const unsigned char*)(p.ws + WS_UB); const unsigned char* VB = (const unsigned char*)(p.ws + WS_VB); const float* USC = (const float*)(p.ws + WS_USC); const float* VSC = (const float*)(p.ws + WS_VSC);
    const float* MOD = (const float*)(p.ws + CTL_MOD);
    LAS float* SCs = (LAS float*)(C.lds + P12_SC); LAS float* TOPS = (LAS float*)(C.lds + P12_TOPS); LAS int* TOPI = (LAS int*)(C.lds + P12_TOPI);
    LAS unsigned short* IDXs = (LAS unsigned short*)(C.lds + P12_IDX); LAS float* PWs = (LAS float*)(C.lds + P12_PW);
    const int lane = C.lane, tid = C.tid;
    const unsigned long long p12_t0 = (PROBE_TS == 12 || PROBE_TS == 13) ? __builtin_amdgcn_s_memrealtime() : 0ull; unsigned long long p12_tA = 0ull;
    LAS unsigned char* CTAB = (LAS unsigned char*)(C.lds + P12_END);
    if (tid < 64) { unsigned v = 0xffu;
        if (tid < 16) v = tid;
        else if (tid < 24) v = 16 + (tid - 16);
        else if (tid < 29) v = 32 + (tid - 24);
        else if (tid < 33) v = 48 + (tid - 29);
        else if (tid < 36) v = 64 + (tid - 33);
        else if (tid < 38) v = 80 + (tid - 36);
        else if (tid < 40) v = 96 + (tid - 38);
        else if (tid < 42) v = 112 + (tid - 40);
        else if (tid < 50) v = (8 + (tid - 42)) * 16;
        CTAB[tid] = (unsigned char)v; }
    __syncthreads();
    for (int blk = C.vcu; blk < ML / 64; blk += C.G) {
        for (int sub = 0; sub < 8; ++sub) {
            { const float* src = SCp + ((size_t)blk * 64 + sub * 8) * 2048;
#pragma unroll 4
              for (int e4 = tid; e4 < 8 * 2048 / 4; e4 += NT_) { const f32x4 v = *(const f32x4*)(src + e4 * 4); const int L = e4 >> 5, k = (e4 & 31) * 4; LAS float* d = SCs + L * 129 + k; d[0] = v.x; d[1] = v.y; d[2] = v.z; d[3] = v.w; } }
            __syncthreads();
            {
                const int L = tid >> 2, qd = tid & 3; const LAS float* s = SCs + L * 129 + qd * 32;
                unsigned k[16], t2[16];
#pragma unroll
                for (int i = 0; i < 16; ++i) k[i] = (ord_u32(s[i]) & ~127u) | (unsigned)(127 - (qd * 32 + i));
                sort16_desc(k);
#pragma unroll
                for (int i = 0; i < 16; ++i) t2[i] = (ord_u32(s[16 + i]) & ~127u) | (unsigned)(127 - (qd * 32 + 16 + i));
                sort16_desc(t2); merge_top16(k, t2);
#pragma unroll
                for (int i = 0; i < 16; ++i) t2[i] = __shfl_xor(k[i], 1);
                merge_top16(k, t2);
#pragma unroll
                for (int i = 0; i < 16; ++i) t2[i] = __shfl_xor(k[i], 2);
                merge_top16(k, t2);
                if (qd == 0) {
#pragma unroll
                    for (int i = 0; i < 16; ++i) { const int ki = 127 - (int)(k[i] & 127u); TOPI[L * 16 + i] = ki; TOPS[L * 16 + i] = SCs[L * 129 + ki]; } }
            }
            __syncthreads();
            if (tid < 256) {
                const int pr = tid >> 2, g4 = tid & 3, tt = pr >> 3, h = pr & 7, L0 = tt * 16 + h * 2, L1 = L0 + 1;
                unsigned k[16], t2[16];
#pragma unroll
                for (int i = 0; i < 16; ++i) { const unsigned ab = CTAB[g4 * 16 + i];
                    const float sv = TOPS[L0 * 16 + ((ab >> 4) & 15)] + TOPS[L1 * 16 + (ab & 15)];
                    k[i] = (ab == 0xffu) ? 0u : ((ord_u32(sv) & ~255u) | (255u - ab)); }
                sort16_desc(k);
#pragma unroll
                for (int i = 0; i < 16; ++i) t2[i] = __shfl_xor(k[i], 1);
                merge_top16(k, t2);
#pragma unroll
                for (int i = 0; i < 16; ++i) t2[i] = __shfl_xor(k[i], 2);
                merge_top16(k, t2);
                float bs[4]; const int orow = (sub * 8 + tt) * 128 + h * 16 + g4 * 4; float mx;
                { const int pos0 = 255 - (int)(k[0] & 255u); mx = TOPS[L0 * 16 + (pos0 >> 4)] + TOPS[L1 * 16 + (pos0 & 15)]; }
                float sm = 0.f;
#pragma unroll
                for (int i = 0; i < 4; ++i) { unsigned kv = k[0];
#pragma unroll
                    for (int j = 1; j < 16; ++j) kv = (g4 * 4 + i == j) ? k[j] : kv;
                    const int pos = 255 - (int)(kv & 255u), a = pos >> 4, b2 = pos & 15;
                    bs[i] = __expf(TOPS[L0 * 16 + a] + TOPS[L1 * 16 + b2] - mx); sm += bs[i];
                    IDXs[orow + i] = (unsigned short)(TOPI[L0 * 16 + a] * 128 + TOPI[L1 * 16 + b2]); }
                sm += __shfl_xor(sm, 1); sm += __shfl_xor(sm, 2);
                const float inv = 1.0f / sm;
#pragma unroll
                for (int i = 0; i < 4; ++i) PWs[orow + i] = bs[i] * inv;
            }
            __syncthreads();
        }
        int lane_b = lane; asm volatile("" : "+v"(lane_b));
        const int tl = C.wave * 8 + (lane_b >> 3), piece = lane_b & 7; const size_t t = (size_t)blk * 64 + tl;
        const LAS unsigned short* idxrow = IDXs + tl * 128; LAS float* pwrow = PWs + tl * 128;
        LAS float* actrow = (LAS float*)(C.lds + P12_SC) + tl * 128;
#pragma unroll
        for (int i = 0; i < 16; ++i) actrow[i * 8 + piece] = 0.f;
#define P12_LOAD(R, TAB, it_) do { const int itx = (it_); const v4u i8 = *(const LAS v4u*)(idxrow + (itx & 15) * 8); const unsigned off_ = (unsigned)((itx >> 4) * 128 + piece * 16); \
            _Pragma("unroll") for (int j = 0; j < 8; ++j) { const unsigned ex = (i8[j >> 1] >> (16 * (j & 1))) & 0xffffu; R[j] = *(const v4u*)(TAB + (ex * 2048u + off_)); } } while (0)
#define P12_HXLOAD(cb_) do { const bf16_t* hp = H2 + t * 2048 + (cb_) * 128 + piece * 16; hra = *(const v4u*)hp; hrb = *(const v4u*)(hp + 8); } while (0)
#define P12_BCOMP(R, it_) do { const int s8x = (it_) & 15; float mine = 0.f; \
            _Pragma("unroll") for (int j = 0; j < 8; ++j) { f32x2_t d2 = {0.f, 0.f}; \
                _Pragma("unroll") for (int w4 = 0; w4 < 4; ++w4) { const int wd = (int)R[j][w4]; const f32x2_t lo = __builtin_amdgcn_cvt_pk_f32_fp8(wd, false), hi2 = __builtin_amdgcn_cvt_pk_f32_fp8(wd, true); \
                    d2 += lo * hx2[2 * w4]; d2 += hi2 * hx2[2 * w4 + 1]; } \
                const float d = octet_sum(d2.x + d2.y); mine = (piece == j) ? d : mine; } \
            actrow[s8x * 8 + piece] += mine; } while (0)
        {
            v4u rA[8], rB[8], rC[8], rD[8], hra, hrb; f32x2_t hx2[8];
            P12_HXLOAD(0);
            P12_LOAD(rA, UB, 0); P12_LOAD(rB, UB, 1); P12_LOAD(rC, UB, 2); P12_LOAD(rD, UB, 3);
            for (int it = 0; it < 256; it += 4) {
                if ((it & 15) == 0) {
                    hx2[0] = (f32x2_t){bflo(hra.x), bfhi(hra.x)}; hx2[1] = (f32x2_t){bflo(hra.y), bfhi(hra.y)}; hx2[2] = (f32x2_t){bflo(hra.z), bfhi(hra.z)}; hx2[3] = (f32x2_t){bflo(hra.w), bfhi(hra.w)};
                    hx2[4] = (f32x2_t){bflo(hrb.x), bfhi(hrb.x)}; hx2[5] = (f32x2_t){bflo(hrb.y), bfhi(hrb.y)}; hx2[6] = (f32x2_t){bflo(hrb.z), bfhi(hrb.z)}; hx2[7] = (f32x2_t){bflo(hrb.w), bfhi(hrb.w)};
                    P12_HXLOAD(min((it >> 4) + 1, 15));
                }
                P12_BCOMP(rA, it);     P12_LOAD(rA, UB, min(it + 4, 255));
                P12_BCOMP(rB, it + 1); P12_LOAD(rB, UB, min(it + 5, 255));
                P12_BCOMP(rC, it + 2); P12_LOAD(rC, UB, min(it + 6, 255));
                P12_BCOMP(rD, it + 3); P12_LOAD(rD, UB, min(it + 7, 255));
            }
        }
#pragma unroll
        for (int s8 = 0; s8 < 16; ++s8) { const int sel = s8 * 8 + piece; const unsigned ex = idxrow[sel];
            pwrow[sel] = pwrow[sel] * gelu_erf(actrow[sel] * USC[ex]) * VSC[ex]; }
        asm volatile("s_waitcnt lgkmcnt(0)" ::: "memory");
        const int bsel = (int)(t >> 13); const float* g2 = MOD + bsel * 12288 + 10240;
        float* orow = p.out + t * 2048; float ssq = 0.f;
#define P12_CCOMP(R, it_) do { const int s8x = (it_) & 15; const f32x4 c0 = *(const LAS f32x4*)(pwrow + s8x * 8), c1 = *(const LAS f32x4*)(pwrow + s8x * 8 + 4); \
            _Pragma("unroll") for (int j = 0; j < 8; ++j) { const float c = (j < 4) ? c0[j & 3] : c1[j & 3]; const f32x2_t cc = {c, c}; \
                _Pragma("unroll") for (int w4 = 0; w4 < 4; ++w4) { const int wd = (int)R[j][w4]; const f32x2_t lo = __builtin_amdgcn_cvt_pk_f32_fp8(wd, false), hi2 = __builtin_amdgcn_cvt_pk_f32_fp8(wd, true); \
                    a2[2 * w4] += cc * lo; a2[2 * w4 + 1] += cc * hi2; } } } while (0)
        {
            v4u rA[8], rB[8], rC[8], rD[8]; f32x2_t a2[8];
            P12_LOAD(rA, VB, 0); P12_LOAD(rB, VB, 1); P12_LOAD(rC, VB, 2); P12_LOAD(rD, VB, 3);
            for (int it = 0; it < 256; it += 4) {
                if ((it & 15) == 0) {
#pragma unroll
                    for (int i = 0; i < 8; ++i) a2[i] = (f32x2_t){0.f, 0.f}; }
                P12_CCOMP(rA, it);     P12_LOAD(rA, VB, min(it + 4, 255));
                P12_CCOMP(rB, it + 1); P12_LOAD(rB, VB, min(it + 5, 255));
                P12_CCOMP(rC, it + 2); P12_LOAD(rC, VB, min(it + 6, 255));
                P12_CCOMP(rD, it + 3); P12_LOAD(rD, VB, min(it + 7, 255));
                if ((it & 15) == 12) {
                    if (do_final) {
                        const int c0i = (it >> 4) * 128 + piece * 16;
                        f32x4 xv4[4], gv4[4];
#pragma unroll
                        for (int q4 = 0; q4 < 4; ++q4) { xv4[q4] = *(const f32x4*)(orow + c0i + 4 * q4); gv4[q4] = *(const f32x4*)(g2 + c0i + 4 * q4); }
                        asm volatile("" ::: "memory");
#pragma unroll
                        for (int q4 = 0; q4 < 4; ++q4) { const f32x4 xv = xv4[q4], gv = gv4[q4];
                            f32x4 y; y[0] = xv[0] + gv[0] * a2[2 * q4].x; y[1] = xv[1] + gv[1] * a2[2 * q4].y; y[2] = xv[2] + gv[2] * a2[2 * q4 + 1].x; y[3] = xv[3] + gv[3] * a2[2 * q4 + 1].y;
                            ssq += (y[0] * y[0] + y[1] * y[1]) + (y[2] * y[2] + y[3] * y[3]);
                            *(f32x4*)(orow + c0i + 4 * q4) = y; }
                    } else { asm volatile("" :: "v"(a2[0]), "v"(a2[3]), "v"(a2[5]), "v"(a2[7])); }
                }
            }
        }
        if (PROBE_TS == 40) {
            if (tid == 0) { const unsigned long long t0 = __hip_atomic_load((unsigned long long*)(p.ws + CTL_TS), __ATOMIC_RELAXED, __HIP_MEMORY_SCOPE_AGENT);
                const unsigned dt = (unsigned)(__builtin_amdgcn_s_memrealtime() - t0); __hip_atomic_fetch_max((unsigned*)(p.ws + CTL_TS + 512), dt, __ATOMIC_RELAXED, __HIP_MEMORY_SCOPE_AGENT); }
            XcdBarrier b_; b_.bar = (unsigned*)(p.ws + CTL_BAR); b_.x = xb_xcc_id(); b_.st = (volatile LAS unsigned*)(C.lds + 147456 - 64); xcd_barrier(b_, tid);
        }
        if (do_final) {
            const float rstd = rsqrtf(octet_sum(ssq) * (1.0f / DM) + EPS);
            float probe_delta = 0.f;
            if (PROBE_TS == 40) probe_delta = (float)__hip_atomic_load((unsigned*)(p.ws + CTL_TS + 512), __ATOMIC_RELAXED, __HIP_MEMORY_SCOPE_AGENT) * 0.01f * PROBE_SCALE;
            else if ((PROBE_TS >= 20 && PROBE_TS <= 24) || (PROBE_TS >= 30 && PROBE_TS <= 33)) probe_delta = ((const float*)(p.ws + CTL_TS + 1024))[C.vcu] * PROBE_SCALE;
            else if (PROBE_TS == 14) { const unsigned long long t0 = __hip_atomic_load((unsigned long long*)(p.ws + CTL_TS), __ATOMIC_RELAXED, __HIP_MEMORY_SCOPE_AGENT); probe_delta = (float)(__builtin_amdgcn_s_memrealtime() - t0) * 0.01f * PROBE_SCALE; }
            else if (PROBE_TS == 12) probe_delta = (float)(__builtin_amdgcn_s_memrealtime() - p12_t0) * 0.01f * PROBE_SCALE;
            else if (PROBE_TS == 13) probe_delta = (float)(p12_tA - p12_t0) * 0.01f * PROBE_SCALE;
            else if (PROBE_TS >= 0) { unsigned long long* ts = (unsigned long long*)(p.ws + CTL_TS); const unsigned long long t1 = __hip_atomic_load(ts + PROBE_TS + 1, __ATOMIC_RELAXED, __HIP_MEMORY_SCOPE_AGENT), t0 = __hip_atomic_load(ts + PROBE_TS, __ATOMIC_RELAXED, __HIP_MEMORY_SCOPE_AGENT); probe_delta = (float)(t1 - t0) * 0.01f * PROBE_SCALE; }
#pragma unroll 2
            for (int cb = 0; cb < 16; cb += 2) {
                f32x4 yv[8], fv[8];
#pragma unroll
                for (int q8 = 0; q8 < 8; ++q8) { const int c0i = (cb + (q8 >> 2)) * 128 + piece * 16 + 4 * (q8 & 3); yv[q8] = *(const f32x4*)(orow + c0i); fv[q8] = *(const f32x4*)(p.final_w + c0i); }
                asm volatile("" ::: "memory");
#pragma unroll
                for (int q8 = 0; q8 < 8; ++q8) { const int c0i = (cb + (q8 >> 2)) * 128 + piece * 16 + 4 * (q8 & 3); *(f32x4*)(orow + c0i) = yv[q8] * rstd * fv[q8] + probe_delta; } }
        }
        __syncthreads();
    }
}
__device__ __forceinline__ void cvt_fp8_rows(const Ctx& C, const float* src, unsigned char* dst, float* scl, int nrows, int part, int nparts) {
    const int gw = part * 8 + C.wave, NGW = nparts * 8, lane = C.lane;
    f32x4 nx[8];
    if (gw < nrows) { const float* sp = src + (size_t)gw * 2048 + 16 * lane;
#pragma unroll
        for (int j = 0; j < 2; ++j)
#pragma unroll
            for (int q = 0; q < 4; ++q) nx[j * 4 + q] = *(const f32x4*)(sp + 1024 * j + 4 * q); }
    for (int r = gw; r < nrows; r += NGW) {
        f32x4 v[8]; float mx = 0.f;
#pragma unroll
        for (int i = 0; i < 8; ++i) { v[i] = nx[i]; const f32x4 a = v[i]; mx = fmaxf(mx, fmaxf(fmaxf(fabsf(a.x), fabsf(a.y)), fmaxf(fabsf(a.z), fabsf(a.w)))); }
        { const int rn = (r + NGW < nrows) ? r + NGW : r; const float* sp = src + (size_t)rn * 2048 + 16 * lane;
#pragma unroll
          for (int j = 0; j < 2; ++j)
#pragma unroll
              for (int q = 0; q < 4; ++q) nx[j * 4 + q] = *(const f32x4*)(sp + 1024 * j + 4 * q); }
        asm volatile("" ::: "memory");
#pragma unroll
        for (int o = 1; o < 64; o <<= 1) mx = fmaxf(mx, __shfl_xor(mx, o));
        mx = fmaxf(mx, 1e-30f); const float inv = 440.0f / mx;
        if (lane == 0) scl[r] = mx * (1.0f / 440.0f);
#pragma unroll
        for (int j = 0; j < 2; ++j) { v4u w;
#pragma unroll
            for (int q = 0; q < 4; ++q) { const f32x4 a = v[j * 4 + q] * inv; int wd = 0; wd = __builtin_amdgcn_cvt_pk_fp8_f32(a.x, a.y, wd, false); wd = __builtin_amdgcn_cvt_pk_fp8_f32(a.z, a.w, wd, true); w[q] = (unsigned)wd; }
            *(v4u*)(dst + (size_t)r * 2048 + 1024 * j + 16 * lane) = w; }
    }
}
__device__ __forceinline__ void cvt_rows(const Ctx& C, const float* src, bf16_t* dst, long n8) {
    for (long i = (long)C.vcu * NT_ + C.tid; i < n8; i += (long)C.G * NT_) { const f32x4 a = *(const f32x4*)(src + i * 8), b = *(const f32x4*)(src + i * 8 + 4);
        v4u w; w.x = pk2(a.x, a.y); w.y = pk2(a.z, a.w); w.z = pk2(b.x, b.y); w.w = pk2(b.z, b.w); *(v4u*)(dst + i * 8) = w; }
}
#ifdef PROBE_ATTN_ALPHA
#define PROBE_MGA(ws) ((bf16_t*)((ws) + 60 * MiB))
#else
#define PROBE_MGA(ws) ((bf16_t*)nullptr)
#endif
constexpr int LDS_BYTES = 147456;
constexpr int N_PHASES = 13;
constexpr int LDS_MISC = LDS_BYTES - 64;
__global__ void __launch_bounds__(NT_, 2) mega_fwd(Params p_arg) {
    extern __shared__ __attribute__((aligned(16))) unsigned char lds_raw[];
    const int wave_s = __builtin_amdgcn_readfirstlane((int)threadIdx.x >> 6);
    const int G_s = gridDim.x, bx_s = blockIdx.x;
    int vcu_s = (G_s % 8 == 0) ? (bx_s % 8) * (G_s / 8) + bx_s / 8 : bx_s;
    if (p_arg.ph_hi - p_arg.ph_lo > 1 && G_s == 256) {
        if (threadIdx.x == 0) { unsigned* xq = (unsigned*)(p_arg.ws + CTL_XQ); const unsigned x0 = xb_xcc_id() & 7u; int v = -1;
            for (unsigned q = 0; q < 8 && v < 0; ++q) { const unsigned xx = (x0 + q) & 7u; const unsigned t = __hip_atomic_fetch_add(xq + 64 * xx, 1u, __ATOMIC_RELAXED, __HIP_MEMORY_SCOPE_AGENT); if (t < 32u) v = (int)(xx * 32u + t); }
            ((volatile LAS int*)(lds_raw + LDS_MISC))[4] = v < 0 ? vcu_s : v; }
        __syncthreads();
        vcu_s = __builtin_amdgcn_readfirstlane(((volatile LAS int*)(lds_raw + LDS_MISC))[4]);
        __syncthreads();
    }
#define MKCTX() Ctx C; { unsigned m_ = ~0u; asm volatile("" : "+s"(m_)); C.lane = (int)__builtin_amdgcn_mbcnt_hi(m_, __builtin_amdgcn_mbcnt_lo(m_, 0u)); } \
    C.lds = (LAS unsigned char*)lds_raw; C.wave = wave_s; C.tid = wave_s * 64 + C.lane; C.G = G_s; C.vcu = vcu_s
    const int lo = p_arg.ph_lo, hi = p_arg.ph_hi;
#if defined(__HIP_DEVICE_COMPILE__)
#define LOADP() MKCTX(); typedef const __attribute__((address_space(4))) Params* CPP_; CPP_ kp_ = (CPP_)__builtin_amdgcn_kernarg_segment_ptr(); asm volatile("" : "+s"(kp_)); const Params p = *kp_; \
    unsigned char* ws = p.ws; const float* MOD = (const float*)(ws + CTL_MOD); (void)MOD
#else
#define LOADP() MKCTX(); const Params p = p_arg; unsigned char* ws = p.ws; const float* MOD = (const float*)(ws + CTL_MOD); (void)MOD
#endif
#ifndef PH_MASK
#define PH_MASK 0xffff
#endif
#define IN(k) (((PH_MASK >> (k)) & 1) && lo <= (k) && (k) < hi)
#ifndef P3DUP
#define P3DUP 0
#endif
#ifndef PROBE_REP
#define PROBE_REP -1
#endif
#define NREP(k) ((PROBE_REP == (k)) ? 2 : 1)
#define BAR_() do { LOADP(); XcdBarrier b_; b_.bar = (unsigned*)(ws + CTL_BAR); b_.x = xb_xcc_id(); b_.st = (volatile LAS unsigned*)(C.lds + LDS_MISC); xcd_barrier(b_, C.tid); } while (0)
#if defined(__HIP_DEVICE_COMPILE__)
#define TSTAMP(idx) do { if (PROBE_TS >= 0 && vcu_s == 0 && wave_s == 0) { if (__builtin_amdgcn_mbcnt_hi(~0u, __builtin_amdgcn_mbcnt_lo(~0u, 0u)) == 0u) { \
        typedef const __attribute__((address_space(4))) Params* CPT_; unsigned char* w_ = ((CPT_)__builtin_amdgcn_kernarg_segment_ptr())->ws; __hip_atomic_store((unsigned long long*)(w_ + CTL_TS) + (idx), (unsigned long long)__builtin_amdgcn_s_memrealtime(), __ATOMIC_RELAXED, __HIP_MEMORY_SCOPE_AGENT); } } } while (0)
#else
#define TSTAMP(idx) do { } while (0)
#endif
#define SEAM(k) do { if (IN(k) && IN((k) + 1)) { LOADP(); XcdBarrier b_; b_.bar = (unsigned*)(ws + CTL_BAR); b_.x = xb_xcc_id(); b_.st = (volatile LAS unsigned*)(C.lds + LDS_MISC); xcd_barrier(b_, C.tid); } TSTAMP((k) + 1); } while (0)
    if (hi - lo > 1) { LOADP(); if (C.tid < 2) ((volatile LAS unsigned*)(C.lds + LDS_MISC))[C.tid] = 0u; __syncthreads();
        (void)xcd_barrier_post((unsigned*)(ws + CTL_BAR), (volatile LAS unsigned*)(C.lds + LDS_MISC), C.tid); }
    TSTAMP(0);
    for (int rep_ = 0; rep_ < NREP(0); ++rep_) if (IN(0)) { if (rep_) BAR_(); LOADP(); p0_prologue(p, C); } SEAM(0);
    for (int rep_ = 0; rep_ < NREP(1); ++rep_) if (IN(1)) { if (rep_) BAR_(); LOADP();
        bf16_t* H = (bf16_t*)(ws + WS_D);
        mod_norm_rows(C, p.x, SEQ, p.norm1_w, MOD, MOD + 2048, H);
        mod_norm_rows(C, p.x + (size_t)SEQ * DM, SEQ, p.norm1_w, MOD + 12288, MOD + 12288 + 2048, H + (size_t)SEQ * DM);
        mod_norm_rows(C, p.ctx, MC, p.norm1_w, MOD + 2 * 12288, MOD + 2 * 12288 + 2048, H + (size_t)ML * DM);
    } SEAM(1);
    for (int rep_ = 0; rep_ < NREP(2); ++rep_) if (IN(2)) { if (rep_) BAR_(); LOADP();
        pg8::Gemm g{(const bf16_t*)(ws + WS_D), (const bf16_t*)(ws + WS_C), M1, NIN_PAD, DM}; pg8::StaticOrder S; S.init(M1, NIN_PAD, C.G, (C.G == 256) ? ((C.vcu & 31) * 8 + (C.vcu >> 5)) : (int)blockIdx.x);
        pg8::EpiIn E{(bf16_t*)(ws + WS_CQ), (bf16_t*)(ws + WS_CKV), (bf16_t*)(ws + WS_QKV), (bf16_t*)(ws + WS_Z), (bf16_t*)(ws + WS_GA), (bf16_t*)(ws + WS_GB),
                     (float*)(ws + WS_KR), (float*)(ws + WS_AB), (float*)(ws + CTL_SSQQ), (float*)(ws + CTL_SSQKV)};
        pg8::gemm_phase<pg8::EpiIn, pg8::StaticOrder, true, true>(C.lds, g, S, E, C.tid);
        if (C.G == 256) { const int cv = (C.vcu & 31) * 8 + (C.vcu >> 5); if (cv >= 72) { cvt_fp8_rows(C, p.peer_u, ws + WS_UB, (float*)(ws + WS_USC), 16384, cv - 72, 184); __syncthreads(); for (int it = cv - 72; it < 512; it += 184) p0_wprime_item(p, C, it); } }
    } SEAM(2);
    for (int rep_ = 0; rep_ < NREP(3); ++rep_) if (IN(3)) { if (rep_) BAR_();
        for (int d_ = 0; d_ < (P3DUP == 1 ? 2 : 1); ++d_) { LOADP(); pg8::Gemm g{(const bf16_t*)(ws + WS_CQ), (const bf16_t*)(ws + WS_WUQ), ML, 1536, 512}; pg8::StaticOrder S; S.init(ML, 1536, C.G, (C.G == 256) ? ((C.vcu & 31) * 8 + (C.vcu >> 5)) : (int)blockIdx.x);
          pg8::EpiQ E{(bf16_t*)(ws + WS_D), (const float*)(ws + CTL_SSQQ), QSCALE};
          pg8::gemm_phase<pg8::EpiQ, pg8::StaticOrder, true, true>(C.lds, g, S, E, C.tid); }
        for (int d_ = 0; d_ < (P3DUP == 2 ? 2 : 1); ++d_) { LOADP(); pg8::Gemm g{(const bf16_t*)(ws + WS_CKV), (const bf16_t*)(ws + WS_WUKV), M1, 2048, 256}; pg8::KvOrder S; S.init(M1, 2048, C.G, (C.G == 256) ? ((C.vcu & 31) * 8 + (C.vcu >> 5)) : (int)blockIdx.x);
          pg8::EpiKV E{(bf16_t*)(ws + WS_K), (bf16_t*)(ws + WS_C), (const float*)(ws + CTL_SSQKV)};
          pg8::gemm_phase<pg8::EpiKV, pg8::KvOrder, true, true>(C.lds, g, S, E, C.tid); }
        for (int d_ = 0; d_ < (P3DUP == 3 ? 2 : 1); ++d_) { LOADP(); p3_conv(p, C); }
        for (int d_ = 0; d_ < (P3DUP == 4 ? 2 : 1); ++d_) { LOADP(); p3_krope_gbeta(p, C); }
    } SEAM(3);
    for (int rep_ = 0; rep_ < NREP(4); ++rep_) if (IN(4)) { if (rep_) BAR_(); LOADP();
        const bf16_t* Q = (const bf16_t*)(ws + WS_D); const bf16_t* K = (const bf16_t*)(ws + WS_K); const bf16_t* V = (const bf16_t*)(ws + WS_C); bf16_t* YA = (bf16_t*)(ws + WS_YA);
        for (int u = C.vcu; u < 512; u += C.G) { const int bh = u >> 5, qb = u & 31, b = bh >> 3, h = bh & 7;
            attn::attn_unit(Q + ((size_t)bh * SEQ + qb * 256) * 192, K + (size_t)bh * LKV * 192, V + (size_t)bh * LKV * 128,
                            YA + ((size_t)b * SEQ + qb * 256) * 1024 + h * 128, 1024, LKV, (char*)lds_raw, C.tid); }
    } SEAM(4);
    for (int rep_ = 0; rep_ < NREP(5); ++rep_) if (IN(5)) { if (rep_) BAR_(); LOADP(); p5_chunk_prep(p, C); } SEAM(5);
    for (int rep_ = 0; rep_ < NREP(6); ++rep_) if (IN(6)) { if (rep_) BAR_(); LOADP(); p6_scan(p, C); } SEAM(6);
    for (int rep_ = 0; rep_ < NREP(7); ++rep_) if (IN(7)) { if (rep_) BAR_(); LOADP(); p7_yb(p, C); } SEAM(7);
    for (int rep_ = 0; rep_ < NREP(8); ++rep_) if (IN(8)) { if (rep_) BAR_();
        { LOADP(); pg8::Gemm g{(const bf16_t*)(ws + WS_YA), (const bf16_t*)(ws + WS_WBA), ML, 2048, 1024, (const bf16_t*)(ws + WS_YB), (const bf16_t*)(ws + WS_WBB)};
          pg8::ChainOrder S; S.init(ML, 2048, C.G, (C.G == 256) ? ((C.vcu & 31) * 8 + (C.vcu >> 5)) : (int)blockIdx.x);
          pg8::EpiMerge2 E{(const bf16_t*)(ws + WS_GA), (const bf16_t*)(ws + WS_GB), (bf16_t*)(ws + WS_MG)};
          pg8::gemm_phase<pg8::EpiMerge2, pg8::ChainOrder, true, true>(C.lds, g, S, E, C.tid); }
    } SEAM(8);
    for (int rep_ = 0; rep_ < NREP(9); ++rep_) if (IN(9)) { if (rep_) BAR_(); LOADP();
        pg8::Gemm g{(const bf16_t*)(ws + WS_MG), (const bf16_t*)(ws + WS_WOUT), ML, 2048, 2048}; pg8::StaticOrder S; S.init(ML, 2048, C.G, (C.G == 256) ? ((C.vcu & 31) * 8 + (C.vcu >> 5)) : (int)blockIdx.x);
        pg8::EpiOut E{p.x, MOD + 4096, p.out};
        pg8::gemm_phase<pg8::EpiOut, pg8::StaticOrder, true, true>(C.lds, g, S, E, C.tid);
    } SEAM(9);
#ifdef PROBE_ATTN_ALPHA
    if (IN(9)) { BAR_(); LOADP();
        pg8::Gemm g{(const bf16_t*)(ws + 60 * MiB), (const bf16_t*)(ws + WS_WOUT), ML, 2048, 2048}; pg8::StaticOrder S; S.init(ML, 2048, C.G, (C.G == 256) ? ((C.vcu & 31) * 8 + (C.vcu >> 5)) : (int)blockIdx.x);
        pg8::EpiDelta E{MOD + 4096, (bf16_t*)(ws + 124 * MiB)};
        pg8::gemm_phase<pg8::EpiDelta, pg8::StaticOrder, true, true>(C.lds, g, S, E, C.tid);
    }
#endif
    for (int rep_ = 0; rep_ < NREP(10); ++rep_) if (IN(10)) { if (rep_) BAR_(); LOADP();
        bf16_t* H2 = (bf16_t*)(ws + WS_H2);
        mod_norm_rows(C, p.out, SEQ, p.norm2_w, MOD + 6144, MOD + 8192, H2);
        mod_norm_rows(C, p.out + (size_t)SEQ * DM, SEQ, p.norm2_w, MOD + 12288 + 6144, MOD + 12288 + 8192, H2 + (size_t)SEQ * DM);
        if (C.G != 256) cvt_fp8_rows(C, p.peer_u, ws + WS_UB, (float*)(ws + WS_USC), 16384, C.vcu, C.G);
        cvt_fp8_rows(C, p.peer_v, ws + WS_VB, (float*)(ws + WS_VSC), 16384, C.vcu, C.G);
    } SEAM(10);
    for (int rep_ = 0; rep_ < NREP(11); ++rep_) if (IN(11)) { if (rep_) BAR_(); LOADP();
        pg8::Gemm g{(const bf16_t*)(ws + WS_H2), (const bf16_t*)(ws + WS_WPQ), ML, 2048, 2048}; pg8::StaticOrder S; S.init(ML, 2048, C.G, (C.G == 256) ? ((C.vcu & 31) * 8 + (C.vcu >> 5)) : (int)blockIdx.x);
        pg8::EpiScore E{(float*)(ws + WS_SC)};
        pg8::gemm_phase<pg8::EpiScore, pg8::StaticOrder, true, true>(C.lds, g, S, E, C.tid);
    } SEAM(11);
    for (int rep_ = 0; rep_ < NREP(12); ++rep_) if (IN(12)) { if (rep_) BAR_(); LOADP(); p12_peer(p, C, rep_ == NREP(12) - 1); }
#undef IN
#undef SEAM
}

#ifndef MK_SINGLE
#define MK_SINGLE 1
#endif
extern "C" void kernel_launch(void* const* d_in, const int* in_sizes, int n_in, void* d_out, int out_size, void* d_ws, size_t ws_size, hipStream_t stream) {
    static int grid = 0;
    if (grid == 0) {
        if (n_in != 25 || out_size != ML * DM || ws_size < WS_END) { fprintf(stderr, "kernel_launch: unexpected shapes: n_in %d out %d ws %zu (need %zu)\n", n_in, out_size, ws_size, (size_t)WS_END); grid = -1; return; }
        int dev = 0, cus = 0, per_cu = 0;
        if (hipGetDevice(&dev) != hipSuccess || hipDeviceGetAttribute(&cus, hipDeviceAttributeMultiprocessorCount, dev) != hipSuccess) { grid = -1; return; }
        if (hipFuncSetAttribute((const void*)mega_fwd, hipFuncAttributeMaxDynamicSharedMemorySize, LDS_BYTES) != hipSuccess) { fprintf(stderr, "kernel_launch: hipFuncSetAttribute failed\n"); grid = -1; return; }
        if (hipOccupancyMaxActiveBlocksPerMultiprocessor(&per_cu, (const void*)mega_fwd, NT_, LDS_BYTES) != hipSuccess || per_cu < 1) { fprintf(stderr, "kernel_launch: occupancy query says %d\n", per_cu); per_cu = 1; }
        (void)hipGetLastError();
        grid = cus;
    }
    if (grid < 0) return;
    (void)hipMemsetAsync((char*)d_ws + WS_CTL, 0, CTL_BYTES, stream);
    Params p{};
    const float** pp = (const float**)&p;
    for (int i = 0; i < 25; ++i) pp[i] = (const float*)d_in[i];
    p.out = (float*)d_out; p.ws = (unsigned char*)d_ws;
#if MK_SINGLE
    p.ph_lo = 0; p.ph_hi = N_PHASES;
    hipLaunchKernelGGL(mega_fwd, dim3(grid), dim3(NT_), LDS_BYTES, stream, p);
#else
    for (int ph = 0; ph < N_PHASES; ++ph) { p.ph_lo = ph; p.ph_hi = ph + 1; hipLaunchKernelGGL(mega_fwd, dim3(grid), dim3(NT_), LDS_BYTES, stream, p); }
#endif
}
```

```cpp
#include <hip/hip_runtime.h>
#include <hip/hip_bf16.h>
#include <cstdio>
#include <cstdint>
#include <cmath>
namespace pg8 {
#define PG8_LAS __attribute__((address_space(3)))
typedef unsigned short bf16_t;
typedef short bf16x8 __attribute__((ext_vector_type(8)));
typedef float f32x4 __attribute__((ext_vector_type(4)));
typedef unsigned u32x4 __attribute__((ext_vector_type(4)));
typedef unsigned u32x2 __attribute__((ext_vector_type(2)));
constexpr int BM = 256, BK = 64, HALF = 128, HTB = HALF * BK * 2  , STAGE_BYTES = 8 * HTB, NXCD = 8, WGM = 8;

__host__ __device__ __forceinline__ int lds_byte(int r, int c) { const int st = (r >> 4) * 2 + (c >> 5), rr = r & 15, cc = c & 31, ob = rr * 64 + cc * 2; return st * 1024 + (ob ^ (((ob >> 9) & 1) << 5)); }
__host__ __device__ __forceinline__ void stage_rc(int b, int& R, int& C) { const int st = b / 1024, sb = b % 1024, swz = sb ^ (((sb >> 9) & 1) << 5); R = (st >> 1) * 16 + swz / 64; C = (st & 1) * 32 + (swz % 64) / 2; }
__host__ __device__ __forceinline__ int perm32(int rho) { const int n = rho >> 4, i = rho & 15; return 8 * (i >> 2) + 4 * n + (i & 3); }

struct Unit { int pm, pn, half; };
struct Gemm { const bf16_t* A; const bf16_t* Bt; int M, N, K; const bf16_t* A2 = nullptr; const bf16_t* Bt2 = nullptr; };

struct StaticOrder {
    int nM, nN, nwg, G, c;
    __host__ __device__ void init(int M, int N, int G_, int c_) { nM = M / BM; nN = N / BM; nwg = nM * nN; G = G_; c = c_; }
    __host__ __device__ bool next(int i, Unit& u) const { return at((long)i * G + c, u); }
    __host__ __device__ bool at(const long L, Unit& u) const {
        if (L >= nwg) return false;
        int wgid = (int)L; { const int q = nwg / NXCD, r = nwg % NXCD, xcd = wgid % NXCD, off = wgid / NXCD; wgid = (xcd < r ? xcd * (q + 1) : r * (q + 1) + (xcd - r) * q) + off; }
        const int nig = WGM * nN, gid = wgid / nig, fm = gid * WGM, gsz = (nM - fm) < WGM ? (nM - fm) : WGM;
        u.pm = fm + ((wgid % nig) % gsz); u.pn = (wgid % nig) / gsz; return true;
    }
    __device__ __forceinline__ void a_ready(const Unit&) const {}
    __device__ __forceinline__ void done(const Unit&) const {}
};
struct KvOrder {
    StaticOrder base; int c;
    __host__ __device__ void init(int M, int N, int G_, int c_) { base.init(M, N, G_, c_); c = c_; }
    __host__ __device__ bool next(int i, Unit& u) const {
        if (base.G != 256 || base.nwg != 528) return base.next(i, u);
        if (c >= 128) return i < 3 ? base.at((long)(c - 128) + 128 * i, u) : false;
        if (i == 0) return base.at(384 + c, u);
        return (i == 1 && c < 16) ? base.at(512 + c, u) : false;
    }
    __device__ __forceinline__ void a_ready(const Unit&) const {}
    __device__ __forceinline__ void done(const Unit&) const {}
};
struct ChainOrder {
    StaticOrder base;
    __host__ __device__ void init(int M, int N, int G_, int c_) { base.init(M, N, G_, c_); }
    __host__ __device__ bool next(int i, Unit& u) const { if (!base.next(i >> 1, u)) return false; u.half = i & 1; return true; }
    __device__ __forceinline__ void a_ready(const Unit&) const {}
    __device__ __forceinline__ void done(const Unit&) const {}
};
typedef float f32x2 __attribute__((ext_vector_type(2)));
typedef __bf16 bf16x2_g __attribute__((ext_vector_type(2)));
__device__ __forceinline__ unsigned cvt_pk_bf16(float lo, float hi) { f32x2 v = {lo, hi}; bf16x2_g b = __builtin_convertvector(v, bf16x2_g); return __builtin_bit_cast(unsigned, b); }
template <class Epi, class Sched, bool ALIGN_EPI = false, bool SP2 = false>
__device__ __forceinline__ void gemm_phase(PG8_LAS unsigned char* lds, const Gemm g, const Sched& S, const Epi& E, const int tid) {
    const int wid = __builtin_amdgcn_readfirstlane(tid >> 6), lane = tid & 63, wr = wid >> 2, wc = wid & 3, fr = lane & 15, fq = lane >> 4;
    const int K = g.K, nt = K / BK;
    unsigned voffA[2], voffB[2];
#pragma unroll
    for (int i = 0; i < 2; ++i) { int R, C; stage_rc(tid * 16 + i * 8192, R, C); const int Rb = Epi::PERM ? ((R & ~31) + perm32(R & 31)) : R;
        voffA[i] = (unsigned)(R * K + C) * 2u; voffB[i] = (unsigned)(Rb * K + C) * 2u; }
    const size_t kstep = (size_t)(BK * 2);
    const size_t hstep = (size_t)HALF * K * 2;
    const size_t tstep = 2 * hstep;
    const unsigned ldsw = (unsigned)wid * 1024u;
    const int aoff = lds_byte(wr * 64 + fr, fq * 8), boff = lds_byte(wc * 32 + fr, fq * 8);
#define PG8_SA(b, h) (((b) * 2 + (h)) * HTB)
#define PG8_SB(b, h) ((4 + (b) * 2 + (h)) * HTB)
#define PG8_STAGE(bufoff, gbase, voff) do { _Pragma("unroll") for (int _i = 0; _i < 2; ++_i) \
        __builtin_amdgcn_global_load_lds((const unsigned*)((const char*)(gbase) + (voff)[_i]), (PG8_LAS unsigned*)(lds + (bufoff) + ldsw + _i * 8192), 16, 0, 0); } while (0)
#define PG8_LDA(dst, b, h) do { _Pragma("unroll") for (int m = 0; m < 4; ++m) _Pragma("unroll") for (int k = 0; k < 2; ++k) dst[m][k] = *(const PG8_LAS bf16x8*)(lds + PG8_SA(b, h) + aoff + m * 2048 + k * 1024); } while (0)
#define PG8_LDB(dst, b, h) do { _Pragma("unroll") for (int n = 0; n < 2; ++n) _Pragma("unroll") for (int k = 0; k < 2; ++k) dst[n][k] = *(const PG8_LAS bf16x8*)(lds + PG8_SB(b, h) + boff + n * 2048 + k * 1024); } while (0)
#define PG8_MMA(ai, bj, At, Bt) do { __builtin_amdgcn_s_setprio(1); _Pragma("unroll") for (int m = 0; m < 4; ++m) _Pragma("unroll") for (int n = 0; n < 2; ++n) _Pragma("unroll") for (int k = 0; k < 2; ++k) \
        acc[ai][bj][m][n] = __builtin_amdgcn_mfma_f32_16x16x32_bf16(Bt[n][k], At[m][k], acc[ai][bj][m][n], 0, 0, 0); __builtin_amdgcn_s_setprio(0); } while (0)
#define PG8_WAIT_V(n) asm volatile("s_waitcnt vmcnt(" #n ")" ::: "memory")
#define PG8_WAIT_L(n) asm volatile("s_waitcnt lgkmcnt(" #n ")" ::: "memory")
#define PG8_BAR __builtin_amdgcn_s_barrier()
#define PG8_SCHED __builtin_amdgcn_sched_barrier(0)
    Unit cur, nxt; int ui = 0;
    if (!S.next(0, cur)) return;
    f32x4 acc[2][2][4][2];
#pragma unroll
    for (int a = 0; a < 2; ++a)
#pragma unroll
        for (int b = 0; b < 2; ++b)
#pragma unroll
            for (int m = 0; m < 4; ++m)
#pragma unroll
                for (int n = 0; n < 2; ++n) acc[a][b][m][n] = (f32x4){0.f, 0.f, 0.f, 0.f};
    bf16x8 At[4][2], B0[2][2], B1[2][2];
    const char* cA; const char* cB;
    if constexpr (Epi::CHAIN) { cA = (const char*)(cur.half ? g.A2 : g.A) + (size_t)cur.pm * tstep; cB = (const char*)(cur.half ? g.Bt2 : g.Bt) + (size_t)cur.pn * tstep; }
    else { cA = (const char*)g.A + (size_t)cur.pm * tstep; cB = (const char*)g.Bt + (size_t)cur.pn * tstep; }
    S.a_ready(cur);
    if constexpr (SP2) {
        PG8_STAGE(PG8_SB(0, 0), cB, voffB); PG8_STAGE(PG8_SB(0, 1), cB + hstep, voffB); PG8_STAGE(PG8_SA(0, 0), cA, voffA); PG8_STAGE(PG8_SA(0, 1), cA + hstep, voffA);
        if (wr == 1) PG8_BAR;
        PG8_WAIT_V(2); PG8_BAR;
        PG8_STAGE(PG8_SB(1, 0), cB + kstep, voffB); PG8_STAGE(PG8_SA(1, 0), cA + kstep, voffA); PG8_STAGE(PG8_SB(1, 1), cB + hstep + kstep, voffB);
        PG8_WAIT_V(6); PG8_BAR;
    } else {
        PG8_STAGE(PG8_SB(0, 0), cB, voffB); PG8_STAGE(PG8_SA(0, 0), cA, voffA); PG8_STAGE(PG8_SB(0, 1), cB + hstep, voffB); PG8_STAGE(PG8_SA(0, 1), cA + hstep, voffA);
        if (wr == 1) PG8_BAR;
        PG8_WAIT_V(4); PG8_BAR;
        PG8_STAGE(PG8_SB(1, 0), cB + kstep, voffB); PG8_STAGE(PG8_SA(1, 0), cA + kstep, voffA); PG8_STAGE(PG8_SB(1, 1), cB + hstep + kstep, voffB);
        PG8_WAIT_V(6); PG8_BAR;
    }
    for (;;) {
        const bool has_next = S.next(ui + 1, nxt);
        const char* nA; const char* nB;
        if constexpr (Epi::CHAIN) { nA = has_next ? (const char*)(nxt.half ? g.A2 : g.A) + (size_t)nxt.pm * tstep : cA; nB = has_next ? (const char*)(nxt.half ? g.Bt2 : g.Bt) + (size_t)nxt.pn * tstep : cB; }
        else { nA = has_next ? (const char*)g.A + (size_t)nxt.pm * tstep : cA; nB = has_next ? (const char*)g.Bt + (size_t)nxt.pn * tstep : cB; }
        for (int t = 0; t < nt; t += 2) {
            const bool last = (t == nt - 2);
            const char* a1 = cA + (size_t)(t + 1) * kstep;
            const char* a2 = last ? nA : cA + (size_t)(t + 2) * kstep; const char* b2 = last ? nB : cB + (size_t)(t + 2) * kstep;
            const char* a3 = a2 + kstep; const char* b3 = b2 + kstep;
            if (last && has_next) S.a_ready(nxt);
            if constexpr (Epi::PREFETCH) E.prefetch(cur, t, tid, (PG8_LAS unsigned*)(lds + 131072 + wid * 256));
            if constexpr (SP2) {
            PG8_LDB(B0, 0, 0); PG8_LDB(B1, 0, 1); PG8_SCHED; PG8_LDA(At, 0, 0); PG8_STAGE(PG8_SA(1, 1), a1 + hstep, voffA);
            PG8_WAIT_V(8); PG8_WAIT_L(0); PG8_BAR; PG8_MMA(0, 0, At, B0); PG8_MMA(0, 1, At, B1); PG8_BAR; PG8_SCHED;
            PG8_LDA(At, 0, 1); PG8_STAGE(PG8_SB(0, 0), b2, voffB); PG8_STAGE(PG8_SB(0, 1), b2 + hstep, voffB); PG8_STAGE(PG8_SA(0, 0), a2, voffA);
            PG8_WAIT_V(8); PG8_WAIT_L(0); PG8_BAR; PG8_MMA(1, 0, At, B0); PG8_MMA(1, 1, At, B1); PG8_BAR; PG8_SCHED;
            PG8_LDB(B0, 1, 0); PG8_LDB(B1, 1, 1); PG8_SCHED; PG8_LDA(At, 1, 0); PG8_STAGE(PG8_SA(0, 1), a2 + hstep, voffA);
            PG8_WAIT_V(8); PG8_WAIT_L(0); PG8_BAR; PG8_MMA(0, 0, At, B0); PG8_MMA(0, 1, At, B1); PG8_BAR; PG8_SCHED;
            PG8_LDA(At, 1, 1); PG8_STAGE(PG8_SB(1, 0), b3, voffB); PG8_STAGE(PG8_SB(1, 1), b3 + hstep, voffB); PG8_STAGE(PG8_SA(1, 0), a3, voffA);
            PG8_WAIT_V(8); PG8_WAIT_L(0); PG8_BAR; PG8_MMA(1, 0, At, B0); PG8_MMA(1, 1, At, B1); PG8_BAR; PG8_SCHED;
            } else {
            PG8_LDB(B0, 0, 0); PG8_SCHED; PG8_LDA(At, 0, 0); PG8_STAGE(PG8_SA(1, 1), a1 + hstep, voffA);
            PG8_WAIT_L(8); PG8_BAR; PG8_WAIT_L(0); PG8_MMA(0, 0, At, B0); PG8_BAR; PG8_SCHED;
            PG8_LDB(B1, 0, 1); PG8_STAGE(PG8_SB(0, 0), b2, voffB);
            PG8_BAR; PG8_WAIT_L(0); PG8_MMA(0, 1, At, B1); PG8_BAR;
            PG8_LDA(At, 0, 1); PG8_STAGE(PG8_SA(0, 0), a2, voffA);
            PG8_BAR; PG8_WAIT_L(0); PG8_MMA(1, 0, At, B0); PG8_BAR; PG8_SCHED;
            PG8_STAGE(PG8_SB(0, 1), b2 + hstep, voffB);
            PG8_WAIT_V(6); PG8_BAR; PG8_MMA(1, 1, At, B1); PG8_BAR;
            PG8_LDB(B0, 1, 0); PG8_SCHED; PG8_LDA(At, 1, 0); PG8_STAGE(PG8_SA(0, 1), a2 + hstep, voffA);
            PG8_WAIT_L(8); PG8_BAR; PG8_WAIT_L(0); PG8_MMA(0, 0, At, B0); PG8_BAR; PG8_SCHED;
            PG8_LDB(B1, 1, 1); PG8_STAGE(PG8_SB(1, 0), b3, voffB);
            PG8_BAR; PG8_WAIT_L(0); PG8_MMA(0, 1, At, B1); PG8_BAR;
            PG8_LDA(At, 1, 1); PG8_STAGE(PG8_SA(1, 0), a3, voffA);
            PG8_BAR; PG8_WAIT_L(0); PG8_MMA(1, 0, At, B0); PG8_BAR; PG8_SCHED;
            PG8_STAGE(PG8_SB(1, 1), b3 + hstep, voffB);
            PG8_WAIT_V(6); PG8_BAR; PG8_MMA(1, 1, At, B1); PG8_BAR;
            }
        }
        if constexpr (ALIGN_EPI) { if (wr == 0) PG8_BAR; }
        if constexpr (!Epi::AFTER_DRAIN) { E(acc, cur, wr, wc, fr, fq); S.done(cur); }
        if (!has_next) break;
        if (!(Epi::CHAIN && cur.half == 0))
#pragma unroll
        for (int a = 0; a < 2; ++a)
#pragma unroll
            for (int b = 0; b < 2; ++b)
#pragma unroll
                for (int m = 0; m < 4; ++m)
#pragma unroll
                    for (int n = 0; n < 2; ++n) acc[a][b][m][n] = (f32x4){0.f, 0.f, 0.f, 0.f};
        cur = nxt; cA = nA; cB = nB; ++ui;
        if constexpr (ALIGN_EPI) { if (wr == 1) PG8_BAR; }
    }
    PG8_WAIT_V(0);
    if constexpr (!ALIGN_EPI) { if (wr == 0) PG8_BAR; }
    PG8_BAR;
    if constexpr (Epi::AFTER_DRAIN) { E.fused(acc, cur, wr, wc, fr, fq, lds, wid, lane); S.done(cur); }
#undef PG8_SA
#undef PG8_SB
#undef PG8_STAGE
#undef PG8_LDA
#undef PG8_LDB
#undef PG8_MMA
#undef PG8_WAIT_V
#undef PG8_WAIT_L
#undef PG8_BAR
#undef PG8_SCHED
}
__device__ __forceinline__ float bfu(unsigned short v) { return __uint_as_float(((unsigned)v) << 16); }
__device__ __forceinline__ void fast_sincos(float x, float& sn, float& cs) {
    float rev = x * 0.15915494309189535f; rev -= rintf(rev); sn = __builtin_amdgcn_sinf(rev); cs = __builtin_amdgcn_cosf(rev); }
__device__ __forceinline__ float sigm(float v) { return 1.0f / (1.0f + __expf(-v)); }
__device__ __forceinline__ void store_tile_bf16(const f32x4 (&acc)[2][2][4][2], bf16_t* tile  , int ld, int wr, int wc, int fr, int fq) {
#pragma unroll
    for (int ai = 0; ai < 2; ++ai)
#pragma unroll
        for (int m = 0; m < 4; ++m) { bf16_t* rowp = tile + (size_t)(ai * HALF + wr * 64 + m * 16 + fr) * ld + wc * 32 + 8 * fq;
#pragma unroll
            for (int bj = 0; bj < 2; ++bj) { const f32x4 v0 = acc[ai][bj][m][0], v1 = acc[ai][bj][m][1];
                u32x4 w; w.x = cvt_pk_bf16(v0[0], v0[1]); w.y = cvt_pk_bf16(v0[2], v0[3]); w.z = cvt_pk_bf16(v1[0], v1[1]); w.w = cvt_pk_bf16(v1[2], v1[3]);
                *(u32x4*)(rowp + bj * HALF) = w; } }
}
__device__ __forceinline__ void tile_ssq(const f32x4 (&acc)[2][2][4][2], float* ssq  , int nslot, int slot, int wr, int fr, int fq) {
#pragma unroll
    for (int ai = 0; ai < 2; ++ai)
#pragma unroll
        for (int m = 0; m < 4; ++m) { float s = 0.f;
#pragma unroll
            for (int bj = 0; bj < 2; ++bj)
#pragma unroll
                for (int n = 0; n < 2; ++n) { const f32x4 x = acc[ai][bj][m][n]; s += (x[0] * x[0] + x[1] * x[1]) + (x[2] * x[2] + x[3] * x[3]); }
            s += __shfl_xor(s, 16); s += __shfl_xor(s, 32);
            if (fq == 0) ssq[(size_t)(ai * HALF + wr * 64 + m * 16 + fr) * nslot + slot] = s; }
}
struct EpiIn {
    static constexpr bool PERM = true, AFTER_DRAIN = false, CHAIN = false, PREFETCH = false;
    bf16_t *CQ, *CKV, *QKV, *Z, *GA, *GB; float *KR, *AB, *ssq_q, *ssq_kv;
    __device__ __forceinline__ void operator()(const f32x4 (&acc)[2][2][4][2], const Unit& u, int wr, int wc, int fr, int fq) const {
        const int pn = u.pn, pm = u.pm; const size_t r0 = (size_t)pm * BM;
        const bool lat = pm < 64;
        if (pn == 35) {
            const int cl = wc * 32 + 8 * fq;
            if (cl < 96) {
#pragma unroll
                for (int ai = 0; ai < 2; ++ai)
#pragma unroll
                    for (int m = 0; m < 4; ++m) { const size_t r = r0 + ai * HALF + wr * 64 + m * 16 + fr;
                        float* dst = (cl < 64) ? (KR + r * 64 + cl) : (AB + r * 32 + (cl - 64));
                        *(f32x4*)dst = acc[ai][0][m][0]; *(f32x4*)(dst + 4) = acc[ai][0][m][1]; }
            }
            return;
        }
        bf16_t* base; int ld; bool latonly = true; float* ssq = nullptr; int nslot = 4, slot = wc;
        if (pn < 2) { base = CQ + pn * 256; ld = 512; ssq = ssq_q; nslot = 8; slot = pn * 4 + wc; }
        else if (pn == 2) { base = CKV; ld = 256; ssq = ssq_kv; latonly = false; }
        else if (pn < 15) { base = QKV + (pn - 3) * 256; ld = 3072; latonly = false; }
        else if (pn < 19) { base = Z + (pn - 15) * 256; ld = 1024; }
        else if (pn < 27) { base = GA + (pn - 19) * 256; ld = 2048; }
        else { base = GB + (pn - 27) * 256; ld = 2048; }
        if (latonly && !lat) return;
        store_tile_bf16(acc, base + r0 * ld, ld, wr, wc, fr, fq);
        if (ssq) tile_ssq(acc, ssq + r0 * nslot, nslot, slot, wr, fr, fq);
    }
};
struct EpiQ {
    static constexpr bool PERM = true, AFTER_DRAIN = false, CHAIN = false, PREFETCH = false;
    bf16_t* Q; const float* ssq_q; float qscale;
    __device__ __forceinline__ void operator()(const f32x4 (&acc)[2][2][4][2], const Unit& u, int wr, int wc, int fr, int fq) const {
        const int pn = u.pn;
#pragma unroll
        for (int ai = 0; ai < 2; ++ai)
#pragma unroll
            for (int m = 0; m < 4; ++m) {
                const int r = u.pm * BM + ai * HALF + wr * 64 + m * 16 + fr; const int b = r >> 13, t = r & 8191;
                const f32x4 sa = *(const f32x4*)(ssq_q + (size_t)r * 8), sb = *(const f32x4*)(ssq_q + (size_t)r * 8 + 4);
                const float rs = rsqrtf((((sa[0] + sa[1]) + (sa[2] + sa[3])) + ((sb[0] + sb[1]) + (sb[2] + sb[3]))) * (1.0f / 512.0f) + 1e-6f) * qscale;
#pragma unroll
                for (int bj = 0; bj < 2; ++bj) {
                    f32x4 v0 = acc[ai][bj][m][0] * rs, v1 = acc[ai][bj][m][1] * rs;
                    bf16_t* dst;
                    if (pn < 4) { const int head = pn * 2 + bj; dst = Q + ((size_t)(b * 8 + head) * 8192 + t) * 192 + wc * 32 + 8 * fq; }
                    else {
                        const int head = (pn - 4) * 4 + bj * 2 + (wc >> 1), half = wc & 1;
                        const float pos = (float)(half == 0 ? (t >> 6) : (t & 63));
                        const int i0 = (8 * fq) & 15;
                        float xs[8] = {v0[0], v0[1], v0[2], v0[3], v1[0], v1[1], v1[2], v1[3]};
#pragma unroll
                        for (int e = 0; e < 8; ++e) {
                            const float other = __shfl_xor(xs[e], 32);
                            const float invf = exp2f(-(float)(i0 + e) * (13.287712379549449f / 16.0f));
                            float sn, cs; fast_sincos(pos * invf, sn, cs);
                            xs[e] = (fq < 2) ? (xs[e] * cs - other * sn) : (other * sn + xs[e] * cs);
                        }
                        v0 = (f32x4){xs[0], xs[1], xs[2], xs[3]}; v1 = (f32x4){xs[4], xs[5], xs[6], xs[7]};
                        dst = Q + ((size_t)(b * 8 + head) * 8192 + t) * 192 + 128 + half * 32 + 8 * fq;
                    }
                    u32x4 w; w.x = cvt_pk_bf16(v0[0], v0[1]); w.y = cvt_pk_bf16(v0[2], v0[3]); w.z = cvt_pk_bf16(v1[0], v1[1]); w.w = cvt_pk_bf16(v1[2], v1[3]);
                    *(u32x4*)dst = w;
                }
            }
    }
};
struct EpiKV {
    static constexpr bool PERM = true, AFTER_DRAIN = false, CHAIN = false, PREFETCH = false;
    bf16_t *K, *V; const float* ssq_kv;
    __device__ __forceinline__ void operator()(const f32x4 (&acc)[2][2][4][2], const Unit& u, int wr, int wc, int fr, int fq) const {
        const int head = u.pn;
#pragma unroll
        for (int ai = 0; ai < 2; ++ai)
#pragma unroll
            for (int m = 0; m < 4; ++m) {
                const int r = u.pm * BM + ai * HALF + wr * 64 + m * 16 + fr;
                int b, l; if (r < 16384) { b = r >> 13; l = 256 + (r & 8191); } else { b = (r - 16384) >> 8; l = (r - 16384) & 255; }
                const f32x4 sa = *(const f32x4*)(ssq_kv + (size_t)r * 4);
                const float rs = rsqrtf(((sa[0] + sa[1]) + (sa[2] + sa[3])) * (1.0f / 256.0f) + 1e-6f);
                const size_t rowi = (size_t)(b * 8 + head) * 8448 + l;
#pragma unroll
                for (int bj = 0; bj < 2; ++bj) {
                    const f32x4 v0 = acc[ai][bj][m][0] * rs, v1 = acc[ai][bj][m][1] * rs;
                    bf16_t* dst = (bj == 0) ? (K + rowi * 192 + wc * 32 + 8 * fq) : (V + rowi * 128 + wc * 32 + 8 * fq);
                    u32x4 w; w.x = cvt_pk_bf16(v0[0], v0[1]); w.y = cvt_pk_bf16(v0[2], v0[3]); w.z = cvt_pk_bf16(v1[0], v1[1]); w.w = cvt_pk_bf16(v1[2], v1[3]);
                    *(u32x4*)dst = w;
                }
            }
    }
};
template <bool FIRST> struct EpiMerge {
    static constexpr bool PERM = true, AFTER_DRAIN = false, CHAIN = false, PREFETCH = false;
    const bf16_t* G; bf16_t* MG; bf16_t* MGA;
    __device__ __forceinline__ void operator()(const f32x4 (&acc)[2][2][4][2], const Unit& u, int wr, int wc, int fr, int fq) const {
#pragma unroll
        for (int ai = 0; ai < 2; ++ai) {
            u32x4 gq[4][2], pq[4][2];
#pragma unroll
            for (int m = 0; m < 4; ++m)
#pragma unroll
                for (int bj = 0; bj < 2; ++bj) { const size_t off = (size_t)(u.pm * BM + ai * HALF + wr * 64 + m * 16 + fr) * 2048 + u.pn * BM + wc * 32 + 8 * fq + bj * HALF;
                    gq[m][bj] = *(const u32x4*)(G + off); if (!FIRST) pq[m][bj] = *(const u32x4*)(MG + off); }
            asm volatile("" ::: "memory");
#pragma unroll
            for (int m = 0; m < 4; ++m)
#pragma unroll
                for (int bj = 0; bj < 2; ++bj) { const size_t off = (size_t)(u.pm * BM + ai * HALF + wr * 64 + m * 16 + fr) * 2048 + u.pn * BM + wc * 32 + 8 * fq + bj * HALF;
                    const u32x4 g = gq[m][bj];
                    float gv[8] = {__uint_as_float(g.x << 16), __uint_as_float(g.x & 0xffff0000u), __uint_as_float(g.y << 16), __uint_as_float(g.y & 0xffff0000u),
                                   __uint_as_float(g.z << 16), __uint_as_float(g.z & 0xffff0000u), __uint_as_float(g.w << 16), __uint_as_float(g.w & 0xffff0000u)};
                    float o[8];
#pragma unroll
                    for (int e2 = 0; e2 < 8; ++e2) o[e2] = sigm(gv[e2]) * acc[ai][bj][m][e2 >> 2][e2 & 3];
                    if (!FIRST) { const u32x4 p = pq[m][bj];
                        o[0] += __uint_as_float(p.x << 16); o[1] += __uint_as_float(p.x & 0xffff0000u); o[2] += __uint_as_float(p.y << 16); o[3] += __uint_as_float(p.y & 0xffff0000u);
                        o[4] += __uint_as_float(p.z << 16); o[5] += __uint_as_float(p.z & 0xffff0000u); o[6] += __uint_as_float(p.w << 16); o[7] += __uint_as_float(p.w & 0xffff0000u); }
                    u32x4 w; w.x = cvt_pk_bf16(o[0], o[1]); w.y = cvt_pk_bf16(o[2], o[3]); w.z = cvt_pk_bf16(o[4], o[5]); w.w = cvt_pk_bf16(o[6], o[7]);
                    *(u32x4*)(MG + off) = w;
                    if (FIRST && MGA) *(u32x4*)(MGA + off) = w;
                }
            asm volatile("" ::: "memory");
        }
    }
};
struct EpiMerge2 {
    static constexpr bool PERM = true, AFTER_DRAIN = false, CHAIN = true, PREFETCH = false;
    const bf16_t* GA; const bf16_t* GB; bf16_t* MG;
    __device__ __forceinline__ void prefetch(const Unit& u, int t, int tid, PG8_LAS unsigned* dump) const {
        if (u.half == 0 && t < 8) { const int it = t >> 1, line = (it & 1) * 512 + tid, row = line >> 2, seg = line & 3; const bf16_t* G = (it < 2) ? GA : GB;
            __builtin_amdgcn_global_load_lds((const unsigned*)(G + (size_t)(u.pm * BM + row) * 2048 + u.pn * BM + seg * 64), dump, 4, 0, 0); } }
    __device__ __forceinline__ void operator()(f32x4 (&acc)[2][2][4][2], const Unit& u, int wr, int wc, int fr, int fq) const {
#pragma unroll
        for (int ai = 0; ai < 2; ++ai) {
            u32x4 gq[4][2], hq[4][2];
#pragma unroll
            for (int m = 0; m < 4; ++m)
#pragma unroll
                for (int bj = 0; bj < 2; ++bj) { const size_t off = (size_t)(u.pm * BM + ai * HALF + wr * 64 + m * 16 + fr) * 2048 + u.pn * BM + wc * 32 + 8 * fq + bj * HALF;
                    hq[m][bj] = *(const u32x4*)(GB + off); if (u.half == 0) gq[m][bj] = *(const u32x4*)(GA + off); }
            asm volatile("" ::: "memory");
#pragma unroll
            for (int m = 0; m < 4; ++m)
#pragma unroll
                for (int bj = 0; bj < 2; ++bj) { const size_t off = (size_t)(u.pm * BM + ai * HALF + wr * 64 + m * 16 + fr) * 2048 + u.pn * BM + wc * 32 + 8 * fq + bj * HALF;
                    const u32x4 h = hq[m][bj];
                    float hv[8] = {__uint_as_float(h.x << 16), __uint_as_float(h.x & 0xffff0000u), __uint_as_float(h.y << 16), __uint_as_float(h.y & 0xffff0000u),
                                   __uint_as_float(h.z << 16), __uint_as_float(h.z & 0xffff0000u), __uint_as_float(h.w << 16), __uint_as_float(h.w & 0xffff0000u)};
                    float eb[8];
#pragma unroll
                    for (int e2 = 0; e2 < 8; ++e2) eb[e2] = 1.0f + __expf(-fmaxf(hv[e2], -30.0f));
                    if (u.half == 0) { const u32x4 g = gq[m][bj];
                        float gv[8] = {__uint_as_float(g.x << 16), __uint_as_float(g.x & 0xffff0000u), __uint_as_float(g.y << 16), __uint_as_float(g.y & 0xffff0000u),
                                       __uint_as_float(g.z << 16), __uint_as_float(g.z & 0xffff0000u), __uint_as_float(g.w << 16), __uint_as_float(g.w & 0xffff0000u)};
#pragma unroll
                        for (int e2 = 0; e2 < 8; ++e2) acc[ai][bj][m][e2 >> 2][e2 & 3] *= eb[e2] * __builtin_amdgcn_rcpf(1.0f + __expf(-gv[e2]));
                    } else { float o[8];
#pragma unroll
                        for (int e2 = 0; e2 < 8; ++e2) o[e2] = acc[ai][bj][m][e2 >> 2][e2 & 3] * __builtin_amdgcn_rcpf(eb[e2]);
                        u32x4 w; w.x = cvt_pk_bf16(o[0], o[1]); w.y = cvt_pk_bf16(o[2], o[3]); w.z = cvt_pk_bf16(o[4], o[5]); w.w = cvt_pk_bf16(o[6], o[7]);
                        *(u32x4*)(MG + off) = w; }
                }
            asm volatile("" ::: "memory");
        }
    }
};
struct EpiOut {
    static constexpr bool PERM = false, AFTER_DRAIN = false, CHAIN = false, PREFETCH = false;
    const float* X; const float* G1  ; float* X1;
    __device__ __forceinline__ void prefetch(const Unit& u, int t, int tid, PG8_LAS unsigned* dump) const {
        if (t < 8) { const int line = (t >> 1) * 512 + tid, row = line >> 3, seg = line & 7;
            __builtin_amdgcn_global_load_lds((const unsigned*)(X + (size_t)(u.pm * BM + row) * 2048 + u.pn * BM + seg * 32), dump, 4, 0, 0); } }
    __device__ __forceinline__ void operator()(const f32x4 (&acc)[2][2][4][2], const Unit& u, int wr, int wc, int fr, int fq) const {
        const int b = u.pm >> 5;
        const int col0 = u.pn * BM + wc * 32 + 4 * fq;
#pragma unroll
        for (int bj = 0; bj < 2; ++bj)
#pragma unroll
            for (int n = 0; n < 2; ++n) { const int c = col0 + bj * HALF + n * 16; const f32x4 g = *(const f32x4*)(G1 + b * 12288 + c);
                f32x4 xv[2][4];
#pragma unroll
                for (int ai = 0; ai < 2; ++ai)
#pragma unroll
                    for (int m = 0; m < 4; ++m) xv[ai][m] = *(const f32x4*)(X + (size_t)(u.pm * BM + ai * HALF + wr * 64 + m * 16 + fr) * 2048 + c);
                asm volatile("" ::: "memory");
#pragma unroll
                for (int ai = 0; ai < 2; ++ai)
#pragma unroll
                    for (int m = 0; m < 4; ++m) *(f32x4*)(X1 + (size_t)(u.pm * BM + ai * HALF + wr * 64 + m * 16 + fr) * 2048 + c) = xv[ai][m] + g * acc[ai][bj][m][n];
                asm volatile("" ::: "memory"); }
    }
};
struct EpiDelta {
    static constexpr bool PERM = true, AFTER_DRAIN = false, CHAIN = false, PREFETCH = false;
    const float* G1; bf16_t* DA;
    __device__ __forceinline__ void operator()(const f32x4 (&acc)[2][2][4][2], const Unit& u, int wr, int wc, int fr, int fq) const {
        const int b = u.pm >> 5;
#pragma unroll
        for (int ai = 0; ai < 2; ++ai)
#pragma unroll
            for (int m = 0; m < 4; ++m) {
                const size_t off = (size_t)(u.pm * BM + ai * HALF + wr * 64 + m * 16 + fr) * 2048 + u.pn * BM + wc * 32 + 8 * fq;
#pragma unroll
                for (int bj = 0; bj < 2; ++bj) { const int c = u.pn * BM + wc * 32 + 8 * fq + bj * HALF;
                    const f32x4 g0 = *(const f32x4*)(G1 + b * 12288 + c), g1v = *(const f32x4*)(G1 + b * 12288 + c + 4);
                    const f32x4 v0 = acc[ai][bj][m][0] * g0, v1 = acc[ai][bj][m][1] * g1v;
                    u32x4 w; w.x = cvt_pk_bf16(v0[0], v0[1]); w.y = cvt_pk_bf16(v0[2], v0[3]); w.z = cvt_pk_bf16(v1[0], v1[1]); w.w = cvt_pk_bf16(v1[2], v1[3]);
                    *(u32x4*)(DA + off + bj * HALF) = w; }
            }
    }
};
struct EpiScore {
    static constexpr bool PERM = false, AFTER_DRAIN = false, CHAIN = false, PREFETCH = false;
    float* SC;
    __device__ __forceinline__ void operator()(const f32x4 (&acc)[2][2][4][2], const Unit& u, int wr, int wc, int fr, int fq) const {
        const int col0 = u.pn * BM + wc * 32 + 4 * fq;
#pragma unroll
        for (int ai = 0; ai < 2; ++ai)
#pragma unroll
            for (int m = 0; m < 4; ++m) { const size_t off = (size_t)(u.pm * BM + ai * HALF + wr * 64 + m * 16 + fr) * 2048 + col0;
#pragma unroll
                for (int bj = 0; bj < 2; ++bj)
#pragma unroll
                    for (int n = 0; n < 2; ++n) *(f32x4*)(SC + off + bj * HALF + n * 16) = acc[ai][bj][m][n]; }
    }
};
}
namespace attn {
using bf16x8 = __attribute__((ext_vector_type(8))) short;
using s16x4  = __attribute__((ext_vector_type(4))) short;
using f32x16 = __attribute__((ext_vector_type(16))) float;
using u32x4  = __attribute__((ext_vector_type(4))) unsigned;
typedef unsigned short bf16_t;
constexpr int DQK = 192, DV = 128, NW = 8, QBLK = 32, KVBLK = 64;
constexpr int SHM_V = KVBLK * DV * 2  , SHM_K = KVBLK * DQK * 2  , SHM_QR = 2 * SHM_V + 2 * SHM_K + NW * 64 * 4, SHM_ATTN = SHM_QR + NW * 4096;
constexpr float THR = 8.0f;
#define KSWZ(row, colB) ((row) * 384 + ((colB) ^ (((row) & 7) << 4)))
#define SBAR() __builtin_amdgcn_sched_barrier(0)
__device__ __forceinline__ int crow(int r, int hi) { return (r & 3) + 8 * (r >> 2) + 4 * hi; }
__device__ __forceinline__ unsigned cvtpk(float lo, float hi) { unsigned r; asm volatile("v_cvt_pk_bf16_f32 %0, %1, %2" : "=v"(r) : "v"(lo), "v"(hi)); return r; }
__device__ __forceinline__ void partialSM(f32x16& p0, f32x16& p1, float& m_reg, float& mn, float& alpha) {
  float pmax = p0[0];
#pragma unroll
  for (int r = 1; r < 16; ++r) pmax = fmaxf(pmax, p0[r]);
#pragma unroll
  for (int r = 0; r < 16; ++r) pmax = fmaxf(pmax, p1[r]);
  { auto rr = __builtin_amdgcn_permlane32_swap(__float_as_uint(pmax), __float_as_uint(pmax), false, false);
    pmax = fmaxf(__uint_as_float(rr[0]), __uint_as_float(rr[1])); }
  if (__builtin_expect(__all(pmax - m_reg <= THR), 1)) { mn = m_reg; alpha = 1.f; }
  else { mn = fmaxf(m_reg, pmax); alpha = __builtin_amdgcn_exp2f(m_reg - mn); m_reg = mn; }
#pragma unroll
  for (int r = 0; r < 16; ++r) p0[r] = p0[r] - mn;
#pragma unroll
  for (int r = 0; r < 16; ++r) p1[r] = p1[r] - mn;
#pragma unroll
  for (int r = 0; r < 16; ++r) p0[r] = __builtin_amdgcn_exp2f(p0[r]);
}
__device__ __forceinline__ void finishSM(f32x16& p0, f32x16& p1, float alpha, float& l_reg, bf16x8& pa0, bf16x8& pa1, bf16x8& pa2, bf16x8& pa3) {
#pragma unroll
  for (int r = 0; r < 16; ++r) p1[r] = __builtin_amdgcn_exp2f(p1[r]);
  float ps = 0;
#pragma unroll
  for (int r = 0; r < 16; ++r) ps += p0[r];
#pragma unroll
  for (int r = 0; r < 16; ++r) ps += p1[r];
  { auto rr = __builtin_amdgcn_permlane32_swap(__float_as_uint(ps), __float_as_uint(ps), false, false);
    ps = __uint_as_float(rr[0]) + __uint_as_float(rr[1]); }
  l_reg = l_reg * alpha + ps;
#define PK4(P, BASE, OUT) do { unsigned a0 = cvtpk(P[BASE + 0], P[BASE + 1]), a1 = cvtpk(P[BASE + 2], P[BASE + 3]);   \
    unsigned b0 = cvtpk(P[BASE + 4], P[BASE + 5]), b1 = cvtpk(P[BASE + 6], P[BASE + 7]);                              \
    auto r0 = __builtin_amdgcn_permlane32_swap(a0, b0, false, false); auto r1 = __builtin_amdgcn_permlane32_swap(a1, b1, false, false); \
    u32x4 w = {r0[0], r1[0], r0[1], r1[1]}; OUT = *reinterpret_cast<bf16x8*>(&w); } while (0)
  PK4(p0, 0, pa0); PK4(p0, 8, pa1); PK4(p1, 0, pa2); PK4(p1, 8, pa3);
#undef PK4
}
__device__ __forceinline__ void qkt(f32x16& p0, f32x16& p1, const char* Ks, const bf16x8* qr, const char* qrow, int qx, int r32, int hi) {
  p0 = f32x16{}; p1 = f32x16{};
#pragma unroll
  for (int d0 = 0; d0 < 12; ++d0) { const int cb = (d0 * 16 + hi * 8) * 2;
    bf16x8 b0 = *reinterpret_cast<const bf16x8*>(Ks + KSWZ(r32, cb));
    bf16x8 b1 = *reinterpret_cast<const bf16x8*>(Ks + KSWZ(32 + r32, cb));
    const bf16x8 q = (d0 < 8) ? qr[d0 < 8 ? d0 : 0] : *reinterpret_cast<const bf16x8*>(qrow + (qx ^ ((d0 - 8) << 5)));
    p0 = __builtin_amdgcn_mfma_f32_32x32x16_bf16(b0, q, p0, 0, 0, 0);
    p1 = __builtin_amdgcn_mfma_f32_32x32x16_bf16(b1, q, p1, 0, 0, 0); }
}
__device__ __forceinline__ int v_st(int k, int c) { const int kk = (k & ~0xC) | ((k & 4) << 1) | ((k & 8) >> 1); return ((kk >> 3) * 4 + (c >> 5)) * 512 + ((kk & 7) * 32 + (c & 31)) * 2; }
__device__ __forceinline__ int v_rd_base(int lane) { return ((lane & 3) << 3) | (((lane >> 2) & 3) << 6) | (((lane >> 4) & 1) << 5) | (((lane >> 5) & 1) << 8); }
constexpr int v_rd_off(int d0, int ks, int half) { return d0 * 512 + ks * 4096 + half * 2048; }
template <int OFF> __device__ __forceinline__ s16x4 tr_read(int vb) {
  s16x4 r; asm volatile("ds_read_b64_tr_b16 %0, %1 offset:%2" : "=&v"(r) : "v"(vb), "i"(OFF) : "memory"); return r;
}
template <int D0> __device__ __forceinline__ void pv_one(f32x16& od, int vb, bf16x8 pa0, bf16x8 pa1, bf16x8 pa2, bf16x8 pa3) {
  const s16x4 l0 = tr_read<v_rd_off(D0, 0, 0)>(vb), h0 = tr_read<v_rd_off(D0, 0, 1)>(vb), l1 = tr_read<v_rd_off(D0, 1, 0)>(vb), h1 = tr_read<v_rd_off(D0, 1, 1)>(vb);
  const s16x4 l2 = tr_read<v_rd_off(D0, 2, 0)>(vb), h2 = tr_read<v_rd_off(D0, 2, 1)>(vb), l3 = tr_read<v_rd_off(D0, 3, 0)>(vb), h3 = tr_read<v_rd_off(D0, 3, 1)>(vb);
  asm volatile("s_waitcnt lgkmcnt(0)" ::: "memory"); SBAR();
#define PK(L, H) (bf16x8){L[0], L[1], L[2], L[3], H[0], H[1], H[2], H[3]}
  od = __builtin_amdgcn_mfma_f32_32x32x16_bf16(pa0, PK(l0, h0), od, 0, 0, 0);
  od = __builtin_amdgcn_mfma_f32_32x32x16_bf16(pa1, PK(l1, h1), od, 0, 0, 0);
  od = __builtin_amdgcn_mfma_f32_32x32x16_bf16(pa2, PK(l2, h2), od, 0, 0, 0);
  od = __builtin_amdgcn_mfma_f32_32x32x16_bf16(pa3, PK(l3, h3), od, 0, 0, 0);
#undef PK
}
__device__ __forceinline__ void pv_d0(f32x16* o, int vb, bf16x8 pa0, bf16x8 pa1, bf16x8 pa2, bf16x8 pa3) {
  pv_one<0>(o[0], vb, pa0, pa1, pa2, pa3); pv_one<1>(o[1], vb, pa0, pa1, pa2, pa3); pv_one<2>(o[2], vb, pa0, pa1, pa2, pa3); pv_one<3>(o[3], vb, pa0, pa1, pa2, pa3);
}
__device__ __forceinline__ void attn_unit(const bf16_t* __restrict__ Qb, const bf16_t* __restrict__ Kh, const bf16_t* __restrict__ Vh, bf16_t* __restrict__ Ob, int ldo, int seq, char* lds, int tid_in) {
  int tid_ = tid_in; asm volatile("" : "+v"(tid_));
  const int tid = tid_, wid = tid >> 6, lane = tid & 63, r32 = lane & 31, hi = lane >> 5;
  char* V_lds = lds; char* K_lds = lds + 2 * SHM_V;
  float* ws = (float*)(lds + 2 * SHM_V + 2 * SHM_K) + wid * 64; float* li_l = ws; float* al_l = ws + 32;
  float m_reg = -1e30f, l_reg = 0; f32x16 o[4] = {}; bf16x8 qr[8];
  const bf16_t* Qw = Qb + (long)(wid * QBLK + r32) * DQK + hi * 8;
#pragma unroll
  for (int d0 = 0; d0 < 8; ++d0) qr[d0] = *reinterpret_cast<const bf16x8*>(Qw + d0 * 16);
  char* qrow = lds + SHM_QR + wid * 4096 + r32 * 128; const int qx = (hi ^ (r32 & 7)) << 4;
#pragma unroll
  for (int d0 = 8; d0 < 12; ++d0) *reinterpret_cast<bf16x8*>(qrow + (qx ^ ((d0 - 8) << 5))) = *reinterpret_cast<const bf16x8*>(Qw + d0 * 16);
  const int sr = tid >> 4, sc = (tid & 15) * 8, vst0 = v_st(sr, sc); constexpr int vst1d = 8192;
  unsigned kgo[3], klo[3];
#pragma unroll
  for (int i = 0; i < 3; ++i) { const int id = tid + 512 * i, kr_ = id / 24, kc_ = (id % 24) * 16; kgo[i] = (unsigned)(kr_ * 384 + kc_); klo[i] = (unsigned)KSWZ(kr_, kc_); }
  const unsigned vgo0 = (unsigned)((sr * DV + sc) * 2); constexpr unsigned vgo1d = 32 * DV * 2;
  const int vb0 = (int)(uintptr_t)V_lds + v_rd_base(lane);
  bf16x8 vs0, vs1, ks0, ks1, ks2;
#define SLOAD(k0) do { const char* Kt_ = (const char*)Kh + (size_t)(k0) * (DQK * 2); const char* Vt_ = (const char*)Vh + (size_t)(k0) * (DV * 2); \
    vs0 = *reinterpret_cast<const bf16x8*>(Vt_ + vgo0); vs1 = *reinterpret_cast<const bf16x8*>(Vt_ + vgo0 + vgo1d); \
    ks0 = *reinterpret_cast<const bf16x8*>(Kt_ + kgo[0]); ks1 = *reinterpret_cast<const bf16x8*>(Kt_ + kgo[1]); ks2 = *reinterpret_cast<const bf16x8*>(Kt_ + kgo[2]); } while (0)
#define SWRITE(b) do { *(bf16x8*)(V_lds + (b) * SHM_V + vst0) = vs0; *(bf16x8*)(V_lds + (b) * SHM_V + vst0 + vst1d) = vs1; \
    *(bf16x8*)(K_lds + (b) * SHM_K + klo[0]) = ks0; *(bf16x8*)(K_lds + (b) * SHM_K + klo[1]) = ks1; *(bf16x8*)(K_lds + (b) * SHM_K + klo[2]) = ks2; } while (0)
#define RESC(a) do { if (__any((a) < 1.f)) { if (hi == 0) al_l[r32] = (a); asm volatile("s_waitcnt lgkmcnt(0)" ::: "memory"); \
    _Pragma("unroll") for (int d = 0; d < 4; ++d) _Pragma("unroll") for (int r = 0; r < 16; ++r) o[d][r] *= al_l[crow(r, hi)]; } } while (0)
  f32x16 pA0, pA1, pB0, pB1; float mnA, mnB, alA, alB; bf16x8 pa0, pa1, pa2, pa3; const int NT = seq / KVBLK;
  SLOAD(0); SWRITE(0); __syncthreads();
  qkt(pA0, pA1, K_lds, qr, qrow, qx, r32, hi); partialSM(pA0, pA1, m_reg, mnA, alA);
  SLOAD(KVBLK);
  SWRITE(1); __syncthreads();
  for (int j = 1; j + 1 < NT; j += 2) {
    SBAR(); qkt(pB0, pB1, K_lds + SHM_K, qr, qrow, qx, r32, hi);
    finishSM(pA0, pA1, alA, l_reg, pa0, pa1, pa2, pa3); SBAR();
    SLOAD((j + 1) * KVBLK); SBAR();
    pv_d0(o, vb0, pa0, pa1, pa2, pa3); partialSM(pB0, pB1, m_reg, mnB, alB);
    __syncthreads(); SWRITE(0);
    RESC(alB); __syncthreads();
    SBAR(); qkt(pA0, pA1, K_lds, qr, qrow, qx, r32, hi);
    finishSM(pB0, pB1, alB, l_reg, pa0, pa1, pa2, pa3); SBAR();
    SLOAD((j + 2) * KVBLK); SBAR();
    pv_d0(o, vb0 + SHM_V, pa0, pa1, pa2, pa3); partialSM(pA0, pA1, m_reg, mnA, alA);
    __syncthreads(); SWRITE(1);
    RESC(alA); __syncthreads();
  }
  SBAR(); qkt(pB0, pB1, K_lds + SHM_K, qr, qrow, qx, r32, hi);
  finishSM(pA0, pA1, alA, l_reg, pa0, pa1, pa2, pa3); SBAR();
  pv_d0(o, vb0, pa0, pa1, pa2, pa3); partialSM(pB0, pB1, m_reg, mnB, alB);
  __syncthreads(); RESC(alB);
  finishSM(pB0, pB1, alB, l_reg, pa0, pa1, pa2, pa3); SBAR();
  pv_d0(o, vb0 + SHM_V, pa0, pa1, pa2, pa3);
  if (hi == 0) li_l[r32] = l_reg; asm volatile("s_waitcnt lgkmcnt(0)" ::: "memory");
  float rli[16];
#pragma unroll
  for (int r = 0; r < 16; ++r) rli[r] = __builtin_amdgcn_rcpf(li_l[crow(r, hi)]);
  { int t2 = tid_in; asm volatile("" : "+v"(t2));
    const int w2 = t2 >> 6, l2 = t2 & 63, c2 = l2 & 31, h2 = l2 >> 5;
    bf16_t* Ow = Ob + (unsigned)((w2 * QBLK + 4 * h2) * ldo + c2);
#pragma unroll
    for (int r = 0; r < 16; ++r) { const unsigned ro = (unsigned)(((r & 3) + 8 * (r >> 2)) * ldo);
#pragma unroll
      for (int d0 = 0; d0 < 4; ++d0) { const float v = o[d0][r] * rli[r]; Ow[ro + d0 * 32] = (bf16_t)(cvtpk(v, v) & 0xffffu); } } }
  __syncthreads();
#undef SLOAD
#undef SWRITE
#undef RESC
}
#undef KSWZ
#undef SBAR
}
#define GAS __attribute__((address_space(1)))
#define LAS __attribute__((address_space(3)))
typedef unsigned short bf16_t;
typedef unsigned v4u __attribute__((ext_vector_type(4)));
typedef unsigned v2u __attribute__((ext_vector_type(2)));
typedef float f32x4 __attribute__((ext_vector_type(4)));
typedef short bf16x8 __attribute__((ext_vector_type(8)));
constexpr int NT_ = 512;
constexpr int BATCH = 2, SEQ = 8192, DM = 2048, CTXL = 256;
constexpr int ML = BATCH * SEQ  , MC = BATCH * CTXL  , M1 = ML + MC  ;
constexpr int NIN_PAD = 9216;
constexpr int LKV = CTXL + SEQ;
constexpr int NCH = 132;
constexpr float EPS = 1e-6f;
constexpr float QSCALE = 0.07216878364870322f * 1.4426950408889634f;
constexpr size_t MiB = 1u << 20;
constexpr size_t WS_CTL = 0, CTL_BYTES = 128 * 1024;
#ifndef PROBE_TS
#define PROBE_TS -1
#endif
#ifndef PROBE_SCALE
#define PROBE_SCALE 1e-4f
#endif
constexpr size_t CTL_TS = 65536;
constexpr size_t CTL_XQ = 32768;
constexpr size_t CTL_BAR = 4096;
static_assert(CTL_BAR + 3456 * 4 <= CTL_XQ && CTL_XQ + 8 * 256 <= CTL_TS && CTL_TS + 1024 + 1024 <= CTL_BYTES, "ctl");
constexpr size_t WS_WUQ = 1 * MiB, WS_WUKV = WS_WUQ + 1536 * 512 * 2, WS_WBA = WS_WUKV + 2048 * 256 * 2, WS_WBB = WS_WBA + 4 * MiB, WS_WOUT = WS_WBB + 4 * MiB, WS_WPQ = WS_WOUT + 8 * MiB;
static_assert(WS_WPQ + 8 * MiB <= 28 * MiB, "small weights");
constexpr size_t WS_C = 28 * MiB;
constexpr size_t WS_D = 66 * MiB;
constexpr size_t WS_E1 = 132 * MiB;
constexpr size_t WS_CQ = WS_E1, WS_CKV = WS_CQ + 16 * MiB, WS_KR = WS_CKV + (size_t)M1 * 256 * 2, WS_AB = WS_KR + (size_t)M1 * 64 * 4;
static_assert(WS_AB + (size_t)M1 * 32 * 4 <= 164 * MiB, "E1");
constexpr size_t WS_Z = 164 * MiB, WS_GA = 196 * MiB, WS_GB = 260 * MiB;
constexpr size_t WS_QKV = 324 * MiB;
constexpr size_t WS_K = 423 * MiB;
constexpr size_t WS_DNQ = 473 * MiB;
constexpr size_t WS_GBETA = 572 * MiB;
constexpr size_t WS_EG = 61 * MiB;
constexpr size_t CTL_MOD = 27 * MiB + 512 * 1024;
constexpr size_t CTL_SSQQ = 64 * MiB, CTL_SSQKV = CTL_SSQQ + (size_t)16384 * 8 * 4;
static_assert(CTL_SSQKV + (size_t)16896 * 4 * 4 <= 66 * MiB && CTL_MOD + 3 * 12288 * 4 <= 28 * MiB && WS_WPQ + 8 * MiB <= CTL_MOD, "mod/ssq");
constexpr size_t WS_XB = WS_D;
constexpr size_t WS_W = WS_QKV, WS_U = WS_QKV + 66 * MiB, WS_ATT = WS_C, WS_OF = WS_D, WS_OB = WS_D + 32 * MiB, WS_YA = WS_E1, WS_YB = WS_C;
constexpr size_t WS_MG = 324 * MiB, WS_H2 = 388 * MiB, WS_UB = 574 * MiB + 512 * 1024  , WS_VB = 484 * MiB, WS_USC = WS_UB + 32 * MiB, WS_VSC = 517 * MiB, WS_SC = 196 * MiB, WS_END = 607 * MiB;
static_assert(WS_EG + (size_t)4224 * 132 * 4 <= 64 * MiB && WS_USC + 16384 * 4 <= WS_END && WS_GBETA + (size_t)4 * M1 * 8 * 4 <= WS_UB && WS_K + (size_t)16 * LKV * 192 * 2 <= WS_DNQ && WS_DNQ + (size_t)M1 * 3072 * 2 <= WS_GBETA, "ws map");

__device__ __forceinline__ unsigned f2bf(float f) { unsigned u = __builtin_bit_cast(unsigned, f); return (u + 0x7fffu + ((u >> 16) & 1u)) >> 16; }
typedef float f32x2_c __attribute__((ext_vector_type(2))); typedef __bf16 bf16x2_c __attribute__((ext_vector_type(2)));
__device__ __forceinline__ unsigned pk2(float lo, float hi) { f32x2_c v = {lo, hi}; bf16x2_c b = __builtin_convertvector(v, bf16x2_c); return __builtin_bit_cast(unsigned, b); }
__device__ __forceinline__ float bflo(unsigned w) { return __uint_as_float(w << 16); }
__device__ __forceinline__ float bfhi(unsigned w) { return __uint_as_float(w & 0xffff0000u); }
__device__ __forceinline__ float wave_sum(float v) {
#pragma unroll
    for (int o = 1; o < 64; o <<= 1) v += __shfl_xor(v, o);
    return v;
}
__device__ __forceinline__ float siluf(float v) { return v / (1.0f + __expf(-v)); }

struct Params {
    const float *x, *c, *ctx, *c_ctx, *w_mod, *b_mod, *norm1_w, *w_in, *qn_w, *kvn_w, *w_uq, *w_ukv, *conv_w, *a_log, *dt_bias, *dn_norm_w,
                *w_ba, *w_bb, *w_out, *norm2_w, *peer_wq, *sub_keys, *peer_u, *peer_v, *final_w;
    float* out; unsigned char* ws;
    int ph_lo, ph_hi;
};
#define XB_TMO      128
#define XB_XCNT(j)  (256  + 64 * (j))
#define XB_XSUB(j)  (1280 + 64 * (j))
#define XB_XGEN(j)  (2304 + 64 * (j))
#define XB_TOP      3328
#define XB_TOPGEN   3392
#define XCD_BAR_WORDS 3456
#define XB_SPIN_CAP (1u << 18)

__device__ __forceinline__ unsigned xb_ld(unsigned* p)              { return __hip_atomic_load(p, __ATOMIC_RELAXED, __HIP_MEMORY_SCOPE_AGENT); }
__device__ __forceinline__ unsigned xb_add(unsigned* p, unsigned v) { return __hip_atomic_fetch_add(p, v, __ATOMIC_RELAXED, __HIP_MEMORY_SCOPE_AGENT); }
__device__ __forceinline__ unsigned xb_xcc_id() { return (unsigned)__builtin_amdgcn_s_getreg((3 << 11) | 20) & 0xFu; }
#define XB_SPIN(cond, bar) do { unsigned _sp = 0; while (cond) { __builtin_amdgcn_s_sleep(1); \
    if ((++_sp & 255u) == 0u) { if (xb_ld(&(bar)[XB_TMO])) break; if (_sp > XB_SPIN_CAP) { atomicAdd(&(bar)[XB_TMO], 1u); break; } } } } while (0)

struct XcdBarrier {
    unsigned* bar; unsigned x;
    volatile LAS unsigned* st;
};

__device__ __forceinline__ XcdBarrier xcd_barrier_post(unsigned* bar, volatile LAS unsigned* st, int tid) {
    XcdBarrier b; b.bar = bar; b.x = xb_xcc_id(); b.st = st;
    if (tid == 0) (void)xb_add(&bar[XB_XCNT(b.x)], 1u);
    return b;
}
__device__ __forceinline__ void xcd_barrier_complete(unsigned* bar, unsigned x, unsigned& nloc, unsigned& nx) {
    const unsigned G = gridDim.x * gridDim.y * gridDim.z;
    unsigned sum, cnt, mine, sp = 0u;
    for (;;) {
        sum = 0u; cnt = 0u; mine = 0u;
#pragma unroll
        for (unsigned j = 0; j < 16; ++j) { const unsigned c = xb_ld(&bar[XB_XCNT(j)]); sum += c; cnt += (c > 0u) ? 1u : 0u; mine = (j == x) ? c : mine; }
        if (sum == G) break;
        __builtin_amdgcn_s_sleep(1);
        if ((++sp & 255u) == 0u) { if (xb_ld(&bar[XB_TMO])) break; if (sp > XB_SPIN_CAP) { atomicAdd(&bar[XB_TMO], 1u); break; } }
    }
    nloc = mine > 0u ? mine : 1u; nx = cnt > 0u ? cnt : 1u;
}

__device__ __forceinline__ void xcd_barrier(const XcdBarrier& b, int tid) {
    asm volatile("s_waitcnt vmcnt(0)" ::: "memory");
    __syncthreads();
    if (tid == 0) {
        unsigned* bar = b.bar;
        __builtin_amdgcn_s_waitcnt(0);
        unsigned nloc = b.st[0], nx = b.st[1];
        if (nloc == 0u) { xcd_barrier_complete(bar, b.x, nloc, nx); b.st[0] = nloc; b.st[1] = nx; }
        const unsigned old = xb_add(&bar[XB_XSUB(b.x)], 1u);
        const unsigned gen = old / nloc;
        if (old + 1u == (gen + 1u) * nloc) {
            __builtin_amdgcn_fence(__ATOMIC_RELEASE, "agent");
            asm volatile("s_waitcnt vmcnt(0)" ::: "memory");
            const unsigned og = xb_add(&bar[XB_TOP], 1u);
            const unsigned tg = og / nx;
            if (og + 1u == (tg + 1u) * nx) xb_add(&bar[XB_TOPGEN], 1u);
            else XB_SPIN(xb_ld(&bar[XB_TOPGEN]) == tg, bar);
            __builtin_amdgcn_fence(__ATOMIC_ACQUIRE, "agent");
            xb_add(&bar[XB_XGEN(b.x)], 1u);
            asm volatile("s_waitcnt vmcnt(0)" ::: "memory");
        } else {
            XB_SPIN(xb_ld(&bar[XB_XGEN(b.x)]) == gen, bar);
            __builtin_amdgcn_fence(__ATOMIC_ACQUIRE, "agent");
            asm volatile("s_waitcnt vmcnt(0)" ::: "memory");
        }
    }
    __syncthreads();
}
struct Ctx { LAS unsigned char* lds; int tid, lane, wave, vcu, G; };

__device__ __forceinline__ void p0_mod_item(const Params& p, const Ctx& C, int it) {
    LAS float* sl = (LAS float*)C.lds;
    LAS float* red = sl + 3 * 2048;
    for (int e = C.tid; e < 3 * 2048; e += NT_) { const int i = e >> 11, k = e & 2047; const float v = (i < 2) ? p.c[i * DM + k] : p.c_ctx[k]; sl[e] = siluf(v); }
    __syncthreads();
    typedef float f32x2_ __attribute__((ext_vector_type(2)));
    f32x2_ a0 = {0, 0}, a1 = {0, 0}, a2 = {0, 0};
    const int col = it * 128 + C.lane * 2, k0 = C.wave * 256;
    const float* wp = p.w_mod + (size_t)k0 * 12288 + col;
    for (int kb = 0; kb < 256; kb += 32) {
        f32x2_ wv[32];
#pragma unroll
        for (int k = 0; k < 32; ++k) wv[k] = *(const f32x2_*)(wp + (size_t)(kb + k) * 12288);
#pragma unroll
        for (int k = 0; k < 32; ++k) { a0 += wv[k] * sl[k0 + kb + k]; a1 += wv[k] * sl[2048 + k0 + kb + k]; a2 += wv[k] * sl[4096 + k0 + kb + k]; } }
    LAS float* rw = red + C.wave * 384 + C.lane * 2;
    rw[0] = a0[0]; rw[1] = a0[1]; rw[128] = a1[0]; rw[129] = a1[1]; rw[256] = a2[0]; rw[257] = a2[1];
    __syncthreads();
    if (C.tid < 384) { float s = p.b_mod[it * 128 + (C.tid & 127)];
#pragma unroll
        for (int w = 0; w < 8; ++w) s += red[w * 384 + C.tid];
        ((float*)(p.ws + CTL_MOD))[(C.tid >> 7) * 12288 + it * 128 + (C.tid & 127)] = s; }
    __syncthreads();
}
__device__ __forceinline__ void p0_wprime_item(const Params& p, const Ctx& C, int it) {
    LAS float* As = (LAS float*)C.lds;
    LAS float* Ss = As + 64 * 129;
    LAS unsigned short* Os = (LAS unsigned short*)(Ss + 128 * 129);
    const int hp = it >> 5, i0 = (it & 31) * 64, pp = hp & 1;
    for (int e = C.tid; e < 64 * 128; e += NT_) { const int i = e >> 7, d = e & 127; As[i * 129 + d] = p.peer_wq[(size_t)(i0 + i) * 2048 + hp * 128 + d]; }
    for (int e = C.tid; e < 128 * 128; e += NT_) { const int k = e >> 7, d = e & 127; Ss[k * 129 + d] = p.sub_keys[(size_t)(pp * 128 + k) * 128 + d]; }
    __syncthreads();
    const int l15 = C.lane & 15, lq = C.lane >> 4, tm = C.wave & 3;
#pragma unroll
    for (int q = 0; q < 4; ++q) { const int tn = (C.wave >> 2) * 4 + q;
        f32x4 acc = {0.f, 0.f, 0.f, 0.f};
        const LAS float* ap = As + (tm * 16 + l15) * 129 + lq; const LAS float* bp = Ss + (tn * 16 + l15) * 129 + lq;
#pragma unroll 8
        for (int kk = 0; kk < 32; ++kk) acc = __builtin_amdgcn_mfma_f32_16x16x4f32(ap[4 * kk], bp[4 * kk], acc, 0, 0, 0);
        LAS unsigned short* o = Os + (tn * 16 + l15) * 72 + tm * 16 + 4 * lq; const unsigned w0 = pk2(acc[0], acc[1]), w1 = pk2(acc[2], acc[3]);
        *(LAS v2u*)o = (v2u){w0, w1}; }
    __syncthreads();
    for (int e = C.tid; e < 128 * 8; e += NT_) { const int k = e >> 3, chn = e & 7;
        *(v4u*)((bf16_t*)(p.ws + WS_WPQ) + (size_t)(hp * 128 + k) * 2048 + i0 + chn * 8) = *(const LAS v4u*)(Os + k * 72 + chn * 8); }
    __syncthreads();
}
__device__ __forceinline__ void p0_transpose_item(const float* W, int K, int N, int k0, int n0, bf16_t* WT, int drow0, const float* kscale, LAS float* scr, int lane) {
#pragma unroll 8
    for (int i = 0; i < 32; ++i) { const int kk = 2 * i + (lane >> 5); float v = W[(size_t)(k0 + kk) * N + n0 + (lane & 31)]; if (kscale) v *= kscale[k0 + kk]; scr[kk * 33 + (lane & 31)] = v; }
    asm volatile("s_waitcnt lgkmcnt(0)" ::: "memory");
    const int c = lane & 7;
#pragma unroll
    for (int j = 0; j < 4; ++j) { const int n = (lane >> 3) + 8 * j; const LAS float* s = scr + (8 * c) * 33 + n;
        v4u o; o.x = pk2(s[0 * 33], s[1 * 33]); o.y = pk2(s[2 * 33], s[3 * 33]); o.z = pk2(s[4 * 33], s[5 * 33]); o.w = pk2(s[6 * 33], s[7 * 33]);
        *(v4u*)(WT + (size_t)(drow0 + n) * K + k0 + 8 * c) = o; }
    asm volatile("s_waitcnt lgkmcnt(0)" ::: "memory");
}
__device__ __forceinline__ int win_dest_row(int n0) {
    if (n0 < 768) return n0;
    if (n0 < 832) return 8960 + (n0 - 768);
    if (n0 < 3904) return 768 + (n0 - 832);
    if (n0 < 4928) return 3840 + (n0 - 3904);
    if (n0 < 4960) return 9024 + (n0 - 4928);
    if (n0 < 7008) return 4864 + (n0 - 4960);
    return 6912 + (n0 - 7008);
}
constexpr int P0_I_IN = 32 * 283, P0_I_UQ = 8 * 48, P0_I_UKV = 4 * 64, P0_I_BA = 16 * 64, P0_I_BB = 16 * 64, P0_I_OUT = 32 * 64;
constexpr int P0_NITEMS = P0_I_IN + P0_I_UQ + P0_I_UKV + P0_I_BA + P0_I_BB + P0_I_OUT;
constexpr int P0_SPLIT = 5800;
__device__ __forceinline__ void p0_copy_items(const Params& p, const Ctx& C, int it_lo, int it_hi, int it_lo2, int it_hi2, int part, int nparts) {
    LAS float* scr = (LAS float*)(C.lds + C.wave * 16384);
    const int gw = part * 8 + C.wave, NGW = nparts * 8;
    unsigned char* ws = p.ws;
    const int n1 = it_hi - it_lo, n2 = it_hi2 - it_lo2;
    for (int q = gw; q < n1 + n2; q += NGW) {
        const int it = (q < n1) ? it_lo + q : it_lo2 + (q - n1);
        int r = it;
        if (r < P0_I_IN) { const int kb = r / 283, nb = r % 283; p0_transpose_item(p.w_in, 2048, 9056, kb * 64, nb * 32, (bf16_t*)(ws + WS_C), win_dest_row(nb * 32), nullptr, scr, C.lane); continue; } r -= P0_I_IN;
        if (r < P0_I_UQ) { const int kb = r / 48, nb = r % 48, n0 = nb * 32, h = n0 / 192, j0 = n0 % 192; const int dr = (j0 < 128) ? (h * 128 + j0) : (1024 + h * 64 + (j0 - 128));
            p0_transpose_item(p.w_uq, 512, 1536, kb * 64, n0, (bf16_t*)(ws + WS_WUQ), dr, p.qn_w, scr, C.lane); continue; } r -= P0_I_UQ;
        if (r < P0_I_UKV) { const int kb = r / 64, nb = r % 64; p0_transpose_item(p.w_ukv, 256, 2048, kb * 64, nb * 32, (bf16_t*)(ws + WS_WUKV), nb * 32, p.kvn_w, scr, C.lane); continue; } r -= P0_I_UKV;
        if (r < P0_I_BA) { const int kb = r / 64, nb = r % 64; p0_transpose_item(p.w_ba, 1024, 2048, kb * 64, nb * 32, (bf16_t*)(ws + WS_WBA), nb * 32, nullptr, scr, C.lane); continue; } r -= P0_I_BA;
        if (r < P0_I_BB) { const int kb = r / 64, nb = r % 64; p0_transpose_item(p.w_bb, 1024, 2048, kb * 64, nb * 32, (bf16_t*)(ws + WS_WBB), nb * 32, nullptr, scr, C.lane); continue; } r -= P0_I_BB;
        { const int kb = r / 64, nb = r % 64; p0_transpose_item(p.w_out, 2048, 2048, kb * 64, nb * 32, (bf16_t*)(ws + WS_WOUT), nb * 32, nullptr, scr, C.lane); }
    }
}
#ifndef P0_MODCOPY
#define P0_MODCOPY 0
#endif
__device__ __forceinline__ void p0_prologue(const Params& p, const Ctx& C) {
    if (C.G == 256) {
        const int xl = C.vcu & 31, xg = C.vcu >> 5;
        if (xl < 12) { p0_mod_item(p, C, xg * 12 + xl); p0_copy_items(p, C, 0, P0_MODCOPY, 0, 0, xg * 12 + xl, 96); }
        else p0_copy_items(p, C, P0_MODCOPY, P0_NITEMS, 0, 0, xg * 20 + (xl - 12), 160);
    } else {
        for (int it = C.vcu; it < 96; it += C.G) p0_mod_item(p, C, it);
        for (int it = C.vcu; it < 512; it += C.G) p0_wprime_item(p, C, it);
        p0_copy_items(p, C, 0, P0_NITEMS, 0, 0, C.vcu, C.G);
    }
    { v4u* z = (v4u*)((bf16_t*)(p.ws + WS_C) + (size_t)9056 * 2048); const int n16 = 160 * 2048 * 2 / 16;
      for (int i = C.vcu * NT_ + C.tid; i < n16; i += C.G * NT_) z[i] = (v4u){0u, 0u, 0u, 0u}; }
}
__device__ __forceinline__ void mod_norm_rows_bf(const Ctx& C, const bf16_t* X, int nrows, const float* nw, const float* sh, const float* sc, bf16_t* O) {
    f32x4 a[8], s[8];
#pragma unroll
    for (int j = 0; j < 8; ++j) { const int c = 8 * C.lane + 512 * (j >> 1) + 4 * (j & 1); const f32x4 w = *(const f32x4*)(nw + c), q = *(const f32x4*)(sc + c); a[j] = w * (q + 1.0f); s[j] = *(const f32x4*)(sh + c); }
    const int gw = C.vcu * 8 + C.wave, NGW = C.G * 8;
    for (int r = gw; r < nrows; r += NGW) {
        const v4u* xr = (const v4u*)(X + (size_t)r * DM) + C.lane; v4u v[4]; float ss = 0.f;
#pragma unroll
        for (int j = 0; j < 4; ++j) v[j] = xr[64 * j];
        f32x4 f[8];
#pragma unroll
        for (int j = 0; j < 4; ++j) { f[2 * j] = (f32x4){bflo(v[j].x), bfhi(v[j].x), bflo(v[j].y), bfhi(v[j].y)}; f[2 * j + 1] = (f32x4){bflo(v[j].z), bfhi(v[j].z), bflo(v[j].w), bfhi(v[j].w)}; }
#pragma unroll
        for (int j = 0; j < 8; ++j) ss += (f[j].x * f[j].x + f[j].y * f[j].y) + (f[j].z * f[j].z + f[j].w * f[j].w);
        const float rstd = rsqrtf(wave_sum(ss) * (1.0f / DM) + EPS);
        v4u* o8 = (v4u*)(O + (size_t)r * DM) + C.lane;
#pragma unroll
        for (int j = 0; j < 4; ++j) { const f32x4 y0 = f[2 * j] * rstd * a[2 * j] + s[2 * j], y1 = f[2 * j + 1] * rstd * a[2 * j + 1] + s[2 * j + 1];
            v4u w; w.x = pk2(y0.x, y0.y); w.y = pk2(y0.z, y0.w); w.z = pk2(y1.x, y1.y); w.w = pk2(y1.z, y1.w); o8[64 * j] = w; }
    }
}
__device__ __forceinline__ void mod_norm_rows(const Ctx& C, const float* X, int nrows, const float* nw, const float* sh, const float* sc, bf16_t* O) {
    f32x4 a[8], s[8];
#pragma unroll
    for (int j = 0; j < 8; ++j) { const int c = 4 * C.lane + 256 * j; const f32x4 w = *(const f32x4*)(nw + c), q = *(const f32x4*)(sc + c); a[j] = w * (q + 1.0f); s[j] = *(const f32x4*)(sh + c); }
    const int gw = C.vcu * 8 + C.wave, NGW = C.G * 8;
    for (int r = gw; r < nrows; r += NGW) {
        const f32x4* xr = (const f32x4*)(X + (size_t)r * DM) + C.lane; f32x4 v[8]; float ss = 0.f;
#pragma unroll
        for (int j = 0; j < 8; ++j) { v[j] = xr[64 * j]; ss += (v[j].x * v[j].x + v[j].y * v[j].y) + (v[j].z * v[j].z + v[j].w * v[j].w); }
        const float rstd = rsqrtf(wave_sum(ss) * (1.0f / DM) + EPS);
        v2u* o8 = (v2u*)(O + (size_t)r * DM) + C.lane;
#pragma unroll
        for (int j = 0; j < 8; ++j) { const f32x4 y = v[j] * rstd * a[j] + s[j]; v2u w; w.x = pk2(y.x, y.y); w.y = pk2(y.z, y.w); o8[64 * j] = w; }
    }
}
__device__ __forceinline__ void p3_conv(const Params& p, const Ctx& C) {
    const bf16_t* QKV = (const bf16_t*)(p.ws + WS_QKV); bf16_t* DNQ = (bf16_t*)(p.ws + WS_DNQ);
    const int total = (M1 / 16) * 384;
    const int cvi = (C.G == 256) ? ((((C.vcu & 31) * 8 + (C.vcu >> 5)) + 240) & 255) : C.vcu;
    for (int it = cvi * NT_ + C.tid; it < total; it += C.G * NT_) {
        const int rb = it / 384, c8 = it % 384, ch = c8 * 8, r0 = rb * 16;
        int seg0, segn, t0;
        if (r0 < ML) { seg0 = r0 & ~8191; segn = SEQ; t0 = r0 & 8191; } else { seg0 = ML + ((r0 - ML) & ~255); segn = CTXL; t0 = (r0 - ML) & 255; }
        f32x4 wlo[5], whi[5];
#pragma unroll
        for (int j = 0; j < 5; ++j) { wlo[j] = *(const f32x4*)(p.conv_w + j * 3072 + ch); whi[j] = *(const f32x4*)(p.conv_w + j * 3072 + ch + 4); }
        const float qs = (ch < 1024) ? 0.08838834764831845f : 1.0f; const bool nrm = ch < 2048;
        v4u rowsv[20];
#pragma unroll
        for (int j = 0; j < 20; ++j) { const int tt = t0 + j - 2; rowsv[j] = (tt >= 0 && tt < segn) ? *(const v4u*)(QKV + (size_t)(seg0 + tt) * 3072 + ch) : (v4u){0u, 0u, 0u, 0u}; }
        asm volatile("" ::: "memory");
#pragma unroll
        for (int i = 0; i < 16; ++i) {
            v4u win[5];
#pragma unroll
            for (int j = 0; j < 5; ++j) win[j] = rowsv[i + j];
            float acc[8];
#pragma unroll
            for (int e = 0; e < 8; ++e) acc[e] = 0.f;
#pragma unroll
            for (int j = 0; j < 5; ++j) { const v4u xv = win[j];
                acc[0] += bflo(xv.x) * wlo[j].x; acc[1] += bfhi(xv.x) * wlo[j].y; acc[2] += bflo(xv.y) * wlo[j].z; acc[3] += bfhi(xv.y) * wlo[j].w;
                acc[4] += bflo(xv.z) * whi[j].x; acc[5] += bfhi(xv.z) * whi[j].y; acc[6] += bflo(xv.w) * whi[j].z; acc[7] += bfhi(xv.w) * whi[j].w; }
            float ss = 0.f;
#pragma unroll
            for (int e = 0; e < 8; ++e) { acc[e] = siluf(acc[e]); ss += acc[e] * acc[e]; }
            ss += __shfl_xor(ss, 1); ss += __shfl_xor(ss, 2); ss += __shfl_xor(ss, 4); ss += __shfl_xor(ss, 8);
            const float sc = nrm ? rsqrtf(ss + EPS) * qs : 1.0f;
            v4u w; w.x = pk2(acc[0] * sc, acc[1] * sc); w.y = pk2(acc[2] * sc, acc[3] * sc); w.z = pk2(acc[4] * sc, acc[5] * sc); w.w = pk2(acc[6] * sc, acc[7] * sc);
            *(v4u*)(DNQ + (size_t)(r0 + i) * 3072 + ch) = w;
        }
    }
}
__device__ __forceinline__ void p3_krope_gbeta(const Params& p, const Ctx& C) {
    const float* KR = (const float*)(p.ws + WS_KR); bf16_t* K = (bf16_t*)(p.ws + WS_K);
    for (int it = C.vcu * NT_ + C.tid; it < M1 * 4; it += C.G * NT_) {
        const int r = it >> 2, q = it & 3, half = q >> 1, part = q & 1;
        int b, l, t; bool lat = r < ML;
        if (lat) { b = r >> 13; t = r & 8191; l = CTXL + t; } else { b = (r - ML) >> 8; t = 0; l = (r - ML) & 255; }
        const float* x1p = KR + (size_t)r * 64 + half * 32; const float* x2p = x1p + 16;
        float o[16];
        if (lat) { const float pos = (float)(half == 0 ? (t >> 6) : (t & 63));
#pragma unroll
            for (int i = 0; i < 16; ++i) { const float invf = exp2f(-(float)i * (13.287712379549449f / 16.0f)); float sn, cs; pg8::fast_sincos(pos * invf, sn, cs);
                const float x1 = x1p[i], x2 = x2p[i]; o[i] = part == 0 ? (x1 * cs - x2 * sn) : (x1 * sn + x2 * cs); } }
        else {
#pragma unroll
            for (int i = 0; i < 16; ++i) o[i] = part == 0 ? x1p[i] : x2p[i]; }
        v4u w0, w1; w0.x = pk2(o[0], o[1]); w0.y = pk2(o[2], o[3]); w0.z = pk2(o[4], o[5]); w0.w = pk2(o[6], o[7]);
        w1.x = pk2(o[8], o[9]); w1.y = pk2(o[10], o[11]); w1.z = pk2(o[12], o[13]); w1.w = pk2(o[14], o[15]);
#pragma unroll
        for (int h = 0; h < 8; ++h) { bf16_t* dst = K + ((size_t)(b * 8 + h) * LKV + l) * 192 + 128 + half * 32 + part * 16; *(v4u*)dst = w0; *(v4u*)(dst + 8) = w1; }
    }
    const float* AB = (const float*)(p.ws + WS_AB); float* Gd = (float*)(p.ws + WS_GBETA); float* Bd = Gd + (size_t)2 * M1 * 8;
    for (int it = C.vcu * NT_ + C.tid; it < M1 * 16; it += C.G * NT_) {
        const int r = it >> 4, dh = it & 15, dir = dh >> 3, h = dh & 7;
        const float a = AB[(size_t)r * 32 + dir * 8 + h] + p.dt_bias[dir * 8 + h], bl = AB[(size_t)r * 32 + 16 + dir * 8 + h];
        const float sp = (a > 20.f) ? a : log1pf(__expf(a));
        Gd[((size_t)dir * M1 + r) * 8 + h] = -__expf(p.a_log[dir * 8 + h]) * sp;
        Bd[((size_t)dir * M1 + r) * 8 + h] = 1.0f / (1.0f + __expf(-bl));
    }
}
typedef short s16x4c __attribute__((ext_vector_type(4)));
constexpr int CP_LD = 136;
constexpr int CP_K = 0, CP_Q = CP_K + 64 * CP_LD * 2, CP_V = CP_Q + 64 * CP_LD * 2, CP_VEC = CP_V + 64 * CP_LD * 2  , CP_MLO = CP_VEC + 640 * 4  ,
              CP_DG = CP_MLO + 2 * 64 * 72 * 2  , CP_DB = CP_DG + 2 * 4 * 16 * 17 * 4  , CP_ATS = CP_DB + 2 * 4 * 16 * 24 * 2  ,
              CP_XW = CP_ATS + 2 * 64 * 72 * 2  , CP_END = CP_XW + 8 * 16 * 72 * 2;
static_assert(CP_END <= 147456 - 64 && CP_MLO % 16 == 0 && CP_DB % 16 == 0 && CP_ATS % 16 == 0 && CP_XW % 16 == 0 && CP_DG % 16 == 0, "chunk-prep LDS");
__device__ __forceinline__ unsigned short bf1(float f) { return (unsigned short)(pk2(f, f) & 0xffffu); }
__device__ __forceinline__ void p5_chunk_prep(const Params& p, const Ctx& C) {
    const bf16_t* DNQ = (const bf16_t*)(p.ws + WS_DNQ); const float* Gd = (const float*)(p.ws + WS_GBETA); const float* Bd = Gd + (size_t)2 * M1 * 8;
    bf16_t* Wd = (bf16_t*)(p.ws + WS_W); bf16_t* Ud = (bf16_t*)(p.ws + WS_U); bf16_t* ATd = (bf16_t*)(p.ws + WS_ATT);
    float* EG = (float*)(p.ws + WS_EG); float* EKD = EG + (size_t)4224 * 64; float* EGL = EKD + (size_t)4224 * 64;
    LAS unsigned char* L = C.lds;
    LAS bf16_t* Ks = (LAS bf16_t*)(L + CP_K); LAS bf16_t* Qs = (LAS bf16_t*)(L + CP_Q); LAS bf16_t* Vs = (LAS bf16_t*)(L + CP_V);
    LAS float* Vec = (LAS float*)(L + CP_VEC); LAS bf16_t* MLO = (LAS bf16_t*)(L + CP_MLO); LAS float* DG = (LAS float*)(L + CP_DG); LAS bf16_t* DB = (LAS bf16_t*)(L + CP_DB);
    LAS bf16_t* ATS = (LAS bf16_t*)(L + CP_ATS); LAS bf16_t* XW = (LAS bf16_t*)(L + CP_XW) + C.wave * (16 * 72);
    const int tid = C.tid, lane = C.lane, wave = C.wave, l15 = lane & 15, lq = lane >> 4;
    unsigned long long p5acc = 0ull;
    v4u pre[6]; float pre_g = 0.f, pre_b = 0.f;
#define CP_ROW0(task_) ((((task_) % NCH) < 4) ? (ML + (((task_) / NCH) >> 3) * CTXL + ((task_) % NCH) * 64) : ((((task_) / NCH) >> 3) * SEQ + (((task_) % NCH) - 4) * 64))
#define CP_PREFETCH(task_) do { const int t_ = (task_); const int r0_ = CP_ROW0(t_), h_ = (t_ / NCH) & 7; \
        _Pragma("unroll") for (int q_ = 0; q_ < 6; ++q_) { const int e = tid + q_ * NT_, which = e >> 10, id = e & 1023, i = id >> 4, chn = id & 15; \
            pre[q_] = *(const v4u*)(DNQ + (size_t)(r0_ + i) * 3072 + which * 1024 + h_ * 128 + chn * 8); } \
        if (wave < 2) { const int pi_ = wave ? 63 - lane : lane; pre_g = Gd[((size_t)wave * M1 + r0_ + pi_) * 8 + h_]; pre_b = Bd[((size_t)wave * M1 + r0_ + pi_) * 8 + h_]; } } while (0)
    if (C.vcu < 16 * NCH) CP_PREFETCH(C.vcu);
    for (int task = C.vcu; task < 16 * NCH; task += C.G) {
        const int bh = task / NCH, tc = task % NCH, b = bh >> 3, h = bh & 7;
        const int row0 = (tc < 4) ? (ML + b * CTXL + tc * 64) : (b * SEQ + (tc - 4) * 64);
        const size_t cidx0 = (size_t)(bh * 2 + 0) * NCH + tc, cidx1 = (size_t)(bh * 2 + 1) * NCH + (tc < 4 ? 3 - tc : 135 - tc);
        unsigned long long q5_[5]; if (PROBE_TS >= 30 && PROBE_TS <= 33) q5_[0] = __builtin_amdgcn_s_memrealtime();
#pragma unroll
        for (int q_ = 0; q_ < 6; ++q_) { const int e = tid + q_ * NT_, which = e >> 10, id = e & 1023, i = id >> 4, chn = id & 15;
            LAS bf16_t* dst = (which == 0 ? Qs : (which == 1 ? Ks : Vs)) + i * CP_LD + chn * 8; *(LAS v4u*)dst = pre[q_]; }
        if (wave < 2) { const int dir = wave;
            const float g = pre_g, be = pre_b;
            float v = g;
#pragma unroll
            for (int o = 1; o < 64; o <<= 1) { const float u = __shfl_up(v, o); if (lane >= o) v += u; }
            const float gl = __shfl(v, 63), eg = __expf(v);
            Vec[256 + dir * 64 + lane] = v; Vec[384 + dir * 128 + lane] = be; Vec[384 + dir * 128 + 64 + lane] = eg;
            const size_t cidx = dir ? cidx1 : cidx0;
            EG[cidx * 64 + lane] = eg; EKD[cidx * 64 + lane] = __expf(gl - v); if (lane == 0) EGL[cidx] = __expf(gl); }
        __syncthreads();
        if (PROBE_TS >= 30 && PROBE_TS <= 33) q5_[1] = __builtin_amdgcn_s_memrealtime();
        if (task + C.G < 16 * NCH) CP_PREFETCH(task + C.G);
        {
            float df[2][4], db[2][4], bef[2][4], beb[2][4];
#pragma unroll
            for (int t = 0; t < 2; ++t) { const int t16 = wave * 2 + t, tm = t16 >> 2, tn = t16 & 3;
                const int j = tn * 16 + l15, jb = 63 - j; const float gfj = Vec[256 + j], gbj = Vec[320 + jb];
#pragma unroll
                for (int rg = 0; rg < 4; ++rg) { const int i = tm * 16 + 4 * lq + rg, ib = 63 - i;
                    df[t][rg] = __expf(Vec[256 + i] - gfj); db[t][rg] = __expf(Vec[320 + ib] - gbj);
                    bef[t][rg] = Vec[384 + i]; beb[t][rg] = Vec[384 + 128 + ib]; } }
#pragma unroll
            for (int q = 0; q < 4; ++q) { const int t = q & 1, t16 = wave * 2 + t, tm = t16 >> 2, tn = t16 & 3; const bool isq = q >= 2;
                const LAS bf16_t* Ab = (isq ? Qs : Ks) + (tm * 16 + l15) * CP_LD + 8 * lq; const LAS bf16_t* Bb = Ks + (tn * 16 + l15) * CP_LD + 8 * lq;
                f32x4 acc = {0.f, 0.f, 0.f, 0.f};
#pragma unroll
                for (int kk = 0; kk < 4; ++kk) acc = __builtin_amdgcn_mfma_f32_16x16x32_bf16(*(const LAS bf16x8*)(Ab + kk * 32), *(const LAS bf16x8*)(Bb + kk * 32), acc, 0, 0, 0);
                const int j = tn * 16 + l15, jb = 63 - j;
#pragma unroll
                for (int rg = 0; rg < 4; ++rg) { const int i = tm * 16 + 4 * lq + rg, ib = 63 - i; const float a = acc[rg];
                    if (isq) { ATS[i * 72 + j] = bf1(i >= j ? a * df[t][rg] : 0.f); ATS[64 * 72 + ib * 72 + jb] = bf1(i <= j ? a * db[t][rg] : 0.f); }
                    else if (i > j) { const float m = bef[t][rg] * a * df[t][rg];
                        if (tm == tn) DG[(tm * 16 + (i & 15)) * 17 + (j & 15)] = m; else MLO[i * 72 + j] = bf1(-m); }
                    else if (i < j) { const float m = beb[t][rg] * a * db[t][rg];
                        if (tm == tn) DG[((4 + (3 - tm)) * 16 + (ib & 15)) * 17 + (jb & 15)] = m; else MLO[64 * 72 + ib * 72 + jb] = bf1(-m); }
                }
            }
        }
        __syncthreads();
        if (PROBE_TS >= 30 && PROBE_TS <= 33) q5_[2] = __builtin_amdgcn_s_memrealtime();
        if (tid < 128) { const int blk = tid >> 4, cc = tid & 15; const LAS float* Mb = DG + blk * 16 * 17;
            float d[16];
#pragma unroll
            for (int r = 0; r < 16; ++r) { float v = (r == cc) ? 1.f : 0.f;
#pragma unroll
                for (int k = 0; k < r; ++k) v -= Mb[r * 17 + k] * d[k];
                d[r] = v; }
#pragma unroll
            for (int r = 0; r < 16; ++r) DB[(blk * 16 + r) * 24 + cc] = bf1(d[r]);
        } else { for (int e = tid - 128; e < 2 * 64 * 8; e += NT_ - 128) { const int dir = e >> 9, i = (e >> 3) & 63, chn = e & 7;
                *(v4u*)(ATd + (dir ? cidx1 : cidx0) * 4096 + i * 64 + chn * 8) = *(const LAS v4u*)(ATS + dir * (64 * 72) + i * 72 + chn * 8); } }
        __syncthreads();
        if (PROBE_TS >= 30 && PROBE_TS <= 33) q5_[3] = __builtin_amdgcn_s_memrealtime();
        {
            const int dir = wave >> 2, wq = wave & 3; const bool isw = wq >= 2; const int cb0 = (wq & 1) * 64;
            const LAS bf16_t* src = (isw ? Ks : Vs) + cb0 + l15; const LAS float* bsc = Vec + 384 + dir * 128;
            const LAS bf16_t* Mo = MLO + dir * (64 * 72); const LAS bf16_t* Dd = DB + dir * (4 * 16 * 24);
            s16x4c aoff[6], adg[4];
            { int q = 0;
#pragma unroll
              for (int bb = 1; bb < 4; ++bb)
#pragma unroll
                  for (int j = 0; j < bb; ++j) { aoff[q] = *(const LAS s16x4c*)(Mo + (bb * 16 + l15) * 72 + j * 16 + 4 * lq); ++q; }
#pragma unroll
              for (int bb = 0; bb < 4; ++bb) adg[bb] = *(const LAS s16x4c*)(Dd + (bb * 16 + l15) * 24 + 4 * lq); }
            s16x4c xp[4][4];
            bf16_t* gdst = (isw ? Wd : Ud) + (dir ? cidx1 : cidx0) * 8192 + cb0;
            s16x4c rv[4][4]; f32x4 sc[4];
            { const LAS bf16_t* tb = src - l15 + 4 * (l15 & 3);
#pragma unroll
              for (int bb = 0; bb < 4; ++bb) { const int i0 = bb * 16 + 4 * lq, ir = i0 + (l15 >> 2), pr = dir ? 63 - ir : ir;
                const f32x4 s1 = *(const LAS f32x4*)(bsc + i0), s2 = *(const LAS f32x4*)(bsc + 64 + i0);
#pragma unroll
                for (int rg = 0; rg < 4; ++rg) sc[bb][rg] = isw ? s1[rg] * s2[rg] : s1[rg];
#pragma unroll
                for (int ct = 0; ct < 4; ++ct) rv[bb][ct] = __builtin_amdgcn_ds_read_tr16_b64_v4i16((LAS s16x4c*)(tb + pr * CP_LD + ct * 16)); } }
            asm volatile("s_waitcnt lgkmcnt(0)" ::: "memory");
#pragma unroll
            for (int bb = 0; bb < 4; ++bb) {
#pragma unroll
                for (int ct = 0; ct < 4; ++ct) {
                    f32x4 acc;
#pragma unroll
                    for (int rg = 0; rg < 4; ++rg) acc[rg] = __uint_as_float(((unsigned)(unsigned short)rv[bb][ct][rg]) << 16) * sc[bb][rg];
#pragma unroll
                    for (int j = 0; j < bb; ++j) acc = __builtin_amdgcn_mfma_f32_16x16x16bf16_1k(aoff[bb * (bb - 1) / 2 + j], xp[ct][j], acc, 0, 0, 0);
                    const unsigned a01 = pk2(acc[0], acc[1]), a23 = pk2(acc[2], acc[3]);
                    const s16x4c accb = {(short)(a01 & 0xffff), (short)(a01 >> 16), (short)(a23 & 0xffff), (short)(a23 >> 16)};
                    const f32x4 x = __builtin_amdgcn_mfma_f32_16x16x16bf16_1k(adg[bb], accb, (f32x4){0.f, 0.f, 0.f, 0.f}, 0, 0, 0);
                    const unsigned x01 = pk2(x[0], x[1]), x23 = pk2(x[2], x[3]);
                    xp[ct][bb] = (s16x4c){(short)(x01 & 0xffff), (short)(x01 >> 16), (short)(x23 & 0xffff), (short)(x23 >> 16)};
                    LAS bf16_t* xw = XW + (4 * lq) * 72 + ct * 16 + l15;
                    xw[0] = (bf16_t)(x01 & 0xffff); xw[72] = (bf16_t)(x01 >> 16); xw[144] = (bf16_t)(x23 & 0xffff); xw[216] = (bf16_t)(x23 >> 16);
                }
                asm volatile("s_waitcnt lgkmcnt(0)" ::: "memory");
#pragma unroll
                for (int e2 = 0; e2 < 2; ++e2) { const int pc = lane + 64 * e2, r = pc >> 3, chn = pc & 7;
                    *(v4u*)(gdst + (size_t)(bb * 16 + r) * 128 + chn * 8) = *(const LAS v4u*)(XW + r * 72 + chn * 8); }
                asm volatile("s_waitcnt lgkmcnt(0)" ::: "memory");
            }
        }
        __syncthreads();
        if (PROBE_TS >= 30 && PROBE_TS <= 33) { q5_[4] = __builtin_amdgcn_s_memrealtime(); p5acc += q5_[PROBE_TS - 30 + 1] - q5_[PROBE_TS - 30]; }
    }
    if (PROBE_TS >= 30 && PROBE_TS <= 33 && tid == 0) ((float*)(p.ws + CTL_TS + 1024))[C.vcu] = (float)p5acc * 0.01f;
}
typedef short s16x4_ __attribute__((ext_vector_type(4))); typedef short v4i16_ __attribute__((ext_vector_type(4)));
constexpr int SC_WLD = 136, SC_TLD = 72;
constexpr int SB_W = 0, SB_Q = SB_W + 64 * SC_WLD * 2, SB_K = SB_Q + 64 * SC_WLD * 2, SB_ATT = SB_K + 64 * SC_WLD * 2, SB_U = SB_ATT + 64 * SC_TLD * 2, SB_EV = SB_U + 64 * 16 * 4  , SB_SIZE = SB_EV + 128 * 4;
constexpr int SC_SBT = 2 * SB_SIZE, SC_VNT = SC_SBT + 16 * SC_WLD * 2, SC_VNK = SC_VNT + 16 * SC_TLD * 2, SC_END = SC_VNK + 16 * SC_TLD * 2;
static_assert(SC_END <= 147456 - 64 && SB_SIZE % 16 == 0 && SB_Q % 16 == 0 && SB_ATT % 16 == 0 && SB_U % 16 == 0 && SB_EV % 16 == 0 && SC_SBT % 16 == 0 && SC_VNT % 16 == 0 && SC_VNK % 16 == 0, "scan LDS");
struct ScanRegs { v4u w0, w1, q0, q1, k0, k1, at, u; float ev, egl; };
struct ScanPtrs { const bf16_t *DNQ, *Wd, *Ud, *ATd; const float *EG, *EKD, *EGL; };
__device__ __forceinline__ int scan_base(int s, int b, int dir) { return dir == 0 ? ((s < 4) ? (ML + b * CTXL + s * 64) : (b * SEQ + (s - 4) * 64)) : ((s < 4) ? (ML + b * CTXL + (3 - s) * 64) : (b * SEQ + (131 - s) * 64)); }
__device__ __forceinline__ void scan_load(ScanRegs& R, const ScanPtrs& P, int s, int bhd, int b, int h, int dir, int n0, int tid) {
    const size_t cidx = (size_t)bhd * NCH + s; const int base = scan_base(s, b, dir);
    { const int i = tid >> 4, chn = tid & 15, row = base + (dir ? 63 - i : i);
      R.w0 = *(const v4u*)(P.Wd + cidx * 8192 + i * 128 + chn * 8); R.q0 = *(const v4u*)(P.DNQ + (size_t)row * 3072 + h * 128 + chn * 8); R.k0 = *(const v4u*)(P.DNQ + (size_t)row * 3072 + 1024 + h * 128 + chn * 8); }
    { const int i = 32 + (tid >> 4), chn = tid & 15, row = base + (dir ? 63 - i : i);
      R.w1 = *(const v4u*)(P.Wd + cidx * 8192 + i * 128 + chn * 8); R.q1 = *(const v4u*)(P.DNQ + (size_t)row * 3072 + h * 128 + chn * 8); R.k1 = *(const v4u*)(P.DNQ + (size_t)row * 3072 + 1024 + h * 128 + chn * 8); }
    R.at = *(const v4u*)(P.ATd + cidx * 4096 + (tid >> 3) * 64 + (tid & 7) * 8);
    if (tid < 128) { R.u = *(const v4u*)(P.Ud + cidx * 8192 + (tid >> 1) * 128 + n0 + (tid & 1) * 8); R.ev = (tid < 64) ? P.EG[cidx * 64 + tid] : P.EKD[cidx * 64 + tid - 64]; }
    R.egl = P.EGL[cidx];
}
__device__ __forceinline__ void scan_store(const ScanRegs& R, LAS unsigned char* B, int tid) {
    LAS bf16_t* Ws = (LAS bf16_t*)(B + SB_W); LAS bf16_t* Qs = (LAS bf16_t*)(B + SB_Q); LAS bf16_t* Ks = (LAS bf16_t*)(B + SB_K); LAS bf16_t* ATs = (LAS bf16_t*)(B + SB_ATT);
    const int chn = tid & 15;
    { const int i = tid >> 4; *(LAS v4u*)(Ws + i * SC_WLD + chn * 8) = R.w0; *(LAS v4u*)(Qs + i * SC_WLD + chn * 8) = R.q0; *(LAS v4u*)(Ks + i * SC_WLD + chn * 8) = R.k0; }
    { const int i = 32 + (tid >> 4); *(LAS v4u*)(Ws + i * SC_WLD + chn * 8) = R.w1; *(LAS v4u*)(Qs + i * SC_WLD + chn * 8) = R.q1; *(LAS v4u*)(Ks + i * SC_WLD + chn * 8) = R.k1; }
    *(LAS v4u*)(ATs + (tid >> 3) * SC_TLD + (tid & 7) * 8) = R.at;
    if (tid < 128) { LAS float* ud = (LAS float*)(B + SB_U) + (tid >> 1) * 16 + (tid & 1) * 8; *(LAS f32x4*)ud = (f32x4){bflo(R.u.x), bfhi(R.u.x), bflo(R.u.y), bfhi(R.u.y)}; *(LAS f32x4*)(ud + 4) = (f32x4){bflo(R.u.z), bfhi(R.u.z), bflo(R.u.w), bfhi(R.u.w)};
        ((LAS float*)(B + SB_EV))[tid] = R.ev; }
}
__device__ __forceinline__ void p6_scan(const Params& p, const Ctx& C) {
    ScanPtrs P; P.DNQ = (const bf16_t*)(p.ws + WS_DNQ); P.Wd = (const bf16_t*)(p.ws + WS_W); P.Ud = (const bf16_t*)(p.ws + WS_U); P.ATd = (const bf16_t*)(p.ws + WS_ATT);
    P.EG = (const float*)(p.ws + WS_EG); P.EKD = P.EG + (size_t)4224 * 64; P.EGL = P.EKD + (size_t)4224 * 64;
    LAS unsigned char* L = C.lds;
    LAS bf16_t* SBT = (LAS bf16_t*)(L + SC_SBT); LAS bf16_t* VNT = (LAS bf16_t*)(L + SC_VNT); LAS bf16_t* VNK = (LAS bf16_t*)(L + SC_VNK);
    const int tid = C.tid, lane = C.lane, wave = C.wave, l15 = lane & 15, lq = lane >> 4;
    for (int task = C.vcu; task < 256; task += C.G) {
        const int bhd = task >> 3, cb = task & 7, bh = bhd >> 1, dir = bhd & 1, b = bh >> 3, h = bh & 7, n0 = cb * 16;
        bf16_t* Od = (bf16_t*)(p.ws + (dir ? WS_OB : WS_OF));
        f32x4 S = {0.f, 0.f, 0.f, 0.f};
        for (int e = tid; e < 16 * SC_WLD / 2; e += NT_) ((LAS unsigned*)SBT)[e] = 0u;
        ScanRegs RA, RB; unsigned long long pt0 = 0ull, pacc = 0ull;
#ifdef SCAN_STAGGER
        { const unsigned long long ts0 = __builtin_amdgcn_s_memrealtime(); const unsigned long long lag = (unsigned long long)(cb * SCAN_STAGGER);
          while (__builtin_amdgcn_s_memrealtime() - ts0 < lag) __builtin_amdgcn_s_sleep(8); }
#endif
        scan_load(RA, P, 0, bhd, b, h, dir, n0, tid); scan_load(RB, P, 1, bhd, b, h, dir, n0, tid);
        scan_store(RA, L, tid); float egl_cur = RA.egl;
        scan_load(RA, P, 2, bhd, b, h, dir, n0, tid);
#define SCAN_STEP(RN, s_) do { const int s = (s_); const int base = scan_base(s, b, dir); LAS unsigned char* Bc = L + (s & 1) * SB_SIZE; LAS unsigned char* Bn = L + ((s + 1) & 1) * SB_SIZE; \
            __syncthreads();                                                          \
            if (PROBE_TS == 20 || PROBE_TS == 22) pt0 = __builtin_amdgcn_s_memrealtime(); if (PROBE_TS == 21 && pt0 != 0ull) pacc += __builtin_amdgcn_s_memrealtime() - pt0; \
            const float egl = egl_cur; \
            const int mt = wave & 3; f32x4 acc = {0.f, 0.f, 0.f, 0.f}; \
            { const LAS bf16_t* Ab = (LAS bf16_t*)(Bc + ((wave < 4) ? SB_W : SB_Q)) + (mt * 16 + l15) * SC_WLD + 8 * lq; const LAS bf16_t* Bb = SBT + l15 * SC_WLD + 8 * lq; \
              _Pragma("unroll") for (int kk = 0; kk < 4; ++kk) acc = __builtin_amdgcn_mfma_f32_16x16x32_bf16(*(const LAS bf16x8*)(Ab + kk * 32), *(const LAS bf16x8*)(Bb + kk * 32), acc, 0, 0, 0); } \
            if (wave < 4) { const int i0 = mt * 16 + 4 * lq; const LAS float* Us = (const LAS float*)(Bc + SB_U); const f32x4 ek = *(const LAS f32x4*)((const LAS float*)(Bc + SB_EV) + 64 + i0); \
                const float v0 = Us[(i0 + 0) * 16 + l15] - acc[0], v1 = Us[(i0 + 1) * 16 + l15] - acc[1], v2 = Us[(i0 + 2) * 16 + l15] - acc[2], v3 = Us[(i0 + 3) * 16 + l15] - acc[3]; \
                v2u w; w.x = pk2(v0, v1); w.y = pk2(v2, v3); *(LAS v2u*)(VNT + l15 * SC_TLD + i0) = w; \
                v2u wk; wk.x = pk2(v0 * ek[0], v1 * ek[1]); wk.y = pk2(v2 * ek[2], v3 * ek[3]); *(LAS v2u*)(VNK + l15 * SC_TLD + i0) = wk; } \
            else { const f32x4 eg = *(const LAS f32x4*)((const LAS float*)(Bc + SB_EV) + mt * 16 + 4 * lq); acc = acc * eg; } \
            if (PROBE_TS == 22) pacc += __builtin_amdgcn_s_memrealtime() - pt0; if (PROBE_TS == 23) pt0 = __builtin_amdgcn_s_memrealtime(); \
            if (s + 1 < NCH) { scan_store(RN, Bn, tid); egl_cur = RN.egl; asm volatile("s_waitcnt lgkmcnt(0)" ::: "memory"); if (PROBE_TS == 23) pacc += __builtin_amdgcn_s_memrealtime() - pt0; if (PROBE_TS == 24) pt0 = __builtin_amdgcn_s_memrealtime(); \
                if (s + 3 < NCH) scan_load(RN, P, s + 3, bhd, b, h, dir, n0, tid); if (PROBE_TS == 24) pacc += __builtin_amdgcn_s_memrealtime() - pt0; } \
            __syncthreads();                                                          \
            if (PROBE_TS == 20) pacc += __builtin_amdgcn_s_memrealtime() - pt0; if (PROBE_TS == 21) pt0 = __builtin_amdgcn_s_memrealtime(); \
            if (wave >= 4) { const LAS bf16_t* Ab = (LAS bf16_t*)(Bc + SB_ATT) + (mt * 16 + l15) * SC_TLD + 8 * lq; const LAS bf16_t* Bb = VNT + l15 * SC_TLD + 8 * lq; \
                _Pragma("unroll") for (int kk = 0; kk < 2; ++kk) acc = __builtin_amdgcn_mfma_f32_16x16x32_bf16(*(const LAS bf16x8*)(Ab + kk * 32), *(const LAS bf16x8*)(Bb + kk * 32), acc, 0, 0, 0); \
                if (s >= 4) { _Pragma("unroll") for (int rg = 0; rg < 4; ++rg) { const int i = mt * 16 + 4 * lq + rg; const int row = base + (dir ? 63 - i : i); \
                        Od[(size_t)row * 1024 + h * 128 + n0 + l15] = (bf16_t)f2bf(acc[rg]); } } } \
            { f32x4 sn = S * egl; const LAS bf16_t* Bb = VNK + l15 * SC_TLD + 8 * lq; \
              const LAS bf16_t* Ta = (LAS bf16_t*)(Bc + SB_K) + (8 * lq + (l15 >> 2)) * SC_WLD + wave * 16 + 4 * (l15 & 3); \
              _Pragma("unroll") for (int kk = 0; kk < 2; ++kk) { \
                  const s16x4_ t0 = __builtin_bit_cast(s16x4_, __builtin_amdgcn_ds_read_tr16_b64_v4i16((LAS v4i16_*)(Ta + (kk * 32) * SC_WLD))); \
                  const s16x4_ t1 = __builtin_bit_cast(s16x4_, __builtin_amdgcn_ds_read_tr16_b64_v4i16((LAS v4i16_*)(Ta + (kk * 32 + 4) * SC_WLD))); \
                  const bf16x8 af = (bf16x8){t0[0], t0[1], t0[2], t0[3], t1[0], t1[1], t1[2], t1[3]}; \
                  sn = __builtin_amdgcn_mfma_f32_16x16x32_bf16(af, *(const LAS bf16x8*)(Bb + kk * 32), sn, 0, 0, 0); } \
              S = sn; } \
            { v2u w; w.x = pk2(S[0], S[1]); w.y = pk2(S[2], S[3]); *(LAS v2u*)(SBT + l15 * SC_WLD + wave * 16 + 4 * lq) = w; } \
        } while (0)
        for (int s2 = 0; s2 < NCH; s2 += 2) { SCAN_STEP(RB, s2); SCAN_STEP(RA, s2 + 1); }
#undef SCAN_STEP
        if ((PROBE_TS >= 20 && PROBE_TS <= 24) && tid == 0) ((float*)(p.ws + CTL_TS + 1024))[C.vcu] = (float)pacc * 0.01f;
        __syncthreads();
    }
}
__device__ __forceinline__ void p7_yb(const Params& p, const Ctx& C) {
    const bf16_t* OF = (const bf16_t*)(p.ws + WS_OF); const bf16_t* OB = (const bf16_t*)(p.ws + WS_OB); const bf16_t* Z = (const bf16_t*)(p.ws + WS_Z); bf16_t* YB = (bf16_t*)(p.ws + WS_YB);
    const long total = (long)ML * 128;
    for (long it0 = (long)C.vcu * NT_ + C.tid; it0 < total; it0 += (long)C.G * NT_ * 4) {
        v4u a[4], bq[4], zz[4];
#pragma unroll
        for (int u = 0; u < 4; ++u) { const long itu = it0 + (long)u * C.G * NT_; const size_t off = (size_t)(itu < total ? itu : it0) * 8; a[u] = *(const v4u*)(OF + off); bq[u] = *(const v4u*)(OB + off); zz[u] = *(const v4u*)(Z + off); }
        asm volatile("" ::: "memory");
#pragma unroll
        for (int u = 0; u < 4; ++u) { const long itu = it0 + (long)u * C.G * NT_; const size_t off = (size_t)(itu < total ? itu : it0) * 8; const int d0 = (int)(off & 127);
            float o[8] = {bflo(a[u].x) + bflo(bq[u].x), bfhi(a[u].x) + bfhi(bq[u].x), bflo(a[u].y) + bflo(bq[u].y), bfhi(a[u].y) + bfhi(bq[u].y), bflo(a[u].z) + bflo(bq[u].z), bfhi(a[u].z) + bfhi(bq[u].z), bflo(a[u].w) + bflo(bq[u].w), bfhi(a[u].w) + bfhi(bq[u].w)};
            float zf[8] = {bflo(zz[u].x), bfhi(zz[u].x), bflo(zz[u].y), bfhi(zz[u].y), bflo(zz[u].z), bfhi(zz[u].z), bflo(zz[u].w), bfhi(zz[u].w)};
            float ss = 0.f;
#pragma unroll
            for (int e = 0; e < 8; ++e) ss += o[e] * o[e];
            ss += __shfl_xor(ss, 1); ss += __shfl_xor(ss, 2); ss += __shfl_xor(ss, 4); ss += __shfl_xor(ss, 8);
            const float rstd = rsqrtf(ss * (1.0f / 128.0f) + EPS);
            const f32x4 w0 = *(const f32x4*)(p.dn_norm_w + d0), w1 = *(const f32x4*)(p.dn_norm_w + d0 + 4);
            float y[8];
#pragma unroll
            for (int e = 0; e < 8; ++e) y[e] = o[e] * rstd * (e < 4 ? w0[e] : w1[e - 4]) * siluf(zf[e]);
            v4u w; w.x = pk2(y[0], y[1]); w.y = pk2(y[2], y[3]); w.z = pk2(y[4], y[5]); w.w = pk2(y[6], y[7]);
            *(v4u*)(YB + off) = w; }
    }
}
typedef float f32x2_t __attribute__((ext_vector_type(2)));
__device__ __forceinline__ float gelu_erf(float v) { return 0.5f * v * (1.0f + erff(v * 0.7071067811865476f)); }
__device__ __forceinline__ float dot8(v4u a, v4u b, float acc) {
    acc += bflo(a.x) * bflo(b.x); acc += bfhi(a.x) * bfhi(b.x); acc += bflo(a.y) * bflo(b.y); acc += bfhi(a.y) * bfhi(b.y);
    acc += bflo(a.z) * bflo(b.z); acc += bfhi(a.z) * bfhi(b.z); acc += bflo(a.w) * bflo(b.w); acc += bfhi(a.w) * bfhi(b.w); return acc;
}
__device__ __forceinline__ unsigned ord_u32(float f) { const unsigned u = __float_as_uint(f); return u ^ ((u >> 31) ? 0xffffffffu : 0x80000000u); }
#define INS16(k, x) do { unsigned x_ = (x); _Pragma("unroll") for (int i_ = 0; i_ < 16; ++i_) { const unsigned lo_ = min(k[i_], x_); k[i_] = max(k[i_], x_); x_ = lo_; } } while (0)
#define CE_DESC(k, a, b) do { const unsigned hi_ = max(k[a], k[b]), lo_ = min(k[a], k[b]); k[a] = hi_; k[b] = lo_; } while (0)
#define CE_ASC(k, a, b)  do { const unsigned hi_ = max(k[a], k[b]), lo_ = min(k[a], k[b]); k[a] = lo_; k[b] = hi_; } while (0)
__device__ __forceinline__ void sort16_desc(unsigned (&k)[16]) {
#pragma unroll
    for (int kk = 2; kk <= 16; kk <<= 1)
#pragma unroll
        for (int j = kk >> 1; j >= 1; j >>= 1)
#pragma unroll
            for (int i = 0; i < 16; ++i) { const int l = i ^ j; if (l > i) { if ((i & kk) == 0) CE_DESC(k, i, l); else CE_ASC(k, i, l); } }
}
__device__ __forceinline__ void merge_top16(unsigned (&a)[16], const unsigned (&b)[16]) {
#pragma unroll
    for (int i = 0; i < 16; ++i) a[i] = max(a[i], b[15 - i]);
#pragma unroll
    for (int j = 8; j >= 1; j >>= 1)
#pragma unroll
        for (int i = 0; i < 16; ++i) { const int l = i ^ j; if (l > i) CE_DESC(a, i, l); }
}
constexpr int P12_SC = 0, P12_TOPS = 128 * 129 * 4, P12_TOPI = P12_TOPS + 128 * 16 * 4, P12_IDX = P12_TOPI + 128 * 16 * 4  , P12_PW = P12_IDX + 64 * 128 * 2  , P12_END = P12_PW + 64 * 128 * 4;
static_assert(P12_END + 64 <= 147456 - 64 && P12_IDX % 16 == 0 && P12_PW % 16 == 0, "p12 lds");
__device__ __forceinline__ float octet_sum(float d) {
    d += __builtin_bit_cast(float, __builtin_amdgcn_update_dpp(0, __builtin_bit_cast(int, d), 0xB1, 0xF, 0xF, true));
    d += __builtin_bit_cast(float, __builtin_amdgcn_update_dpp(0, __builtin_bit_cast(int, d), 0x4E, 0xF, 0xF, true));
    d += __builtin_bit_cast(float, __builtin_amdgcn_update_dpp(0, __builtin_bit_cast(int, d), 0x141, 0xF, 0xF, true));
    return d;
}
__device__ __forceinline__ void p12_peer(const Params& p, const Ctx& C, const bool do_final) {
    const float* SCp = (const float*)(p.ws + WS_SC); const bf16_t* H2 = (const bf16_t*)(p.ws + WS_H2);
    const unsigned char* UB = (const unsigned char*)(p.ws + WS_UB); const unsigned char* VB = (const unsigned char*)(p.ws + WS_VB); const float* USC = (const float*)(p.ws + WS_USC); const float* VSC = (const float*)(p.ws + WS_VSC);
    const float* MOD = (const float*)(p.ws + CTL_MOD);
    LAS float* SCs = (LAS float*)(C.lds + P12_SC); LAS float* TOPS = (LAS float*)(C.lds + P12_TOPS); LAS int* TOPI = (LAS int*)(C.lds + P12_TOPI);
    LAS unsigned short* IDXs = (LAS unsigned short*)(C.lds + P12_IDX); LAS float* PWs = (LAS float*)(C.lds + P12_PW);
    const int lane = C.lane, tid = C.tid;
    const unsigned long long p12_t0 = (PROBE_TS == 12 || PROBE_TS == 13) ? __builtin_amdgcn_s_memrealtime() : 0ull; unsigned long long p12_tA = 0ull;
    LAS unsigned char* CTAB = (LAS unsigned char*)(C.lds + P12_END);
    if (tid < 64) { unsigned v = 0xffu;
        if (tid < 16) v = tid;
        else if (tid < 24) v = 16 + (tid - 16);
        else if (tid < 29) v = 32 + (tid - 24);
        else if (tid < 33) v = 48 + (tid - 29);
        else if (tid < 36) v = 64 + (tid - 33);
        else if (tid < 38) v = 80 + (tid - 36);
        else if (tid < 40) v = 96 + (tid - 38);
        else if (tid < 42) v = 112 + (tid - 40);
        else if (tid < 50) v = (8 + (tid - 42)) * 16;
        CTAB[tid] = (unsigned char)v; }
    __syncthreads();
    for (int blk = C.vcu; blk < ML / 64; blk += C.G) {
        for (int sub = 0; sub < 8; ++sub) {
            { const float* src = SCp + ((size_t)blk * 64 + sub * 8) * 2048;
#pragma unroll 4
              for (int e4 = tid; e4 < 8 * 2048 / 4; e4 += NT_) { const f32x4 v = *(const f32x4*)(src + e4 * 4); const int L = e4 >> 5, k = (e4 & 31) * 4; LAS float* d = SCs + L * 129 + k; d[0] = v.x; d[1] = v.y; d[2] = v.z; d[3] = v.w; } }
            __syncthreads();
            {
                const int L = tid >> 2, qd = tid & 3; const LAS float* s = SCs + L * 129 + qd * 32;
                unsigned k[16], t2[16];
#pragma unroll
                for (int i = 0; i < 16; ++i) k[i] = (ord_u32(s[i]) & ~127u) | (unsigned)(127 - (qd * 32 + i));
                sort16_desc(k);
#pragma unroll
                for (int i = 0; i < 16; ++i) t2[i] = (ord_u32(s[16 + i]) & ~127u) | (unsigned)(127 - (qd * 32 + 16 + i));
                sort16_desc(t2); merge_top16(k, t2);
#pragma unroll
                for (int i = 0; i < 16; ++i) t2[i] = __shfl_xor(k[i], 1);
                merge_top16(k, t2);
#pragma unroll
                for (int i = 0; i < 16; ++i) t2[i] = __shfl_xor(k[i], 2);
                merge_top16(k, t2);
                if (qd == 0) {
#pragma unroll
                    for (int i = 0; i < 16; ++i) { const int ki = 127 - (int)(k[i] & 127u); TOPI[L * 16 + i] = ki; TOPS[L * 16 + i] = SCs[L * 129 + ki]; } }
            }
            __syncthreads();
            if (tid < 256) {
                const int pr = tid >> 2, g4 = tid & 3, tt = pr >> 3, h = pr & 7, L0 = tt * 16 + h * 2, L1 = L0 + 1;
                unsigned k[16], t2[16];
#pragma unroll
                for (int i = 0; i < 16; ++i) { const unsigned ab = CTAB[g4 * 16 + i];
                    const float sv = TOPS[L0 * 16 + ((ab >> 4) & 15)] + TOPS[L1 * 16 + (ab & 15)];
                    k[i] = (ab == 0xffu) ? 0u : ((ord_u32(sv) & ~255u) | (255u - ab)); }
                sort16_desc(k);
#pragma unroll
                for (int i = 0; i < 16; ++i) t2[i] = __shfl_xor(k[i], 1);
                merge_top16(k, t2);
#pragma unroll
                for (int i = 0; i < 16; ++i) t2[i] = __shfl_xor(k[i], 2);
                merge_top16(k, t2);
                float bs[4]; const int orow = (sub * 8 + tt) * 128 + h * 16 + g4 * 4; float mx;
                { const int pos0 = 255 - (int)(k[0] & 255u); mx = TOPS[L0 * 16 + (pos0 >> 4)] + TOPS[L1 * 16 + (pos0 & 15)]; }
                float sm = 0.f;
#pragma unroll
                for (int i = 0; i < 4; ++i) { unsigned kv = k[0];
#pragma unroll
                    for (int j = 1; j < 16; ++j) kv = (g4 * 4 + i == j) ? k[j] : kv;
                    const int pos = 255 - (int)(kv & 255u), a = pos >> 4, b2 = pos & 15;
                    bs[i] = __expf(TOPS[L0 * 16 + a] + TOPS[L1 * 16 + b2] - mx); sm += bs[i];
                    IDXs[orow + i] = (unsigned short)(TOPI[L0 * 16 + a] * 128 + TOPI[L1 * 16 + b2]); }
                sm += __shfl_xor(sm, 1); sm += __shfl_xor(sm, 2);
                const float inv = 1.0f / sm;
#pragma unroll
                for (int i = 0; i < 4; ++i) PWs[orow + i] = bs[i] * inv;
            }
            __syncthreads();
        }
        int lane_b = lane; asm volatile("" : "+v"(lane_b));
        const int tl = C.wave * 8 + (lane_b >> 3), piece = lane_b & 7; const size_t t = (size_t)blk * 64 + tl;
        const LAS unsigned short* idxrow = IDXs + tl * 128; LAS float* pwrow = PWs + tl * 128;
        LAS float* actrow = (LAS float*)(C.lds + P12_SC) + tl * 128;
#pragma unroll
        for (int i = 0; i < 16; ++i) actrow[i * 8 + piece] = 0.f;
#define P12_LOAD(R, TAB, it_) do { const int itx = (it_); const v4u i8 = *(const LAS v4u*)(idxrow + (itx & 15) * 8); const unsigned off_ = (unsigned)((itx >> 4) * 128 + piece * 16); \
            _Pragma("unroll") for (int j = 0; j < 8; ++j) { const unsigned ex = (i8[j >> 1] >> (16 * (j & 1))) & 0xffffu; R[j] = *(const v4u*)(TAB + (ex * 2048u + off_)); } } while (0)
#define P12_HXLOAD(cb_) do { const bf16_t* hp = H2 + t * 2048 + (cb_) * 128 + piece * 16; hra = *(const v4u*)hp; hrb = *(const v4u*)(hp + 8); } while (0)
#define P12_BCOMP(R, it_) do { const int s8x = (it_) & 15; float mine = 0.f; \
            _Pragma("unroll") for (int j = 0; j < 8; ++j) { f32x2_t d2 = {0.f, 0.f}; \
                _Pragma("unroll") for (int w4 = 0; w4 < 4; ++w4) { const int wd = (int)R[j][w4]; const f32x2_t lo = __builtin_amdgcn_cvt_pk_f32_fp8(wd, false), hi2 = __builtin_amdgcn_cvt_pk_f32_fp8(wd, true); \
                    d2 += lo * hx2[2 * w4]; d2 += hi2 * hx2[2 * w4 + 1]; } \
                const float d = octet_sum(d2.x + d2.y); mine = (piece == j) ? d : mine; } \
            actrow[s8x * 8 + piece] += mine; } while (0)
        {
            v4u rA[8], rB[8], rC[8], rD[8], hra, hrb; f32x2_t hx2[8];
            P12_HXLOAD(0);
            P12_LOAD(rA, UB, 0); P12_LOAD(rB, UB, 1); P12_LOAD(rC, UB, 2); P12_LOAD(rD, UB, 3);
            for (int it = 0; it < 256; it += 4) {
                if ((it & 15) == 0) {
                    hx2[0] = (f32x2_t){bflo(hra.x), bfhi(hra.x)}; hx2[1] = (f32x2_t){bflo(hra.y), bfhi(hra.y)}; hx2[2] = (f32x2_t){bflo(hra.z), bfhi(hra.z)}; hx2[3] = (f32x2_t){bflo(hra.w), bfhi(hra.w)};
                    hx2[4] = (f32x2_t){bflo(hrb.x), bfhi(hrb.x)}; hx2[5] = (f32x2_t){bflo(hrb.y), bfhi(hrb.y)}; hx2[6] = (f32x2_t){bflo(hrb.z), bfhi(hrb.z)}; hx2[7] = (f32x2_t){bflo(hrb.w), bfhi(hrb.w)};
                    P12_HXLOAD(min((it >> 4) + 1, 15));
                }
                P12_BCOMP(rA, it);     P12_LOAD(rA, UB, min(it + 4, 255));
                P12_BCOMP(rB, it + 1); P12_LOAD(rB, UB, min(it + 5, 255));
                P12_BCOMP(rC, it + 2); P12_LOAD(rC, UB, min(it + 6, 255));
                P12_BCOMP(rD, it + 3); P12_LOAD(rD, UB, min(it + 7, 255));
            }
        }
#pragma unroll
        for (int s8 = 0; s8 < 16; ++s8) { const int sel = s8 * 8 + piece; const unsigned ex = idxrow[sel];
            pwrow[sel] = pwrow[sel] * gelu_erf(actrow[sel] * USC[ex]) * VSC[ex]; }
        asm volatile("s_waitcnt lgkmcnt(0)" ::: "memory");
        const int bsel = (int)(t >> 13); const float* g2 = MOD + bsel * 12288 + 10240;
        float* orow = p.out + t * 2048; float ssq = 0.f;
#define P12_CCOMP(R, it_) do { const int s8x = (it_) & 15; const f32x4 c0 = *(const LAS f32x4*)(pwrow + s8x * 8), c1 = *(const LAS f32x4*)(pwrow + s8x * 8 + 4); \
            _Pragma("unroll") for (int j = 0; j < 8; ++j) { const float c = (j < 4) ? c0[j & 3] : c1[j & 3]; const f32x2_t cc = {c, c}; \
                _Pragma("unroll") for (int w4 = 0; w4 < 4; ++w4) { const int wd = (int)R[j][w4]; const f32x2_t lo = __builtin_amdgcn_cvt_pk_f32_fp8(wd, false), hi2 = __builtin_amdgcn_cvt_pk_f32_fp8(wd, true); \
                    a2[2 * w4] += cc * lo; a2[2 * w4 + 1] += cc * hi2; } } } while (0)
        {
            v4u rA[8], rB[8], rC[8], rD[8]; f32x2_t a2[8];
            P12_LOAD(rA, VB, 0); P12_LOAD(rB, VB, 1); P12_LOAD(rC, VB, 2); P12_LOAD(rD, VB, 3);
            for (int it = 0; it < 256; it += 4) {
                if ((it & 15) == 0) {
#pragma unroll
                    for (int i = 0; i < 8; ++i) a2[i] = (f32x2_t){0.f, 0.f}; }
                P12_CCOMP(rA, it);     P12_LOAD(rA, VB, min(it + 4, 255));
                P12_CCOMP(rB, it + 1); P12_LOAD(rB, VB, min(it + 5, 255));
                P12_CCOMP(rC, it + 2); P12_LOAD(rC, VB, min(it + 6, 255));
                P12_CCOMP(rD, it + 3); P12_LOAD(rD, VB, min(it + 7, 255));
                if ((it & 15) == 12) {
                    if (do_final) {
                        const int c0i = (it >> 4) * 128 + piece * 16;
                        f32x4 xv4[4], gv4[4];
#pragma unroll
                        for (int q4 = 0; q4 < 4; ++q4) { xv4[q4] = *(const f32x4*)(orow + c0i + 4 * q4); gv4[q4] = *(const f32x4*)(g2 + c0i + 4 * q4); }
                        asm volatile("" ::: "memory");
#pragma unroll
                        for (int q4 = 0; q4 < 4; ++q4) { const f32x4 xv = xv4[q4], gv = gv4[q4];
                            f32x4 y; y[0] = xv[0] + gv[0] * a2[2 * q4].x; y[1] = xv[1] + gv[1] * a2[2 * q4].y; y[2] = xv[2] + gv[2] * a2[2 * q4 + 1].x; y[3] = xv[3] + gv[3] * a2[2 * q4 + 1].y;
                            ssq += (y[0] * y[0] + y[1] * y[1]) + (y[2] * y[2] + y[3] * y[3]);
                            *(f32x4*)(orow + c0i + 4 * q4) = y; }
                    } else { asm volatile("" :: "v"(a2[0]), "v"(a2[3]), "v"(a2[5]), "v"(a2[7])); }
                }
            }
        }
        if (PROBE_TS == 40) {
            if (tid == 0) { const unsigned long long t0 = __hip_atomic_load((unsigned long long*)(p.ws + CTL_TS), __ATOMIC_RELAXED, __HIP_MEMORY_SCOPE_AGENT);
                const unsigned dt = (unsigned)(__builtin_amdgcn_s_memrealtime() - t0); __hip_atomic_fetch_max((unsigned*)(p.ws + CTL_TS + 512), dt, __ATOMIC_RELAXED, __HIP_MEMORY_SCOPE_AGENT); }
            XcdBarrier b_; b_.bar = (unsigned*)(p.ws + CTL_BAR); b_.x = xb_xcc_id(); b_.st = (volatile LAS unsigned*)(C.lds + 147456 - 64); xcd_barrier(b_, tid);
        }
        if (do_final) {
            const float rstd = rsqrtf(octet_sum(ssq) * (1.0f / DM) + EPS);
            float probe_delta = 0.f;
            if (PROBE_TS == 40) probe_delta = (float)__hip_atomic_load((unsigned*)(p.ws + CTL_TS + 512), __ATOMIC_RELAXED, __HIP_MEMORY_SCOPE_AGENT) * 0.01f * PROBE_SCALE;
            else if ((PROBE_TS >= 20 && PROBE_TS <= 24) || (PROBE_TS >= 30 && PROBE_TS <= 33)) probe_delta = ((const float*)(p.ws + CTL_TS + 1024))[C.vcu] * PROBE_SCALE;
            else if (PROBE_TS == 14) { const unsigned long long t0 = __hip_atomic_load((unsigned long long*)(p.ws + CTL_TS), __ATOMIC_RELAXED, __HIP_MEMORY_SCOPE_AGENT); probe_delta = (float)(__builtin_amdgcn_s_memrealtime() - t0) * 0.01f * PROBE_SCALE; }
            else if (PROBE_TS == 12) probe_delta = (float)(__builtin_amdgcn_s_memrealtime() - p12_t0) * 0.01f * PROBE_SCALE;
            else if (PROBE_TS == 13) probe_delta = (float)(p12_tA - p12_t0) * 0.01f * PROBE_SCALE;
            else if (PROBE_TS >= 0) { unsigned long long* ts = (unsigned long long*)(p.ws + CTL_TS); const unsigned long long t1 = __hip_atomic_load(ts + PROBE_TS + 1, __ATOMIC_RELAXED, __HIP_MEMORY_SCOPE_AGENT), t0 = __hip_atomic_load(ts + PROBE_TS, __ATOMIC_RELAXED, __HIP_MEMORY_SCOPE_AGENT); probe_delta = (float)(t1 - t0) * 0.01f * PROBE_SCALE; }
#pragma unroll 2
            for (int cb = 0; cb < 16; cb += 2) {
                f32x4 yv[8], fv[8];
#pragma unroll
                for (int q8 = 0; q8 < 8; ++q8) { const int c0i = (cb + (q8 >> 2)) * 128 + piece * 16 + 4 * (q8 & 3); yv[q8] = *(const f32x4*)(orow + c0i); fv[q8] = *(const f32x4*)(p.final_w + c0i); }
                asm volatile("" ::: "memory");
#pragma unroll
                for (int q8 = 0; q8 < 8; ++q8) { const int c0i = (cb + (q8 >> 2)) * 128 + piece * 16 + 4 * (q8 & 3); *(f32x4*)(orow + c0i) = yv[q8] * rstd * fv[q8] + probe_delta; } }
        }
        __syncthreads();
    }
}
__device__ __forceinline__ void cvt_fp8_rows(const Ctx& C, const float* src, unsigned char* dst, float* scl, int nrows, int part, int nparts) {
    const int gw = part * 8 + C.wave, NGW = nparts * 8, lane = C.lane;
    f32x4 nx[8];
    if (gw < nrows) { const float* sp = src + (size_t)gw * 2048 + 16 * lane;
#pragma unroll
        for (int j = 0; j < 2; ++j)
#pragma unroll
            for (int q = 0; q < 4; ++q) nx[j * 4 + q] = *(const f32x4*)(sp + 1024 * j + 4 * q); }
    for (int r = gw; r < nrows; r += NGW) {
        f32x4 v[8]; float mx = 0.f;
#pragma unroll
        for (int i = 0; i < 8; ++i) { v[i] = nx[i]; const f32x4 a = v[i]; mx = fmaxf(mx, fmaxf(fmaxf(fabsf(a.x), fabsf(a.y)), fmaxf(fabsf(a.z), fabsf(a.w)))); }
        { const int rn = (r + NGW < nrows) ? r + NGW : r; const float* sp = src + (size_t)rn * 2048 + 16 * lane;
#pragma unroll
          for (int j = 0; j < 2; ++j)
#pragma unroll
              for (int q = 0; q < 4; ++q) nx[j * 4 + q] = *(const f32x4*)(sp + 1024 * j + 4 * q); }
        asm volatile("" ::: "memory");
#pragma unroll
        for (int o = 1; o < 64; o <<= 1) mx = fmaxf(mx, __shfl_xor(mx, o));
        mx = fmaxf(mx, 1e-30f); const float inv = 440.0f / mx;
        if (lane == 0) scl[r] = mx * (1.0f / 440.0f);
#pragma unroll
        for (int j = 0; j < 2; ++j) { v4u w;
#pragma unroll
            for (int q = 0; q < 4; ++q) { const f32x4 a = v[j * 4 + q] * inv; int wd = 0; wd = __builtin_amdgcn_cvt_pk_fp8_f32(a.x, a.y, wd, false); wd = __builtin_amdgcn_cvt_pk_fp8_f32(a.z, a.w, wd, true); w[q] = (unsigned)wd; }
            *(v4u*)(dst + (size_t)r * 2048 + 1024 * j + 16 * lane) = w; }
    }
}
__device__ __forceinline__ void cvt_rows(const Ctx& C, const float* src, bf16_t* dst, long n8) {
    for (long i = (long)C.vcu * NT_ + C.tid; i < n8; i += (long)C.G * NT_) { const f32x4 a = *(const f32x4*)(src + i * 8), b = *(const f32x4*)(src + i * 8 + 4);
        v4u w; w.x = pk2(a.x, a.y); w.y = pk2(a.z, a.w); w.z = pk2(b.x, b.y); w.w = pk2(b.z, b.w); *(v4u*)(dst + i * 8) = w; }
}
#ifdef PROBE_ATTN_ALPHA
#define PROBE_MGA(ws) ((bf16_t*)((ws) + 60 * MiB))
#else
#define PROBE_MGA(ws) ((bf16_t*)nullptr)
#endif
constexpr int LDS_BYTES = 147456;
constexpr int N_PHASES = 13;
constexpr int LDS_MISC = LDS_BYTES - 64;
__global__ void __launch_bounds__(NT_, 2) mega_fwd(Params p_arg) {
    extern __shared__ __attribute__((aligned(16))) unsigned char lds_raw[];
    const int wave_s = __builtin_amdgcn_readfirstlane((int)threadIdx.x >> 6);
    const int G_s = gridDim.x, bx_s = blockIdx.x;
    int vcu_s = (G_s % 8 == 0) ? (bx_s % 8) * (G_s / 8) + bx_s / 8 : bx_s;
    if (p_arg.ph_hi - p_arg.ph_lo > 1 && G_s == 256) {
        if (threadIdx.x == 0) { unsigned* xq = (unsigned*)(p_arg.ws + CTL_XQ); const unsigned x0 = xb_xcc_id() & 7u; int v = -1;
            for (unsigned q = 0; q < 8 && v < 0; ++q) { const unsigned xx = (x0 + q) & 7u; const unsigned t = __hip_atomic_fetch_add(xq + 64 * xx, 1u, __ATOMIC_RELAXED, __HIP_MEMORY_SCOPE_AGENT); if (t < 32u) v = (int)(xx * 32u + t); }
            ((volatile LAS int*)(lds_raw + LDS_MISC))[4] = v < 0 ? vcu_s : v; }
        __syncthreads();
        vcu_s = __builtin_amdgcn_readfirstlane(((volatile LAS int*)(lds_raw + LDS_MISC))[4]);
        __syncthreads();
    }
#define MKCTX() Ctx C; { unsigned m_ = ~0u; asm volatile("" : "+s"(m_)); C.lane = (int)__builtin_amdgcn_mbcnt_hi(m_, __builtin_amdgcn_mbcnt_lo(m_, 0u)); } \
    C.lds = (LAS unsigned char*)lds_raw; C.wave = wave_s; C.tid = wave_s * 64 + C.lane; C.G = G_s; C.vcu = vcu_s
    const int lo = p_arg.ph_lo, hi = p_arg.ph_hi;
#if defined(__HIP_DEVICE_COMPILE__)
#define LOADP() MKCTX(); typedef const __attribute__((address_space(4))) Params* CPP_; CPP_ kp_ = (CPP_)__builtin_amdgcn_kernarg_segment_ptr(); asm volatile("" : "+s"(kp_)); const Params p = *kp_; \
    unsigned char* ws = p.ws; const float* MOD = (const float*)(ws + CTL_MOD); (void)MOD
#else
#define LOADP() MKCTX(); const Params p = p_arg; unsigned char* ws = p.ws; const float* MOD = (const float*)(ws + CTL_MOD); (void)MOD
#endif
#ifndef PH_MASK
#define PH_MASK 0xffff
#endif
#define IN(k) (((PH_MASK >> (k)) & 1) && lo <= (k) && (k) < hi)
#ifndef P3DUP
#define P3DUP 0
#endif
#ifndef PROBE_REP
#define PROBE_REP -1
#endif
#define NREP(k) ((PROBE_REP == (k)) ? 2 : 1)
#define BAR_() do { LOADP(); XcdBarrier b_; b_.bar = (unsigned*)(ws + CTL_BAR); b_.x = xb_xcc_id(); b_.st = (volatile LAS unsigned*)(C.lds + LDS_MISC); xcd_barrier(b_, C.tid); } while (0)
#if defined(__HIP_DEVICE_COMPILE__)
#define TSTAMP(idx) do { if (PROBE_TS >= 0 && vcu_s == 0 && wave_s == 0) { if (__builtin_amdgcn_mbcnt_hi(~0u, __builtin_amdgcn_mbcnt_lo(~0u, 0u)) == 0u) { \
        typedef const __attribute__((address_space(4))) Params* CPT_; unsigned char* w_ = ((CPT_)__builtin_amdgcn_kernarg_segment_ptr())->ws; __hip_atomic_store((unsigned long long*)(w_ + CTL_TS) + (idx), (unsigned long long)__builtin_amdgcn_s_memrealtime(), __ATOMIC_RELAXED, __HIP_MEMORY_SCOPE_AGENT); } } } while (0)
#else
#define TSTAMP(idx) do { } while (0)
#endif
#define SEAM(k) do { if (IN(k) && IN((k) + 1)) { LOADP(); XcdBarrier b_; b_.bar = (unsigned*)(ws + CTL_BAR); b_.x = xb_xcc_id(); b_.st = (volatile LAS unsigned*)(C.lds + LDS_MISC); xcd_barrier(b_, C.tid); } TSTAMP((k) + 1); } while (0)
    if (hi - lo > 1) { LOADP(); if (C.tid < 2) ((volatile LAS unsigned*)(C.lds + LDS_MISC))[C.tid] = 0u; __syncthreads();
        (void)xcd_barrier_post((unsigned*)(ws + CTL_BAR), (volatile LAS unsigned*)(C.lds + LDS_MISC), C.tid); }
    TSTAMP(0);
    for (int rep_ = 0; rep_ < NREP(0); ++rep_) if (IN(0)) { if (rep_) BAR_(); LOADP(); p0_prologue(p, C); } SEAM(0);
    for (int rep_ = 0; rep_ < NREP(1); ++rep_) if (IN(1)) { if (rep_) BAR_(); LOADP();
        bf16_t* H = (bf16_t*)(ws + WS_D);
        mod_norm_rows(C, p.x, SEQ, p.norm1_w, MOD, MOD + 2048, H);
        mod_norm_rows(C, p.x + (size_t)SEQ * DM, SEQ, p.norm1_w, MOD + 12288, MOD + 12288 + 2048, H + (size_t)SEQ * DM);
        mod_norm_rows(C, p.ctx, MC, p.norm1_w, MOD + 2 * 12288, MOD + 2 * 12288 + 2048, H + (size_t)ML * DM);
    } SEAM(1);
    for (int rep_ = 0; rep_ < NREP(2); ++rep_) if (IN(2)) { if (rep_) BAR_(); LOADP();
        pg8::Gemm g{(const bf16_t*)(ws + WS_D), (const bf16_t*)(ws + WS_C), M1, NIN_PAD, DM}; pg8::StaticOrder S; S.init(M1, NIN_PAD, C.G, (C.G == 256) ? ((C.vcu & 31) * 8 + (C.vcu >> 5)) : (int)blockIdx.x);
        pg8::EpiIn E{(bf16_t*)(ws + WS_CQ), (bf16_t*)(ws + WS_CKV), (bf16_t*)(ws + WS_QKV), (bf16_t*)(ws + WS_Z), (bf16_t*)(ws + WS_GA), (bf16_t*)(ws + WS_GB),
                     (float*)(ws + WS_KR), (float*)(ws + WS_AB), (float*)(ws + CTL_SSQQ), (float*)(ws + CTL_SSQKV)};
        pg8::gemm_phase<pg8::EpiIn, pg8::StaticOrder, true, true>(C.lds, g, S, E, C.tid);
        if (C.G == 256) { const int cv = (C.vcu & 31) * 8 + (C.vcu >> 5); if (cv >= 72) { cvt_fp8_rows(C, p.peer_u, ws + WS_UB, (float*)(ws + WS_USC), 16384, cv - 72, 184); __syncthreads(); for (int it = cv - 72; it < 512; it += 184) p0_wprime_item(p, C, it); } }
    } SEAM(2);
    for (int rep_ = 0; rep_ < NREP(3); ++rep_) if (IN(3)) { if (rep_) BAR_();
        for (int d_ = 0; d_ < (P3DUP == 1 ? 2 : 1); ++d_) { LOADP(); pg8::Gemm g{(const bf16_t*)(ws + WS_CQ), (const bf16_t*)(ws + WS_WUQ), ML, 1536, 512}; pg8::StaticOrder S; S.init(ML, 1536, C.G, (C.G == 256) ? ((C.vcu & 31) * 8 + (C.vcu >> 5)) : (int)blockIdx.x);
          pg8::EpiQ E{(bf16_t*)(ws + WS_D), (const float*)(ws + CTL_SSQQ), QSCALE};
          pg8::gemm_phase<pg8::EpiQ, pg8::StaticOrder, true, true>(C.lds, g, S, E, C.tid); }
        for (int d_ = 0; d_ < (P3DUP == 2 ? 2 : 1); ++d_) { LOADP(); pg8::Gemm g{(const bf16_t*)(ws + WS_CKV), (const bf16_t*)(ws + WS_WUKV), M1, 2048, 256}; pg8::KvOrder S; S.init(M1, 2048, C.G, (C.G == 256) ? ((C.vcu & 31) * 8 + (C.vcu >> 5)) : (int)blockIdx.x);
          pg8::EpiKV E{(bf16_t*)(ws + WS_K), (bf16_t*)(ws + WS_C), (const float*)(ws + CTL_SSQKV)};
          pg8::gemm_phase<pg8::EpiKV, pg8::KvOrder, true, true>(C.lds, g, S, E, C.tid); }
        for (int d_ = 0; d_ < (P3DUP == 3 ? 2 : 1); ++d_) { LOADP(); p3_conv(p, C); }
        for (int d_ = 0; d_ < (P3DUP == 4 ? 2 : 1); ++d_) { LOADP(); p3_krope_gbeta(p, C); }
    } SEAM(3);
    for (int rep_ = 0; rep_ < NREP(4); ++rep_) if (IN(4)) { if (rep_) BAR_(); LOADP();
        const bf16_t* Q = (const bf16_t*)(ws + WS_D); const bf16_t* K = (const bf16_t*)(ws + WS_K); const bf16_t* V = (const bf16_t*)(ws + WS_C); bf16_t* YA = (bf16_t*)(ws + WS_YA);
        for (int u = C.vcu; u < 512; u += C.G) { const int bh = u >> 5, qb = u & 31, b = bh >> 3, h = bh & 7;
            attn::attn_unit(Q + ((size_t)bh * SEQ + qb * 256) * 192, K + (size_t)bh * LKV * 192, V + (size_t)bh * LKV * 128,
                            YA + ((size_t)b * SEQ + qb * 256) * 1024 + h * 128, 1024, LKV, (char*)lds_raw, C.tid); }
    } SEAM(4);
    for (int rep_ = 0; rep_ < NREP(5); ++rep_) if (IN(5)) { if (rep_) BAR_(); LOADP(); p5_chunk_prep(p, C); } SEAM(5);
    for (int rep_ = 0; rep_ < NREP(6); ++rep_) if (IN(6)) { if (rep_) BAR_(); LOADP(); p6_scan(p, C); } SEAM(6);
    for (int rep_ = 0; rep_ < NREP(7); ++rep_) if (IN(7)) { if (rep_) BAR_(); LOADP(); p7_yb(p, C); } SEAM(7);
    for (int rep_ = 0; rep_ < NREP(8); ++rep_) if (IN(8)) { if (rep_) BAR_();
        { LOADP(); pg8::Gemm g{(const bf16_t*)(ws + WS_YA), (const bf16_t*)(ws + WS_WBA), ML, 2048, 1024, (const bf16_t*)(ws + WS_YB), (const bf16_t*)(ws + WS_WBB)};
          pg8::ChainOrder S; S.init(ML, 2048, C.G, (C.G == 256) ? ((C.vcu & 31) * 8 + (C.vcu >> 5)) : (int)blockIdx.x);
          pg8::EpiMerge2 E{(const bf16_t*)(ws + WS_GA), (const bf16_t*)(ws + WS_GB), (bf16_t*)(ws + WS_MG)};
          pg8::gemm_phase<pg8::EpiMerge2, pg8::ChainOrder, true, true>(C.lds, g, S, E, C.tid); }
    } SEAM(8);
    for (int rep_ = 0; rep_ < NREP(9); ++rep_) if (IN(9)) { if (rep_) BAR_(); LOADP();
        pg8::Gemm g{(const bf16_t*)(ws + WS_MG), (const bf16_t*)(ws + WS_WOUT), ML, 2048, 2048}; pg8::StaticOrder S; S.init(ML, 2048, C.G, (C.G == 256) ? ((C.vcu & 31) * 8 + (C.vcu >> 5)) : (int)blockIdx.x);
        pg8::EpiOut E{p.x, MOD + 4096, p.out};
        pg8::gemm_phase<pg8::EpiOut, pg8::StaticOrder, true, true>(C.lds, g, S, E, C.tid);
    } SEAM(9);
#ifdef PROBE_ATTN_ALPHA
    if (IN(9)) { BAR_(); LOADP();
        pg8::Gemm g{(const bf16_t*)(ws + 60 * MiB), (const bf16_t*)(ws + WS_WOUT), ML, 2048, 2048}; pg8::StaticOrder S; S.init(ML, 2048, C.G, (C.G == 256) ? ((C.vcu & 31) * 8 + (C.vcu >> 5)) : (int)blockIdx.x);
        pg8::EpiDelta E{MOD + 4096, (bf16_t*)(ws + 124 * MiB)};
        pg8::gemm_phase<pg8::EpiDelta, pg8::StaticOrder, true, true>(C.lds, g, S, E, C.tid);
    }
#endif
    for (int rep_ = 0; rep_ < NREP(10); ++rep_) if (IN(10)) { if (rep_) BAR_(); LOADP();
        bf16_t* H2 = (bf16_t*)(ws + WS_H2);
        mod_norm_rows(C, p.out, SEQ, p.norm2_w, MOD + 6144, MOD + 8192, H2);
        mod_norm_rows(C, p.out + (size_t)SEQ * DM, SEQ, p.norm2_w, MOD + 12288 + 6144, MOD + 12288 + 8192, H2 + (size_t)SEQ * DM);
        if (C.G != 256) cvt_fp8_rows(C, p.peer_u, ws + WS_UB, (float*)(ws + WS_USC), 16384, C.vcu, C.G);
        cvt_fp8_rows(C, p.peer_v, ws + WS_VB, (float*)(ws + WS_VSC), 16384, C.vcu, C.G);
    } SEAM(10);
    for (int rep_ = 0; rep_ < NREP(11); ++rep_) if (IN(11)) { if (rep_) BAR_(); LOADP();
        pg8::Gemm g{(const bf16_t*)(ws + WS_H2), (const bf16_t*)(ws + WS_WPQ), ML, 2048, 2048}; pg8::StaticOrder S; S.init(ML, 2048, C.G, (C.G == 256) ? ((C.vcu & 31) * 8 + (C.vcu >> 5)) : (int)blockIdx.x);
        pg8::EpiScore E{(float*)(ws + WS_SC)};
        pg8::gemm_phase<pg8::EpiScore, pg8::StaticOrder, true, true>(C.lds, g, S, E, C.tid);
    } SEAM(11);
    for (int rep_ = 0; rep_ < NREP(12); ++rep_) if (IN(12)) { if (rep_) BAR_(); LOADP(); p12_peer(p, C, rep_ == NREP(12) - 1); }
#undef IN
#undef SEAM
}

#ifndef MK_SINGLE
#define MK_SINGLE 1
#endif
extern "C" void kernel_launch(void* const* d_in, const int* in_sizes, int n_in, void* d_out, int out_size, void* d_ws, size_t ws_size, hipStream_t stream) {
    static int grid = 0;
    if (grid == 0) {
        if (n_in != 25 || out_size != ML * DM || ws_size < WS_END) { fprintf(stderr, "kernel_launch: unexpected shapes: n_in %d out %d ws %zu (need %zu)\n", n_in, out_size, ws_size, (size_t)WS_END); grid = -1; return; }
        int dev = 0, cus = 0, per_cu = 0;
        if (hipGetDevice(&dev) != hipSuccess || hipDeviceGetAttribute(&cus, hipDeviceAttributeMultiprocessorCount, dev) != hipSuccess) { grid = -1; return; }
        if (hipFuncSetAttribute((const void*)mega_fwd, hipFuncAttributeMaxDynamicSharedMemorySize, LDS_BYTES) != hipSuccess) { fprintf(stderr, "kernel_launch: hipFuncSetAttribute failed\n"); grid = -1; return; }
        if (hipOccupancyMaxActiveBlocksPerMultiprocessor(&per_cu, (const void*)mega_fwd, NT_, LDS_BYTES) != hipSuccess || per_cu < 1) { fprintf(stderr, "kernel_launch: occupancy query says %d\n", per_cu); per_cu = 1; }
        (void)hipGetLastError();
        grid = cus;
    }
    if (grid < 0) return;
    (void)hipMemsetAsync((char*)d_ws + WS_CTL, 0, CTL_BYTES, stream);
    Params p{};
    const float** pp = (const float**)&p;
    for (int i = 0; i < 25; ++i) pp[i] = (const float*)d_in[i];
    p.out = (float*)d_out; p.ws = (unsigned char*)d_ws;
#if MK_SINGLE
    p.ph_lo = 0; p.ph_hi = N_PHASES;
    hipLaunchKernelGGL(mega_fwd, dim3(grid), dim3(NT_), LDS_BYTES, stream, p);
#else
    for (int ph = 0; ph < N_PHASES; ++ph) { p.ph_lo = ph; p.ph_hi = ph + 1; hipLaunchKernelGGL(mega_fwd, dim3(grid), dim3(NT_), LDS_BYTES, stream, p); }
#endif
}
```
